# Optimizing an MI355X kernel written in HIP

```python
import jax, jax.numpy as jnp
from jax import lax
import numpy as np

D_MODEL = 1024
BATCH = 16
SEQ = 2048
DEPTH = 4

POOL_WIDTH = D_MODEL
N_POOL_GROUPS = 4
POOL_WINDOWS = (2, 4, 8, 16)
POOL_GROUP = POOL_WIDTH // N_POOL_GROUPS
RWKV_WIDTH = D_MODEL
HEAD_SIZE = 64
N_HEADS = RWKV_WIDTH // HEAD_SIZE
D_DECAY_LORA = 64
D_AAA_LORA = 64
D_MV_LORA = 32
N_BRANCHES = 2
NORM_EPS = 1e-6
LNX_EPS = 1e-5 * HEAD_SIZE
SHIFT_WIDTH = 3 * RWKV_WIDTH + D_DECAY_LORA + D_AAA_LORA
IN_SPLITS = (POOL_WIDTH, POOL_WIDTH, SHIFT_WIDTH, RWKV_WIDTH, N_BRANCHES * D_MODEL)
IN_WIDTH = 2 * POOL_WIDTH + SHIFT_WIDTH + RWKV_WIDTH + N_BRANCHES * D_MODEL

kernel_name = 'pool_rwkv7_gated_hybrid'


def rms_norm(x, g):
    xf = x.astype(jnp.float32)
    y = xf * lax.rsqrt(jnp.mean(xf * xf, axis=-1, keepdims=True) + NORM_EPS)
    return (y * g.astype(jnp.float32)).astype(x.dtype)


def split_cols(z, widths):
    points = [int(p) for p in np.cumsum(widths)[:-1]]
    return jnp.split(z, points, axis=-1)


def token_shift(z, mu):
    z_prev = jnp.pad(z, ((0, 0), (1, 0), (0, 0)))[:, :-1]
    return z + mu * (z_prev - z)


def pool_mixer(u, lin, scale):
    b, s, _ = u.shape
    groups = u.astype(jnp.float32).reshape(b, s, N_POOL_GROUPS, POOL_GROUP)
    csum = jnp.cumsum(groups, axis=1)
    pos = jnp.arange(1, s + 1, dtype=jnp.float32)
    pooled = []
    for gi, w in enumerate(POOL_WINDOWS):
        c = csum[:, :, gi]
        c_lag = jnp.pad(c, ((0, 0), (w, 0), (0, 0)))[:, :s]
        count = jnp.minimum(pos, float(w))[None, :, None]
        pooled.append((c - c_lag) / count)
    pooled = jnp.stack(pooled, axis=2)
    mixed = jnp.einsum('bsgc,gcd->bsgd', (pooled - groups).astype(u.dtype), lin)
    return mixed.reshape(b, s, POOL_WIDTH) * scale


def rwkv7_scan(r, decay, k, v, a_vec, b_vec):
    b, s, hh, n = r.shape
    xs = tuple(jnp.moveaxis(t, 1, 0) for t in (r, decay, k, v, a_vec, b_vec))
    state0 = jnp.zeros((b, hh, n, n), jnp.float32)

    def step(state, inp):
        r_t, w_t, k_t, v_t, a_t, b_t = inp
        sa = jnp.einsum('bhvk,bhk->bhv', state, a_t)
        state = (state * w_t[:, :, None, :] + sa[..., None] * b_t[:, :, None, :]
                 + v_t[..., None] * k_t[:, :, None, :])
        y_t = jnp.einsum('bhvk,bhk->bhv', state, r_t)
        return state, y_t

    _, ys = lax.scan(step, state0, xs)
    return jnp.moveaxis(ys, 0, 1)


def heads(z):
    b, s, _ = z.shape
    return z.astype(jnp.float32).reshape(b, s, N_HEADS, HEAD_SIZE)


def setup_inputs(seed: int = 0) -> dict:
    key = jax.random.key(seed)
    ks = jax.random.split(key, 24)
    nrm = lambda kk, shape, sc: sc * jax.random.normal(kk, shape, jnp.float32)
    x = nrm(ks[0], (BATCH, SEQ, D_MODEL), 1.0)
    norm_g = 1.0 + nrm(ks[1], (DEPTH, D_MODEL), 0.05)
    w_in = nrm(ks[2], (DEPTH, D_MODEL, IN_WIDTH), D_MODEL ** -0.5)
    pool_lin = nrm(ks[3], (DEPTH, N_POOL_GROUPS, POOL_GROUP, POOL_GROUP), POOL_GROUP ** -0.5)
    pool_scale = 1.0 + nrm(ks[4], (DEPTH, POOL_WIDTH), 0.1)
    w_pool_proj = nrm(ks[5], (DEPTH, POOL_WIDTH, D_MODEL), POOL_WIDTH ** -0.5)
    mu_shift = jax.random.uniform(ks[6], (DEPTH, SHIFT_WIDTH), jnp.float32)
    decay_w0 = jax.random.uniform(ks[7], (DEPTH, RWKV_WIDTH), jnp.float32, -6.0, -1.0)
    decay_w2 = nrm(ks[8], (DEPTH, D_DECAY_LORA, RWKV_WIDTH), 0.5 * D_DECAY_LORA ** -0.5)
    a0 = nrm(ks[9], (DEPTH, RWKV_WIDTH), 0.5)
    a2 = nrm(ks[10], (DEPTH, D_AAA_LORA, RWKV_WIDTH), 0.5 * D_AAA_LORA ** -0.5)
    vres_v0 = nrm(ks[11], (DEPTH - 1, RWKV_WIDTH), 0.5)
    vres_v1 = nrm(ks[12], (DEPTH - 1, RWKV_WIDTH, D_MV_LORA), RWKV_WIDTH ** -0.5)
    vres_v2 = nrm(ks[13], (DEPTH - 1, D_MV_LORA, RWKV_WIDTH), 0.5 * D_MV_LORA ** -0.5)
    k_k = 0.85 + nrm(ks[14], (DEPTH, RWKV_WIDTH), 0.05)
    k_a = 1.0 + nrm(ks[15], (DEPTH, RWKV_WIDTH), 0.05)
    r_k = nrm(ks[16], (DEPTH, N_HEADS, HEAD_SIZE), 0.1)
    lnx_w = 1.0 + nrm(ks[17], (DEPTH, RWKV_WIDTH), 0.05)
    lnx_b = nrm(ks[18], (DEPTH, RWKV_WIDTH), 0.01)
    w_rwkv_proj = nrm(ks[19], (DEPTH, RWKV_WIDTH, D_MODEL), RWKV_WIDTH ** -0.5)
    w_out = nrm(ks[20], (DEPTH, D_MODEL, D_MODEL), D_MODEL ** -0.5)
    final_g = 1.0 + nrm(ks[21], (D_MODEL,), 0.05)
    return {'x': x, 'norm_g': norm_g, 'w_in': w_in, 'pool_lin': pool_lin, 'pool_scale': pool_scale,
            'w_pool_proj': w_pool_proj, 'mu_shift': mu_shift, 'decay_w0': decay_w0, 'decay_w2': decay_w2,
            'a0': a0, 'a2': a2, 'vres_v0': vres_v0, 'vres_v1': vres_v1, 'vres_v2': vres_v2,
            'k_k': k_k, 'k_a': k_a, 'r_k': r_k, 'lnx_w': lnx_w, 'lnx_b': lnx_b,
            'w_rwkv_proj': w_rwkv_proj, 'w_out': w_out, 'final_g': final_g}


def reference(x, norm_g, w_in, pool_lin, pool_scale, w_pool_proj, mu_shift, decay_w0, decay_w2,
              a0, a2, vres_v0, vres_v1, vres_v2, k_k, k_a, r_k, lnx_w, lnx_b,
              w_rwkv_proj, w_out, final_g):
    b, s, _ = x.shape
    v_first = None
    for i in range(DEPTH):
        h = rms_norm(x, norm_g[i])
        proj = jnp.einsum('bsd,de->bse', h, w_in[i])
        pool_in, pool_gate, rkvwa, rwkv_gate, merge_logits = split_cols(proj, IN_SPLITS)

        y_pool = pool_mixer(pool_in, pool_lin[i], pool_scale[i]) * jax.nn.silu(pool_gate)
        y_pool = jnp.einsum('bsp,pd->bsd', y_pool, w_pool_proj[i])

        rkvwa = token_shift(rkvwa, mu_shift[i])
        r, k, v, w_dn, a_dn = split_cols(
            rkvwa, (RWKV_WIDTH, RWKV_WIDTH, RWKV_WIDTH, D_DECAY_LORA, D_AAA_LORA))
        w_dn = w_dn.astype(jnp.float32)
        decay_logit = -jax.nn.softplus(-(decay_w0[i] + jnp.tanh(w_dn) @ decay_w2[i])) - 0.5
        decay = jnp.exp(-jnp.exp(decay_logit.astype(jnp.float32)))
        a = jax.nn.sigmoid((a0[i] + a_dn @ a2[i]).astype(jnp.float32))
        if i == 0:
            v_first = v
        else:
            mix = jax.nn.sigmoid(vres_v0[i - 1] + (v @ vres_v1[i - 1]) @ vres_v2[i - 1])
            v = v + (v_first - v) * mix
        kk = heads(k * k_k[i])
        kk = kk / jnp.maximum(jnp.linalg.norm(kk, axis=-1, keepdims=True), 1e-12)
        k = k.astype(jnp.float32) * (1.0 + (a - 1.0) * k_a[i])
        rh, kh, vh, ah = heads(r), heads(k), heads(v), heads(a)
        y = rwkv7_scan(rh, heads(decay), kh, vh, -kk, kk * ah)
        mu = jnp.mean(y, axis=-1, keepdims=True)
        var = jnp.mean(jnp.square(y - mu), axis=-1, keepdims=True)
        y = (y - mu) * lax.rsqrt(var + LNX_EPS)
        y = y.reshape(b, s, RWKV_WIDTH) * lnx_w[i] + lnx_b[i]
        bonus = jnp.sum(rh * kh * r_k[i], axis=-1, keepdims=True) * vh
        y = (y + bonus.reshape(b, s, RWKV_WIDTH)).astype(x.dtype)
        y_rwkv = jnp.einsum('bsc,cd->bsd', y * jax.nn.silu(rwkv_gate), w_rwkv_proj[i])

        g_pool, g_rwkv = split_cols(merge_logits, (D_MODEL, D_MODEL))
        merged = jax.nn.sigmoid(g_pool) * y_pool + jax.nn.sigmoid(g_rwkv) * y_rwkv
        x = x + jnp.einsum('bsd,de->bse', merged, w_out[i])
    return rms_norm(x, final_g)
```

```cpp
#include <hip/hip_runtime.h>
#include <cstdio>
#include <cstdint>

#define LAS __attribute__((address_space(3)))
typedef unsigned short bf16_t;
typedef short bf16x8 __attribute__((ext_vector_type(8)));
typedef float f32x4 __attribute__((ext_vector_type(4)));
typedef float f32x2 __attribute__((ext_vector_type(2)));
typedef unsigned u32x4 __attribute__((ext_vector_type(4)));
typedef unsigned u32x2 __attribute__((ext_vector_type(2)));

#ifndef MK_PER_PHASE
#define MK_PER_PHASE 0
#endif

constexpr int M = 32768, D = 1024, SEQ = 2048, NLAYER = 4, INW = 8320, NHEAD = 16;
constexpr int RAWLD = 3328;
constexpr float NORM_EPS = 1e-6f, LNX_EPS = 64e-5f;

constexpr size_t MiB = 1u << 20;
constexpr size_t WS_CTL = 0, CTL_ZERO_BYTES = 16384;
constexpr size_t WS_WINT = 1 * MiB;
constexpr size_t WS_WPP = WS_WINT + (size_t)INW * D * 2;
constexpr size_t WS_WRP = WS_WPP + 2 * MiB;
constexpr size_t WS_WOUT = WS_WRP + 2 * MiB;
constexpr size_t WS_LINT = WS_WOUT + 2 * MiB;
constexpr size_t WS_EAT = WS_LINT + MiB / 2;
constexpr size_t WS_VFIRST = 25 * MiB;
constexpr size_t WS_RAW = 89 * MiB;
constexpr size_t WS_RAWB = 153 * MiB;
constexpr size_t WS_S1 = 297 * MiB, WS_S2 = 361 * MiB, WS_S3 = 425 * MiB;
constexpr size_t WS_TW = 489 * MiB;
constexpr size_t WS_END = 505 * MiB;
static_assert(WS_EAT + MiB <= WS_VFIRST, "weights fit");

#define XB_TMO      128
#define XB_XCNT(j)  (256  + 64 * (j))
#define XB_XSUB(j)  (1280 + 64 * (j))
#define XB_XGEN(j)  (2304 + 64 * (j))
#define XB_TOP      3328
#define XB_TOPGEN   3392
#define XCD_BAR_WORDS 3456
#define XB_SPIN_CAP (1u << 18)

__device__ __forceinline__ unsigned xb_ld(unsigned* p)              { return __hip_atomic_load(p, __ATOMIC_RELAXED, __HIP_MEMORY_SCOPE_AGENT); }
__device__ __forceinline__ unsigned xb_add(unsigned* p, unsigned v) { return __hip_atomic_fetch_add(p, v, __ATOMIC_RELAXED, __HIP_MEMORY_SCOPE_AGENT); }
__device__ __forceinline__ unsigned xb_xcc_id() { return (unsigned)__builtin_amdgcn_s_getreg((3 << 11) | 20) & 0xFu; }
#define XB_SPIN(cond, bar) do { unsigned _sp = 0; while (cond) { __builtin_amdgcn_s_sleep(1); \
    if ((++_sp & 255u) == 0u) { if (xb_ld(&(bar)[XB_TMO])) break; if (_sp > XB_SPIN_CAP) { atomicAdd(&(bar)[XB_TMO], 1u); break; } } } } while (0)

struct XcdBarrier { unsigned* bar; unsigned x; volatile LAS unsigned* st; };

__device__ __forceinline__ XcdBarrier xcd_barrier_post(unsigned* bar, volatile LAS unsigned* st) {
    XcdBarrier b; b.bar = bar; b.x = xb_xcc_id(); b.st = st;
    if (threadIdx.x == 0) (void)xb_add(&bar[XB_XCNT(b.x)], 1u);
    return b;
}
__device__ __forceinline__ void xcd_barrier_complete(unsigned* bar, unsigned x, unsigned& nloc, unsigned& nx) {
    const unsigned G = gridDim.x * gridDim.y * gridDim.z;
    unsigned sum, cnt, mine, sp = 0u;
    for (;;) {
        sum = 0u; cnt = 0u; mine = 0u;
#pragma unroll
        for (unsigned j = 0; j < 16; ++j) { const unsigned c = xb_ld(&bar[XB_XCNT(j)]); sum += c; cnt += (c > 0u) ? 1u : 0u; }
        if (sum == G) { mine = xb_ld(&bar[XB_XCNT(x)]); break; }
        __builtin_amdgcn_s_sleep(1);
        if ((++sp & 255u) == 0u) { if (xb_ld(&bar[XB_TMO])) { mine = xb_ld(&bar[XB_XCNT(x)]); break; } if (sp > XB_SPIN_CAP) { atomicAdd(&bar[XB_TMO], 1u); mine = xb_ld(&bar[XB_XCNT(x)]); break; } }
    }
    nloc = mine > 0u ? mine : 1u; nx = cnt > 0u ? cnt : 1u;
}
__device__ __forceinline__ void xcd_barrier(const XcdBarrier& b) {
    asm volatile("s_waitcnt vmcnt(0)" ::: "memory");
    __syncthreads();
    if (threadIdx.x == 0) {
        unsigned* bar = b.bar; asm volatile("" : "+s"(bar));
        __builtin_amdgcn_s_waitcnt(0);
        unsigned nloc = b.st[0], nx = b.st[1];
        if (nloc == 0u) { xcd_barrier_complete(bar, b.x, nloc, nx); b.st[0] = nloc; b.st[1] = nx; }
        const unsigned old = xb_add(&bar[XB_XSUB(b.x)], 1u);
        const unsigned gen = old / nloc;
        if (old + 1u == (gen + 1u) * nloc) {
            __builtin_amdgcn_fence(__ATOMIC_RELEASE, "agent");
            asm volatile("s_waitcnt vmcnt(0)" ::: "memory");
            const unsigned og = xb_add(&bar[XB_TOP], 1u);
            const unsigned tg = og / nx;
            if (og + 1u == (tg + 1u) * nx) xb_add(&bar[XB_TOPGEN], 1u);
            else XB_SPIN(xb_ld(&bar[XB_TOPGEN]) == tg, bar);
            __builtin_amdgcn_fence(__ATOMIC_ACQUIRE, "agent");
            xb_add(&bar[XB_XGEN(b.x)], 1u);
            asm volatile("s_waitcnt vmcnt(0)" ::: "memory");
        } else {
            XB_SPIN(xb_ld(&bar[XB_XGEN(b.x)]) == gen, bar);
            __builtin_amdgcn_fence(__ATOMIC_ACQUIRE, "agent");
            asm volatile("s_waitcnt vmcnt(0)" ::: "memory");
        }
    }
    __syncthreads();
}

__device__ __forceinline__ float bf_lo(unsigned w) { return __uint_as_float(w << 16); }
__device__ __forceinline__ float bf_hi(unsigned w) { return __uint_as_float(w & 0xffff0000u); }
typedef __bf16 bf16x2_t __attribute__((ext_vector_type(2)));
__device__ __forceinline__ unsigned pk_bf16(float lo, float hi) { bf16x2_t v; v[0] = (__bf16)lo; v[1] = (__bf16)hi; return __builtin_bit_cast(unsigned, v); }
__device__ __forceinline__ float sigmoidf_(float x) { return __builtin_amdgcn_rcpf(1.0f + __expf(-x)); }
__device__ __forceinline__ float tanhf_(float x) { return 1.0f - 2.0f * __builtin_amdgcn_rcpf(1.0f + __expf(2.0f * x)); }
template <int CTRL> __device__ __forceinline__ float dppf(float x) { return __int_as_float(__builtin_amdgcn_update_dpp(0, __float_as_int(x), CTRL, 0xf, 0xf, true)); }
__device__ __forceinline__ float red8(float x) {
    x += dppf<0xB1>(x);
    x += dppf<0x4E>(x);
    x += dppf<0x141>(x);
    return x;
}
__device__ __forceinline__ float red16(float x) {
    x += dppf<0xB1>(x);
    x += dppf<0x4E>(x);
    x += dppf<0x141>(x);
    x += dppf<0x140>(x);
    return x;
}
__device__ __forceinline__ float red64(float x) {
    x = red16(x);
    return __int_as_float(__builtin_amdgcn_readlane(__float_as_int(x), 0)) + __int_as_float(__builtin_amdgcn_readlane(__float_as_int(x), 16)) +
           __int_as_float(__builtin_amdgcn_readlane(__float_as_int(x), 32)) + __int_as_float(__builtin_amdgcn_readlane(__float_as_int(x), 48));
}

namespace pg8 {
constexpr int BM = 256, BK = 64, HALF = 128, HTB = HALF * BK * 2, STAGE_BYTES = 8 * HTB, NXCD = 8, WGM = 8;
__host__ __device__ __forceinline__ int lds_byte(int r, int c) { const int st = (r >> 4) * 2 + (c >> 5), rr = r & 15, cc = c & 31, ob = rr * 64 + cc * 2; return st * 1024 + (ob ^ (((ob >> 9) & 1) << 5)); }
__host__ __device__ __forceinline__ void stage_rc(int b, int& R, int& C) { const int st = b / 1024, sb = b % 1024, swz = sb ^ (((sb >> 9) & 1) << 5); R = (st >> 1) * 16 + swz / 64; C = (st & 1) * 32 + (swz % 64) / 2; }
__host__ __device__ __forceinline__ int perm32(int rho) { const int n = rho >> 4, i = rho & 15; return 8 * (i >> 2) + 4 * n + (i & 3); }

struct Unit { int pm, pn; };
struct Gemm { const bf16_t* A; const bf16_t* Bt; int lda, ldb, K, nM, nN, a_pn_bytes; };

struct StaticOrder {
    int nM, nN, nwg, G, c;
    __device__ void init(int nM_, int nN_, int G_, int c_) { nM = nM_; nN = nN_; nwg = nM * nN; G = G_; c = c_; }
    __device__ bool next(int i, Unit& u) const {
        const long L = (long)i * G + c; if (L >= nwg) return false;
        int wgid = (int)L; { const int q = nwg / NXCD, r = nwg % NXCD, xcd = wgid % NXCD, off = wgid / NXCD; wgid = (xcd < r ? xcd * (q + 1) : r * (q + 1) + (xcd - r) * q) + off; }
        const int nig = WGM * nN, gid = wgid / nig, fm = gid * WGM, gsz = (nM - fm) < WGM ? (nM - fm) : WGM;
        u.pm = fm + ((wgid % nig) % gsz); u.pn = (wgid % nig) / gsz; return true;
    }
};

template <class Epi, bool ALIGN_EPI = true, bool SP2 = true>
__device__ __forceinline__ void gemm_phase(LAS unsigned char* lds, const Gemm g, const StaticOrder& S, const Epi& E) {
    int tid_ = threadIdx.x; asm volatile("" : "+v"(tid_));
    const int tid = tid_, wid = __builtin_amdgcn_readfirstlane(tid >> 6), lane = tid & 63, wr = wid >> 2, wc = wid & 3, fr = lane & 15, fq = lane >> 4;
    const int K = g.K, nt = K / BK;
    unsigned voffA[2], voffB[2];
#pragma unroll
    for (int i = 0; i < 2; ++i) { int R, C; stage_rc(tid * 16 + i * 8192, R, C); const int Rb = Epi::PERM ? ((R & ~31) + perm32(R & 31)) : R;
        voffA[i] = (unsigned)(R * g.lda + C) * 2u; voffB[i] = (unsigned)(Rb * g.ldb + C) * 2u; }
    const size_t kstep = (size_t)(BK * 2);
    const size_t hstepA = (size_t)HALF * g.lda * 2, hstepB = (size_t)HALF * g.ldb * 2;
    const size_t tstepA = 2 * hstepA, tstepB = 2 * hstepB;
    const unsigned ldsw = (unsigned)wid * 1024u;
    const int aoff = lds_byte(wr * 64 + fr, fq * 8), boff = lds_byte(wc * 32 + fr, fq * 8);
#define PG8_SA(b, h) (((b) * 2 + (h)) * HTB)
#define PG8_SB(b, h) ((4 + (b) * 2 + (h)) * HTB)
#define PG8_STAGE(bufoff, gbase, voff) do { _Pragma("unroll") for (int _i = 0; _i < 2; ++_i) \
        __builtin_amdgcn_global_load_lds((const unsigned*)((const char*)(gbase) + (voff)[_i]), (LAS unsigned*)(lds + (bufoff) + ldsw + _i * 8192), 16, 0, 0); } while (0)
#define PG8_LDA(dst, b, h) do { _Pragma("unroll") for (int m = 0; m < 4; ++m) _Pragma("unroll") for (int k = 0; k < 2; ++k) dst[m][k] = *(const LAS bf16x8*)(lds + PG8_SA(b, h) + aoff + m * 2048 + k * 1024); } while (0)
#define PG8_LDB(dst, b, h) do { _Pragma("unroll") for (int n = 0; n < 2; ++n) _Pragma("unroll") for (int k = 0; k < 2; ++k) dst[n][k] = *(const LAS bf16x8*)(lds + PG8_SB(b, h) + boff + n * 2048 + k * 1024); } while (0)
#define PG8_MMA(ai, bj, At, Bt) do { __builtin_amdgcn_s_setprio(1); _Pragma("unroll") for (int m = 0; m < 4; ++m) _Pragma("unroll") for (int n = 0; n < 2; ++n) _Pragma("unroll") for (int k = 0; k < 2; ++k) \
        acc[ai][bj][m][n] = __builtin_amdgcn_mfma_f32_16x16x32_bf16(Bt[n][k], At[m][k], acc[ai][bj][m][n], 0, 0, 0); __builtin_amdgcn_s_setprio(0); } while (0)
#define PG8_WAIT_V(n) asm volatile("s_waitcnt vmcnt(" #n ")" ::: "memory")
#define PG8_WAIT_L(n) asm volatile("s_waitcnt lgkmcnt(" #n ")" ::: "memory")
#define PG8_BAR __builtin_amdgcn_s_barrier()
#define PG8_SCHED __builtin_amdgcn_sched_barrier(0)
    Unit cur, nxt; int ui = 0;
    if (!S.next(0, cur)) return;
    f32x4 acc[2][2][4][2];
#pragma unroll
    for (int a = 0; a < 2; ++a)
#pragma unroll
        for (int b = 0; b < 2; ++b)
#pragma unroll
            for (int m = 0; m < 4; ++m)
#pragma unroll
                for (int n = 0; n < 2; ++n) acc[a][b][m][n] = (f32x4){0.f, 0.f, 0.f, 0.f};
    bf16x8 At[4][2], B0[2][2], B1[2][2];
    const char* cA = (const char*)g.A + (size_t)cur.pm * tstepA + (size_t)cur.pn * g.a_pn_bytes; const char* cB = (const char*)g.Bt + (size_t)cur.pn * tstepB;
    if constexpr (SP2) {
        PG8_STAGE(PG8_SB(0, 0), cB, voffB); PG8_STAGE(PG8_SB(0, 1), cB + hstepB, voffB); PG8_STAGE(PG8_SA(0, 0), cA, voffA); PG8_STAGE(PG8_SA(0, 1), cA + hstepA, voffA);
        if (wr == 1) PG8_BAR;
        PG8_WAIT_V(2); PG8_BAR;
        PG8_STAGE(PG8_SB(1, 0), cB + kstep, voffB); PG8_STAGE(PG8_SA(1, 0), cA + kstep, voffA); PG8_STAGE(PG8_SB(1, 1), cB + hstepB + kstep, voffB);
        PG8_WAIT_V(6); PG8_BAR;
    } else {
        PG8_STAGE(PG8_SB(0, 0), cB, voffB); PG8_STAGE(PG8_SA(0, 0), cA, voffA); PG8_STAGE(PG8_SB(0, 1), cB + hstepB, voffB); PG8_STAGE(PG8_SA(0, 1), cA + hstepA, voffA);
        if (wr == 1) PG8_BAR;
        PG8_WAIT_V(4); PG8_BAR;
        PG8_STAGE(PG8_SB(1, 0), cB + kstep, voffB); PG8_STAGE(PG8_SA(1, 0), cA + kstep, voffA); PG8_STAGE(PG8_SB(1, 1), cB + hstepB + kstep, voffB);
        PG8_WAIT_V(6); PG8_BAR;
    }
    for (;;) {
        const bool has_next = S.next(ui + 1, nxt);
        const char* nA = has_next ? (const char*)g.A + (size_t)nxt.pm * tstepA + (size_t)nxt.pn * g.a_pn_bytes : cA; const char* nB = has_next ? (const char*)g.Bt + (size_t)nxt.pn * tstepB : cB;
        for (int t = 0; t < nt; t += 2) {
            const bool last = (t == nt - 2);
            const char* a1 = cA + (size_t)(t + 1) * kstep;
            const char* a2 = last ? nA : cA + (size_t)(t + 2) * kstep; const char* b2 = last ? nB : cB + (size_t)(t + 2) * kstep;
            const char* a3 = a2 + kstep; const char* b3 = b2 + kstep;
            if constexpr (SP2) {
            PG8_LDB(B0, 0, 0); PG8_LDB(B1, 0, 1); PG8_SCHED; PG8_LDA(At, 0, 0); PG8_STAGE(PG8_SA(1, 1), a1 + hstepA, voffA);
            PG8_WAIT_V(8); PG8_WAIT_L(0); PG8_BAR; PG8_MMA(0, 0, At, B0); PG8_MMA(0, 1, At, B1); PG8_BAR; PG8_SCHED;
            PG8_LDA(At, 0, 1); PG8_STAGE(PG8_SB(0, 0), b2, voffB); PG8_STAGE(PG8_SB(0, 1), b2 + hstepB, voffB); PG8_STAGE(PG8_SA(0, 0), a2, voffA);
            PG8_WAIT_V(8); PG8_WAIT_L(0); PG8_BAR; PG8_MMA(1, 0, At, B0); PG8_MMA(1, 1, At, B1); PG8_BAR; PG8_SCHED;
            PG8_LDB(B0, 1, 0); PG8_LDB(B1, 1, 1); PG8_SCHED; PG8_LDA(At, 1, 0); PG8_STAGE(PG8_SA(0, 1), a2 + hstepA, voffA);
            PG8_WAIT_V(8); PG8_WAIT_L(0); PG8_BAR; PG8_MMA(0, 0, At, B0); PG8_MMA(0, 1, At, B1); PG8_BAR; PG8_SCHED;
            PG8_LDA(At, 1, 1); PG8_STAGE(PG8_SB(1, 0), b3, voffB); PG8_STAGE(PG8_SB(1, 1), b3 + hstepB, voffB); PG8_STAGE(PG8_SA(1, 0), a3, voffA);
            PG8_WAIT_V(8); PG8_WAIT_L(0); PG8_BAR; PG8_MMA(1, 0, At, B0); PG8_MMA(1, 1, At, B1); PG8_BAR; PG8_SCHED;
            } else {
            PG8_LDB(B0, 0, 0); PG8_SCHED; PG8_LDA(At, 0, 0); PG8_STAGE(PG8_SA(1, 1), a1 + hstepA, voffA);
            PG8_WAIT_L(8); PG8_BAR; PG8_WAIT_L(0); PG8_MMA(0, 0, At, B0); PG8_BAR; PG8_SCHED;
            PG8_LDB(B1, 0, 1); PG8_STAGE(PG8_SB(0, 0), b2, voffB);
            PG8_BAR; PG8_WAIT_L(0); PG8_MMA(0, 1, At, B1); PG8_BAR;
            PG8_LDA(At, 0, 1); PG8_STAGE(PG8_SA(0, 0), a2, voffA);
            PG8_BAR; PG8_WAIT_L(0); PG8_MMA(1, 0, At, B0); PG8_BAR; PG8_SCHED;
            PG8_STAGE(PG8_SB(0, 1), b2 + hstepB, voffB);
            PG8_WAIT_V(6); PG8_BAR; PG8_MMA(1, 1, At, B1); PG8_BAR;
            PG8_LDB(B0, 1, 0); PG8_SCHED; PG8_LDA(At, 1, 0); PG8_STAGE(PG8_SA(0, 1), a2 + hstepA, voffA);
            PG8_WAIT_L(8); PG8_BAR; PG8_WAIT_L(0); PG8_MMA(0, 0, At, B0); PG8_BAR; PG8_SCHED;
            PG8_LDB(B1, 1, 1); PG8_STAGE(PG8_SB(1, 0), b3, voffB);
            PG8_BAR; PG8_WAIT_L(0); PG8_MMA(0, 1, At, B1); PG8_BAR;
            PG8_LDA(At, 1, 1); PG8_STAGE(PG8_SA(1, 0), a3, voffA);
            PG8_BAR; PG8_WAIT_L(0); PG8_MMA(1, 0, At, B0); PG8_BAR; PG8_SCHED;
            PG8_STAGE(PG8_SB(1, 1), b3 + hstepB, voffB);
            PG8_WAIT_V(6); PG8_BAR; PG8_MMA(1, 1, At, B1); PG8_BAR;
            }
        }
        if constexpr (ALIGN_EPI) { if (wr == 0) PG8_BAR; }
        E(acc, cur, wr, wc, fr, fq);
        if (!has_next) break;
#pragma unroll
        for (int a = 0; a < 2; ++a)
#pragma unroll
            for (int b = 0; b < 2; ++b)
#pragma unroll
                for (int m = 0; m < 4; ++m)
#pragma unroll
                    for (int n = 0; n < 2; ++n) acc[a][b][m][n] = (f32x4){0.f, 0.f, 0.f, 0.f};
        cur = nxt; cA = nA; cB = nB; ++ui;
        if constexpr (ALIGN_EPI) { if (wr == 1) PG8_BAR; }
    }
    PG8_WAIT_V(0);
    if constexpr (!ALIGN_EPI) { if (wr == 0) PG8_BAR; }
    PG8_BAR;
#undef PG8_SA
#undef PG8_SB
#undef PG8_STAGE
#undef PG8_LDA
#undef PG8_LDB
#undef PG8_MMA
#undef PG8_WAIT_V
#undef PG8_WAIT_L
#undef PG8_BAR
#undef PG8_SCHED
}

enum { ACT_NONE = 0, ACT_SILU = 1, ACT_SIGMOID = 2, ACT_DECAY = 3 };
template <int ACT> __device__ __forceinline__ float actf(float v) {
    if (ACT == ACT_SILU) return v * sigmoidf_(v);
    if (ACT == ACT_SIGMOID) return sigmoidf_(v);
    if (ACT == ACT_DECAY) return 0.60653065971f * sigmoidf_(v);
    return v;
}
struct EpiCfg {
    bf16_t* out; int ldo;
    const float* bias;
    const float* cscale;
    const bf16_t* in1; int ld1;
    const bf16_t* in2; int ld2;
};
template <int ACT_A, int ACT_B> struct EpiG {
    static constexpr bool PERM = true;
    EpiCfg a, b; int split;
    template <int ACT> __device__ __forceinline__ void run(const EpiCfg& c, int colt, const f32x4 (&acc)[2][2][4][2], const Unit& u, int wr, int wc, int fr, int fq) const {
        const int row0 = u.pm * BM + wr * 64 + fr, col0 = colt + wc * 32 + 8 * fq;
        f32x4 bv[2][2], sv[2][2];
#pragma unroll
        for (int bj = 0; bj < 2; ++bj)
#pragma unroll
            for (int n = 0; n < 2; ++n) {
                bv[bj][n] = c.bias ? *(const f32x4*)(c.bias + col0 + bj * HALF + 4 * n) : (f32x4){0.f, 0.f, 0.f, 0.f};
                sv[bj][n] = c.cscale ? *(const f32x4*)(c.cscale + col0 + bj * HALF + 4 * n) : (f32x4){1.f, 1.f, 1.f, 1.f};
            }
#pragma unroll
        for (int ai = 0; ai < 2; ++ai)
#pragma unroll
            for (int m = 0; m < 4; ++m) {
                const size_t row = (size_t)(row0 + ai * HALF + m * 16);
#pragma unroll
                for (int bj = 0; bj < 2; ++bj) {
                    const int cc = col0 + bj * HALF;
                    f32x4 v0 = acc[ai][bj][m][0] + bv[bj][0], v1 = acc[ai][bj][m][1] + bv[bj][1];
#pragma unroll
                    for (int j = 0; j < 4; ++j) { v0[j] = actf<ACT>(v0[j]); v1[j] = actf<ACT>(v1[j]); }
                    if (c.in1) { const u32x4 w = *(const u32x4*)(c.in1 + row * c.ld1 + cc);
                        v0[0] *= bf_lo(w.x); v0[1] *= bf_hi(w.x); v0[2] *= bf_lo(w.y); v0[3] *= bf_hi(w.y);
                        v1[0] *= bf_lo(w.z); v1[1] *= bf_hi(w.z); v1[2] *= bf_lo(w.w); v1[3] *= bf_hi(w.w); }
                    if (c.cscale) { v0 *= sv[bj][0]; v1 *= sv[bj][1]; }
                    if (c.in2) { const u32x4 w = *(const u32x4*)(c.in2 + row * c.ld2 + cc);
                        v0[0] += bf_lo(w.x); v0[1] += bf_hi(w.x); v0[2] += bf_lo(w.y); v0[3] += bf_hi(w.y);
                        v1[0] += bf_lo(w.z); v1[1] += bf_hi(w.z); v1[2] += bf_lo(w.w); v1[3] += bf_hi(w.w); }
                    u32x4 w; w.x = pk_bf16(v0[0], v0[1]); w.y = pk_bf16(v0[2], v0[3]); w.z = pk_bf16(v1[0], v1[1]); w.w = pk_bf16(v1[2], v1[3]);
                    *(u32x4*)(c.out + row * c.ldo + cc) = w;
                }
            }
    }
    __device__ __forceinline__ void operator()(const f32x4 (&acc)[2][2][4][2], const Unit& u, int wr, int wc, int fr, int fq) const {
        const int colt = u.pn * BM;
        if (colt >= split) run<ACT_B>(b, colt - split, acc, u, wr, wc, fr, fq);
        else run<ACT_A>(a, colt, acc, u, wr, wc, fr, fq);
    }
};
struct EpiResid {
    static constexpr bool PERM = false;
    float* X; int ldc;
    __device__ __forceinline__ void operator()(const f32x4 (&acc)[2][2][4][2], const Unit& u, int wr, int wc, int fr, int fq) const {
        const int row0 = u.pm * BM + wr * 64 + fr, col0 = u.pn * BM + wc * 32 + 4 * fq;
#pragma unroll
        for (int ai = 0; ai < 2; ++ai)
#pragma unroll
            for (int m = 0; m < 4; ++m) { float* rowp = X + (size_t)(row0 + ai * HALF + m * 16) * ldc + col0;
#pragma unroll
                for (int bj = 0; bj < 2; ++bj)
#pragma unroll
                    for (int n = 0; n < 2; ++n) { f32x4* p = (f32x4*)(rowp + bj * HALF + n * 16); *p = *p + acc[ai][bj][m][n]; } }
    }
};
}

struct Args {
    const float* in[22];
    float* out; unsigned char* ws;
    int ph_lo, ph_hi;
};
typedef const Args __attribute__((address_space(4)))* ArgsP;
struct Frame {
    LAS unsigned char* lds;
    int tid, lane, wave, G, bid;
    ArgsP ap;
    float* X; unsigned char* ws;
    bf16_t *WinT, *WppT, *WrpT, *WoutT, *LinT, *EAT, *VF, *RAW, *RAWB, *S1, *S2, *S3, *TW;
};

__device__ __forceinline__ void set_ws(Frame& F, unsigned char* ws) {
    F.ws = ws;
    F.WinT = (bf16_t*)(ws + WS_WINT); F.WppT = (bf16_t*)(ws + WS_WPP); F.WrpT = (bf16_t*)(ws + WS_WRP); F.WoutT = (bf16_t*)(ws + WS_WOUT);
    F.LinT = (bf16_t*)(ws + WS_LINT); F.EAT = (bf16_t*)(ws + WS_EAT); F.VF = (bf16_t*)(ws + WS_VFIRST);
    F.RAW = (bf16_t*)(ws + WS_RAW); F.RAWB = (bf16_t*)(ws + WS_RAWB); F.S1 = (bf16_t*)(ws + WS_S1); F.S2 = (bf16_t*)(ws + WS_S2); F.S3 = (bf16_t*)(ws + WS_S3);
    F.TW = (bf16_t*)(ws + WS_TW);
}
__device__ __forceinline__ void transpose_cvt(const Frame& F, const float* src, int ldn, int K, int N, bf16_t* dst, int ldk) {
    LAS float* tile = (LAS float*)F.lds;
    const int tilesK = K / 64, ntile = tilesK * (N / 64);
    for (int tl = F.bid; tl < ntile; tl += F.G) {
        const int k0 = (tl % tilesK) * 64, n0 = (tl / tilesK) * 64;
#pragma unroll
        for (int i = 0; i < 8; ++i) { const int idx = F.tid + 512 * i, r = idx >> 6, c = idx & 63; tile[r * 65 + c] = src[(size_t)(k0 + r) * ldn + n0 + c]; }
        __syncthreads();
#pragma unroll
        for (int i = 0; i < 4; ++i) { const int idx = F.tid + 512 * i, n = idx >> 5, kp = idx & 31;
            *(unsigned*)(dst + (size_t)(n0 + n) * ldk + k0 + 2 * kp) = pk_bf16(tile[(2 * kp) * 65 + n], tile[(2 * kp + 1) * 65 + n]); }
        __syncthreads();
    }
}
__device__ __forceinline__ void convert_weights(const Frame& F, int L) {
    transpose_cvt(F, F.ap->in[2] + (size_t)L * D * INW, INW, D, INW, F.WinT, D);
    transpose_cvt(F, F.ap->in[5] + (size_t)L * D * D, D, D, D, F.WppT, D);
    transpose_cvt(F, F.ap->in[19] + (size_t)L * D * D, D, D, D, F.WrpT, D);
    transpose_cvt(F, F.ap->in[20] + (size_t)L * D * D, D, D, D, F.WoutT, D);
    for (int g = 0; g < 4; ++g) transpose_cvt(F, F.ap->in[3] + (size_t)(L * 4 + g) * 65536, 256, 256, 256, F.LinT + (size_t)g * 65536, 256);
    const float* w2 = F.ap->in[8] + (size_t)L * 64 * D; const float* a2 = F.ap->in[10] + (size_t)L * 64 * D;
    for (int idx = F.bid * 512 + F.tid; idx < 2048 * 128; idx += F.G * 512) {
        const int n = idx >> 7, k = (idx & 127) * 2; float v0 = 0.f, v1 = 0.f;
        if (n < 1024) { if (k < 64) { v0 = w2[(size_t)k * D + n]; v1 = w2[(size_t)(k + 1) * D + n]; } }
        else { if (k >= 64 && k < 128) { v0 = a2[(size_t)(k - 64) * D + (n - 1024)]; v1 = a2[(size_t)(k - 63) * D + (n - 1024)]; } }
        *(unsigned*)(F.EAT + (size_t)n * 256 + k) = pk_bf16(v0, v1);
    }
}
__device__ __forceinline__ void rmsnorm_rows(const Frame& F, const float* src, const float* g, bf16_t* H, float* copy_to) {
    for (int m = F.bid * 8 + F.wave; m < M; m += F.G * 8) {
        const float* xr = src + (size_t)m * D;
        f32x4 v[4]; float ss = 0.f;
#pragma unroll
        for (int i = 0; i < 4; ++i) { v[i] = *(const f32x4*)(xr + F.lane * 4 + 256 * i); ss += v[i][0] * v[i][0] + v[i][1] * v[i][1] + v[i][2] * v[i][2] + v[i][3] * v[i][3]; }
        ss = red64(ss);
        const float rs = __builtin_amdgcn_rsqf(ss * (1.0f / D) + NORM_EPS);
#pragma unroll
        for (int i = 0; i < 4; ++i) {
            const int c = F.lane * 4 + 256 * i;
            if (copy_to) *(f32x4*)(copy_to + (size_t)m * D + c) = v[i];
            const f32x4 gg = *(const f32x4*)(g + c);
            u32x2 w; w.x = pk_bf16(v[i][0] * rs * gg[0], v[i][1] * rs * gg[1]); w.y = pk_bf16(v[i][2] * rs * gg[2], v[i][3] * rs * gg[3]);
            *(u32x2*)(H + (size_t)m * D + c) = w;
        }
    }
}
__device__ __forceinline__ void final_norm(const Frame& F) {
    const float* g = F.ap->in[21];
    for (int m = F.bid * 8 + F.wave; m < M; m += F.G * 8) {
        float* xr = F.X + (size_t)m * D;
        f32x4 v[4]; float ss = 0.f;
#pragma unroll
        for (int i = 0; i < 4; ++i) { v[i] = *(const f32x4*)(xr + F.lane * 4 + 256 * i); ss += v[i][0] * v[i][0] + v[i][1] * v[i][1] + v[i][2] * v[i][2] + v[i][3] * v[i][3]; }
        ss = red64(ss);
        const float rs = __builtin_amdgcn_rsqf(ss * (1.0f / D) + NORM_EPS);
#pragma unroll
        for (int i = 0; i < 4; ++i) { const int c = F.lane * 4 + 256 * i; const f32x4 gg = *(const f32x4*)(g + c); *(f32x4*)(xr + c) = v[i] * rs * gg; }
    }
}
__device__ __forceinline__ void tw_phase(const Frame& F, int L) {
    const float* mu = F.ap->in[6] + (size_t)L * 3200;
    for (int it = F.bid * 512 + F.tid; it < M * 32; it += F.G * 512) {
        const int m = it >> 5, j = it & 31; u32x4 o = (u32x4){0u, 0u, 0u, 0u};
        if (j < 16) {
            const int c0 = 3072 + 8 * j, t = m & (SEQ - 1);
            const u32x4 cw = *(const u32x4*)(F.RAW + (size_t)m * RAWLD + c0);
            u32x4 pw = (u32x4){0u, 0u, 0u, 0u}; if (t > 0) pw = *(const u32x4*)(F.RAW + (size_t)(m - 1) * RAWLD + c0);
            const f32x4 m0 = *(const f32x4*)(mu + c0), m1 = *(const f32x4*)(mu + c0 + 4);
            float s[8];
#define SH(i, cwv, pwv, muv, hi) { const float c_ = hi ? bf_hi(cwv) : bf_lo(cwv), p_ = hi ? bf_hi(pwv) : bf_lo(pwv); s[i] = c_ + (muv) * (p_ - c_); }
            SH(0, cw.x, pw.x, m0[0], 0) SH(1, cw.x, pw.x, m0[1], 1) SH(2, cw.y, pw.y, m0[2], 0) SH(3, cw.y, pw.y, m0[3], 1)
            SH(4, cw.z, pw.z, m1[0], 0) SH(5, cw.z, pw.z, m1[1], 1) SH(6, cw.w, pw.w, m1[2], 0) SH(7, cw.w, pw.w, m1[3], 1)
#undef SH
            if (j < 8) {
#pragma unroll
                for (int i = 0; i < 8; ++i) s[i] = tanhf_(s[i]);
            }
            o.x = pk_bf16(s[0], s[1]); o.y = pk_bf16(s[2], s[3]); o.z = pk_bf16(s[4], s[5]); o.w = pk_bf16(s[6], s[7]);
        }
        *(u32x4*)(F.TW + (size_t)m * 256 + 8 * j) = o;
    }
}
__device__ __forceinline__ void vmix_phase(const Frame& F, int L) {
    const float* mu = F.ap->in[6] + (size_t)L * 3200 + 2048;
    const int tid = F.tid, c0 = 2 * tid;
    const f32x2 muv = *(const f32x2*)(mu + c0);
    LAS float* vsh = (LAS float*)F.lds;
    LAS float* part = (LAS float*)(F.lds + 16384);
    LAS float* midl = (LAS float*)(F.lds + 16384 + 8192);
    bf16_t* dst = (L == 0) ? F.VF : F.S3;
    float v1r[64]; f32x2 v2r[32]; f32x2 v0v = (f32x2){0.f, 0.f};
    const int jj = tid & 31, cs = tid >> 5;
    if (L > 0) {
        const float* V1 = F.ap->in[12] + (size_t)(L - 1) * D * 32; const float* V2 = F.ap->in[13] + (size_t)(L - 1) * 32 * D;
#pragma unroll
        for (int i = 0; i < 64; ++i) v1r[i] = V1[(size_t)(cs * 64 + i) * 32 + jj];
#pragma unroll
        for (int j = 0; j < 32; ++j) v2r[j] = *(const f32x2*)(V2 + (size_t)j * D + c0);
        v0v = *(const f32x2*)(F.ap->in[11] + (size_t)(L - 1) * D + c0);
    }
    for (int grp = F.bid; grp < M / 4; grp += F.G) {
        const int m0 = grp * 4, t0 = m0 & (SEQ - 1);
        unsigned rw[5];
        rw[0] = (t0 > 0) ? *(const unsigned*)(F.RAW + (size_t)(m0 - 1) * RAWLD + 2048 + c0) : 0u;
#pragma unroll
        for (int i = 0; i < 4; ++i) rw[i + 1] = *(const unsigned*)(F.RAW + (size_t)(m0 + i) * RAWLD + 2048 + c0);
        f32x2 vs[4];
#pragma unroll
        for (int i = 0; i < 4; ++i) { const float c_lo = bf_lo(rw[i + 1]), c_hi = bf_hi(rw[i + 1]), p_lo = bf_lo(rw[i]), p_hi = bf_hi(rw[i]);
            vs[i].x = c_lo + muv.x * (p_lo - c_lo); vs[i].y = c_hi + muv.y * (p_hi - c_hi); }
        if (L == 0) {
#pragma unroll
            for (int i = 0; i < 4; ++i) *(unsigned*)(dst + (size_t)(m0 + i) * D + c0) = pk_bf16(vs[i].x, vs[i].y);
            continue;
        }
#pragma unroll
        for (int i = 0; i < 4; ++i) *(LAS f32x2*)(vsh + i * 1024 + c0) = vs[i];
        __syncthreads();
#pragma unroll
        for (int i = 0; i < 4; ++i) {
            float p = 0.f;
#pragma unroll
            for (int k4 = 0; k4 < 16; ++k4) { const f32x4 x = *(const LAS f32x4*)(vsh + i * 1024 + cs * 64 + 4 * k4);
                p += x[0] * v1r[4 * k4] + x[1] * v1r[4 * k4 + 1] + x[2] * v1r[4 * k4 + 2] + x[3] * v1r[4 * k4 + 3]; }
            part[(i * 16 + cs) * 32 + jj] = p;
        }
        __syncthreads();
        if (tid < 128) { const int i = tid >> 5; float s = 0.f;
#pragma unroll
            for (int k = 0; k < 16; ++k) s += part[(i * 16 + k) * 32 + jj];
            midl[i * 32 + jj] = s; }
        __syncthreads();
#pragma unroll
        for (int i = 0; i < 4; ++i) {
            float z0 = v0v.x, z1 = v0v.y;
#pragma unroll
            for (int j4 = 0; j4 < 8; ++j4) { const f32x4 mm = *(const LAS f32x4*)(midl + i * 32 + 4 * j4);
#pragma unroll
                for (int e = 0; e < 4; ++e) { z0 += mm[e] * v2r[4 * j4 + e].x; z1 += mm[e] * v2r[4 * j4 + e].y; } }
            const float g0 = sigmoidf_(z0), g1 = sigmoidf_(z1);
            const unsigned fw = *(const unsigned*)(F.VF + (size_t)(m0 + i) * D + c0);
            const float o0 = vs[i].x + (bf_lo(fw) - vs[i].x) * g0, o1 = vs[i].y + (bf_hi(fw) - vs[i].y) * g1;
            *(unsigned*)(dst + (size_t)(m0 + i) * D + c0) = pk_bf16(o0, o1);
        }
        __syncthreads();
    }
}
__device__ __forceinline__ void poold_phase(const Frame& F, const bf16_t* PIN, bf16_t* DB) {
    for (int it = F.bid * 512 + F.tid; it < M * 128; it += F.G * 512) {
        const int m = it >> 7, j = it & 127, t = m & (SEQ - 1), w = 2 << (j >> 5);
        const int cnt = (t + 1 < w) ? (t + 1) : w;
        float s[8];
#pragma unroll
        for (int i = 0; i < 8; ++i) s[i] = 0.f;
        float c[8];
        for (int i = 0; i < cnt; ++i) {
            const u32x4 x = *(const u32x4*)(PIN + (size_t)(m - i) * D + 8 * j);
            const float f[8] = {bf_lo(x.x), bf_hi(x.x), bf_lo(x.y), bf_hi(x.y), bf_lo(x.z), bf_hi(x.z), bf_lo(x.w), bf_hi(x.w)};
#pragma unroll
            for (int e = 0; e < 8; ++e) { s[e] += f[e]; if (i == 0) c[e] = f[e]; }
        }
        const float inv = 1.0f / (float)cnt;
        u32x4 o; o.x = pk_bf16(s[0] * inv - c[0], s[1] * inv - c[1]); o.y = pk_bf16(s[2] * inv - c[2], s[3] * inv - c[3]);
        o.z = pk_bf16(s[4] * inv - c[4], s[5] * inv - c[5]); o.w = pk_bf16(s[6] * inv - c[6], s[7] * inv - c[7]);
        *(u32x4*)(DB + (size_t)m * D + 8 * j) = o;
    }
}

constexpr int SC_T = 32;
constexpr int SC_ARR = SC_T * 64;
constexpr int SC_BUF_BYTES = 6 * SC_ARR * 4;
constexpr int SC_YS = 2 * SC_BUF_BYTES, SC_RAWR = SC_YS + SC_ARR * 4, SC_RAWK = SC_RAWR + SC_ARR * 4, SC_PREV = SC_RAWK + SC_ARR * 4;
static_assert(SC_PREV + 1024 <= 131072, "scan LDS");
struct ScanRegs { u32x2 rr, kr, ee, aa, vv; };
__device__ __forceinline__ void scan_phase(const Frame& F, int L, const bf16_t* VP) {
    const int tid = F.tid, lane = F.lane, wave = F.wave;
    LAS float* Ys = (LAS float*)(F.lds + SC_YS);
    LAS float* rawR = (LAS float*)(F.lds + SC_RAWR);
    LAS float* rawK = (LAS float*)(F.lds + SC_RAWK);
    LAS float* prevRK = (LAS float*)(F.lds + SC_PREV);
    const int tok = tid >> 4, q = tid & 15;
    const int row = wave * 8 + (lane >> 3), c2 = (lane & 7) * 2;
    for (int unit = F.bid; unit < 256; unit += F.G) {
        const int b = unit >> 4, h = unit & 15, hc = h * 64 + 4 * q;
        const f32x4 kk4 = *(const f32x4*)(F.ap->in[14] + (size_t)L * D + hc), ka4 = *(const f32x4*)(F.ap->in[15] + (size_t)L * D + hc);
        const f32x4 rk4 = *(const f32x4*)(F.ap->in[16] + (size_t)L * D + hc);
        const f32x4 lw4 = *(const f32x4*)(F.ap->in[17] + (size_t)L * D + hc), lb4 = *(const f32x4*)(F.ap->in[18] + (size_t)L * D + hc);
        const f32x4 mur4 = *(const f32x4*)(F.ap->in[6] + (size_t)L * 3200 + hc), muk4 = *(const f32x4*)(F.ap->in[6] + (size_t)L * 3200 + 1024 + hc);
        const size_t mrow0 = (size_t)b * SEQ;
        float S[8];
#pragma unroll
        for (int j = 0; j < 8; ++j) S[j] = 0.f;
        ScanRegs R;
#define SC_LOAD(cidx) do { const size_t m_ = mrow0 + (size_t)(cidx) * SC_T + tok; \
            R.rr = *(const u32x2*)(F.RAW + m_ * RAWLD + hc); R.kr = *(const u32x2*)(F.RAW + m_ * RAWLD + 1024 + hc); \
            R.ee = *(const u32x2*)(F.S1 + m_ * D + hc); R.aa = *(const u32x2*)(F.S2 + m_ * D + hc); R.vv = *(const u32x2*)(VP + m_ * D + hc); } while (0)
#define SC_PREP(cidx) do { \
            const f32x4 rc = (f32x4){bf_lo(R.rr.x), bf_hi(R.rr.x), bf_lo(R.rr.y), bf_hi(R.rr.y)}; \
            const f32x4 kc = (f32x4){bf_lo(R.kr.x), bf_hi(R.kr.x), bf_lo(R.kr.y), bf_hi(R.kr.y)}; \
            *(LAS f32x4*)(rawR + tok * 64 + 4 * q) = rc; *(LAS f32x4*)(rawK + tok * 64 + 4 * q) = kc; \
            __syncthreads(); \
            f32x4 rp, kp; \
            if (tok > 0) { rp = *(const LAS f32x4*)(rawR + (tok - 1) * 64 + 4 * q); kp = *(const LAS f32x4*)(rawK + (tok - 1) * 64 + 4 * q); } \
            else if ((cidx) > 0) { rp = *(const LAS f32x4*)(prevRK + (((cidx) & 1) * 2 + 0) * 64 + 4 * q); kp = *(const LAS f32x4*)(prevRK + (((cidx) & 1) * 2 + 1) * 64 + 4 * q); } \
            else { rp = (f32x4){0.f, 0.f, 0.f, 0.f}; kp = rp; } \
            if (tok == SC_T - 1) { *(LAS f32x4*)(prevRK + ((((cidx) + 1) & 1) * 2 + 0) * 64 + 4 * q) = rc; *(LAS f32x4*)(prevRK + ((((cidx) + 1) & 1) * 2 + 1) * 64 + 4 * q) = kc; } \
            const f32x4 rs = rc + mur4 * (rp - rc), ks = kc + muk4 * (kp - kc); \
            const f32x4 ev = (f32x4){bf_lo(R.ee.x), bf_hi(R.ee.x), bf_lo(R.ee.y), bf_hi(R.ee.y)}; \
            const f32x4 av = (f32x4){bf_lo(R.aa.x), bf_hi(R.aa.x), bf_lo(R.aa.y), bf_hi(R.aa.y)}; \
            const f32x4 vv = (f32x4){bf_lo(R.vv.x), bf_hi(R.vv.x), bf_lo(R.vv.y), bf_hi(R.vv.y)}; \
            f32x4 kkv = ks * kk4; \
            float ss = kkv[0] * kkv[0] + kkv[1] * kkv[1] + kkv[2] * kkv[2] + kkv[3] * kkv[3]; ss = red16(ss); \
            const float inv = 1.0f / fmaxf(sqrtf(ss), 1e-12f); kkv = kkv * inv; \
            const f32x4 kmod = ks * (1.0f + (av - 1.0f) * ka4); \
            f32x4 wv; wv[0] = __expf(-ev[0]); wv[1] = __expf(-ev[1]); wv[2] = __expf(-ev[2]); wv[3] = __expf(-ev[3]); \
            LAS float* cb_ = (LAS float*)(F.lds + ((cidx) & 1) * SC_BUF_BYTES) + tok * 64 + 4 * q; \
            *(LAS f32x4*)(cb_ + 0 * SC_ARR) = rs; *(LAS f32x4*)(cb_ + 1 * SC_ARR) = wv; *(LAS f32x4*)(cb_ + 2 * SC_ARR) = kmod; \
            *(LAS f32x4*)(cb_ + 3 * SC_ARR) = -kkv; *(LAS f32x4*)(cb_ + 4 * SC_ARR) = kkv * av; *(LAS f32x4*)(cb_ + 5 * SC_ARR) = vv; } while (0)
        SC_LOAD(0);
        SC_PREP(0);
        __syncthreads();
        for (int c = 0; c < SEQ / SC_T; ++c) {
            if (c + 1 < SEQ / SC_T) SC_LOAD(c + 1);
            const LAS float* cb = (const LAS float*)(F.lds + (c & 1) * SC_BUF_BYTES);
            const LAS f32x4* R4 = (const LAS f32x4*)(cb + 0 * SC_ARR); const LAS f32x4* W4 = (const LAS f32x4*)(cb + 1 * SC_ARR); const LAS f32x4* K4 = (const LAS f32x4*)(cb + 2 * SC_ARR);
            const LAS f32x4* A4 = (const LAS f32x4*)(cb + 3 * SC_ARR); const LAS f32x4* B4 = (const LAS f32x4*)(cb + 4 * SC_ARR); const LAS float* Vs = cb + 5 * SC_ARR;
#pragma unroll 2
            for (int t = 0; t < SC_T; ++t) {
                const f32x4 a0 = A4[t * 16 + c2], a1 = A4[t * 16 + c2 + 1], w0 = W4[t * 16 + c2], w1 = W4[t * 16 + c2 + 1];
                const f32x4 b0 = B4[t * 16 + c2], b1 = B4[t * 16 + c2 + 1], k0 = K4[t * 16 + c2], k1 = K4[t * 16 + c2 + 1];
                const f32x4 r0 = R4[t * 16 + c2], r1 = R4[t * 16 + c2 + 1]; const float vv = Vs[t * 64 + row];
                float sa = (S[0] * a0[0] + S[1] * a0[1]) + (S[2] * a0[2] + S[3] * a0[3]) + (S[4] * a1[0] + S[5] * a1[1]) + (S[6] * a1[2] + S[7] * a1[3]);
                sa = red8(sa);
#pragma unroll
                for (int j = 0; j < 4; ++j) { S[j] = S[j] * w0[j] + sa * b0[j] + vv * k0[j]; S[4 + j] = S[4 + j] * w1[j] + sa * b1[j] + vv * k1[j]; }
                float y = (S[0] * r0[0] + S[1] * r0[1]) + (S[2] * r0[2] + S[3] * r0[3]) + (S[4] * r1[0] + S[5] * r1[1]) + (S[6] * r1[2] + S[7] * r1[3]);
                y = red8(y);
                if ((lane & 7) == 0) Ys[t * 64 + row] = y;
            }
            __syncthreads();
            {
                const f32x4 y4 = *(const LAS f32x4*)(Ys + tok * 64 + 4 * q);
                const float mean = red16((y4[0] + y4[1]) + (y4[2] + y4[3])) * (1.0f / 64.0f);
                const f32x4 d = y4 - mean;
                const float var = red16((d[0] * d[0] + d[1] * d[1]) + (d[2] * d[2] + d[3] * d[3])) * (1.0f / 64.0f);
                const float rstd = __builtin_amdgcn_rsqf(var + LNX_EPS);
                const f32x4 rs = *(const LAS f32x4*)(cb + 0 * SC_ARR + tok * 64 + 4 * q), km = *(const LAS f32x4*)(cb + 2 * SC_ARR + tok * 64 + 4 * q), vv = *(const LAS f32x4*)(cb + 5 * SC_ARR + tok * 64 + 4 * q);
                const f32x4 pr = rs * km * rk4;
                const float bon = red16((pr[0] + pr[1]) + (pr[2] + pr[3]));
                const f32x4 z = d * rstd * lw4 + lb4 + bon * vv;
                u32x2 o; o.x = pk_bf16(z[0], z[1]); o.y = pk_bf16(z[2], z[3]);
                *(u32x2*)(F.RAW + (mrow0 + (size_t)c * SC_T + tok) * RAWLD + hc) = o;
            }
            if (c + 1 < SEQ / SC_T) SC_PREP(c + 1);
            __syncthreads();
        }
#undef SC_LOAD
#undef SC_PREP
    }
}

constexpr int LDS_BYTES = 147456;
constexpr int LDSCTL_OFF = 131072;
constexpr int PPL = 15;
constexpr int NPHASE = NLAYER * PPL + 1;

template <int PH> __device__ __forceinline__ void run_phase(Frame& F, int L) {
    using namespace pg8;
    { int t_ = threadIdx.x; asm volatile("" : "+v"(t_)); F.tid = t_; F.lane = t_ & 63; F.wave = __builtin_amdgcn_readfirstlane(t_ >> 6);
      ArgsP a_ = (ArgsP)__builtin_amdgcn_kernarg_segment_ptr(); asm volatile("" : "+s"(a_)); F.ap = a_; F.X = a_->out; set_ws(F, a_->ws); }
    if constexpr (PH == 0) {
        convert_weights(F, L);
        rmsnorm_rows(F, L == 0 ? F.ap->in[0] : F.X, F.ap->in[1] + (size_t)L * D, F.S1, L == 0 ? F.X : nullptr);
    } else if constexpr (PH == 1) {
        Gemm g{F.S1, F.WinT + (size_t)2048 * D, D, D, D, M / 256, RAWLD / 256, 0}; StaticOrder S; S.init(g.nM, g.nN, F.G, F.bid);
        EpiG<ACT_NONE, ACT_NONE> E{{F.RAW, RAWLD, nullptr, nullptr, nullptr, 0, nullptr, 0}, {}, 1 << 30};
        gemm_phase(F.lds, g, S, E);
    } else if constexpr (PH == 2) {
        tw_phase(F, L); vmix_phase(F, L);
    } else if constexpr (PH == 3) {
        Gemm g{F.TW, F.EAT, 256, 256, 256, M / 256, 8, 0}; StaticOrder S; S.init(g.nM, g.nN, F.G, F.bid);
#ifdef PROBE_SWAP
        EpiG<ACT_DECAY, ACT_SIGMOID> E{{F.S2, D, F.ap->in[7] + (size_t)L * D, nullptr, nullptr, 0, nullptr, 0}, {F.S1, D, F.ap->in[9] + (size_t)L * D, nullptr, nullptr, 0, nullptr, 0}, 1024};
#else
        EpiG<ACT_DECAY, ACT_SIGMOID> E{{F.S1, D, F.ap->in[7] + (size_t)L * D, nullptr, nullptr, 0, nullptr, 0}, {F.S2, D, F.ap->in[9] + (size_t)L * D, nullptr, nullptr, 0, nullptr, 0}, 1024};
#endif
#ifdef PROBE_G3
        gemm_phase<decltype(E), false, false>(F.lds, g, S, E);
#else
        gemm_phase(F.lds, g, S, E);
#endif
    } else if constexpr (PH == 4) {
        scan_phase(F, L, L == 0 ? F.VF : F.S3);
    } else if constexpr (PH == 5) {
        rmsnorm_rows(F, L == 0 ? F.ap->in[0] : F.X, F.ap->in[1] + (size_t)L * D, F.S1, nullptr);
    } else if constexpr (PH == 6) {
        Gemm g{F.S1, F.WinT + (size_t)5248 * D, D, D, D, M / 256, 4, 0}; StaticOrder S; S.init(g.nM, g.nN, F.G, F.bid);
        EpiG<ACT_SILU, ACT_NONE> E{{F.S2, D, nullptr, nullptr, F.RAW, RAWLD, nullptr, 0}, {}, 1 << 30};
        gemm_phase(F.lds, g, S, E);
    } else if constexpr (PH == 7) {
        Gemm g{F.S2, F.WrpT, D, D, D, M / 256, 4, 0}; StaticOrder S; S.init(g.nM, g.nN, F.G, F.bid);
        EpiG<ACT_NONE, ACT_NONE> E{{F.S3, D, nullptr, nullptr, nullptr, 0, nullptr, 0}, {}, 1 << 30};
        gemm_phase(F.lds, g, S, E);
    } else if constexpr (PH == 8) {
        Gemm g{F.S1, F.WinT + (size_t)7296 * D, D, D, D, M / 256, 4, 0}; StaticOrder S; S.init(g.nM, g.nN, F.G, F.bid);
        EpiG<ACT_SIGMOID, ACT_NONE> E{{F.S3, D, nullptr, nullptr, F.S3, D, nullptr, 0}, {}, 1 << 30};
        gemm_phase(F.lds, g, S, E);
    } else if constexpr (PH == 9) {
        Gemm g{F.S1, F.WinT, D, D, D, M / 256, 8, 0}; StaticOrder S; S.init(g.nM, g.nN, F.G, F.bid);
        EpiG<ACT_NONE, ACT_SILU> E{{F.RAW, D, nullptr, nullptr, nullptr, 0, nullptr, 0}, {F.S2, D, nullptr, nullptr, nullptr, 0, nullptr, 0}, 1024};
        gemm_phase(F.lds, g, S, E);
    } else if constexpr (PH == 10) {
        poold_phase(F, F.RAW, F.RAWB);
    } else if constexpr (PH == 11) {
        Gemm g{F.RAWB, F.LinT, D, 256, 256, M / 256, 4, 512}; StaticOrder S; S.init(g.nM, g.nN, F.G, F.bid);
        EpiG<ACT_NONE, ACT_NONE> E{{F.S2, D, nullptr, F.ap->in[4] + (size_t)L * D, F.S2, D, nullptr, 0}, {}, 1 << 30};
        gemm_phase(F.lds, g, S, E);
    } else if constexpr (PH == 12) {
        Gemm g{F.S2, F.WppT, D, D, D, M / 256, 4, 0}; StaticOrder S; S.init(g.nM, g.nN, F.G, F.bid);
        EpiG<ACT_NONE, ACT_NONE> E{{F.RAW, D, nullptr, nullptr, nullptr, 0, nullptr, 0}, {}, 1 << 30};
        gemm_phase(F.lds, g, S, E);
    } else if constexpr (PH == 13) {
        Gemm g{F.S1, F.WinT + (size_t)6272 * D, D, D, D, M / 256, 4, 0}; StaticOrder S; S.init(g.nM, g.nN, F.G, F.bid);
        EpiG<ACT_SIGMOID, ACT_NONE> E{{F.RAW, D, nullptr, nullptr, F.RAW, D, F.S3, D}, {}, 1 << 30};
        gemm_phase(F.lds, g, S, E);
    } else if constexpr (PH == 14) {
        Gemm g{F.RAW, F.WoutT, D, D, D, M / 256, 4, 0}; StaticOrder S; S.init(g.nM, g.nN, F.G, F.bid);
        EpiResid E{F.X, D};
        gemm_phase(F.lds, g, S, E);
    } else {
        final_norm(F);
    }
}
__device__ __forceinline__ void frame_init(Frame& F, unsigned char* lds_raw) {
    F.lds = (LAS unsigned char*)lds_raw;
    F.tid = threadIdx.x; F.lane = F.tid & 63; F.wave = __builtin_amdgcn_readfirstlane(F.tid >> 6); F.G = gridDim.x; F.bid = blockIdx.x;
    F.ap = (ArgsP)__builtin_amdgcn_kernarg_segment_ptr();
    F.X = F.ap->out;
    set_ws(F, F.ap->ws);
}
#ifndef PROBE_STAGE
#define PROBE_STAGE -1
#endif
#if MK_PER_PHASE
__global__ void __launch_bounds__(512, 2) mk_dump(Args args, size_t ws_off, int ld, int rowmask) {
    const bf16_t* src = (const bf16_t*)(args.ws + ws_off);
    for (size_t it = (size_t)blockIdx.x * 512 + threadIdx.x; it < (size_t)M * 512; it += (size_t)gridDim.x * 512) {
        const size_t m = it >> 9; const int c = (int)(it & 511) * 2; const unsigned w = *(const unsigned*)(src + (m & (size_t)rowmask) * ld + (ld == 256 ? (c & 255) : c));
        args.out[m * D + c] = 1000.f * bf_lo(w); args.out[m * D + c + 1] = 1000.f * bf_hi(w);
    }
}
template <int PH> __global__ void __launch_bounds__(512, 2) mk_phase(Args args) {
    extern __shared__ __attribute__((aligned(16))) unsigned char lds_raw[];
    Frame F; frame_init(F, lds_raw);
    run_phase<PH>(F, F.ap->ph_lo);
}
#else
__global__ void __launch_bounds__(512, 2) mk_fwd(Args args) {
    extern __shared__ __attribute__((aligned(16))) unsigned char lds_raw[];
    Frame F; frame_init(F, lds_raw);
    volatile LAS unsigned* ctlw = (volatile LAS unsigned*)(F.lds + LDSCTL_OFF);
    if (F.tid < 16) ctlw[F.tid] = 0u;
    __syncthreads();
    XcdBarrier bar = xcd_barrier_post((unsigned*)(F.ws + WS_CTL), ctlw);
    for (int L = 0; L < NLAYER; ++L) {
        run_phase<0>(F, L); xcd_barrier(bar);
        run_phase<1>(F, L); xcd_barrier(bar);
        run_phase<2>(F, L); xcd_barrier(bar);
        run_phase<3>(F, L); xcd_barrier(bar);
        run_phase<4>(F, L); xcd_barrier(bar);
        run_phase<5>(F, L); xcd_barrier(bar);
        run_phase<6>(F, L); xcd_barrier(bar);
        run_phase<7>(F, L); xcd_barrier(bar);
        run_phase<8>(F, L); xcd_barrier(bar);
        run_phase<9>(F, L); xcd_barrier(bar);
        run_phase<10>(F, L); xcd_barrier(bar);
        run_phase<11>(F, L); xcd_barrier(bar);
        run_phase<12>(F, L); xcd_barrier(bar);
        run_phase<13>(F, L); xcd_barrier(bar);
        run_phase<14>(F, L); xcd_barrier(bar);
    }
    run_phase<15>(F, 0);
}
#endif

#if MK_PER_PHASE
template <int PH> static void launch_phase(int grid, hipStream_t stream, Args a, int L) { a.ph_lo = L; a.ph_hi = PH; hipLaunchKernelGGL(mk_phase<PH>, dim3(grid), dim3(512), LDS_BYTES, stream, a); }
template <int PH> static bool set_lds() { return hipFuncSetAttribute((const void*)mk_phase<PH>, hipFuncAttributeMaxDynamicSharedMemorySize, LDS_BYTES) == hipSuccess; }
#endif
extern "C" void kernel_launch(void* const* d_in, const int* in_sizes, int n_in, void* d_out, int out_size, void* d_ws, size_t ws_size, hipStream_t stream) {
    static int grid = 0;
    if (grid == 0) {
        if (n_in != 22 || in_sizes[0] != M * D || out_size != M * D || ws_size < WS_END) { fprintf(stderr, "kernel_launch: unexpected shapes / workspace (%d inputs, ws %zu)\n", n_in, ws_size); grid = -1; return; }
        int dev = 0, cus = 0;
        if (hipGetDevice(&dev) != hipSuccess || hipDeviceGetAttribute(&cus, hipDeviceAttributeMultiprocessorCount, dev) != hipSuccess) { grid = -1; return; }
#if MK_PER_PHASE
        bool ok = set_lds<0>() && set_lds<1>() && set_lds<2>() && set_lds<3>() && set_lds<4>() && set_lds<5>() && set_lds<6>() && set_lds<7>() && set_lds<8>() && set_lds<9>() && set_lds<10>() && set_lds<11>()
               && set_lds<12>() && set_lds<13>() && set_lds<14>() && set_lds<15>();
        if (!ok) { fprintf(stderr, "kernel_launch: hipFuncSetAttribute failed\n"); grid = -1; return; }
#else
        int per_cu = 0;
        if (hipFuncSetAttribute((const void*)mk_fwd, hipFuncAttributeMaxDynamicSharedMemorySize, LDS_BYTES) != hipSuccess) { fprintf(stderr, "kernel_launch: hipFuncSetAttribute failed\n"); grid = -1; return; }
        if (hipOccupancyMaxActiveBlocksPerMultiprocessor(&per_cu, (const void*)mk_fwd, 512, LDS_BYTES) != hipSuccess || per_cu < 1) { fprintf(stderr, "kernel_launch: occupancy query says %d\n", per_cu); }
#endif
        (void)hipGetLastError();
        grid = cus;
    }
    if (grid < 0) return;
    Args a{};
    for (int i = 0; i < 22; ++i) a.in[i] = (const float*)d_in[i];
    a.out = (float*)d_out; a.ws = (unsigned char*)d_ws;
#if MK_PER_PHASE
    if (PROBE_STAGE >= 0) {
        const int L = 0;
        launch_phase<0>(grid, stream, a, L); launch_phase<1>(grid, stream, a, L);
        if (PROBE_STAGE >= 2) launch_phase<2>(grid, stream, a, L);
        if (PROBE_STAGE >= 3) launch_phase<3>(grid, stream, a, L);
        if (PROBE_STAGE >= 4) launch_phase<4>(grid, stream, a, L);
        if (PROBE_STAGE >= 5) launch_phase<5>(grid, stream, a, L);
        if (PROBE_STAGE >= 6) launch_phase<6>(grid, stream, a, L);
        if (PROBE_STAGE >= 7) launch_phase<7>(grid, stream, a, L);
        if (PROBE_STAGE >= 8) launch_phase<8>(grid, stream, a, L);
        if (PROBE_STAGE >= 9) launch_phase<9>(grid, stream, a, L);
        if (PROBE_STAGE >= 10) launch_phase<10>(grid, stream, a, L);
        if (PROBE_STAGE >= 11) launch_phase<11>(grid, stream, a, L);
        if (PROBE_STAGE >= 12) launch_phase<12>(grid, stream, a, L);
        if (PROBE_STAGE >= 13) launch_phase<13>(grid, stream, a, L);
        size_t off = WS_RAW; int ld = RAWLD; int rowmask = 0x7fffffff;
        if (PROBE_STAGE == 2) { off = WS_VFIRST; ld = D; }
        if (PROBE_STAGE == 3) { off = WS_S1; ld = D; }
        if (PROBE_STAGE == 5) { off = WS_S1; ld = D; }
#if defined(PROBE_ALT) || defined(PROBE_SWAP)
        if (PROBE_STAGE == 3) { off = WS_S2; ld = D; }
        if (PROBE_STAGE == 2) { off = WS_EAT; ld = 256; rowmask = 2047; }
        if (PROBE_STAGE == 1) { off = WS_RAW + 4608; ld = RAWLD; }
#endif
        if (PROBE_STAGE == 6) { off = WS_S2; ld = D; }
        if (PROBE_STAGE == 7 || PROBE_STAGE == 8) { off = WS_S3; ld = D; }
        if (PROBE_STAGE == 9) { off = WS_S2; ld = D; }
        if (PROBE_STAGE == 10) { off = WS_RAWB; ld = D; }
        if (PROBE_STAGE == 11) { off = WS_S2; ld = D; }
        if (PROBE_STAGE == 12 || PROBE_STAGE == 13) { off = WS_RAW; ld = D; }
        hipLaunchKernelGGL(mk_dump, dim3(grid), dim3(512), 0, stream, a, off, ld, rowmask);
        return;
    }
    for (int L = 0; L < NLAYER; ++L) {
        launch_phase<0>(grid, stream, a, L); launch_phase<1>(grid, stream, a, L); launch_phase<2>(grid, stream, a, L); launch_phase<3>(grid, stream, a, L);
        launch_phase<4>(grid, stream, a, L); launch_phase<5>(grid, stream, a, L); launch_phase<6>(grid, stream, a, L); launch_phase<7>(grid, stream, a, L);
        launch_phase<8>(grid, stream, a, L); launch_phase<9>(grid, stream, a, L); launch_phase<10>(grid, stream, a, L); launch_phase<11>(grid, stream, a, L);
        launch_phase<12>(grid, stream, a, L); launch_phase<13>(grid, stream, a, L); launch_phase<14>(grid, stream, a, L);
    }
    launch_phase<15>(grid, stream, a, 0);
#else
    (void)hipMemsetAsync((char*)d_ws + WS_CTL, 0, CTL_ZERO_BYTES, stream);
    a.ph_lo = 0; a.ph_hi = 0;
    hipLaunchKernelGGL(mk_fwd, dim3(grid), dim3(512), LDS_BYTES, stream, a);
#endif
}
```

```cpp
#include <hip/hip_runtime.h>
#include <cstdio>
#include <cstdint>

#define LAS __attribute__((address_space(3)))
typedef unsigned short bf16_t;
typedef short bf16x8 __attribute__((ext_vector_type(8)));
typedef float f32x4 __attribute__((ext_vector_type(4)));
typedef float f32x2 __attribute__((ext_vector_type(2)));
typedef unsigned u32x4 __attribute__((ext_vector_type(4)));
typedef unsigned u32x2 __attribute__((ext_vector_type(2)));

#define SCAN_DUP 0
#ifndef SCAN_DUP
#define SCAN_DUP 0
#endif
#ifndef MK_PER_PHASE
#define MK_PER_PHASE 0
#endif

constexpr int M = 32768, D = 1024, SEQ = 2048, NLAYER = 4, INW = 8320, NHEAD = 16;
constexpr int RAWLD = 3328;
constexpr float NORM_EPS = 1e-6f, LNX_EPS = 64e-5f;

constexpr size_t MiB = 1u << 20;
constexpr size_t WS_CTL = 0, CTL_ZERO_BYTES = 16384;
constexpr size_t WS_WINT = 1 * MiB;
constexpr size_t WS_WPP = WS_WINT + (size_t)(INW + 128) * D * 2;
constexpr size_t WS_WRP = WS_WPP + 2 * MiB;
constexpr size_t WS_WOUT = WS_WRP + 2 * MiB;
constexpr size_t WS_LINT = WS_WOUT + 2 * MiB;
constexpr size_t WS_EAT = WS_LINT + MiB / 2;
constexpr size_t WS_VFIRST = 25 * MiB;
constexpr size_t WS_RAW = 89 * MiB;
constexpr size_t WS_RAWB = 153 * MiB;
constexpr size_t WS_S1 = 297 * MiB, WS_S2 = 361 * MiB, WS_S3 = 425 * MiB;
constexpr size_t WS_TW = 489 * MiB;
constexpr size_t WS_END = 505 * MiB;
static_assert(WS_EAT + MiB <= WS_VFIRST, "weights fit");
constexpr int R_RGATE = 2048, R_RKV = 3072, R_FOLD = 6272, R_GPOOL = 6400, R_GRWKV = 7424;

#define XB_TMO      128
#define XB_XCNT(j)  (256  + 64 * (j))
#define XB_XSUB(j)  (1280 + 64 * (j))
#define XB_XGEN(j)  (2304 + 64 * (j))
#define XB_TOP      3328
#define XB_TOPGEN   3392
#define XCD_BAR_WORDS 3456
#define XB_SPIN_CAP (1u << 18)

__device__ __forceinline__ unsigned xb_ld(unsigned* p)              { return __hip_atomic_load(p, __ATOMIC_RELAXED, __HIP_MEMORY_SCOPE_AGENT); }
__device__ __forceinline__ unsigned xb_add(unsigned* p, unsigned v) { return __hip_atomic_fetch_add(p, v, __ATOMIC_RELAXED, __HIP_MEMORY_SCOPE_AGENT); }
__device__ __forceinline__ unsigned xb_xcc_id() { return (unsigned)__builtin_amdgcn_s_getreg((3 << 11) | 20) & 0xFu; }
#define XB_SPIN(cond, bar) do { unsigned _sp = 0; while (cond) { __builtin_amdgcn_s_sleep(1); \
    if ((++_sp & 255u) == 0u) { if (xb_ld(&(bar)[XB_TMO])) break; if (_sp > XB_SPIN_CAP) { atomicAdd(&(bar)[XB_TMO], 1u); break; } } } } while (0)

struct XcdBarrier { unsigned* bar; unsigned x; volatile LAS unsigned* st; };

__device__ __forceinline__ XcdBarrier xcd_barrier_post(unsigned* bar, volatile LAS unsigned* st) {
    XcdBarrier b; b.bar = bar; b.x = xb_xcc_id(); b.st = st;
    if (threadIdx.x == 0) (void)xb_add(&bar[XB_XCNT(b.x)], 1u);
    return b;
}
__device__ __forceinline__ void xcd_barrier_complete(unsigned* bar, unsigned x, unsigned& nloc, unsigned& nx) {
    const unsigned G = gridDim.x * gridDim.y * gridDim.z;
    unsigned sum, cnt, mine, sp = 0u;
    for (;;) {
        sum = 0u; cnt = 0u; mine = 0u;
#pragma unroll
        for (unsigned j = 0; j < 16; ++j) { const unsigned c = xb_ld(&bar[XB_XCNT(j)]); sum += c; cnt += (c > 0u) ? 1u : 0u; }
        if (sum == G) { mine = xb_ld(&bar[XB_XCNT(x)]); break; }
        __builtin_amdgcn_s_sleep(1);
        if ((++sp & 255u) == 0u) { if (xb_ld(&bar[XB_TMO])) { mine = xb_ld(&bar[XB_XCNT(x)]); break; } if (sp > XB_SPIN_CAP) { atomicAdd(&bar[XB_TMO], 1u); mine = xb_ld(&bar[XB_XCNT(x)]); break; } }
    }
    nloc = mine > 0u ? mine : 1u; nx = cnt > 0u ? cnt : 1u;
}
__device__ __forceinline__ void xcd_barrier(const XcdBarrier& b) {
    asm volatile("s_waitcnt vmcnt(0)" ::: "memory");
    __syncthreads();
    if (threadIdx.x == 0) {
        unsigned* bar = b.bar; asm volatile("" : "+s"(bar));
        __builtin_amdgcn_s_waitcnt(0);
        unsigned nloc = b.st[0], nx = b.st[1];
        if (nloc == 0u) { xcd_barrier_complete(bar, b.x, nloc, nx); b.st[0] = nloc; b.st[1] = nx; }
        const unsigned old = xb_add(&bar[XB_XSUB(b.x)], 1u);
        const unsigned gen = old / nloc;
        if (old + 1u == (gen + 1u) * nloc) {
            __builtin_amdgcn_fence(__ATOMIC_RELEASE, "agent");
            asm volatile("s_waitcnt vmcnt(0)" ::: "memory");
            const unsigned og = xb_add(&bar[XB_TOP], 1u);
            const unsigned tg = og / nx;
            if (og + 1u == (tg + 1u) * nx) xb_add(&bar[XB_TOPGEN], 1u);
            else XB_SPIN(xb_ld(&bar[XB_TOPGEN]) == tg, bar);
            __builtin_amdgcn_fence(__ATOMIC_ACQUIRE, "agent");
            xb_add(&bar[XB_XGEN(b.x)], 1u);
            asm volatile("s_waitcnt vmcnt(0)" ::: "memory");
        } else {
            XB_SPIN(xb_ld(&bar[XB_XGEN(b.x)]) == gen, bar);
            __builtin_amdgcn_fence(__ATOMIC_ACQUIRE, "agent");
            asm volatile("s_waitcnt vmcnt(0)" ::: "memory");
        }
    }
    __syncthreads();
}

__device__ __forceinline__ float bf_lo(unsigned w) { return __uint_as_float(w << 16); }
__device__ __forceinline__ float bf_hi(unsigned w) { return __uint_as_float(w & 0xffff0000u); }
typedef __bf16 bf16x2_t __attribute__((ext_vector_type(2)));
__device__ __forceinline__ unsigned pk_bf16(float lo, float hi) { bf16x2_t v; v[0] = (__bf16)lo; v[1] = (__bf16)hi; return __builtin_bit_cast(unsigned, v); }
__device__ __forceinline__ unsigned short f2bf_s(float x) { return (unsigned short)(pk_bf16(x, 0.f) & 0xffffu); }
__device__ __forceinline__ float sigmoidf_(float x) { return __builtin_amdgcn_rcpf(1.0f + __expf(-x)); }
__device__ __forceinline__ float tanhf_(float x) { return 1.0f - 2.0f * __builtin_amdgcn_rcpf(1.0f + __expf(2.0f * x)); }
template <int CTRL> __device__ __forceinline__ float dppf(float x) { return __int_as_float(__builtin_amdgcn_update_dpp(0, __float_as_int(x), CTRL, 0xf, 0xf, true)); }
__device__ __forceinline__ float red8(float x) {
    x += dppf<0xB1>(x);
    x += dppf<0x4E>(x);
    x += dppf<0x141>(x);
    return x;
}
__device__ __forceinline__ float red16(float x) {
    x += dppf<0xB1>(x);
    x += dppf<0x4E>(x);
    x += dppf<0x141>(x);
    x += dppf<0x140>(x);
    return x;
}
__device__ __forceinline__ float red64(float x) {
    x = red16(x);
    return __int_as_float(__builtin_amdgcn_readlane(__float_as_int(x), 0)) + __int_as_float(__builtin_amdgcn_readlane(__float_as_int(x), 16)) +
           __int_as_float(__builtin_amdgcn_readlane(__float_as_int(x), 32)) + __int_as_float(__builtin_amdgcn_readlane(__float_as_int(x), 48));
}

namespace pg8 {
constexpr int BM = 256, BK = 64, HALF = 128, HTB = HALF * BK * 2, STAGE_BYTES = 8 * HTB, NXCD = 8, WGM = 8;
__host__ __device__ __forceinline__ int lds_byte(int r, int c) { const int st = (r >> 4) * 2 + (c >> 5), rr = r & 15, cc = c & 31, ob = rr * 64 + cc * 2; return st * 1024 + (ob ^ (((ob >> 9) & 1) << 5)); }
__host__ __device__ __forceinline__ void stage_rc(int b, int& R, int& C) { const int st = b / 1024, sb = b % 1024, swz = sb ^ (((sb >> 9) & 1) << 5); R = (st >> 1) * 16 + swz / 64; C = (st & 1) * 32 + (swz % 64) / 2; }
__host__ __device__ __forceinline__ int perm32(int rho) { const int n = rho >> 4, i = rho & 15; return 8 * (i >> 2) + 4 * n + (i & 3); }

struct Unit { int pm, pn; };
struct Gemm { const bf16_t* A; const bf16_t* Bt; int lda, ldb, K, nM, nN, a_pn_bytes; };

struct StaticOrder {
    int nM, nN, nwg, G, c;
    __device__ void init(int nM_, int nN_, int G_, int c_) { nM = nM_; nN = nN_; nwg = nM * nN; G = G_; c = c_; }
    __device__ bool next(int i, Unit& u) const {
        const long L = (long)i * G + c; if (L >= nwg) return false;
        int wgid = (int)L; { const int q = nwg / NXCD, r = nwg % NXCD, xcd = wgid % NXCD, off = wgid / NXCD; wgid = (xcd < r ? xcd * (q + 1) : r * (q + 1) + (xcd - r) * q) + off; }
        const int nig = WGM * nN, gid = wgid / nig, fm = gid * WGM, gsz = (nM - fm) < WGM ? (nM - fm) : WGM;
        u.pm = fm + ((wgid % nig) % gsz); u.pn = (wgid % nig) / gsz; return true;
    }
};

template <class Epi, bool ALIGN_EPI = true, bool SP2 = true>
__device__ __forceinline__ void gemm_phase(LAS unsigned char* lds, const Gemm g, const StaticOrder& S, const Epi& E) {
    int tid_ = threadIdx.x; asm volatile("" : "+v"(tid_));
    const int tid = tid_, wid = __builtin_amdgcn_readfirstlane(tid >> 6), lane = tid & 63, wr = wid >> 2, wc = wid & 3, fr = lane & 15, fq = lane >> 4;
    int K_ = g.K; asm volatile("" : "+s"(K_));
    const int K = K_, nt = K / BK;
    unsigned voffA[2], voffB[2];
#pragma unroll
    for (int i = 0; i < 2; ++i) { int R, C; stage_rc(tid * 16 + i * 8192, R, C); const int Rb = Epi::PERM ? ((R & ~31) + perm32(R & 31)) : R;
        voffA[i] = (unsigned)(R * g.lda + C) * 2u; voffB[i] = (unsigned)(Rb * g.ldb + C) * 2u; }
    const size_t kstep = (size_t)(BK * 2);
    const size_t hstepA = (size_t)HALF * g.lda * 2, hstepB = (size_t)HALF * g.ldb * 2;
    const size_t tstepA = 2 * hstepA, tstepB = 2 * hstepB;
    const unsigned ldsw = (unsigned)wid * 1024u;
    const int aoff = lds_byte(wr * 64 + fr, fq * 8), boff = lds_byte(wc * 32 + fr, fq * 8);
#define PG8_SA(b, h) (((b) * 2 + (h)) * HTB)
#define PG8_SB(b, h) ((4 + (b) * 2 + (h)) * HTB)
#define PG8_STAGE(bufoff, gbase, voff) do { _Pragma("unroll") for (int _i = 0; _i < 2; ++_i) \
        __builtin_amdgcn_global_load_lds((const unsigned*)((const char*)(gbase) + (voff)[_i]), (LAS unsigned*)(lds + (bufoff) + ldsw + _i * 8192), 16, 0, 0); } while (0)
#define PG8_LDA(dst, b, h) do { _Pragma("unroll") for (int m = 0; m < 4; ++m) _Pragma("unroll") for (int k = 0; k < 2; ++k) dst[m][k] = *(const LAS bf16x8*)(lds + PG8_SA(b, h) + aoff + m * 2048 + k * 1024); } while (0)
#define PG8_LDB(dst, b, h) do { _Pragma("unroll") for (int n = 0; n < 2; ++n) _Pragma("unroll") for (int k = 0; k < 2; ++k) dst[n][k] = *(const LAS bf16x8*)(lds + PG8_SB(b, h) + boff + n * 2048 + k * 1024); } while (0)
#define PG8_MMA(ai, bj, At, Bt) do { __builtin_amdgcn_s_setprio(1); _Pragma("unroll") for (int m = 0; m < 4; ++m) _Pragma("unroll") for (int n = 0; n < 2; ++n) _Pragma("unroll") for (int k = 0; k < 2; ++k) \
        acc[ai][bj][m][n] = __builtin_amdgcn_mfma_f32_16x16x32_bf16(Bt[n][k], At[m][k], acc[ai][bj][m][n], 0, 0, 0); __builtin_amdgcn_s_setprio(0); } while (0)
#define PG8_WAIT_V(n) asm volatile("s_waitcnt vmcnt(" #n ")" ::: "memory")
#define PG8_WAIT_L(n) asm volatile("s_waitcnt lgkmcnt(" #n ")" ::: "memory")
#define PG8_BAR __builtin_amdgcn_s_barrier()
#define PG8_SCHED __builtin_amdgcn_sched_barrier(0)
    Unit cur, nxt; int ui = 0;
    if (!S.next(0, cur)) return;
    f32x4 acc[2][2][4][2];
#pragma unroll
    for (int a = 0; a < 2; ++a)
#pragma unroll
        for (int b = 0; b < 2; ++b)
#pragma unroll
            for (int m = 0; m < 4; ++m)
#pragma unroll
                for (int n = 0; n < 2; ++n) acc[a][b][m][n] = (f32x4){0.f, 0.f, 0.f, 0.f};
    bf16x8 At[4][2], B0[2][2], B1[2][2];
    const char* cA = (const char*)g.A + (size_t)cur.pm * tstepA + (size_t)cur.pn * g.a_pn_bytes; const char* cB = (const char*)g.Bt + (size_t)cur.pn * tstepB;
    if constexpr (SP2) {
        PG8_STAGE(PG8_SB(0, 0), cB, voffB); PG8_STAGE(PG8_SB(0, 1), cB + hstepB, voffB); PG8_STAGE(PG8_SA(0, 0), cA, voffA); PG8_STAGE(PG8_SA(0, 1), cA + hstepA, voffA);
        if (wr == 1) PG8_BAR;
        PG8_WAIT_V(2); PG8_BAR;
        PG8_STAGE(PG8_SB(1, 0), cB + kstep, voffB); PG8_STAGE(PG8_SA(1, 0), cA + kstep, voffA); PG8_STAGE(PG8_SB(1, 1), cB + hstepB + kstep, voffB);
        PG8_WAIT_V(6); PG8_BAR;
    } else {
        PG8_STAGE(PG8_SB(0, 0), cB, voffB); PG8_STAGE(PG8_SA(0, 0), cA, voffA); PG8_STAGE(PG8_SB(0, 1), cB + hstepB, voffB); PG8_STAGE(PG8_SA(0, 1), cA + hstepA, voffA);
        if (wr == 1) PG8_BAR;
        PG8_WAIT_V(4); PG8_BAR;
        PG8_STAGE(PG8_SB(1, 0), cB + kstep, voffB); PG8_STAGE(PG8_SA(1, 0), cA + kstep, voffA); PG8_STAGE(PG8_SB(1, 1), cB + hstepB + kstep, voffB);
        PG8_WAIT_V(6); PG8_BAR;
    }
    for (;;) {
        const bool has_next = S.next(ui + 1, nxt);
        const char* nA = has_next ? (const char*)g.A + (size_t)nxt.pm * tstepA + (size_t)nxt.pn * g.a_pn_bytes : cA; const char* nB = has_next ? (const char*)g.Bt + (size_t)nxt.pn * tstepB : cB;
        for (int t = 0; t < nt; t += 2) {
            const bool last = (t == nt - 2);
            const char* a1 = cA + (size_t)(t + 1) * kstep;
            const char* a2 = last ? nA : cA + (size_t)(t + 2) * kstep; const char* b2 = last ? nB : cB + (size_t)(t + 2) * kstep;
            const char* a3 = a2 + kstep; const char* b3 = b2 + kstep;
            if constexpr (SP2) {
            PG8_LDB(B0, 0, 0); PG8_LDB(B1, 0, 1); PG8_SCHED; PG8_LDA(At, 0, 0); PG8_STAGE(PG8_SA(1, 1), a1 + hstepA, voffA);
            PG8_WAIT_V(8); PG8_WAIT_L(0); PG8_BAR; PG8_MMA(0, 0, At, B0); PG8_MMA(0, 1, At, B1); PG8_BAR; PG8_SCHED;
            PG8_LDA(At, 0, 1); PG8_STAGE(PG8_SB(0, 0), b2, voffB); PG8_STAGE(PG8_SB(0, 1), b2 + hstepB, voffB); PG8_STAGE(PG8_SA(0, 0), a2, voffA);
            PG8_WAIT_V(8); PG8_WAIT_L(0); PG8_BAR; PG8_MMA(1, 0, At, B0); PG8_MMA(1, 1, At, B1); PG8_BAR; PG8_SCHED;
            PG8_LDB(B0, 1, 0); PG8_LDB(B1, 1, 1); PG8_SCHED; PG8_LDA(At, 1, 0); PG8_STAGE(PG8_SA(0, 1), a2 + hstepA, voffA);
            PG8_WAIT_V(8); PG8_WAIT_L(0); PG8_BAR; PG8_MMA(0, 0, At, B0); PG8_MMA(0, 1, At, B1); PG8_BAR; PG8_SCHED;
            PG8_LDA(At, 1, 1); PG8_STAGE(PG8_SB(1, 0), b3, voffB); PG8_STAGE(PG8_SB(1, 1), b3 + hstepB, voffB); PG8_STAGE(PG8_SA(1, 0), a3, voffA);
            PG8_WAIT_V(8); PG8_WAIT_L(0); PG8_BAR; PG8_MMA(1, 0, At, B0); PG8_MMA(1, 1, At, B1); PG8_BAR; PG8_SCHED;
            } else {
            PG8_LDB(B0, 0, 0); PG8_SCHED; PG8_LDA(At, 0, 0); PG8_STAGE(PG8_SA(1, 1), a1 + hstepA, voffA);
            PG8_WAIT_L(8); PG8_BAR; PG8_WAIT_L(0); PG8_MMA(0, 0, At, B0); PG8_BAR; PG8_SCHED;
            PG8_LDB(B1, 0, 1); PG8_STAGE(PG8_SB(0, 0), b2, voffB);
            PG8_BAR; PG8_WAIT_L(0); PG8_MMA(0, 1, At, B1); PG8_BAR;
            PG8_LDA(At, 0, 1); PG8_STAGE(PG8_SA(0, 0), a2, voffA);
            PG8_BAR; PG8_WAIT_L(0); PG8_MMA(1, 0, At, B0); PG8_BAR; PG8_SCHED;
            PG8_STAGE(PG8_SB(0, 1), b2 + hstepB, voffB);
            PG8_WAIT_V(6); PG8_BAR; PG8_MMA(1, 1, At, B1); PG8_BAR;
            PG8_LDB(B0, 1, 0); PG8_SCHED; PG8_LDA(At, 1, 0); PG8_STAGE(PG8_SA(0, 1), a2 + hstepA, voffA);
            PG8_WAIT_L(8); PG8_BAR; PG8_WAIT_L(0); PG8_MMA(0, 0, At, B0); PG8_BAR; PG8_SCHED;
            PG8_LDB(B1, 1, 1); PG8_STAGE(PG8_SB(1, 0), b3, voffB);
            PG8_BAR; PG8_WAIT_L(0); PG8_MMA(0, 1, At, B1); PG8_BAR;
            PG8_LDA(At, 1, 1); PG8_STAGE(PG8_SA(1, 0), a3, voffA);
            PG8_BAR; PG8_WAIT_L(0); PG8_MMA(1, 0, At, B0); PG8_BAR; PG8_SCHED;
            PG8_STAGE(PG8_SB(1, 1), b3 + hstepB, voffB);
            PG8_WAIT_V(6); PG8_BAR; PG8_MMA(1, 1, At, B1); PG8_BAR;
            }
        }
        if constexpr (ALIGN_EPI) { if (wr == 0) PG8_BAR; }
        E(acc, cur, wr, wc, fr, fq);
        if (!has_next) break;
#pragma unroll
        for (int a = 0; a < 2; ++a)
#pragma unroll
            for (int b = 0; b < 2; ++b)
#pragma unroll
                for (int m = 0; m < 4; ++m)
#pragma unroll
                    for (int n = 0; n < 2; ++n) acc[a][b][m][n] = (f32x4){0.f, 0.f, 0.f, 0.f};
        cur = nxt; cA = nA; cB = nB; ++ui;
        if constexpr (ALIGN_EPI) { if (wr == 1) PG8_BAR; }
    }
    PG8_WAIT_V(0);
    if constexpr (!ALIGN_EPI) { if (wr == 0) PG8_BAR; }
    PG8_BAR;
#undef PG8_SA
#undef PG8_SB
#undef PG8_STAGE
#undef PG8_LDA
#undef PG8_LDB
#undef PG8_MMA
#undef PG8_WAIT_V
#undef PG8_WAIT_L
#undef PG8_BAR
#undef PG8_SCHED
}

enum { ACT_NONE = 0, ACT_SILU = 1, ACT_SIGMOID = 2, ACT_DECAY = 3 };
template <int ACT> __device__ __forceinline__ float actf(float v) {
    if (ACT == ACT_SILU) return v * sigmoidf_(v);
    if (ACT == ACT_SIGMOID) return sigmoidf_(v);
    if (ACT == ACT_DECAY) return 0.60653065971f * sigmoidf_(v);
    return v;
}
struct EpiCfg {
    bf16_t* out; int ldo;
    const float* bias;
    const float* cscale;
    const bf16_t* in1; int ld1;
    const bf16_t* in2; int ld2;
};
template <int ACT_A, int ACT_B, int ACT_C = ACT_NONE> struct EpiG {
    static constexpr bool PERM = true;
    EpiCfg a, b; int split; EpiCfg c = {}; int split2 = 1 << 30;
    template <int ACT> __device__ __forceinline__ void run(const EpiCfg& c, int colt, const f32x4 (&acc)[2][2][4][2], const Unit& u, int wr, int wc, int fr, int fq) const {
        const int row0 = u.pm * BM + wr * 64 + fr, col0 = colt + wc * 32 + 8 * fq;
        f32x4 bv[2][2], sv[2][2];
#pragma unroll
        for (int bj = 0; bj < 2; ++bj)
#pragma unroll
            for (int n = 0; n < 2; ++n) {
                bv[bj][n] = c.bias ? *(const f32x4*)(c.bias + col0 + bj * HALF + 4 * n) : (f32x4){0.f, 0.f, 0.f, 0.f};
                sv[bj][n] = c.cscale ? *(const f32x4*)(c.cscale + col0 + bj * HALF + 4 * n) : (f32x4){1.f, 1.f, 1.f, 1.f};
            }
#pragma unroll
        for (int ai = 0; ai < 2; ++ai)
#pragma unroll
            for (int m = 0; m < 4; ++m) {
                const size_t row = (size_t)(row0 + ai * HALF + m * 16);
#pragma unroll
                for (int bj = 0; bj < 2; ++bj) {
                    const int cc = col0 + bj * HALF;
                    f32x4 v0 = acc[ai][bj][m][0] + bv[bj][0], v1 = acc[ai][bj][m][1] + bv[bj][1];
#pragma unroll
                    for (int j = 0; j < 4; ++j) { v0[j] = actf<ACT>(v0[j]); v1[j] = actf<ACT>(v1[j]); }
                    if (c.in1) { const u32x4 w = *(const u32x4*)(c.in1 + row * c.ld1 + cc);
                        v0[0] *= bf_lo(w.x); v0[1] *= bf_hi(w.x); v0[2] *= bf_lo(w.y); v0[3] *= bf_hi(w.y);
                        v1[0] *= bf_lo(w.z); v1[1] *= bf_hi(w.z); v1[2] *= bf_lo(w.w); v1[3] *= bf_hi(w.w); }
                    if (c.cscale) { v0 *= sv[bj][0]; v1 *= sv[bj][1]; }
                    if (c.in2) { const u32x4 w = *(const u32x4*)(c.in2 + row * c.ld2 + cc);
                        v0[0] += bf_lo(w.x); v0[1] += bf_hi(w.x); v0[2] += bf_lo(w.y); v0[3] += bf_hi(w.y);
                        v1[0] += bf_lo(w.z); v1[1] += bf_hi(w.z); v1[2] += bf_lo(w.w); v1[3] += bf_hi(w.w); }
                    u32x4 w; w.x = pk_bf16(v0[0], v0[1]); w.y = pk_bf16(v0[2], v0[3]); w.z = pk_bf16(v1[0], v1[1]); w.w = pk_bf16(v1[2], v1[3]);
                    *(u32x4*)(c.out + row * c.ldo + cc) = w;
                }
            }
    }
    __device__ __forceinline__ void operator()(const f32x4 (&acc)[2][2][4][2], const Unit& u, int wr, int wc, int fr, int fq) const {
        const int colt = u.pn * BM;
        if (colt >= split2) run<ACT_C>(c, colt - split2, acc, u, wr, wc, fr, fq);
        else if (colt >= split) run<ACT_B>(b, colt - split, acc, u, wr, wc, fr, fq);
        else run<ACT_A>(a, colt, acc, u, wr, wc, fr, fq);
    }
};
struct EpiRawT {
    static constexpr bool PERM = true;
    bf16_t* out; int ncols;
    __device__ __forceinline__ void operator()(const f32x4 (&acc)[2][2][4][2], const Unit& u, int wr, int wc, int fr, int fq) const {
        const int ch0 = u.pm * BM + wr * 64 + fr, tok0 = u.pn * BM + wc * 32 + 8 * fq;
#pragma unroll
        for (int ai = 0; ai < 2; ++ai)
#pragma unroll
            for (int m = 0; m < 4; ++m) {
                const int ch = ch0 + ai * HALF + m * 16;
#pragma unroll
                for (int bj = 0; bj < 2; ++bj) {
                    const int tok = tok0 + bj * HALF;
                    const f32x4 v0 = acc[ai][bj][m][0], v1 = acc[ai][bj][m][1];
                    u32x4 w; w.x = pk_bf16(v0[0], v0[1]); w.y = pk_bf16(v0[2], v0[3]); w.z = pk_bf16(v1[0], v1[1]); w.w = pk_bf16(v1[2], v1[3]);
                    *(u32x4*)(out + ((size_t)(tok >> 4) * ncols + ch) * 16 + (tok & 15)) = w;
                }
            }
    }
};
struct EpiResid {
    static constexpr bool PERM = false;
    float* X; int ldc; const float* Xin;
    __device__ __forceinline__ void operator()(const f32x4 (&acc)[2][2][4][2], const Unit& u, int wr, int wc, int fr, int fq) const {
        const int row0 = u.pm * BM + wr * 64 + fr, col0 = u.pn * BM + wc * 32 + 4 * fq;
#pragma unroll
        for (int ai = 0; ai < 2; ++ai)
#pragma unroll
            for (int m = 0; m < 4; ++m) { float* rowp = X + (size_t)(row0 + ai * HALF + m * 16) * ldc + col0;
#pragma unroll
                for (int bj = 0; bj < 2; ++bj)
#pragma unroll
                    for (int n = 0; n < 2; ++n) { f32x4* p = (f32x4*)(rowp + bj * HALF + n * 16); *p = *(const f32x4*)(Xin + (p - (f32x4*)X) * 4) + acc[ai][bj][m][n]; } }
    }
};
}

struct Args {
    const float* in[22];
    float* out; unsigned char* ws;
    int ph_lo, ph_hi;
};
typedef const Args __attribute__((address_space(4)))* ArgsP;
struct Frame {
    LAS unsigned char* lds;
    int tid, lane, wave, G, bid;
    ArgsP ap;
    float* X; unsigned char* ws;
    bf16_t *WinT, *WppT, *WrpT, *WoutT, *LinT, *EAT, *VF, *RAW, *RAWB, *S1, *S2, *S3, *TW;
};

__device__ __forceinline__ void set_ws(Frame& F, unsigned char* ws) {
    F.ws = ws;
    F.WinT = (bf16_t*)(ws + WS_WINT); F.WppT = (bf16_t*)(ws + WS_WPP); F.WrpT = (bf16_t*)(ws + WS_WRP); F.WoutT = (bf16_t*)(ws + WS_WOUT);
    F.LinT = (bf16_t*)(ws + WS_LINT); F.EAT = (bf16_t*)(ws + WS_EAT); F.VF = (bf16_t*)(ws + WS_VFIRST);
    F.RAW = (bf16_t*)(ws + WS_RAW); F.RAWB = (bf16_t*)(ws + WS_RAWB); F.S1 = (bf16_t*)(ws + WS_S1); F.S2 = (bf16_t*)(ws + WS_S2); F.S3 = (bf16_t*)(ws + WS_S3);
    F.TW = (bf16_t*)(ws + WS_TW);
}
__device__ __forceinline__ void transpose_cvt(const Frame& F, const float* src, int ldn, int K, int N, bf16_t* dst, int ldk) {
    LAS float* tile = (LAS float*)F.lds;
    const int tilesK = K / 64, ntile = tilesK * (N / 64);
    for (int tl = F.bid; tl < ntile; tl += F.G) {
        const int k0 = (tl % tilesK) * 64, n0 = (tl / tilesK) * 64;
#pragma unroll
        for (int i = 0; i < 8; ++i) { const int idx = F.tid + 512 * i, r = idx >> 6, c = idx & 63; tile[r * 65 + c] = src[(size_t)(k0 + r) * ldn + n0 + c]; }
        __syncthreads();
#pragma unroll
        for (int i = 0; i < 4; ++i) { const int idx = F.tid + 512 * i, n = idx >> 5, kp = idx & 31;
            *(unsigned*)(dst + (size_t)(n0 + n) * ldk + k0 + 2 * kp) = pk_bf16(tile[(2 * kp) * 65 + n], tile[(2 * kp + 1) * 65 + n]); }
        __syncthreads();
    }
}
__device__ __forceinline__ void fold_weights(const Frame& F, int L) {
    const int fr = F.lane & 15, fq = F.lane >> 4;
    LAS float* red = (LAS float*)F.lds;
    for (int tl = F.bid; tl < 64 * 4; tl += F.G) {
        const int k0 = (tl >> 2) * 16, j0 = (tl & 3) * 16, jj = j0 + fr;
        f32x4 acc = (f32x4){0.f, 0.f, 0.f, 0.f};
        if (L > 0) {
            const int cw = F.wave * 128 + 32 * fq;
            const float* arow = F.ap->in[2] + (size_t)L * D * INW + 4096 + (size_t)(k0 + fr) * INW + cw;
            const float* mu = F.ap->in[6] + (size_t)L * 3200 + 2048 + cw;
            const float* V1 = F.ap->in[12] + (size_t)(L - 1) * D * 32 + (size_t)cw * 32 + (jj & 31);
#pragma unroll
            for (int s4 = 0; s4 < 8; ++s4) {
                const f32x4 a4 = *(const f32x4*)(arow + 4 * s4), m4 = *(const f32x4*)(mu + 4 * s4);
#pragma unroll
                for (int e = 0; e < 4; ++e) acc = __builtin_amdgcn_mfma_f32_16x16x4f32(a4[e], V1[(size_t)(4 * s4 + e) * 32] * ((jj < 32) ? (1.0f - m4[e]) : m4[e]), acc, 0, 0, 0);
            }
        }
        *(LAS f32x4*)(red + (F.wave * 64 + F.lane) * 4) = acc;
        __syncthreads();
        if (F.wave == 0) {
            f32x4 t = acc;
#pragma unroll
            for (int w = 1; w < 8; ++w) t += *(const LAS f32x4*)(red + (w * 64 + F.lane) * 4);
            *(u32x2*)(F.WinT + (size_t)(R_FOLD + jj) * D + k0 + 4 * fq) = (u32x2){pk_bf16(t[0], t[1]), pk_bf16(t[2], t[3])};
            unsigned zz = 0u; asm volatile("" : "+v"(zz));
            *(u32x2*)(F.WinT + (size_t)(R_FOLD + 64 + jj) * D + k0 + 4 * fq) = (u32x2){zz, zz};
        }
        __syncthreads();
    }
    if (L > 0) { const float* V2 = F.ap->in[13] + (size_t)(L - 1) * 32 * D;
        for (int idx = F.bid * 512 + F.tid; idx < D * 32; idx += F.G * 512) { const int n = idx >> 5, j = idx & 31; F.EAT[131072 + idx] = f2bf_s(V2[(size_t)j * D + n]); } }
}
__device__ __forceinline__ void fold_pool_lin(const Frame& F, int L) {
    const float* win = F.ap->in[2] + (size_t)L * D * INW;
    const int fr = F.lane & 15, fq = F.lane >> 4;
    for (int tl = F.bid * 8 + F.wave; tl < 4 * 64 * 16; tl += F.G * 8) {
        const int g = tl >> 10, k0 = ((tl >> 4) & 63) * 16, d0 = (tl & 15) * 16;
        const float* arow = win + (size_t)(k0 + fr) * INW + 256 * g + 64 * fq;
        const float* bcol = F.ap->in[3] + ((size_t)(L * 4 + g) * 256 + 64 * fq) * 256 + d0 + fr;
        f32x4 acc = (f32x4){0.f, 0.f, 0.f, 0.f};
#pragma unroll 4
        for (int s4 = 0; s4 < 16; ++s4) {
            const f32x4 a4 = *(const f32x4*)(arow + 4 * s4);
#pragma unroll
            for (int e = 0; e < 4; ++e) acc = __builtin_amdgcn_mfma_f32_16x16x4f32(a4[e], bcol[(size_t)(4 * s4 + e) * 256], acc, 0, 0, 0);
        }
        *(u32x2*)(F.WinT + (size_t)(256 * g + d0 + fr) * D + k0 + 4 * fq) = (u32x2){pk_bf16(acc[0], acc[1]), pk_bf16(acc[2], acc[3])};
    }
}
__device__ __forceinline__ void convert_weights(const Frame& F, int L) {
    transpose_cvt(F, F.ap->in[2] + (size_t)L * D * INW + 1024, INW, D, 1024, F.WinT + (size_t)1024 * D, D);
    transpose_cvt(F, F.ap->in[2] + (size_t)L * D * INW + 2048, INW, D, 3200, F.WinT + (size_t)R_RKV * D, D);
    fold_pool_lin(F, L);
    transpose_cvt(F, F.ap->in[2] + (size_t)L * D * INW + 5248, INW, D, 1024, F.WinT + (size_t)R_RGATE * D, D);
    transpose_cvt(F, F.ap->in[2] + (size_t)L * D * INW + 6272, INW, D, 2048, F.WinT + (size_t)R_GPOOL * D, D);
    fold_weights(F, L);
    transpose_cvt(F, F.ap->in[5] + (size_t)L * D * D, D, D, D, F.WppT, D);
    transpose_cvt(F, F.ap->in[19] + (size_t)L * D * D, D, D, D, F.WrpT, D);
    transpose_cvt(F, F.ap->in[20] + (size_t)L * D * D, D, D, D, F.WoutT, D);
    transpose_cvt(F, F.ap->in[8] + (size_t)L * 64 * D, D, 64, D, F.EAT, 64);
    transpose_cvt(F, F.ap->in[10] + (size_t)L * 64 * D, D, 64, D, F.EAT + 65536, 64);
}
__device__ __forceinline__ void rmsnorm_rows(const Frame& F, const float* src, const float* g, bf16_t* H, bf16_t* copy_to) {
    for (int m = F.bid * 8 + F.wave; m < M; m += F.G * 8) {
        const float* xr = src + (size_t)m * D;
        f32x4 v[4]; float ss = 0.f;
#pragma unroll
        for (int i = 0; i < 4; ++i) { v[i] = *(const f32x4*)(xr + F.lane * 4 + 256 * i); ss += v[i][0] * v[i][0] + v[i][1] * v[i][1] + v[i][2] * v[i][2] + v[i][3] * v[i][3]; }
        ss = red64(ss);
        const float rs = __builtin_amdgcn_rsqf(ss * (1.0f / D) + NORM_EPS);
#pragma unroll
        for (int i = 0; i < 4; ++i) {
            const int c = F.lane * 4 + 256 * i;
            if (copy_to) *(u32x2*)(copy_to + (size_t)m * D + c) = (u32x2){pk_bf16(v[i][0], v[i][1]), pk_bf16(v[i][2], v[i][3])};
            const f32x4 gg = *(const f32x4*)(g + c);
            u32x2 w; w.x = pk_bf16(v[i][0] * rs * gg[0], v[i][1] * rs * gg[1]); w.y = pk_bf16(v[i][2] * rs * gg[2], v[i][3] * rs * gg[3]);
            *(u32x2*)(H + (size_t)m * D + c) = w;
        }
    }
}
__device__ __forceinline__ void rmsnorm_rows_bf(const Frame& F, const bf16_t* Xb, const float* g, bf16_t* H) {
    for (int m = F.bid * 8 + F.wave; m < M; m += F.G * 8) {
        const bf16_t* xr = Xb + (size_t)m * D;
        u32x4 w[2]; float ss = 0.f;
#pragma unroll
        for (int i = 0; i < 2; ++i) { w[i] = *(const u32x4*)(xr + F.lane * 8 + 512 * i);
#pragma unroll
            for (int e = 0; e < 4; ++e) { const float a = bf_lo(w[i][e]), b = bf_hi(w[i][e]); ss += a * a + b * b; } }
        ss = red64(ss);
        const float rs = __builtin_amdgcn_rsqf(ss * (1.0f / D) + NORM_EPS);
#pragma unroll
        for (int i = 0; i < 2; ++i) {
            const int c = F.lane * 8 + 512 * i;
            const f32x4 g0 = *(const f32x4*)(g + c), g1 = *(const f32x4*)(g + c + 4);
            u32x4 o; o.x = pk_bf16(bf_lo(w[i].x) * rs * g0[0], bf_hi(w[i].x) * rs * g0[1]); o.y = pk_bf16(bf_lo(w[i].y) * rs * g0[2], bf_hi(w[i].y) * rs * g0[3]);
            o.z = pk_bf16(bf_lo(w[i].z) * rs * g1[0], bf_hi(w[i].z) * rs * g1[1]); o.w = pk_bf16(bf_lo(w[i].w) * rs * g1[2], bf_hi(w[i].w) * rs * g1[3]);
            *(u32x4*)(H + (size_t)m * D + c) = o;
        }
    }
}
__device__ __forceinline__ void final_norm(const Frame& F, const bf16_t* Xb) {
    const float* g = F.ap->in[21];
    for (int m = F.bid * 8 + F.wave; m < M; m += F.G * 8) {
        const bf16_t* xr = Xb + (size_t)m * D;
        u32x4 w[2]; float ss = 0.f;
#pragma unroll
        for (int i = 0; i < 2; ++i) { w[i] = *(const u32x4*)(xr + F.lane * 8 + 512 * i);
#pragma unroll
            for (int e = 0; e < 4; ++e) { const float a = bf_lo(w[i][e]), b = bf_hi(w[i][e]); ss += a * a + b * b; } }
        ss = red64(ss);
        const float rs = __builtin_amdgcn_rsqf(ss * (1.0f / D) + NORM_EPS);
#pragma unroll
        for (int i = 0; i < 2; ++i) {
            const int c = F.lane * 8 + 512 * i;
            const f32x4 g0 = *(const f32x4*)(g + c), g1 = *(const f32x4*)(g + c + 4);
            *(f32x4*)(F.X + (size_t)m * D + c) = (f32x4){bf_lo(w[i].x) * rs * g0[0], bf_hi(w[i].x) * rs * g0[1], bf_lo(w[i].y) * rs * g0[2], bf_hi(w[i].y) * rs * g0[3]};
            *(f32x4*)(F.X + (size_t)m * D + c + 4) = (f32x4){bf_lo(w[i].z) * rs * g1[0], bf_hi(w[i].z) * rs * g1[1], bf_lo(w[i].w) * rs * g1[2], bf_hi(w[i].w) * rs * g1[3]};
        }
    }
}
__device__ __forceinline__ void tw_phase(const Frame& F, int L) {
    const float* mu = F.ap->in[6] + (size_t)L * 3200;
    for (int it = F.bid * 512 + F.tid; it < M * 32; it += F.G * 512) {
        const int m = it >> 5, j = it & 31; u32x4 o = (u32x4){0u, 0u, 0u, 0u};
        if (j < 16) {
            const int c0 = 3072 + 8 * j, t = m & (SEQ - 1);
            const u32x4 cw = *(const u32x4*)(F.RAW + (size_t)m * RAWLD + c0);
            u32x4 pw = (u32x4){0u, 0u, 0u, 0u}; if (t > 0) pw = *(const u32x4*)(F.RAW + (size_t)(m - 1) * RAWLD + c0);
            const f32x4 m0 = *(const f32x4*)(mu + c0), m1 = *(const f32x4*)(mu + c0 + 4);
            float s[8];
#define SH(i, cwv, pwv, muv, hi) { const float c_ = hi ? bf_hi(cwv) : bf_lo(cwv), p_ = hi ? bf_hi(pwv) : bf_lo(pwv); s[i] = c_ + (muv) * (p_ - c_); }
            SH(0, cw.x, pw.x, m0[0], 0) SH(1, cw.x, pw.x, m0[1], 1) SH(2, cw.y, pw.y, m0[2], 0) SH(3, cw.y, pw.y, m0[3], 1)
            SH(4, cw.z, pw.z, m1[0], 0) SH(5, cw.z, pw.z, m1[1], 1) SH(6, cw.w, pw.w, m1[2], 0) SH(7, cw.w, pw.w, m1[3], 1)
#undef SH
            if (j < 8) {
#pragma unroll
                for (int i = 0; i < 8; ++i) s[i] = tanhf_(s[i]);
            }
            o.x = pk_bf16(s[0], s[1]); o.y = pk_bf16(s[2], s[3]); o.z = pk_bf16(s[4], s[5]); o.w = pk_bf16(s[6], s[7]);
        }
        *(u32x4*)(F.TW + (size_t)m * 256 + 8 * j) = o;
    }
}
__device__ __forceinline__ void vmix_phase(const Frame& F, int L) {
    const float* mu = F.ap->in[6] + (size_t)L * 3200 + 2048;
    const int tid = F.tid, c0 = 2 * tid;
    const f32x2 muv = *(const f32x2*)(mu + c0);
    LAS float* vsh = (LAS float*)F.lds;
    LAS float* part = (LAS float*)(F.lds + 16384);
    LAS float* midl = (LAS float*)(F.lds + 16384 + 8192);
    bf16_t* dst = (L == 0) ? F.VF : F.S3;
    float v1r[64]; f32x2 v2r[32]; f32x2 v0v = (f32x2){0.f, 0.f};
    const int jj = tid & 31, cs = tid >> 5;
    if (L > 0) {
        const float* V1 = F.ap->in[12] + (size_t)(L - 1) * D * 32; const float* V2 = F.ap->in[13] + (size_t)(L - 1) * 32 * D;
#pragma unroll
        for (int i = 0; i < 64; ++i) v1r[i] = V1[(size_t)(cs * 64 + i) * 32 + jj];
#pragma unroll
        for (int j = 0; j < 32; ++j) v2r[j] = *(const f32x2*)(V2 + (size_t)j * D + c0);
        v0v = *(const f32x2*)(F.ap->in[11] + (size_t)(L - 1) * D + c0);
    }
    for (int grp = F.bid; grp < M / 4; grp += F.G) {
        const int m0 = grp * 4, t0 = m0 & (SEQ - 1);
        unsigned rw[5];
        rw[0] = (t0 > 0) ? *(const unsigned*)(F.RAW + (size_t)(m0 - 1) * RAWLD + 2048 + c0) : 0u;
#pragma unroll
        for (int i = 0; i < 4; ++i) rw[i + 1] = *(const unsigned*)(F.RAW + (size_t)(m0 + i) * RAWLD + 2048 + c0);
        f32x2 vs[4];
#pragma unroll
        for (int i = 0; i < 4; ++i) { const float c_lo = bf_lo(rw[i + 1]), c_hi = bf_hi(rw[i + 1]), p_lo = bf_lo(rw[i]), p_hi = bf_hi(rw[i]);
            vs[i].x = c_lo + muv.x * (p_lo - c_lo); vs[i].y = c_hi + muv.y * (p_hi - c_hi); }
        if (L == 0) {
#pragma unroll
            for (int i = 0; i < 4; ++i) *(unsigned*)(dst + (size_t)(m0 + i) * D + c0) = pk_bf16(vs[i].x, vs[i].y);
            continue;
        }
#pragma unroll
        for (int i = 0; i < 4; ++i) *(LAS f32x2*)(vsh + i * 1024 + c0) = vs[i];
        __syncthreads();
#pragma unroll
        for (int i = 0; i < 4; ++i) {
            float p = 0.f;
#pragma unroll
            for (int k4 = 0; k4 < 16; ++k4) { const f32x4 x = *(const LAS f32x4*)(vsh + i * 1024 + cs * 64 + 4 * k4);
                p += x[0] * v1r[4 * k4] + x[1] * v1r[4 * k4 + 1] + x[2] * v1r[4 * k4 + 2] + x[3] * v1r[4 * k4 + 3]; }
            part[(i * 16 + cs) * 32 + jj] = p;
        }
        __syncthreads();
        if (tid < 128) { const int i = tid >> 5; float s = 0.f;
#pragma unroll
            for (int k = 0; k < 16; ++k) s += part[(i * 16 + k) * 32 + jj];
            midl[i * 32 + jj] = s; }
        __syncthreads();
#pragma unroll
        for (int i = 0; i < 4; ++i) {
            float z0 = v0v.x, z1 = v0v.y;
#pragma unroll
            for (int j4 = 0; j4 < 8; ++j4) { const f32x4 mm = *(const LAS f32x4*)(midl + i * 32 + 4 * j4);
#pragma unroll
                for (int e = 0; e < 4; ++e) { z0 += mm[e] * v2r[4 * j4 + e].x; z1 += mm[e] * v2r[4 * j4 + e].y; } }
            const float g0 = sigmoidf_(z0), g1 = sigmoidf_(z1);
            const unsigned fw = *(const unsigned*)(F.VF + (size_t)(m0 + i) * D + c0);
            const float o0 = vs[i].x + (bf_lo(fw) - vs[i].x) * g0, o1 = vs[i].y + (bf_hi(fw) - vs[i].y) * g1;
            *(unsigned*)(dst + (size_t)(m0 + i) * D + c0) = pk_bf16(o0, o1);
        }
        __syncthreads();
    }
}
__device__ __forceinline__ void poold_phase(const Frame& F, const bf16_t* PIN, bf16_t* SGIO, const float* scale) {
    for (int it = F.bid * 512 + F.tid; it < (M / 32) * 128; it += F.G * 512) {
        const int j = it & 127, m0 = (it >> 7) * 32, t0 = m0 & (SEQ - 1), w = 2 << (j >> 5);
        const bf16_t* col = PIN + 8 * j;
        const f32x4 sc0 = *(const f32x4*)(scale + 8 * j), sc1 = *(const f32x4*)(scale + 8 * j + 4);
        float s[8];
#pragma unroll
        for (int e = 0; e < 8; ++e) s[e] = 0.f;
        if (t0 > 0) {
            for (int i = 1; i < w; ++i) { const u32x4 x = *(const u32x4*)(col + (size_t)(m0 - i) * D);
                s[0] += bf_lo(x.x); s[1] += bf_hi(x.x); s[2] += bf_lo(x.y); s[3] += bf_hi(x.y); s[4] += bf_lo(x.z); s[5] += bf_hi(x.z); s[6] += bf_lo(x.w); s[7] += bf_hi(x.w); }
        }
        for (int i = 0; i < 32; ++i) {
            const int t = t0 + i; const size_t m = (size_t)(m0 + i);
            const u32x4 x = *(const u32x4*)(col + m * D);
            const float c[8] = {bf_lo(x.x), bf_hi(x.x), bf_lo(x.y), bf_hi(x.y), bf_lo(x.z), bf_hi(x.z), bf_lo(x.w), bf_hi(x.w)};
#pragma unroll
            for (int e = 0; e < 8; ++e) s[e] += c[e];
            if (t >= w && i > 0) { const u32x4 o = *(const u32x4*)(col + (m - w) * D);
                s[0] -= bf_lo(o.x); s[1] -= bf_hi(o.x); s[2] -= bf_lo(o.y); s[3] -= bf_hi(o.y); s[4] -= bf_lo(o.z); s[5] -= bf_hi(o.z); s[6] -= bf_lo(o.w); s[7] -= bf_hi(o.w); }
            const float inv = __builtin_amdgcn_rcpf((float)((t + 1 < w) ? (t + 1) : w));
            const u32x4 gw = *(const u32x4*)(SGIO + m * D + 8 * j);
            u32x4 r; r.x = pk_bf16((s[0] * inv - c[0]) * sc0[0] * bf_lo(gw.x), (s[1] * inv - c[1]) * sc0[1] * bf_hi(gw.x)); r.y = pk_bf16((s[2] * inv - c[2]) * sc0[2] * bf_lo(gw.y), (s[3] * inv - c[3]) * sc0[3] * bf_hi(gw.y));
            r.z = pk_bf16((s[4] * inv - c[4]) * sc1[0] * bf_lo(gw.z), (s[5] * inv - c[5]) * sc1[1] * bf_hi(gw.z)); r.w = pk_bf16((s[6] * inv - c[6]) * sc1[2] * bf_lo(gw.w), (s[7] * inv - c[7]) * sc1[3] * bf_hi(gw.w));
            *(u32x4*)(SGIO + m * D + 8 * j) = r;
        }
    }
}

constexpr int SC_T = 32;
constexpr int SC_ARR = SC_T * 64;
constexpr int SC_BUF_BYTES = 6 * SC_ARR * 4;
constexpr int SC_YS = 2 * SC_BUF_BYTES, SC_RAWR = SC_YS + SC_ARR * 4, SC_RAWK = SC_RAWR + SC_ARR * 4, SC_PREV = SC_RAWK + SC_ARR * 4;
static_assert(SC_PREV + 1024 <= 131072, "scan LDS");

#define QP(n) "quad_perm:[" #n "," #n "," #n "," #n "] row_mask:0xf bank_mask:0xf"
__device__ __forceinline__ void sc_matvec(float& o0, float& o1, const f32x2 x, const float (&S)[8]) {
    asm volatile("s_nop 1\n\t"
        "v_mul_f32_dpp %0, %2, %4 " QP(0) "\n\t"  "v_mul_f32_dpp %1, %3, %5 " QP(0) "\n\t"
        "v_fmac_f32_dpp %0, %2, %6 " QP(1) "\n\t" "v_fmac_f32_dpp %1, %3, %7 " QP(1) "\n\t"
        "v_fmac_f32_dpp %0, %2, %8 " QP(2) "\n\t" "v_fmac_f32_dpp %1, %3, %9 " QP(2) "\n\t"
        "v_fmac_f32_dpp %0, %2, %10 " QP(3) "\n\t" "v_fmac_f32_dpp %1, %3, %11 " QP(3)
        : "=&v"(o0), "=&v"(o1) : "v"(x.x), "v"(x.y), "v"(S[0]), "v"(S[1]), "v"(S[2]), "v"(S[3]), "v"(S[4]), "v"(S[5]), "v"(S[6]), "v"(S[7]));
}
__device__ __forceinline__ void sc_update(float (&S)[8], const f32x2 w, const f32x2 b, const f32x2 k, const float sa, const float vv) {
    asm volatile("s_nop 1\n\t"
        "v_mul_f32_dpp %0, %8, %0 " QP(0) "\n\t" "v_mul_f32_dpp %1, %9, %1 " QP(0) "\n\t"
        "v_mul_f32_dpp %2, %8, %2 " QP(1) "\n\t" "v_mul_f32_dpp %3, %9, %3 " QP(1) "\n\t"
        "v_mul_f32_dpp %4, %8, %4 " QP(2) "\n\t" "v_mul_f32_dpp %5, %9, %5 " QP(2) "\n\t"
        "v_mul_f32_dpp %6, %8, %6 " QP(3) "\n\t" "v_mul_f32_dpp %7, %9, %7 " QP(3) "\n\t"
        "v_fmac_f32_dpp %0, %10, %14 " QP(0) "\n\t" "v_fmac_f32_dpp %1, %11, %14 " QP(0) "\n\t"
        "v_fmac_f32_dpp %2, %10, %14 " QP(1) "\n\t" "v_fmac_f32_dpp %3, %11, %14 " QP(1) "\n\t"
        "v_fmac_f32_dpp %4, %10, %14 " QP(2) "\n\t" "v_fmac_f32_dpp %5, %11, %14 " QP(2) "\n\t"
        "v_fmac_f32_dpp %6, %10, %14 " QP(3) "\n\t" "v_fmac_f32_dpp %7, %11, %14 " QP(3) "\n\t"
        "v_fmac_f32_dpp %0, %12, %15 " QP(0) "\n\t" "v_fmac_f32_dpp %1, %13, %15 " QP(0) "\n\t"
        "v_fmac_f32_dpp %2, %12, %15 " QP(1) "\n\t" "v_fmac_f32_dpp %3, %13, %15 " QP(1) "\n\t"
        "v_fmac_f32_dpp %4, %12, %15 " QP(2) "\n\t" "v_fmac_f32_dpp %5, %13, %15 " QP(2) "\n\t"
        "v_fmac_f32_dpp %6, %12, %15 " QP(3) "\n\t" "v_fmac_f32_dpp %7, %13, %15 " QP(3)
        : "+v"(S[0]), "+v"(S[1]), "+v"(S[2]), "+v"(S[3]), "+v"(S[4]), "+v"(S[5]), "+v"(S[6]), "+v"(S[7])
        : "v"(w.x), "v"(w.y), "v"(b.x), "v"(b.y), "v"(k.x), "v"(k.y), "v"(sa), "v"(vv));
}
__device__ __forceinline__ float sc_red(float x) {
    asm volatile("s_nop 1\n\tv_add_f32_dpp %0, %0, %0 row_ror:4 row_mask:0xf bank_mask:0xf\n\ts_nop 1\n\tv_add_f32_dpp %0, %0, %0 row_ror:8 row_mask:0xf bank_mask:0xf" : "+v"(x));
    const auto r = __builtin_amdgcn_permlane32_swap(__float_as_uint(x), __float_as_uint(x), false, false);
    return __uint_as_float(r[0]) + __uint_as_float(r[1]);
}
#undef QP
struct ScanRegs { u32x2 rr, kr, ee, aa, vv; };
__device__ __forceinline__ void scan_phase(const Frame& F, int L, const bf16_t* VP) {
    const int tid = F.tid, lane = F.lane, wave = F.wave;
    LAS float* Ys = (LAS float*)(F.lds + SC_YS);
    LAS float* rawR = (LAS float*)(F.lds + SC_RAWR);
    LAS float* rawK = (LAS float*)(F.lds + SC_RAWK);
    LAS float* prevRK = (LAS float*)(F.lds + SC_PREV);
    const int tok = tid >> 4, q = tid & 15;
    const int kc = ((lane >> 5) << 2) | ((lane >> 2) & 3), row = wave * 8 + ((lane >> 4) & 1) * 4 + (lane & 3), koff = 8 * kc + 2 * (lane & 3);
    for (int unit = F.bid; unit < 256; unit += F.G) {
        const int b = unit >> 4, h = unit & 15, hc = h * 64 + 4 * q;
        const f32x4 kk4 = *(const f32x4*)(F.ap->in[14] + (size_t)L * D + hc), ka4 = *(const f32x4*)(F.ap->in[15] + (size_t)L * D + hc);
        const f32x4 rk4 = *(const f32x4*)(F.ap->in[16] + (size_t)L * D + hc);
        const f32x4 lw4 = *(const f32x4*)(F.ap->in[17] + (size_t)L * D + hc), lb4 = *(const f32x4*)(F.ap->in[18] + (size_t)L * D + hc);
        const f32x4 mur4 = *(const f32x4*)(F.ap->in[6] + (size_t)L * 3200 + hc), muk4 = *(const f32x4*)(F.ap->in[6] + (size_t)L * 3200 + 1024 + hc);
        const size_t mrow0 = (size_t)b * SEQ;
        float S[8];
#pragma unroll
        for (int j = 0; j < 8; ++j) S[j] = 0.f;
        ScanRegs R;
#define SC_LOAD(cidx) do { const size_t m_ = mrow0 + (size_t)(cidx) * SC_T + tok; \
            R.rr = *(const u32x2*)(F.RAW + m_ * RAWLD + hc); R.kr = *(const u32x2*)(F.RAW + m_ * RAWLD + 1024 + hc); \
            R.ee = *(const u32x2*)(F.S1 + m_ * D + hc); R.aa = *(const u32x2*)(F.S2 + m_ * D + hc); R.vv = *(const u32x2*)(VP + m_ * D + hc); } while (0)
#define SC_PREP(cidx) do { \
            const f32x4 rc = (f32x4){bf_lo(R.rr.x), bf_hi(R.rr.x), bf_lo(R.rr.y), bf_hi(R.rr.y)}; \
            const f32x4 kc = (f32x4){bf_lo(R.kr.x), bf_hi(R.kr.x), bf_lo(R.kr.y), bf_hi(R.kr.y)}; \
            *(LAS f32x4*)(rawR + tok * 64 + 4 * q) = rc; *(LAS f32x4*)(rawK + tok * 64 + 4 * q) = kc; \
            __syncthreads(); \
            f32x4 rp, kp; \
            if (tok > 0) { rp = *(const LAS f32x4*)(rawR + (tok - 1) * 64 + 4 * q); kp = *(const LAS f32x4*)(rawK + (tok - 1) * 64 + 4 * q); } \
            else if ((cidx) > 0) { rp = *(const LAS f32x4*)(prevRK + (((cidx) & 1) * 2 + 0) * 64 + 4 * q); kp = *(const LAS f32x4*)(prevRK + (((cidx) & 1) * 2 + 1) * 64 + 4 * q); } \
            else { rp = (f32x4){0.f, 0.f, 0.f, 0.f}; kp = rp; } \
            if (tok == SC_T - 1) { *(LAS f32x4*)(prevRK + ((((cidx) + 1) & 1) * 2 + 0) * 64 + 4 * q) = rc; *(LAS f32x4*)(prevRK + ((((cidx) + 1) & 1) * 2 + 1) * 64 + 4 * q) = kc; } \
            const f32x4 rs = rc + mur4 * (rp - rc), ks = kc + muk4 * (kp - kc); \
            const f32x4 ev = (f32x4){bf_lo(R.ee.x), bf_hi(R.ee.x), bf_lo(R.ee.y), bf_hi(R.ee.y)}; \
            const f32x4 av = (f32x4){bf_lo(R.aa.x), bf_hi(R.aa.x), bf_lo(R.aa.y), bf_hi(R.aa.y)}; \
            const f32x4 vv = (f32x4){bf_lo(R.vv.x), bf_hi(R.vv.x), bf_lo(R.vv.y), bf_hi(R.vv.y)}; \
            f32x4 kkv = ks * kk4; \
            float ss = kkv[0] * kkv[0] + kkv[1] * kkv[1] + kkv[2] * kkv[2] + kkv[3] * kkv[3]; ss = red16(ss); \
            const float inv = 1.0f / fmaxf(sqrtf(ss), 1e-12f); kkv = kkv * inv; \
            const f32x4 kmod = ks * (1.0f + (av - 1.0f) * ka4); \
            f32x4 wv; wv[0] = __expf(-ev[0]); wv[1] = __expf(-ev[1]); wv[2] = __expf(-ev[2]); wv[3] = __expf(-ev[3]); \
            LAS float* cb_ = (LAS float*)(F.lds + ((cidx) & 1) * SC_BUF_BYTES) + tok * 64 + 4 * q; \
            *(LAS f32x4*)(cb_ + 0 * SC_ARR) = rs; *(LAS f32x4*)(cb_ + 1 * SC_ARR) = wv; *(LAS f32x4*)(cb_ + 2 * SC_ARR) = kmod; \
            *(LAS f32x4*)(cb_ + 3 * SC_ARR) = -kkv; *(LAS f32x4*)(cb_ + 4 * SC_ARR) = kkv * av; *(LAS f32x4*)(cb_ + 5 * SC_ARR) = vv; } while (0)
        SC_LOAD(0);
        SC_PREP(0);
        __syncthreads();
        for (int c = 0; c < SEQ / SC_T; ++c) {
            if (c + 1 < SEQ / SC_T) SC_LOAD(c + 1);
            const LAS float* cb = (const LAS float*)(F.lds + (c & 1) * SC_BUF_BYTES);
            const LAS float* pin = cb + koff;
            const LAS float* pv = cb + 5 * SC_ARR + row;
#define SC_LD(dst, t_) do { dst##r = *(const LAS f32x2*)(pin + 0 * SC_ARR + (t_) * 64); dst##w = *(const LAS f32x2*)(pin + 1 * SC_ARR + (t_) * 64); dst##k = *(const LAS f32x2*)(pin + 2 * SC_ARR + (t_) * 64); \
                dst##a = *(const LAS f32x2*)(pin + 3 * SC_ARR + (t_) * 64); dst##b = *(const LAS f32x2*)(pin + 4 * SC_ARR + (t_) * 64); dst##v = pv[(t_) * 64]; } while (0)
#define SC_STEP(src, t_) do { float p0_, p1_; sc_matvec(p0_, p1_, src##a, S); const float sa_ = sc_red(p0_ + p1_); sc_update(S, src##w, src##b, src##k, sa_, src##v); \
                sc_matvec(p0_, p1_, src##r, S); const float y_ = sc_red(p0_ + p1_); if (kc == 0) Ys[(t_) * 64 + row] = y_; } while (0)
            f32x2 Ar, Aw, Ak, Aa, Ab, Br, Bw, Bk, Ba, Bb; float Av, Bv;
            SC_LD(A, 0);
            for (int t = 0; t < SC_T; t += 2) {
                SC_LD(B, t + 1);
                SC_STEP(A, t);
                if (t + 2 < SC_T) SC_LD(A, t + 2);
                SC_STEP(B, t + 1);
            }
#undef SC_LD
#undef SC_STEP
            __syncthreads();
            {
                const f32x4 y4 = *(const LAS f32x4*)(Ys + tok * 64 + 4 * q);
                const float mean = red16((y4[0] + y4[1]) + (y4[2] + y4[3])) * (1.0f / 64.0f);
                const f32x4 d = y4 - mean;
                const float var = red16((d[0] * d[0] + d[1] * d[1]) + (d[2] * d[2] + d[3] * d[3])) * (1.0f / 64.0f);
                const float rstd = __builtin_amdgcn_rsqf(var + LNX_EPS);
                const f32x4 rs = *(const LAS f32x4*)(cb + 0 * SC_ARR + tok * 64 + 4 * q), km = *(const LAS f32x4*)(cb + 2 * SC_ARR + tok * 64 + 4 * q), vv = *(const LAS f32x4*)(cb + 5 * SC_ARR + tok * 64 + 4 * q);
                const f32x4 pr = rs * km * rk4;
                const float bon = red16((pr[0] + pr[1]) + (pr[2] + pr[3]));
                const f32x4 z = d * rstd * lw4 + lb4 + bon * vv;
                u32x2 o; o.x = pk_bf16(z[0], z[1]); o.y = pk_bf16(z[2], z[3]);
                *(u32x2*)(F.RAW + (mrow0 + (size_t)c * SC_T + tok) * RAWLD + hc) = o;
            }
            if (c + 1 < SEQ / SC_T) SC_PREP(c + 1);
            __syncthreads();
        }
#undef SC_LOAD
#undef SC_PREP
    }
}


constexpr int C2_AT = 0, C2_RT = 2048, C2_BK = 4096, C2_VT = 8192, C2_NAK = 10240, C2_NRBK = 10752, C2_MT = 11776, C2_GTV = 12288, C2_BON = 12544, C2_CH = 12800;
constexpr int C2_YS = 8 * C2_CH;
constexpr int C2_PREV = C2_YS + 32768;
constexpr int C2_W2S = C2_PREV + 512, C2_A2S = C2_W2S + 8192;
constexpr int C2_V2S = C2_A2S + 8192;
static_assert(C2_V2S + 8192 <= 163776, "scan LDS");
typedef short s16x4 __attribute__((ext_vector_type(4)));
__device__ __forceinline__ u32x2 tr4(const LAS unsigned char* img, int k0, int lane) {
    return __builtin_bit_cast(u32x2, __builtin_amdgcn_ds_read_tr16_b64_v4i16((LAS s16x4*)(img + (k0 + ((lane & 15) >> 2)) * 32 + (lane & 3) * 8)));
}
__device__ __forceinline__ u32x2 tr4bk(const LAS unsigned char* img, int k0, int lane) {
    return __builtin_bit_cast(u32x2, __builtin_amdgcn_ds_read_tr16_b64_v4i16((LAS s16x4*)(img + (k0 + ((lane & 15) >> 2)) * 64 + (lane & 3) * 16)));
}
__device__ __forceinline__ void wr_row(LAS unsigned char* img, int lane, const unsigned (&w)[8]) {
    *(LAS u32x4*)(img + lane * 32) = (u32x4){w[0], w[1], w[2], w[3]}; *(LAS u32x4*)(img + lane * 32 + 16) = (u32x4){w[4], w[5], w[6], w[7]};
}
__device__ __forceinline__ bf16x8 mk_frag(u32x2 lo, u32x2 hi) { return __builtin_bit_cast(bf16x8, (u32x4){lo.x, lo.y, hi.x, hi.y}); }
__device__ __forceinline__ u32x2 pk4(const f32x4 a) { return (u32x2){pk_bf16(a[0], a[1]), pk_bf16(a[2], a[3])}; }
__device__ __forceinline__ float bf1(unsigned short v) { return __uint_as_float((unsigned)v << 16); }
__device__ __forceinline__ unsigned short f2bf(float x) { return (unsigned short)(pk_bf16(x, 0.f) & 0xffffu); }
__device__ __forceinline__ void st2(LAS unsigned char* p0, LAS unsigned char* p1, float a, float b) { const unsigned w = pk_bf16(a, b); *(LAS unsigned short*)p0 = (unsigned short)w; *(LAS unsigned short*)p1 = (unsigned short)(w >> 16); }
__device__ __forceinline__ void scan2_phase(const Frame& F, int L) {
    const int tid = F.tid, lane = F.lane, wave = F.wave, fr = lane & 15, fq = lane >> 4;
    LAS unsigned char* lds = F.lds;
    for (int unit = F.bid; unit < 256; unit += F.G) {
        const int b = unit >> 4, h = unit & 15, ch = h * 64 + lane;
        const size_t mrow0 = (size_t)b * SEQ;
        const float c_kk = F.ap->in[14][(size_t)L * D + ch], c_ka = F.ap->in[15][(size_t)L * D + ch], c_rk = F.ap->in[16][(size_t)L * D + ch];
        const float c_mur = F.ap->in[6][(size_t)L * 3200 + ch], c_muk = F.ap->in[6][(size_t)L * 3200 + 1024 + ch];
        const int ptok = tid >> 2, pj = tid & 3;
        f32x4 St[4];
#pragma unroll
        for (int i = 0; i < 4; ++i) St[i] = (f32x4){0.f, 0.f, 0.f, 0.f};
        int tid_u = tid; asm volatile("" : "+v"(tid_u));
        for (int i = tid_u; i < 1024; i += 512) { const int which = i >> 9, e = i & 511;
            *(LAS u32x4*)(lds + C2_W2S + which * 8192 + e * 16) = *(const u32x4*)(F.EAT + (size_t)which * 65536 + (size_t)h * 64 * 64 + e * 8); }
        if (L > 0) for (int e = tid_u; e < 512; e += 512) { const int chl = e >> 3, p = e & 7;
            *(LAS u32x4*)(lds + C2_V2S + e * 16) = *(const u32x4*)(F.EAT + 131072 + (size_t)(h * 64 + chl) * 32 + ((8 * p) & 31)); }
        const float c_muw = F.ap->in[6][(size_t)L * 3200 + 3072 + lane], c_mua = F.ap->in[6][(size_t)L * 3200 + 3136 + lane], c_muv = F.ap->in[6][(size_t)L * 3200 + 2048 + ch];
        float c_v0[4];
#pragma unroll
        for (int i = 0; i < 4; ++i) c_v0[i] = F.ap->in[11][(size_t)(L > 0 ? L - 1 : 0) * D + h * 64 + 16 * i + (lane & 15)];
        float c_w0[4], c_a0[4];
#pragma unroll
        for (int i = 0; i < 4; ++i) { c_w0[i] = F.ap->in[7][(size_t)L * D + h * 64 + 16 * i + (lane & 15)]; c_a0[i] = F.ap->in[9][(size_t)L * D + h * 64 + 16 * i + (lane & 15)]; }
        __syncthreads();
        const auto rs_raw = __builtin_amdgcn_make_buffer_rsrc((void*)F.RAW, 0, (int)((size_t)M * RAWLD * 2), 0x00020000);
        const auto rs_vf = __builtin_amdgcn_make_buffer_rsrc((void*)F.VF, 0, M * D * 2, 0x00020000);
        const int voh = ch * 32, vol = lane * 32;
#define LDQ(vofs, q, tb) __builtin_bit_cast(u32x4, __builtin_amdgcn_raw_buffer_load_b128(rs_raw, (vofs) + (q) * 16, (int)(tb) * (RAWLD * 32), 0))
#define LDP(vofs, tb) __builtin_amdgcn_raw_buffer_load_b16(rs_raw, (vofs) + 30, (int)(tb) * (RAWLD * 32), 0)
#define QF(q, t) (((t) & 1) ? bf_hi((q)[(t) >> 1]) : bf_lo((q)[(t) >> 1]))
#define QP(q, pv, i) (((i) == 0) ? bf1(pv) : QF(q, ((i) > 0 ? (i) - 1 : 0)))

        for (int g = 0; g < SEQ / 128; ++g) {
            {
                int lane_ = lane; asm volatile("" : "+v"(lane_));
                const int fr = lane_ & 15, fq = lane_ >> 4;
                const int m0 = (int)mrow0 + g * 128 + wave * 16;
                LAS unsigned char* cb = lds + wave * C2_CH;
                LAS unsigned char* scr = lds + C2_YS + wave * 4096;
                const int tb = m0 >> 4, tbp = (tb > 0) ? tb - 1 : 0;
                unsigned rrq[8], krq[8], aaq[8], eeq[8], vvp[8];
                unsigned vrq[8], xrq[8], mixq[8]; unsigned short vprev, xprev;
                {
                    unsigned wdq[8], adq[8]; unsigned short wprev, aprev;
                    const bool has_prev = (g > 0) || (wave > 0);
                    const unsigned short pm = has_prev ? (unsigned short)0xffffu : (unsigned short)0;
                    wprev = LDP(vol + 3072 * 32, tbp) & pm; aprev = LDP(vol + 3136 * 32, tbp) & pm;
#pragma unroll
                    for (int q = 0; q < 2; ++q) { const u32x4 w4 = LDQ(vol + 3072 * 32, q, tb), a4 = LDQ(vol + 3136 * 32, q, tb);
#pragma unroll
                        for (int e = 0; e < 4; ++e) { wdq[4 * q + e] = w4[e]; adq[4 * q + e] = a4[e]; } }
                    {
                        vprev = LDP(voh + 2048 * 32, tbp) & pm; xprev = LDP(vol + 3200 * 32, tbp) & pm;
#pragma unroll
                        for (int q = 0; q < 2; ++q) { const u32x4 v4 = LDQ(voh + 2048 * 32, q, tb), x4 = LDQ(vol + 3200 * 32, q, tb);
                            const u32x4 f4 = __builtin_bit_cast(u32x4, __builtin_amdgcn_raw_buffer_load_b128(rs_vf, voh + q * 16, tb * (D * 32), 0));
#pragma unroll
                            for (int e = 0; e < 4; ++e) { vrq[4 * q + e] = v4[e]; xrq[4 * q + e] = x4[e]; mixq[4 * q + e] = f4[e]; } }
                    }
                    __builtin_amdgcn_sched_barrier(0);
                    unsigned twp[8], adp[8];
#pragma unroll
                    for (int t = 0; t < 16; t += 2) {
                        const float w0_ = QP(wdq, wprev, t), w1_ = QP(wdq, wprev, t + 1), w2_ = QP(wdq, wprev, t + 2), a0_ = QP(adq, aprev, t), a1_ = QP(adq, aprev, t + 1), a2_ = QP(adq, aprev, t + 2);
                        twp[t >> 1] = pk_bf16(tanhf_(w1_ + c_muw * (w0_ - w1_)), tanhf_(w2_ + c_muw * (w1_ - w2_)));
                        adp[t >> 1] = pk_bf16(a1_ + c_mua * (a0_ - a1_), a2_ + c_mua * (a1_ - a2_));
                    }
                    wr_row(scr, lane, twp); wr_row(scr + 2048, lane, adp);
                    asm volatile("s_waitcnt lgkmcnt(0)" ::: "memory");
                    f32x4 le[4], la[4];
#pragma unroll
                    for (int i = 0; i < 4; ++i) { le[i] = (f32x4){0.f, 0.f, 0.f, 0.f}; la[i] = le[i]; }
#pragma unroll
                    for (int s2 = 0; s2 < 2; ++s2) {
                        const int k0 = 32 * s2 + 8 * fq;
                        const bf16x8 fw = mk_frag(tr4(scr, k0, lane), tr4(scr, k0 + 4, lane)), fa = mk_frag(tr4(scr + 2048, k0, lane), tr4(scr + 2048, k0 + 4, lane));
#pragma unroll
                        for (int i = 0; i < 4; ++i) {
                            le[i] = __builtin_amdgcn_mfma_f32_16x16x32_bf16(fw, *(const LAS bf16x8*)(lds + C2_W2S + (16 * i + fr) * 128 + (32 * s2 + 8 * fq) * 2), le[i], 0, 0, 0);
                            la[i] = __builtin_amdgcn_mfma_f32_16x16x32_bf16(fa, *(const LAS bf16x8*)(lds + C2_A2S + (16 * i + fr) * 128 + (32 * s2 + 8 * fq) * 2), la[i], 0, 0, 0);
                        }
                    }
#pragma unroll
                    for (int i = 0; i < 4; ++i)
                        {
                            *(LAS u32x2*)(scr + (16 * i + fr) * 32 + fq * 8) = (u32x2){pk_bf16(0.60653065971f * sigmoidf_(le[i][0] + c_w0[i]), 0.60653065971f * sigmoidf_(le[i][1] + c_w0[i])), pk_bf16(0.60653065971f * sigmoidf_(le[i][2] + c_w0[i]), 0.60653065971f * sigmoidf_(le[i][3] + c_w0[i]))};
                            *(LAS u32x2*)(scr + 2048 + (16 * i + fr) * 32 + fq * 8) = (u32x2){pk_bf16(sigmoidf_(la[i][0] + c_a0[i]), sigmoidf_(la[i][1] + c_a0[i])), pk_bf16(sigmoidf_(la[i][2] + c_a0[i]), sigmoidf_(la[i][3] + c_a0[i]))};
                        }
                    asm volatile("s_waitcnt lgkmcnt(0)" ::: "memory");
#pragma unroll
                    for (int q = 0; q < 2; ++q) { const u32x4 we = *(const LAS u32x4*)(scr + lane * 32 + q * 16), wa = *(const LAS u32x4*)(scr + 2048 + lane * 32 + q * 16);
#pragma unroll
                        for (int e = 0; e < 4; ++e) { eeq[4 * q + e] = we[e]; aaq[4 * q + e] = wa[e]; } }
                    asm volatile("s_waitcnt lgkmcnt(0)" ::: "memory");
                }
                unsigned tch[7];
                {   const int tbn = ((int)mrow0 + (g + 1 < SEQ / 128 ? g + 1 : g) * 128 + wave * 16) >> 4;
                    tch[0] = __builtin_amdgcn_raw_buffer_load_b32(rs_raw, vol + 3072 * 32, tbn * (RAWLD * 32), 0); tch[1] = __builtin_amdgcn_raw_buffer_load_b32(rs_raw, vol + 3136 * 32, tbn * (RAWLD * 32), 0);
                    tch[2] = __builtin_amdgcn_raw_buffer_load_b32(rs_raw, vol + 3200 * 32, tbn * (RAWLD * 32), 0); tch[3] = __builtin_amdgcn_raw_buffer_load_b32(rs_raw, voh, tbn * (RAWLD * 32), 0);
                    tch[4] = __builtin_amdgcn_raw_buffer_load_b32(rs_raw, voh + 1024 * 32, tbn * (RAWLD * 32), 0); tch[5] = __builtin_amdgcn_raw_buffer_load_b32(rs_raw, voh + 2048 * 32, tbn * (RAWLD * 32), 0);
                    tch[6] = __builtin_amdgcn_raw_buffer_load_b32(rs_vf, voh, tbn * (D * 32), 0); }
                {
                    __builtin_amdgcn_sched_barrier(0);
#pragma unroll
                    for (int q = 0; q < 2; ++q) { const u32x4 r4 = LDQ(voh, q, tb), k4 = LDQ(voh + 1024 * 32, q, tb);
#pragma unroll
                        for (int e = 0; e < 4; ++e) { rrq[4 * q + e] = r4[e]; krq[4 * q + e] = k4[e]; } }
                    __builtin_amdgcn_sched_barrier(0);
                    if (L > 0) {
                        unsigned xp[8];
#pragma unroll
                        for (int i = 0; i < 8; ++i) { const unsigned xs = (i == 0) ? ((unsigned)xprev | (xrq[0] << 16)) : __builtin_amdgcn_alignbit(xrq[i], xrq[i > 0 ? i - 1 : 0], 16);
                            xp[i] = (lane < 32) ? xrq[i] : xs; }
                        wr_row(scr, lane, xp);
                        asm volatile("s_waitcnt lgkmcnt(0)" ::: "memory");
                        f32x4 mx[4];
#pragma unroll
                        for (int i = 0; i < 4; ++i) mx[i] = (f32x4){0.f, 0.f, 0.f, 0.f};
#pragma unroll
                        for (int s2 = 0; s2 < 2; ++s2) { const bf16x8 fx = mk_frag(tr4(scr, 32 * s2 + 8 * fq, lane), tr4(scr, 32 * s2 + 8 * fq + 4, lane));
#pragma unroll
                            for (int i = 0; i < 4; ++i) mx[i] = __builtin_amdgcn_mfma_f32_16x16x32_bf16(fx, *(const LAS bf16x8*)(lds + C2_V2S + (16 * i + fr) * 128 + (32 * s2 + 8 * fq) * 2), mx[i], 0, 0, 0); }
#pragma unroll
                        for (int i = 0; i < 4; ++i)
                            *(LAS u32x2*)(scr + (16 * i + fr) * 32 + fq * 8) = (u32x2){pk_bf16(sigmoidf_(mx[i][0] + c_v0[i]), sigmoidf_(mx[i][1] + c_v0[i])), pk_bf16(sigmoidf_(mx[i][2] + c_v0[i]), sigmoidf_(mx[i][3] + c_v0[i]))};
                        asm volatile("s_waitcnt lgkmcnt(0)" ::: "memory");
                    }
                    if (L > 0) {
                        const u32x4 mw0 = *(const LAS u32x4*)(scr + lane * 32), mw1 = *(const LAS u32x4*)(scr + lane * 32 + 16);
#pragma unroll
                        for (int t = 0; t < 16; t += 2) {
                            const float v0_ = QP(vrq, vprev, t), v1_ = QP(vrq, vprev, t + 1), v2_ = QP(vrq, vprev, t + 2), vs0 = v1_ + c_muv * (v0_ - v1_), vs1 = v2_ + c_muv * (v1_ - v2_);
                            const unsigned mwp = (t < 8) ? mw0[t >> 1] : mw1[(t - 8) >> 1];
                            const float mix0 = bf_lo(mwp), mix1 = bf_hi(mwp);
                            vvp[t >> 1] = pk_bf16(vs0 + (QF(mixq, t) - vs0) * mix0, vs1 + (QF(mixq, t + 1) - vs1) * mix1);
                        }
                    } else {
#pragma unroll
                        for (int t = 0; t < 16; t += 2) {
                            const float v0_ = QP(vrq, vprev, t), v1_ = QP(vrq, vprev, t + 1), v2_ = QP(vrq, vprev, t + 2);
                            vvp[t >> 1] = pk_bf16(v1_ + c_muv * (v0_ - v1_), v2_ + c_muv * (v1_ - v2_));
                        }
#pragma unroll
                        for (int q = 0; q < 2; ++q) __builtin_amdgcn_raw_buffer_store_b128(__builtin_bit_cast(decltype(__builtin_amdgcn_raw_buffer_load_b128(rs_vf, 0, 0, 0)), (u32x4){vvp[4 * q], vvp[4 * q + 1], vvp[4 * q + 2], vvp[4 * q + 3]}), rs_vf, voh + q * 16, tb * (D * 32), 0);
                    }
                    asm volatile("s_waitcnt lgkmcnt(0)" ::: "memory");
                }
                float rprev = 0.f, kprev = 0.f;
                {
                    const float rp_g = bf1(LDP(voh, tbp)), kp_g = bf1(LDP(voh + 1024 * 32, tbp));
                    rprev = (wave > 0 || g > 0) ? rp_g : 0.f; kprev = (wave > 0 || g > 0) ? kp_g : 0.f;
                }
                const float rprev0 = rprev, kprev0 = kprev;
                float sql = 0.f, pbl = 0.f; unsigned sqp[4], pbp[4];
#pragma unroll
                for (int t = 0; t < 16; ++t) {
                    const float r_c = QF(rrq, t), k_c = QF(krq, t);
                    const float rs = r_c + c_mur * (rprev - r_c), ks = k_c + c_muk * (kprev - k_c); rprev = r_c; kprev = k_c;
                    const float al = QF(aaq, t), kmod = ks * (1.0f + (al - 1.0f) * c_ka), kkv = ks * c_kk;
                    if (t & 1) { sqp[(t >> 1) & 3] = pk_bf16(sql, kkv * kkv); pbp[(t >> 1) & 3] = pk_bf16(pbl, rs * kmod * c_rk); }
                    if ((t & 7) == 7) { *(LAS u32x4*)(scr + lane * 32 + (t >> 3) * 16) = (u32x4){sqp[0], sqp[1], sqp[2], sqp[3]}; *(LAS u32x4*)(scr + 2048 + lane * 32 + (t >> 3) * 16) = (u32x4){pbp[0], pbp[1], pbp[2], pbp[3]}; }
                    else { sql = kkv * kkv; pbl = rs * kmod * c_rk; }
                }
                asm volatile("s_waitcnt lgkmcnt(0)" ::: "memory");
                {
                    f32x4 sn = (f32x4){0.f, 0.f, 0.f, 0.f}, sb = sn;
                    const bf16x8 ones = __builtin_bit_cast(bf16x8, (u32x4){0x3f803f80u, 0x3f803f80u, 0x3f803f80u, 0x3f803f80u});
#pragma unroll
                    for (int s2 = 0; s2 < 2; ++s2) { const int k0 = 32 * s2 + 8 * fq;
                        sn = __builtin_amdgcn_mfma_f32_16x16x32_bf16(mk_frag(tr4(scr, k0, lane), tr4(scr, k0 + 4, lane)), ones, sn, 0, 0, 0);
                        sb = __builtin_amdgcn_mfma_f32_16x16x32_bf16(mk_frag(tr4(scr + 2048, k0, lane), tr4(scr + 2048, k0 + 4, lane)), ones, sb, 0, 0, 0); }
                    if (fr == 0) { *(LAS f32x4*)(cb + C2_BON + 64 + fq * 16) = sn; *(LAS f32x4*)(cb + C2_BON + fq * 16) = sb; }
                }
                asm volatile("s_waitcnt lgkmcnt(0)" ::: "memory");
                f32x4 n2v[4];
#pragma unroll
                for (int i = 0; i < 4; ++i) n2v[i] = *(const LAS f32x4*)(cb + C2_BON + 64 + i * 16);
#pragma unroll
                for (int i = 0; i < 7; ++i) asm volatile("" :: "v"(tch[i]));
                float lg = 0.f, gcarry = 1.0f;
                unsigned atp[4], rtp[4]; unsigned bkp[16];
                float btl = 0.f, ktl = 0.f, atl = 0.f, rtl = 0.f;
                rprev = rprev0; kprev = kprev0;
#pragma unroll
                for (int t = 0; t < 16; ++t) {
                    const float r_c = QF(rrq, t), k_c = QF(krq, t);
                    const float rs = r_c + c_mur * (rprev - r_c), ks = k_c + c_muk * (kprev - k_c); rprev = r_c; kprev = k_c;
                    const float al = QF(aaq, t), kmod = ks * (1.0f + (al - 1.0f) * c_ka), kkv = ks * c_kk;
                    const float kkn = kkv * __builtin_amdgcn_rsqf(fmaxf(n2v[t >> 2][t & 3], 1e-24f));
                    const float gprev = gcarry; lg -= QF(eeq, t);
                    const float gcur = __expf(lg), ginv = __builtin_amdgcn_rcpf(gcur); gcarry = gcur;
                    const float at = -kkn * gprev, rt = rs * gcur, bt = kkn * al * ginv, kt = kmod * ginv;
                    if (t & 1) {
                        atp[(t >> 1) & 3] = pk_bf16(atl, at); rtp[(t >> 1) & 3] = pk_bf16(rtl, rt); bkp[t >> 1] = pk_bf16(btl, bt); bkp[8 + (t >> 1)] = pk_bf16(ktl, kt);
                        if ((t & 7) == 7) { *(LAS u32x4*)(cb + C2_AT + lane * 32 + (t >> 3) * 16) = (u32x4){atp[0], atp[1], atp[2], atp[3]}; *(LAS u32x4*)(cb + C2_RT + lane * 32 + (t >> 3) * 16) = (u32x4){rtp[0], rtp[1], rtp[2], rtp[3]}; }
                    } else { btl = bt; ktl = kt; atl = at; rtl = rt; }
                }
                *(LAS float*)(cb + C2_GTV + lane * 4) = __expf(lg);
#pragma unroll
                for (int q = 0; q < 4; ++q) *(LAS u32x4*)(cb + C2_BK + lane * 64 + q * 16) = (u32x4){bkp[2 * q], bkp[2 * q + 1], bkp[8 + 2 * q], bkp[8 + 2 * q + 1]};
#pragma unroll
                for (int q = 0; q < 2; ++q) *(LAS u32x4*)(cb + C2_VT + lane * 32 + q * 16) = (u32x4){vvp[4 * q], vvp[4 * q + 1], vvp[4 * q + 2], vvp[4 * q + 3]};
                asm volatile("s_waitcnt lgkmcnt(0)" ::: "memory");
                f32x4 nab = (f32x4){0.f, 0.f, 0.f, 0.f}, nabT = nab, nakT = nab, nrbT = nab, nrkT = nab;
#pragma unroll
                for (int s2 = 0; s2 < 2; ++s2) {
                    const int k0 = 32 * s2 + 8 * fq;
                    const bf16x8 fa = mk_frag(tr4(cb + C2_AT, k0, lane), tr4(cb + C2_AT, k0 + 4, lane)), fr_ = mk_frag(tr4(cb + C2_RT, k0, lane), tr4(cb + C2_RT, k0 + 4, lane));
                    const bf16x8 fb = mk_frag(tr4bk(cb + C2_BK, k0, lane), tr4bk(cb + C2_BK, k0 + 4, lane)), fk = mk_frag(tr4bk(cb + C2_BK + 8, k0, lane), tr4bk(cb + C2_BK + 8, k0 + 4, lane));
                    nab = __builtin_amdgcn_mfma_f32_16x16x32_bf16(fa, fb, nab, 0, 0, 0); nabT = __builtin_amdgcn_mfma_f32_16x16x32_bf16(fb, fa, nabT, 0, 0, 0);
                    nakT = __builtin_amdgcn_mfma_f32_16x16x32_bf16(fk, fa, nakT, 0, 0, 0);
                    nrbT = __builtin_amdgcn_mfma_f32_16x16x32_bf16(fb, fr_, nrbT, 0, 0, 0); nrkT = __builtin_amdgcn_mfma_f32_16x16x32_bf16(fk, fr_, nrkT, 0, 0, 0);
                }
                const u32x2 z2 = (u32x2){0u, 0u};
                f32x4 dg;
#pragma unroll
                for (int r = 0; r < 4; ++r) {
                    const int c = 4 * fq + r;
                    dg[r] = (c == fr) ? 1.f : 0.f;
                    nakT[r] = (c < fr) ? nakT[r] : 0.f; nabT[r] = (c < fr) ? nabT[r] : 0.f; nab[r] = (fr < c) ? nab[r] : 0.f;
                    nrbT[r] = (c <= fr) ? nrbT[r] : 0.f; nrkT[r] = (c <= fr) ? nrkT[r] : 0.f;
                }
                *(LAS u32x2*)(cb + C2_NAK + fr * 32 + fq * 8) = pk4(nakT);
                { const u32x2 wb = pk4(nrbT), wk = pk4(nrkT); *(LAS u32x4*)(cb + C2_NRBK + fr * 64 + fq * 16) = (u32x4){wb.x, wb.y, wk.x, wk.y}; }
#define FRG(X) mk_frag(pk4(X), z2)
#define MM(X, Y) __builtin_amdgcn_mfma_f32_16x16x32_bf16(FRG(X), FRG(Y), (f32x4){0.f, 0.f, 0.f, 0.f}, 0, 0, 0)
                {
                    const f32x4 p2 = MM(nabT, nab), q2 = MM(nab, nabT);
                    const f32x4 p4 = MM(q2, p2), q4 = MM(p2, q2);
                    const f32x4 p8 = MM(q4, p4);
                    const f32x4 m1 = MM(nabT + dg, p2 + dg);
                    const f32x4 m2t = MM(p8 + dg, q4 + dg);
                    const f32x4 mt = MM(m1, m2t);
                    *(LAS u32x2*)(cb + C2_MT + fr * 32 + fq * 8) = pk4(mt);
                }
#undef FRG
#undef MM
            }
            __syncthreads();
            if (wave < 4) {
                const int vrow = 16 * wave + fr;
                const u32x2 z2 = (u32x2){0u, 0u};
#define CH_DECL(P) u32x2 P##nak, P##mt, P##vq; bf16x8 P##fa0, P##fa1, P##fr0, P##fr1, P##nrbk, P##bk0, P##bk1, P##bk2, P##bk3; f32x4 P##g0, P##g1, P##g2, P##g3;
#define CH_LOAD(P, c_) do { const LAS unsigned char* cb = lds + (c_) * C2_CH; \
                    P##vq = *(const LAS u32x2*)(cb + C2_VT + vrow * 32 + fq * 8); P##nak = *(const LAS u32x2*)(cb + C2_NAK + fr * 32 + fq * 8); P##mt = *(const LAS u32x2*)(cb + C2_MT + fr * 32 + fq * 8); \
                    P##fa0 = mk_frag(tr4(cb + C2_AT, 4 * fq, lane), tr4(cb + C2_AT, 16 + 4 * fq, lane)); P##fa1 = mk_frag(tr4(cb + C2_AT, 32 + 4 * fq, lane), tr4(cb + C2_AT, 48 + 4 * fq, lane)); \
                    P##fr0 = mk_frag(tr4(cb + C2_RT, 4 * fq, lane), tr4(cb + C2_RT, 16 + 4 * fq, lane)); P##fr1 = mk_frag(tr4(cb + C2_RT, 32 + 4 * fq, lane), tr4(cb + C2_RT, 48 + 4 * fq, lane)); \
                    P##nrbk = *(const LAS bf16x8*)(cb + C2_NRBK + fr * 64 + fq * 16); \
                    P##bk0 = *(const LAS bf16x8*)(cb + C2_BK + (fr) * 64 + fq * 16); P##bk1 = *(const LAS bf16x8*)(cb + C2_BK + (16 + fr) * 64 + fq * 16); \
                    P##bk2 = *(const LAS bf16x8*)(cb + C2_BK + (32 + fr) * 64 + fq * 16); P##bk3 = *(const LAS bf16x8*)(cb + C2_BK + (48 + fr) * 64 + fq * 16); \
                    P##g0 = *(const LAS f32x4*)(cb + C2_GTV + (4 * fq) * 4); P##g1 = *(const LAS f32x4*)(cb + C2_GTV + (16 + 4 * fq) * 4); \
                    P##g2 = *(const LAS f32x4*)(cb + C2_GTV + (32 + 4 * fq) * 4); P##g3 = *(const LAS f32x4*)(cb + C2_GTV + (48 + 4 * fq) * 4); } while (0)
#define CH_STEP(P, c_) do { \
                    const bf16x8 bs0 = mk_frag(pk4(St[0]), pk4(St[1])), bs1 = mk_frag(pk4(St[2]), pk4(St[3]));     \
                    f32x4 acc = (f32x4){0.f, 0.f, 0.f, 0.f}, y = acc, u = acc; \
                    acc = __builtin_amdgcn_mfma_f32_16x16x32_bf16(mk_frag(P##nak, z2), mk_frag(P##vq, z2), acc, 0, 0, 0); \
                    acc = __builtin_amdgcn_mfma_f32_16x16x32_bf16(P##fa0, bs0, acc, 0, 0, 0); \
                    acc = __builtin_amdgcn_mfma_f32_16x16x32_bf16(P##fa1, bs1, acc, 0, 0, 0); \
                    y = __builtin_amdgcn_mfma_f32_16x16x32_bf16(P##fr0, bs0, y, 0, 0, 0); \
                    y = __builtin_amdgcn_mfma_f32_16x16x32_bf16(P##fr1, bs1, y, 0, 0, 0); \
                    u = __builtin_amdgcn_mfma_f32_16x16x32_bf16(mk_frag(P##mt, z2), mk_frag(pk4(acc), z2), u, 0, 0, 0); \
                    const bf16x8 buv = mk_frag(pk4(u), P##vq); \
                    St[0] = __builtin_amdgcn_mfma_f32_16x16x32_bf16(P##bk0, buv, St[0], 0, 0, 0); St[1] = __builtin_amdgcn_mfma_f32_16x16x32_bf16(P##bk1, buv, St[1], 0, 0, 0); \
                    St[2] = __builtin_amdgcn_mfma_f32_16x16x32_bf16(P##bk2, buv, St[2], 0, 0, 0); St[3] = __builtin_amdgcn_mfma_f32_16x16x32_bf16(P##bk3, buv, St[3], 0, 0, 0); \
                    y = __builtin_amdgcn_mfma_f32_16x16x32_bf16(P##nrbk, buv, y, 0, 0, 0); \
                    St[0] = St[0] * P##g0; St[1] = St[1] * P##g1; St[2] = St[2] * P##g2; St[3] = St[3] * P##g3; \
                    _Pragma("unroll") for (int r = 0; r < 4; ++r) *(LAS float*)(lds + C2_YS + (size_t)(((c_) * 16 + 4 * fq + r) * 64 + vrow) * 4) = y[r]; } while (0)
                CH_DECL(A) CH_DECL(B)
                CH_LOAD(A, 0);
                for (int c = 0; c < 8; c += 2) {
                    CH_LOAD(B, c + 1);
                    CH_STEP(A, c);
                    if (c + 2 < 8) CH_LOAD(A, c + 2);
                    CH_STEP(B, c + 1);
                }
#undef CH_DECL
#undef CH_LOAD
#undef CH_STEP
            }
            __syncthreads();
            {
                const LAS unsigned char* cb = lds + (ptok >> 4) * C2_CH;
                f32x4 lw[4], lb[4];
#pragma unroll
                for (int i = 0; i < 4; ++i) { lw[i] = *(const f32x4*)(F.ap->in[17] + (size_t)L * D + h * 64 + 16 * pj + 4 * i); lb[i] = *(const f32x4*)(F.ap->in[18] + (size_t)L * D + h * 64 + 16 * pj + 4 * i); }
                f32x4 y4[4]; float sm = 0.f;
#pragma unroll
                for (int i = 0; i < 4; ++i) { y4[i] = *(const LAS f32x4*)(lds + C2_YS + (size_t)(ptok * 64 + 16 * pj + 4 * i) * 4); sm += (y4[i][0] + y4[i][1]) + (y4[i][2] + y4[i][3]); }
                sm += dppf<0xB1>(sm); sm += dppf<0x4E>(sm);
                const float mean = sm * (1.0f / 64.0f); float vs = 0.f;
#pragma unroll
                for (int i = 0; i < 4; ++i) { y4[i] = y4[i] - mean; vs += (y4[i][0] * y4[i][0] + y4[i][1] * y4[i][1]) + (y4[i][2] * y4[i][2] + y4[i][3] * y4[i][3]); }
                vs += dppf<0xB1>(vs); vs += dppf<0x4E>(vs);
                const float rstd = __builtin_amdgcn_rsqf(vs * (1.0f / 64.0f) + LNX_EPS);
                const float bon = *(const LAS float*)(cb + C2_BON + (ptok & 15) * 4);
                unsigned ow[8];
#pragma unroll
                for (int i = 0; i < 4; ++i) {
                    float z[4];
#pragma unroll
                    for (int e = 0; e < 4; ++e) { const float vvl = bf1(*(const LAS unsigned short*)(cb + C2_VT + (16 * pj + 4 * i + e) * 32 + (ptok & 15) * 2)); z[e] = y4[i][e] * rstd * lw[i][e] + lb[i][e] + bon * vvl; }
                    ow[2 * i] = pk_bf16(z[0], z[1]); ow[2 * i + 1] = pk_bf16(z[2], z[3]);
                }
                int ptok_ = ptok; asm volatile("" : "+v"(ptok_));
                bf16_t* zp = F.S2 + (mrow0 + (size_t)g * 128 + ptok_) * D + h * 64 + 16 * pj;
                *(u32x4*)zp = (u32x4){ow[0], ow[1], ow[2], ow[3]}; *(u32x4*)(zp + 8) = (u32x4){ow[4], ow[5], ow[6], ow[7]};
            }
            __syncthreads();
        }
    }
}

constexpr int LDS_BYTES = 163840;
constexpr int LDSCTL_OFF = 163776;
constexpr int PPL = 15;
constexpr int NPHASE = NLAYER * PPL + 1;

template <int PH> __device__ __forceinline__ void run_phase(Frame& F, int L) {
    using namespace pg8;
    { int t_ = threadIdx.x; asm volatile("" : "+v"(t_)); F.tid = t_; F.lane = t_ & 63; F.wave = __builtin_amdgcn_readfirstlane(t_ >> 6);
      int g_ = gridDim.x, b_ = blockIdx.x; asm volatile("" : "+s"(g_), "+s"(b_)); F.G = g_; F.bid = b_;
      ArgsP a_ = (ArgsP)__builtin_amdgcn_kernarg_segment_ptr(); asm volatile("" : "+s"(a_)); F.ap = a_; F.X = a_->out; set_ws(F, a_->ws); }
    if constexpr (PH == 0) {
        convert_weights(F, L);
        if (L == 0) rmsnorm_rows(F, F.ap->in[0], F.ap->in[1], F.S1, (bf16_t*)F.X);
        else rmsnorm_rows_bf(F, (const bf16_t*)F.X, F.ap->in[1] + (size_t)L * D, F.S1);
    } else if constexpr (PH == 1) {
        Gemm g{F.WinT + (size_t)R_RKV * D, F.S1, D, D, D, RAWLD / 256, M / 256, 0}; StaticOrder S; S.init(g.nM, g.nN, F.G, F.bid);
        EpiRawT E{F.RAW, RAWLD};
        gemm_phase(F.lds, g, S, E);
    } else if constexpr (PH == 2) {
    } else if constexpr (PH == 3) {
    } else if constexpr (PH == 4) {
        scan2_phase(F, L);
    } else if constexpr (PH == 5) {
    } else if constexpr (PH == 6) {
        Gemm g{F.S1, F.WinT, D, D, D, M / 256, 12, 0}; StaticOrder S; S.init(g.nM, g.nN, F.G, F.bid);
        EpiG<ACT_NONE, ACT_SILU, ACT_SILU> E{{F.RAW, D, nullptr, nullptr, nullptr, 0, nullptr, 0}, {F.RAWB, D, nullptr, nullptr, nullptr, 0, nullptr, 0}, 1024, {F.S2, D, nullptr, nullptr, F.S2, D, nullptr, 0}, 2048};
        gemm_phase(F.lds, g, S, E);
    } else if constexpr (PH == 7) {
        Gemm g{F.S2, F.WrpT, D, D, D, M / 256, 4, 0}; StaticOrder S; S.init(g.nM, g.nN, F.G, F.bid);
        EpiG<ACT_NONE, ACT_NONE> E{{F.S3, D, nullptr, nullptr, nullptr, 0, nullptr, 0}, {}, 1 << 30};
        gemm_phase(F.lds, g, S, E);
    } else if constexpr (PH == 8) {
        Gemm g{F.S1, F.WinT + (size_t)R_GRWKV * D, D, D, D, M / 256, 4, 0}; StaticOrder S; S.init(g.nM, g.nN, F.G, F.bid);
        EpiG<ACT_SIGMOID, ACT_NONE> E{{F.S3, D, nullptr, nullptr, F.S3, D, nullptr, 0}, {}, 1 << 30};
        gemm_phase(F.lds, g, S, E);
    } else if constexpr (PH == 9) {
    } else if constexpr (PH == 10) {
        poold_phase(F, F.RAW, F.RAWB, F.ap->in[4] + (size_t)L * D);
    } else if constexpr (PH == 11) {
    } else if constexpr (PH == 12) {
        Gemm g{F.RAWB, F.WppT, D, D, D, M / 256, 4, 0}; StaticOrder S; S.init(g.nM, g.nN, F.G, F.bid);
        EpiG<ACT_NONE, ACT_NONE> E{{F.RAW, D, nullptr, nullptr, nullptr, 0, nullptr, 0}, {}, 1 << 30};
        gemm_phase(F.lds, g, S, E);
    } else if constexpr (PH == 13) {
        Gemm g{F.S1, F.WinT + (size_t)R_GPOOL * D, D, D, D, M / 256, 4, 0}; StaticOrder S; S.init(g.nM, g.nN, F.G, F.bid);
        EpiG<ACT_SIGMOID, ACT_NONE> E{{F.RAW, D, nullptr, nullptr, F.RAW, D, F.S3, D}, {}, 1 << 30};
        gemm_phase(F.lds, g, S, E);
    } else if constexpr (PH == 14) {
        Gemm g{F.RAW, F.WoutT, D, D, D, M / 256, 4, 0}; StaticOrder S; S.init(g.nM, g.nN, F.G, F.bid);
        EpiG<ACT_NONE, ACT_NONE> E{{L == NLAYER - 1 ? F.S2 : (bf16_t*)F.X, D, nullptr, nullptr, nullptr, 0, (const bf16_t*)F.X, D}, {}, 1 << 30};
        gemm_phase(F.lds, g, S, E);
    } else {
        final_norm(F, F.S2);
    }
}
__device__ __forceinline__ void frame_init(Frame& F, unsigned char* lds_raw) {
    F.lds = (LAS unsigned char*)lds_raw;
    F.tid = threadIdx.x; F.lane = F.tid & 63; F.wave = __builtin_amdgcn_readfirstlane(F.tid >> 6); F.G = gridDim.x; F.bid = blockIdx.x;
    F.ap = (ArgsP)__builtin_amdgcn_kernarg_segment_ptr();
    F.X = F.ap->out;
    set_ws(F, F.ap->ws);
}
#ifndef PROBE_STAGE
#define PROBE_STAGE -1
#endif
#if MK_PER_PHASE
__global__ void __launch_bounds__(512, 2) mk_dump(Args args, size_t ws_off, int ld, int rowmask) {
    const bf16_t* src = (const bf16_t*)(args.ws + ws_off);
    for (size_t it = (size_t)blockIdx.x * 512 + threadIdx.x; it < (size_t)M * 512; it += (size_t)gridDim.x * 512) {
        const size_t m = it >> 9; const int c = (int)(it & 511) * 2; const unsigned w = *(const unsigned*)(src + (m & (size_t)rowmask) * ld + (ld == 256 ? (c & 255) : c));
        args.out[m * D + c] = 1000.f * bf_lo(w); args.out[m * D + c + 1] = 1000.f * bf_hi(w);
    }
}
template <int PH> __global__ void __launch_bounds__(512, 2) mk_phase(Args args) {
    extern __shared__ __attribute__((aligned(16))) unsigned char lds_raw[];
    Frame F; frame_init(F, lds_raw);
    run_phase<PH>(F, F.ap->ph_lo);
}
#else
__global__ void __launch_bounds__(512, 2) mk_fwd(Args args) {
    extern __shared__ __attribute__((aligned(16))) unsigned char lds_raw[];
    Frame F; frame_init(F, lds_raw);
    volatile LAS unsigned* ctlw = (volatile LAS unsigned*)(F.lds + LDSCTL_OFF);
    if (F.tid < 16) ctlw[F.tid] = 0u;
    __syncthreads();
    XcdBarrier bar = xcd_barrier_post((unsigned*)(F.ws + WS_CTL), ctlw);
    for (int L = 0; L < NLAYER; ++L) {
        run_phase<0>(F, L); xcd_barrier(bar);
        run_phase<1>(F, L); xcd_barrier(bar);
        run_phase<4>(F, L); xcd_barrier(bar);
        run_phase<6>(F, L); xcd_barrier(bar);
        run_phase<7>(F, L); xcd_barrier(bar);
        run_phase<8>(F, L); xcd_barrier(bar);
        run_phase<10>(F, L); xcd_barrier(bar);
        run_phase<12>(F, L); xcd_barrier(bar);
        run_phase<13>(F, L); xcd_barrier(bar);
        run_phase<14>(F, L); xcd_barrier(bar);
    }
    run_phase<15>(F, 0);
}
#endif

#if MK_PER_PHASE
template <int PH> static void launch_phase(int grid, hipStream_t stream, Args a, int L) { if (PH == 2 || PH == 3 || PH == 5 || PH == 11) return; a.ph_lo = L; a.ph_hi = PH; hipLaunchKernelGGL(mk_phase<PH>, dim3(grid), dim3(512), LDS_BYTES, stream, a); }
template <int PH> static bool set_lds() { return hipFuncSetAttribute((const void*)mk_phase<PH>, hipFuncAttributeMaxDynamicSharedMemorySize, LDS_BYTES) == hipSuccess; }
#endif
extern "C" void kernel_launch(void* const* d_in, const int* in_sizes, int n_in, void* d_out, int out_size, void* d_ws, size_t ws_size, hipStream_t stream) {
    static int grid = 0;
    if (grid == 0) {
        if (n_in != 22 || in_sizes[0] != M * D || out_size != M * D || ws_size < WS_END) { fprintf(stderr, "kernel_launch: unexpected shapes / workspace (%d inputs, ws %zu)\n", n_in, ws_size); grid = -1; return; }
        int dev = 0, cus = 0;
        if (hipGetDevice(&dev) != hipSuccess || hipDeviceGetAttribute(&cus, hipDeviceAttributeMultiprocessorCount, dev) != hipSuccess) { grid = -1; return; }
#if MK_PER_PHASE
        bool ok = set_lds<0>() && set_lds<1>() && set_lds<2>() && set_lds<3>() && set_lds<4>() && set_lds<5>() && set_lds<6>() && set_lds<7>() && set_lds<8>() && set_lds<9>() && set_lds<10>() && set_lds<11>()
               && set_lds<12>() && set_lds<13>() && set_lds<14>() && set_lds<15>();
        if (!ok) { fprintf(stderr, "kernel_launch: hipFuncSetAttribute failed\n"); grid = -1; return; }
#else
        int per_cu = 0;
        if (hipFuncSetAttribute((const void*)mk_fwd, hipFuncAttributeMaxDynamicSharedMemorySize, LDS_BYTES) != hipSuccess) { fprintf(stderr, "kernel_launch: hipFuncSetAttribute failed\n"); grid = -1; return; }
        if (hipOccupancyMaxActiveBlocksPerMultiprocessor(&per_cu, (const void*)mk_fwd, 512, LDS_BYTES) != hipSuccess || per_cu < 1) { fprintf(stderr, "kernel_launch: occupancy query says %d\n", per_cu); }
#endif
        (void)hipGetLastError();
        grid = cus;
    }
    if (grid < 0) return;
    Args a{};
    for (int i = 0; i < 22; ++i) a.in[i] = (const float*)d_in[i];
    a.out = (float*)d_out; a.ws = (unsigned char*)d_ws;
#if MK_PER_PHASE
    if (PROBE_STAGE >= 0) {
        const int L = 0;
        launch_phase<0>(grid, stream, a, L); launch_phase<1>(grid, stream, a, L);
        if (PROBE_STAGE >= 2) launch_phase<2>(grid, stream, a, L);
        if (PROBE_STAGE >= 3) launch_phase<3>(grid, stream, a, L);
        if (PROBE_STAGE >= 4) launch_phase<4>(grid, stream, a, L);
        if (PROBE_STAGE >= 5) launch_phase<5>(grid, stream, a, L);
        if (PROBE_STAGE >= 6) launch_phase<6>(grid, stream, a, L);
        if (PROBE_STAGE >= 7) launch_phase<7>(grid, stream, a, L);
        if (PROBE_STAGE >= 8) launch_phase<8>(grid, stream, a, L);
        if (PROBE_STAGE >= 9) launch_phase<9>(grid, stream, a, L);
        if (PROBE_STAGE >= 10) launch_phase<10>(grid, stream, a, L);
        if (PROBE_STAGE >= 11) launch_phase<11>(grid, stream, a, L);
        if (PROBE_STAGE >= 12) launch_phase<12>(grid, stream, a, L);
        if (PROBE_STAGE >= 13) launch_phase<13>(grid, stream, a, L);
        size_t off = WS_RAW; int ld = RAWLD; int rowmask = 0x7fffffff;
        if (PROBE_STAGE == 2) { off = WS_VFIRST; ld = D; }
        if (PROBE_STAGE == 3) { off = WS_S1; ld = D; }
        if (PROBE_STAGE == 5) { off = WS_S1; ld = D; }
#if defined(PROBE_ALT) || defined(PROBE_SWAP)
        if (PROBE_STAGE == 3) { off = WS_S2; ld = D; }
        if (PROBE_STAGE == 2) { off = WS_EAT; ld = 256; rowmask = 2047; }
        if (PROBE_STAGE == 1) { off = WS_RAW + 4608; ld = RAWLD; }
#endif
        if (PROBE_STAGE == 6) { off = WS_S2; ld = D; }
        if (PROBE_STAGE == 7 || PROBE_STAGE == 8) { off = WS_S3; ld = D; }
        if (PROBE_STAGE == 9) { off = WS_S2; ld = D; }
        if (PROBE_STAGE == 10) { off = WS_RAWB; ld = D; }
        if (PROBE_STAGE == 11) { off = WS_S2; ld = D; }
        if (PROBE_STAGE == 12 || PROBE_STAGE == 13) { off = WS_RAW; ld = D; }
        hipLaunchKernelGGL(mk_dump, dim3(grid), dim3(512), 0, stream, a, off, ld, rowmask);
        return;
    }
    for (int L = 0; L < NLAYER; ++L) {
        launch_phase<0>(grid, stream, a, L); launch_phase<1>(grid, stream, a, L); launch_phase<2>(grid, stream, a, L); launch_phase<3>(grid, stream, a, L);
        launch_phase<4>(grid, stream, a, L); launch_phase<5>(grid, stream, a, L); launch_phase<6>(grid, stream, a, L); launch_phase<7>(grid, stream, a, L);
        launch_phase<8>(grid, stream, a, L); launch_phase<9>(grid, stream, a, L); launch_phase<10>(grid, stream, a, L); launch_phase<11>(grid, stream, a, L);
        launch_phase<12>(grid, stream, a, L); launch_phase<13>(grid, stream, a, L); launch_phase<14>(grid, stream, a, L);
    }
    launch_phase<15>(grid, stream, a, 0);
#else
    (void)hipMemsetAsync((char*)d_ws + WS_CTL, 0, CTL_ZERO_BYTES, stream);
    a.ph_lo = 0; a.ph_hi = 0;
    hipLaunchKernelGGL(mk_fwd, dim3(grid), dim3(512), LDS_BYTES, stream, a);
#endif
}
```

```cpp
#include <hip/hip_runtime.h>
#include <cstdio>
#include <cstdint>

#define LAS __attribute__((address_space(3)))
typedef unsigned short bf16_t;
typedef short bf16x8 __attribute__((ext_vector_type(8)));
typedef float f32x4 __attribute__((ext_vector_type(4)));
typedef float f32x2 __attribute__((ext_vector_type(2)));
typedef unsigned u32x4 __attribute__((ext_vector_type(4)));
typedef unsigned u32x2 __attribute__((ext_vector_type(2)));

#define SCAN_DUP 0
#ifndef SCAN_DUP
#define SCAN_DUP 0
#endif
#ifndef MK_PER_PHASE
#define MK_PER_PHASE 0
#endif

constexpr int M = 32768, D = 1024, SEQ = 2048, NLAYER = 4, INW = 8320, NHEAD = 16;
constexpr int RAWLD = 3328;
constexpr float NORM_EPS = 1e-6f, LNX_EPS = 64e-5f;

constexpr size_t MiB = 1u << 20;
constexpr size_t WS_CTL = 0, CTL_ZERO_BYTES = 16384;
constexpr size_t WS_WINT = 1 * MiB;
constexpr size_t WS_WPP = WS_WINT + (size_t)(INW + 128) * D * 2;
constexpr size_t WS_WRP = WS_WPP + 2 * MiB;
constexpr size_t WS_WOUT = WS_WRP + 2 * MiB;
constexpr size_t WS_LINT = WS_WOUT + 2 * MiB;
constexpr size_t WS_EAT = WS_LINT + MiB / 2;
constexpr size_t WS_VFIRST = 25 * MiB;
constexpr size_t WS_RAW = 89 * MiB;
constexpr size_t WS_RAWB = 153 * MiB;
constexpr size_t WS_S1 = 297 * MiB, WS_S2 = 361 * MiB, WS_S3 = 425 * MiB;
constexpr size_t WS_TW = 489 * MiB;
constexpr size_t WS_END = 505 * MiB;
static_assert(WS_EAT + MiB <= WS_VFIRST, "weights fit");
constexpr int R_RGATE = 2048, R_GRWKV = 3072, R_GPOOL = 4096, R_RKV = 5120, R_FOLD = 8320;

#define XB_TMO      128
#define XB_XCNT(j)  (256  + 64 * (j))
#define XB_XSUB(j)  (1280 + 64 * (j))
#define XB_XGEN(j)  (2304 + 64 * (j))
#define XB_TOP      3328
#define XB_TOPGEN   3392
#define XCD_BAR_WORDS 3456
#define XB_SPIN_CAP (1u << 18)

__device__ __forceinline__ unsigned xb_ld(unsigned* p)              { return __hip_atomic_load(p, __ATOMIC_RELAXED, __HIP_MEMORY_SCOPE_AGENT); }
__device__ __forceinline__ unsigned xb_add(unsigned* p, unsigned v) { return __hip_atomic_fetch_add(p, v, __ATOMIC_RELAXED, __HIP_MEMORY_SCOPE_AGENT); }
__device__ __forceinline__ unsigned xb_xcc_id() { return (unsigned)__builtin_amdgcn_s_getreg((3 << 11) | 20) & 0xFu; }
#define XB_SPIN(cond, bar) do { unsigned _sp = 0; while (cond) { __builtin_amdgcn_s_sleep(1); \
    if ((++_sp & 255u) == 0u) { if (xb_ld(&(bar)[XB_TMO])) break; if (_sp > XB_SPIN_CAP) { atomicAdd(&(bar)[XB_TMO], 1u); break; } } } } while (0)

struct XcdBarrier { unsigned* bar; unsigned x; volatile LAS unsigned* st; };

__device__ __forceinline__ XcdBarrier xcd_barrier_post(unsigned* bar, volatile LAS unsigned* st) {
    XcdBarrier b; b.bar = bar; b.x = xb_xcc_id(); b.st = st;
    if (threadIdx.x == 0) (void)xb_add(&bar[XB_XCNT(b.x)], 1u);
    return b;
}
__device__ __forceinline__ void xcd_barrier_complete(unsigned* bar, unsigned x, unsigned& nloc, unsigned& nx) {
    const unsigned G = gridDim.x * gridDim.y * gridDim.z;
    unsigned sum, cnt, mine, sp = 0u;
    for (;;) {
        sum = 0u; cnt = 0u; mine = 0u;
#pragma unroll
        for (unsigned j = 0; j < 16; ++j) { const unsigned c = xb_ld(&bar[XB_XCNT(j)]); sum += c; cnt += (c > 0u) ? 1u : 0u; }
        if (sum == G) { mine = xb_ld(&bar[XB_XCNT(x)]); break; }
        __builtin_amdgcn_s_sleep(1);
        if ((++sp & 255u) == 0u) { if (xb_ld(&bar[XB_TMO])) { mine = xb_ld(&bar[XB_XCNT(x)]); break; } if (sp > XB_SPIN_CAP) { atomicAdd(&bar[XB_TMO], 1u); mine = xb_ld(&bar[XB_XCNT(x)]); break; } }
    }
    nloc = mine > 0u ? mine : 1u; nx = cnt > 0u ? cnt : 1u;
}
__device__ __forceinline__ void xcd_barrier(const XcdBarrier& b) {
    asm volatile("s_waitcnt vmcnt(0)" ::: "memory");
    __syncthreads();
    if (threadIdx.x == 0) {
        unsigned* bar = b.bar; asm volatile("" : "+s"(bar));
        __builtin_amdgcn_s_waitcnt(0);
        unsigned nloc = b.st[0], nx = b.st[1];
        if (nloc == 0u) { xcd_barrier_complete(bar, b.x, nloc, nx); b.st[0] = nloc; b.st[1] = nx; }
        const unsigned old = xb_add(&bar[XB_XSUB(b.x)], 1u);
        const unsigned gen = old / nloc;
        if (old + 1u == (gen + 1u) * nloc) {
            __builtin_amdgcn_fence(__ATOMIC_RELEASE, "agent");
            asm volatile("s_waitcnt vmcnt(0)" ::: "memory");
            const unsigned og = xb_add(&bar[XB_TOP], 1u);
            const unsigned tg = og / nx;
            if (og + 1u == (tg + 1u) * nx) xb_add(&bar[XB_TOPGEN], 1u);
            else XB_SPIN(xb_ld(&bar[XB_TOPGEN]) == tg, bar);
            __builtin_amdgcn_fence(__ATOMIC_ACQUIRE, "agent");
            xb_add(&bar[XB_XGEN(b.x)], 1u);
            asm volatile("s_waitcnt vmcnt(0)" ::: "memory");
        } else {
            XB_SPIN(xb_ld(&bar[XB_XGEN(b.x)]) == gen, bar);
            __builtin_amdgcn_fence(__ATOMIC_ACQUIRE, "agent");
            asm volatile("s_waitcnt vmcnt(0)" ::: "memory");
        }
    }
    __syncthreads();
}

__device__ __forceinline__ float bf_lo(unsigned w) { return __uint_as_float(w << 16); }
__device__ __forceinline__ float bf_hi(unsigned w) { return __uint_as_float(w & 0xffff0000u); }
typedef __bf16 bf16x2_t __attribute__((ext_vector_type(2)));
__device__ __forceinline__ unsigned pk_bf16(float lo, float hi) { bf16x2_t v; v[0] = (__bf16)lo; v[1] = (__bf16)hi; return __builtin_bit_cast(unsigned, v); }
__device__ __forceinline__ unsigned short f2bf_s(float x) { return (unsigned short)(pk_bf16(x, 0.f) & 0xffffu); }
__device__ __forceinline__ float sigmoidf_(float x) { return __builtin_amdgcn_rcpf(1.0f + __expf(-x)); }
__device__ __forceinline__ float tanhf_(float x) { return 1.0f - 2.0f * __builtin_amdgcn_rcpf(1.0f + __expf(2.0f * x)); }
template <int CTRL> __device__ __forceinline__ float dppf(float x) { return __int_as_float(__builtin_amdgcn_update_dpp(0, __float_as_int(x), CTRL, 0xf, 0xf, true)); }
__device__ __forceinline__ float red8(float x) {
    x += dppf<0xB1>(x);
    x += dppf<0x4E>(x);
    x += dppf<0x141>(x);
    return x;
}
__device__ __forceinline__ float red16(float x) {
    x += dppf<0xB1>(x);
    x += dppf<0x4E>(x);
    x += dppf<0x141>(x);
    x += dppf<0x140>(x);
    return x;
}
__device__ __forceinline__ float red64(float x) {
    x = red16(x);
    return __int_as_float(__builtin_amdgcn_readlane(__float_as_int(x), 0)) + __int_as_float(__builtin_amdgcn_readlane(__float_as_int(x), 16)) +
           __int_as_float(__builtin_amdgcn_readlane(__float_as_int(x), 32)) + __int_as_float(__builtin_amdgcn_readlane(__float_as_int(x), 48));
}

namespace pg8 {
constexpr int BM = 256, BK = 64, HALF = 128, HTB = HALF * BK * 2, STAGE_BYTES = 8 * HTB, NXCD = 8, WGM = 8;
__host__ __device__ __forceinline__ int lds_byte(int r, int c) { const int st = (r >> 4) * 2 + (c >> 5), rr = r & 15, cc = c & 31, ob = rr * 64 + cc * 2; return st * 1024 + (ob ^ (((ob >> 9) & 1) << 5)); }
__host__ __device__ __forceinline__ void stage_rc(int b, int& R, int& C) { const int st = b / 1024, sb = b % 1024, swz = sb ^ (((sb >> 9) & 1) << 5); R = (st >> 1) * 16 + swz / 64; C = (st & 1) * 32 + (swz % 64) / 2; }
__host__ __device__ __forceinline__ int perm32(int rho) { const int n = rho >> 4, i = rho & 15; return 8 * (i >> 2) + 4 * n + (i & 3); }

struct Unit { int pm, pn; };
struct Gemm { const bf16_t* A; const bf16_t* Bt; int lda, ldb, K, nM, nN, a_pn_bytes; };

struct StaticOrder {
    int nM, nN, nwg, G, c;
    __device__ void init(int nM_, int nN_, int G_, int c_) { nM = nM_; nN = nN_; nwg = nM * nN; G = G_; c = c_; }
    __device__ bool next(int i, Unit& u) const {
        const long L = (long)i * G + c; if (L >= nwg) return false;
        int wgid = (int)L; { const int q = nwg / NXCD, r = nwg % NXCD, xcd = wgid % NXCD, off = wgid / NXCD; wgid = (xcd < r ? xcd * (q + 1) : r * (q + 1) + (xcd - r) * q) + off; }
        const int nig = WGM * nN, gid = wgid / nig, fm = gid * WGM, gsz = (nM - fm) < WGM ? (nM - fm) : WGM;
        u.pm = fm + ((wgid % nig) % gsz); u.pn = (wgid % nig) / gsz; return true;
    }
};

template <class Epi, bool ALIGN_EPI = true, bool SP2 = true>
__device__ __forceinline__ void gemm_phase(LAS unsigned char* lds, const Gemm g, const StaticOrder& S, const Epi& E) {
    int tid_ = threadIdx.x; asm volatile("" : "+v"(tid_));
    const int tid = tid_, wid = __builtin_amdgcn_readfirstlane(tid >> 6), lane = tid & 63, wr = wid >> 2, wc = wid & 3, fr = lane & 15, fq = lane >> 4;
    int K_ = g.K; asm volatile("" : "+s"(K_));
    const int K = K_, nt = K / BK;
    unsigned voffA[2], voffB[2];
#pragma unroll
    for (int i = 0; i < 2; ++i) { int R, C; stage_rc(tid * 16 + i * 8192, R, C); const int Rb = Epi::PERM ? ((R & ~31) + perm32(R & 31)) : R;
        voffA[i] = (unsigned)(R * g.lda + C) * 2u; voffB[i] = (unsigned)(Rb * g.ldb + C) * 2u; }
    const size_t kstep = (size_t)(BK * 2);
    const size_t hstepA = (size_t)HALF * g.lda * 2, hstepB = (size_t)HALF * g.ldb * 2;
    const size_t tstepA = 2 * hstepA, tstepB = 2 * hstepB;
    const unsigned ldsw = (unsigned)wid * 1024u;
    const int aoff = lds_byte(wr * 64 + fr, fq * 8), boff = lds_byte(wc * 32 + fr, fq * 8);
#define PG8_SA(b, h) (((b) * 2 + (h)) * HTB)
#define PG8_SB(b, h) ((4 + (b) * 2 + (h)) * HTB)
#define PG8_STAGE(bufoff, gbase, voff) do { _Pragma("unroll") for (int _i = 0; _i < 2; ++_i) \
        __builtin_amdgcn_global_load_lds((const unsigned*)((const char*)(gbase) + (voff)[_i]), (LAS unsigned*)(lds + (bufoff) + ldsw + _i * 8192), 16, 0, 0); } while (0)
#define PG8_LDA(dst, b, h) do { _Pragma("unroll") for (int m = 0; m < 4; ++m) _Pragma("unroll") for (int k = 0; k < 2; ++k) dst[m][k] = *(const LAS bf16x8*)(lds + PG8_SA(b, h) + aoff + m * 2048 + k * 1024); } while (0)
#define PG8_LDB(dst, b, h) do { _Pragma("unroll") for (int n = 0; n < 2; ++n) _Pragma("unroll") for (int k = 0; k < 2; ++k) dst[n][k] = *(const LAS bf16x8*)(lds + PG8_SB(b, h) + boff + n * 2048 + k * 1024); } while (0)
#define PG8_MMA(ai, bj, At, Bt) do { __builtin_amdgcn_s_setprio(1); _Pragma("unroll") for (int m = 0; m < 4; ++m) _Pragma("unroll") for (int n = 0; n < 2; ++n) _Pragma("unroll") for (int k = 0; k < 2; ++k) \
        acc[ai][bj][m][n] = __builtin_amdgcn_mfma_f32_16x16x32_bf16(Bt[n][k], At[m][k], acc[ai][bj][m][n], 0, 0, 0); __builtin_amdgcn_s_setprio(0); } while (0)
#define PG8_WAIT_V(n) asm volatile("s_waitcnt vmcnt(" #n ")" ::: "memory")
#define PG8_WAIT_L(n) asm volatile("s_waitcnt lgkmcnt(" #n ")" ::: "memory")
#define PG8_BAR __builtin_amdgcn_s_barrier()
#define PG8_SCHED __builtin_amdgcn_sched_barrier(0)
    Unit cur, nxt; int ui = 0;
    if (!S.next(0, cur)) return;
    f32x4 acc[2][2][4][2];
#pragma unroll
    for (int a = 0; a < 2; ++a)
#pragma unroll
        for (int b = 0; b < 2; ++b)
#pragma unroll
            for (int m = 0; m < 4; ++m)
#pragma unroll
                for (int n = 0; n < 2; ++n) acc[a][b][m][n] = (f32x4){0.f, 0.f, 0.f, 0.f};
    bf16x8 At[4][2], B0[2][2], B1[2][2];
    const char* cA = (const char*)g.A + (size_t)cur.pm * tstepA + (size_t)cur.pn * g.a_pn_bytes; const char* cB = (const char*)g.Bt + (size_t)cur.pn * tstepB;
    if constexpr (SP2) {
        PG8_STAGE(PG8_SB(0, 0), cB, voffB); PG8_STAGE(PG8_SB(0, 1), cB + hstepB, voffB); PG8_STAGE(PG8_SA(0, 0), cA, voffA); PG8_STAGE(PG8_SA(0, 1), cA + hstepA, voffA);
        if (wr == 1) PG8_BAR;
        PG8_WAIT_V(2); PG8_BAR;
        PG8_STAGE(PG8_SB(1, 0), cB + kstep, voffB); PG8_STAGE(PG8_SA(1, 0), cA + kstep, voffA); PG8_STAGE(PG8_SB(1, 1), cB + hstepB + kstep, voffB);
        PG8_WAIT_V(6); PG8_BAR;
    } else {
        PG8_STAGE(PG8_SB(0, 0), cB, voffB); PG8_STAGE(PG8_SA(0, 0), cA, voffA); PG8_STAGE(PG8_SB(0, 1), cB + hstepB, voffB); PG8_STAGE(PG8_SA(0, 1), cA + hstepA, voffA);
        if (wr == 1) PG8_BAR;
        PG8_WAIT_V(4); PG8_BAR;
        PG8_STAGE(PG8_SB(1, 0), cB + kstep, voffB); PG8_STAGE(PG8_SA(1, 0), cA + kstep, voffA); PG8_STAGE(PG8_SB(1, 1), cB + hstepB + kstep, voffB);
        PG8_WAIT_V(6); PG8_BAR;
    }
    for (;;) {
        const bool has_next = S.next(ui + 1, nxt);
        const char* nA = has_next ? (const char*)g.A + (size_t)nxt.pm * tstepA + (size_t)nxt.pn * g.a_pn_bytes : cA; const char* nB = has_next ? (const char*)g.Bt + (size_t)nxt.pn * tstepB : cB;
        for (int t = 0; t < nt; t += 2) {
            const bool last = (t == nt - 2);
            const char* a1 = cA + (size_t)(t + 1) * kstep;
            const char* a2 = last ? nA : cA + (size_t)(t + 2) * kstep; const char* b2 = last ? nB : cB + (size_t)(t + 2) * kstep;
            const char* a3 = a2 + kstep; const char* b3 = b2 + kstep;
            if constexpr (SP2) {
            PG8_LDB(B0, 0, 0); PG8_LDB(B1, 0, 1); PG8_SCHED; PG8_LDA(At, 0, 0); PG8_STAGE(PG8_SA(1, 1), a1 + hstepA, voffA);
            PG8_WAIT_V(8); PG8_WAIT_L(0); PG8_BAR; PG8_MMA(0, 0, At, B0); PG8_MMA(0, 1, At, B1); PG8_BAR; PG8_SCHED;
            PG8_LDA(At, 0, 1); PG8_STAGE(PG8_SB(0, 0), b2, voffB); PG8_STAGE(PG8_SB(0, 1), b2 + hstepB, voffB); PG8_STAGE(PG8_SA(0, 0), a2, voffA);
            PG8_WAIT_V(8); PG8_WAIT_L(0); PG8_BAR; PG8_MMA(1, 0, At, B0); PG8_MMA(1, 1, At, B1); PG8_BAR; PG8_SCHED;
            PG8_LDB(B0, 1, 0); PG8_LDB(B1, 1, 1); PG8_SCHED; PG8_LDA(At, 1, 0); PG8_STAGE(PG8_SA(0, 1), a2 + hstepA, voffA);
            PG8_WAIT_V(8); PG8_WAIT_L(0); PG8_BAR; PG8_MMA(0, 0, At, B0); PG8_MMA(0, 1, At, B1); PG8_BAR; PG8_SCHED;
            PG8_LDA(At, 1, 1); PG8_STAGE(PG8_SB(1, 0), b3, voffB); PG8_STAGE(PG8_SB(1, 1), b3 + hstepB, voffB); PG8_STAGE(PG8_SA(1, 0), a3, voffA);
            PG8_WAIT_V(8); PG8_WAIT_L(0); PG8_BAR; PG8_MMA(1, 0, At, B0); PG8_MMA(1, 1, At, B1); PG8_BAR; PG8_SCHED;
            } else {
            PG8_LDB(B0, 0, 0); PG8_SCHED; PG8_LDA(At, 0, 0); PG8_STAGE(PG8_SA(1, 1), a1 + hstepA, voffA);
            PG8_WAIT_L(8); PG8_BAR; PG8_WAIT_L(0); PG8_MMA(0, 0, At, B0); PG8_BAR; PG8_SCHED;
            PG8_LDB(B1, 0, 1); PG8_STAGE(PG8_SB(0, 0), b2, voffB);
            PG8_BAR; PG8_WAIT_L(0); PG8_MMA(0, 1, At, B1); PG8_BAR;
            PG8_LDA(At, 0, 1); PG8_STAGE(PG8_SA(0, 0), a2, voffA);
            PG8_BAR; PG8_WAIT_L(0); PG8_MMA(1, 0, At, B0); PG8_BAR; PG8_SCHED;
            PG8_STAGE(PG8_SB(0, 1), b2 + hstepB, voffB);
            PG8_WAIT_V(6); PG8_BAR; PG8_MMA(1, 1, At, B1); PG8_BAR;
            PG8_LDB(B0, 1, 0); PG8_SCHED; PG8_LDA(At, 1, 0); PG8_STAGE(PG8_SA(0, 1), a2 + hstepA, voffA);
            PG8_WAIT_L(8); PG8_BAR; PG8_WAIT_L(0); PG8_MMA(0, 0, At, B0); PG8_BAR; PG8_SCHED;
            PG8_LDB(B1, 1, 1); PG8_STAGE(PG8_SB(1, 0), b3, voffB);
            PG8_BAR; PG8_WAIT_L(0); PG8_MMA(0, 1, At, B1); PG8_BAR;
            PG8_LDA(At, 1, 1); PG8_STAGE(PG8_SA(1, 0), a3, voffA);
            PG8_BAR; PG8_WAIT_L(0); PG8_MMA(1, 0, At, B0); PG8_BAR; PG8_SCHED;
            PG8_STAGE(PG8_SB(1, 1), b3 + hstepB, voffB);
            PG8_WAIT_V(6); PG8_BAR; PG8_MMA(1, 1, At, B1); PG8_BAR;
            }
        }
        if constexpr (ALIGN_EPI) { if (wr == 0) PG8_BAR; }
        E(acc, cur, wr, wc, fr, fq);
        if (!has_next) break;
#pragma unroll
        for (int a = 0; a < 2; ++a)
#pragma unroll
            for (int b = 0; b < 2; ++b)
#pragma unroll
                for (int m = 0; m < 4; ++m)
#pragma unroll
                    for (int n = 0; n < 2; ++n) acc[a][b][m][n] = (f32x4){0.f, 0.f, 0.f, 0.f};
        cur = nxt; cA = nA; cB = nB; ++ui;
        if constexpr (ALIGN_EPI) { if (wr == 1) PG8_BAR; }
    }
    PG8_WAIT_V(0);
    if constexpr (!ALIGN_EPI) { if (wr == 0) PG8_BAR; }
    PG8_BAR;
#undef PG8_SA
#undef PG8_SB
#undef PG8_STAGE
#undef PG8_LDA
#undef PG8_LDB
#undef PG8_MMA
#undef PG8_WAIT_V
#undef PG8_WAIT_L
#undef PG8_BAR
#undef PG8_SCHED
}

enum { ACT_NONE = 0, ACT_SILU = 1, ACT_SIGMOID = 2, ACT_DECAY = 3 };
template <int ACT> __device__ __forceinline__ float actf(float v) {
    if (ACT == ACT_SILU) return v * sigmoidf_(v);
    if (ACT == ACT_SIGMOID) return sigmoidf_(v);
    if (ACT == ACT_DECAY) return 0.60653065971f * sigmoidf_(v);
    return v;
}
struct EpiCfg {
    bf16_t* out; int ldo;
    const float* bias;
    const float* cscale;
    const bf16_t* in1; int ld1;
    const bf16_t* in2; int ld2;
};
template <int ACT_A, int ACT_B, int ACT_C = ACT_NONE, int ACT_D = ACT_NONE, int ACT_E = ACT_NONE> struct EpiG {
    static constexpr bool PERM = true;
    EpiCfg a, b; int split; EpiCfg c = {}; int split2 = 1 << 30; EpiCfg d = {}; int split3 = 1 << 30; EpiCfg e = {}; int split4 = 1 << 30;
    template <int ACT> __device__ __forceinline__ void run(const EpiCfg& c, int colt, const f32x4 (&acc)[2][2][4][2], const Unit& u, int wr, int wc, int fr, int fq) const {
        const int row0 = u.pm * BM + wr * 64 + fr, col0 = colt + wc * 32 + 8 * fq;
        f32x4 bv[2][2], sv[2][2];
#pragma unroll
        for (int bj = 0; bj < 2; ++bj)
#pragma unroll
            for (int n = 0; n < 2; ++n) {
                bv[bj][n] = c.bias ? *(const f32x4*)(c.bias + col0 + bj * HALF + 4 * n) : (f32x4){0.f, 0.f, 0.f, 0.f};
                sv[bj][n] = c.cscale ? *(const f32x4*)(c.cscale + col0 + bj * HALF + 4 * n) : (f32x4){1.f, 1.f, 1.f, 1.f};
            }
#pragma unroll
        for (int ai = 0; ai < 2; ++ai)
#pragma unroll
            for (int m = 0; m < 4; ++m) {
                const size_t row = (size_t)(row0 + ai * HALF + m * 16);
#pragma unroll
                for (int bj = 0; bj < 2; ++bj) {
                    const int cc = col0 + bj * HALF;
                    f32x4 v0 = acc[ai][bj][m][0] + bv[bj][0], v1 = acc[ai][bj][m][1] + bv[bj][1];
#pragma unroll
                    for (int j = 0; j < 4; ++j) { v0[j] = actf<ACT>(v0[j]); v1[j] = actf<ACT>(v1[j]); }
                    if (c.in1) { const u32x4 w = *(const u32x4*)(c.in1 + row * c.ld1 + cc);
                        v0[0] *= bf_lo(w.x); v0[1] *= bf_hi(w.x); v0[2] *= bf_lo(w.y); v0[3] *= bf_hi(w.y);
                        v1[0] *= bf_lo(w.z); v1[1] *= bf_hi(w.z); v1[2] *= bf_lo(w.w); v1[3] *= bf_hi(w.w); }
                    if (c.cscale) { v0 *= sv[bj][0]; v1 *= sv[bj][1]; }
                    if (c.in2) { const u32x4 w = *(const u32x4*)(c.in2 + row * c.ld2 + cc);
                        v0[0] += bf_lo(w.x); v0[1] += bf_hi(w.x); v0[2] += bf_lo(w.y); v0[3] += bf_hi(w.y);
                        v1[0] += bf_lo(w.z); v1[1] += bf_hi(w.z); v1[2] += bf_lo(w.w); v1[3] += bf_hi(w.w); }
                    u32x4 w; w.x = pk_bf16(v0[0], v0[1]); w.y = pk_bf16(v0[2], v0[3]); w.z = pk_bf16(v1[0], v1[1]); w.w = pk_bf16(v1[2], v1[3]);
                    *(u32x4*)(c.out + row * c.ldo + cc) = w;
                }
            }
    }
    __device__ __forceinline__ void operator()(const f32x4 (&acc)[2][2][4][2], const Unit& u, int wr, int wc, int fr, int fq) const {
        const int colt = u.pn * BM;
        if (colt >= split4) run<ACT_E>(e, colt - split4, acc, u, wr, wc, fr, fq);
        else if (colt >= split3) run<ACT_D>(d, colt - split3, acc, u, wr, wc, fr, fq);
        else if (colt >= split2) run<ACT_C>(c, colt - split2, acc, u, wr, wc, fr, fq);
        else if (colt >= split) run<ACT_B>(b, colt - split, acc, u, wr, wc, fr, fq);
        else run<ACT_A>(a, colt, acc, u, wr, wc, fr, fq);
    }
};
struct EpiRawT {
    static constexpr bool PERM = true;
    bf16_t* out; int ncols;
    __device__ __forceinline__ void operator()(const f32x4 (&acc)[2][2][4][2], const Unit& u, int wr, int wc, int fr, int fq) const {
        const int ch0 = u.pm * BM + wr * 64 + fr, tok0 = u.pn * BM + wc * 32 + 8 * fq;
#pragma unroll
        for (int ai = 0; ai < 2; ++ai)
#pragma unroll
            for (int m = 0; m < 4; ++m) {
                const int ch = ch0 + ai * HALF + m * 16;
#pragma unroll
                for (int bj = 0; bj < 2; ++bj) {
                    const int tok = tok0 + bj * HALF;
                    const f32x4 v0 = acc[ai][bj][m][0], v1 = acc[ai][bj][m][1];
                    u32x4 w; w.x = pk_bf16(v0[0], v0[1]); w.y = pk_bf16(v0[2], v0[3]); w.z = pk_bf16(v1[0], v1[1]); w.w = pk_bf16(v1[2], v1[3]);
                    *(u32x4*)(out + ((size_t)(tok >> 4) * ncols + ch) * 16 + (tok & 15)) = w;
                }
            }
    }
};
struct EpiResid {
    static constexpr bool PERM = false;
    float* X; int ldc; const float* Xin;
    __device__ __forceinline__ void operator()(const f32x4 (&acc)[2][2][4][2], const Unit& u, int wr, int wc, int fr, int fq) const {
        const int row0 = u.pm * BM + wr * 64 + fr, col0 = u.pn * BM + wc * 32 + 4 * fq;
#pragma unroll
        for (int ai = 0; ai < 2; ++ai)
#pragma unroll
            for (int m = 0; m < 4; ++m) { float* rowp = X + (size_t)(row0 + ai * HALF + m * 16) * ldc + col0;
#pragma unroll
                for (int bj = 0; bj < 2; ++bj)
#pragma unroll
                    for (int n = 0; n < 2; ++n) { f32x4* p = (f32x4*)(rowp + bj * HALF + n * 16); *p = *(const f32x4*)(Xin + (p - (f32x4*)X) * 4) + acc[ai][bj][m][n]; } }
    }
};
}

struct Args {
    const float* in[22];
    float* out; unsigned char* ws;
    int ph_lo, ph_hi;
};
typedef const Args __attribute__((address_space(4)))* ArgsP;
struct Frame {
    LAS unsigned char* lds;
    int tid, lane, wave, G, bid;
    ArgsP ap;
    float* X; unsigned char* ws;
    bf16_t *WinT, *WppT, *WrpT, *WoutT, *LinT, *EAT, *VF, *RAW, *RAWB, *S1, *S2, *S3, *TW;
};

__device__ __forceinline__ void set_ws(Frame& F, unsigned char* ws) {
    F.ws = ws;
    F.WinT = (bf16_t*)(ws + WS_WINT); F.WppT = (bf16_t*)(ws + WS_WPP); F.WrpT = (bf16_t*)(ws + WS_WRP); F.WoutT = (bf16_t*)(ws + WS_WOUT);
    F.LinT = (bf16_t*)(ws + WS_LINT); F.EAT = (bf16_t*)(ws + WS_EAT); F.VF = (bf16_t*)(ws + WS_VFIRST);
    F.RAW = (bf16_t*)(ws + WS_RAW); F.RAWB = (bf16_t*)(ws + WS_RAWB); F.S1 = (bf16_t*)(ws + WS_S1); F.S2 = (bf16_t*)(ws + WS_S2); F.S3 = (bf16_t*)(ws + WS_S3);
    F.TW = (bf16_t*)(ws + WS_TW);
}
__device__ __forceinline__ void transpose_cvt(const Frame& F, const float* src, int ldn, int K, int N, bf16_t* dst, int ldk) {
    LAS float* tile = (LAS float*)F.lds;
    const int tilesK = K / 64, ntile = tilesK * (N / 64);
    for (int tl = F.bid; tl < ntile; tl += F.G) {
        const int k0 = (tl % tilesK) * 64, n0 = (tl / tilesK) * 64;
#pragma unroll
        for (int i = 0; i < 8; ++i) { const int idx = F.tid + 512 * i, r = idx >> 6, c = idx & 63; tile[r * 65 + c] = src[(size_t)(k0 + r) * ldn + n0 + c]; }
        __syncthreads();
#pragma unroll
        for (int i = 0; i < 4; ++i) { const int idx = F.tid + 512 * i, n = idx >> 5, kp = idx & 31;
            *(unsigned*)(dst + (size_t)(n0 + n) * ldk + k0 + 2 * kp) = pk_bf16(tile[(2 * kp) * 65 + n], tile[(2 * kp + 1) * 65 + n]); }
        __syncthreads();
    }
}
__device__ __forceinline__ void fold_weights(const Frame& F, int L) {
    const int fr = F.lane & 15, fq = F.lane >> 4;
    LAS float* red = (LAS float*)F.lds;
    for (int tl = F.bid; tl < 64 * 4; tl += F.G) {
        const int k0 = (tl >> 2) * 16, j0 = (tl & 3) * 16, jj = j0 + fr;
        f32x4 acc = (f32x4){0.f, 0.f, 0.f, 0.f};
        if (L > 0) {
            const int cw = F.wave * 128 + 32 * fq;
            const float* arow = F.ap->in[2] + (size_t)L * D * INW + 4096 + (size_t)(k0 + fr) * INW + cw;
            const float* mu = F.ap->in[6] + (size_t)L * 3200 + 2048 + cw;
            const float* V1 = F.ap->in[12] + (size_t)(L - 1) * D * 32 + (size_t)cw * 32 + (jj & 31);
#pragma unroll
            for (int s4 = 0; s4 < 8; ++s4) {
                const f32x4 a4 = *(const f32x4*)(arow + 4 * s4), m4 = *(const f32x4*)(mu + 4 * s4);
#pragma unroll
                for (int e = 0; e < 4; ++e) acc = __builtin_amdgcn_mfma_f32_16x16x4f32(a4[e], V1[(size_t)(4 * s4 + e) * 32] * ((jj < 32) ? (1.0f - m4[e]) : m4[e]), acc, 0, 0, 0);
            }
        }
        *(LAS f32x4*)(red + (F.wave * 64 + F.lane) * 4) = acc;
        __syncthreads();
        if (F.wave == 0) {
            f32x4 t = acc;
#pragma unroll
            for (int w = 1; w < 8; ++w) t += *(const LAS f32x4*)(red + (w * 64 + F.lane) * 4);
            *(u32x2*)(F.WinT + (size_t)(R_FOLD + jj) * D + k0 + 4 * fq) = (u32x2){pk_bf16(t[0], t[1]), pk_bf16(t[2], t[3])};
            unsigned zz = 0u; asm volatile("" : "+v"(zz));
            *(u32x2*)(F.WinT + (size_t)(R_FOLD + 64 + jj) * D + k0 + 4 * fq) = (u32x2){zz, zz};
        }
        __syncthreads();
    }
    if (L > 0) { const float* V2 = F.ap->in[13] + (size_t)(L - 1) * 32 * D;
        for (int idx = F.bid * 512 + F.tid; idx < D * 32; idx += F.G * 512) { const int n = idx >> 5, j = idx & 31; F.EAT[131072 + idx] = f2bf_s(V2[(size_t)j * D + n]); } }
}
__device__ __forceinline__ void fold_pool_lin(const Frame& F, int L) {
    const float* win = F.ap->in[2] + (size_t)L * D * INW;
    const int fr = F.lane & 15, fq = F.lane >> 4;
    for (int tl = F.bid * 8 + F.wave; tl < 4 * 64 * 16; tl += F.G * 8) {
        const int g = tl >> 10, k0 = ((tl >> 4) & 63) * 16, d0 = (tl & 15) * 16;
        const float* arow = win + (size_t)(k0 + fr) * INW + 256 * g + 64 * fq;
        const float* bcol = F.ap->in[3] + ((size_t)(L * 4 + g) * 256 + 64 * fq) * 256 + d0 + fr;
        f32x4 acc = (f32x4){0.f, 0.f, 0.f, 0.f};
#pragma unroll 4
        for (int s4 = 0; s4 < 16; ++s4) {
            const f32x4 a4 = *(const f32x4*)(arow + 4 * s4);
#pragma unroll
            for (int e = 0; e < 4; ++e) acc = __builtin_amdgcn_mfma_f32_16x16x4f32(a4[e], bcol[(size_t)(4 * s4 + e) * 256], acc, 0, 0, 0);
        }
        *(u32x2*)(F.WinT + (size_t)(256 * g + d0 + fr) * D + k0 + 4 * fq) = (u32x2){pk_bf16(acc[0], acc[1]), pk_bf16(acc[2], acc[3])};
    }
}
__device__ __forceinline__ void convert_weights(const Frame& F, int L) {
    transpose_cvt(F, F.ap->in[2] + (size_t)L * D * INW + 1024, INW, D, 1024, F.WinT + (size_t)1024 * D, D);
    transpose_cvt(F, F.ap->in[2] + (size_t)L * D * INW + 2048, INW, D, 3200, F.WinT + (size_t)R_RKV * D, D);
    fold_pool_lin(F, L);
    transpose_cvt(F, F.ap->in[2] + (size_t)L * D * INW + 5248, INW, D, 1024, F.WinT + (size_t)R_RGATE * D, D);
    transpose_cvt(F, F.ap->in[2] + (size_t)L * D * INW + 6272, INW, D, 1024, F.WinT + (size_t)R_GPOOL * D, D);
    transpose_cvt(F, F.ap->in[2] + (size_t)L * D * INW + 7296, INW, D, 1024, F.WinT + (size_t)R_GRWKV * D, D);
    fold_weights(F, L);
    transpose_cvt(F, F.ap->in[5] + (size_t)L * D * D, D, D, D, F.WppT, D);
    transpose_cvt(F, F.ap->in[19] + (size_t)L * D * D, D, D, D, F.WrpT, D);
    transpose_cvt(F, F.ap->in[20] + (size_t)L * D * D, D, D, D, F.WoutT, D);
    transpose_cvt(F, F.ap->in[8] + (size_t)L * 64 * D, D, 64, D, F.EAT, 64);
    transpose_cvt(F, F.ap->in[10] + (size_t)L * 64 * D, D, 64, D, F.EAT + 65536, 64);
}
__device__ __forceinline__ void rmsnorm_rows(const Frame& F, const float* src, const float* g, bf16_t* H, bf16_t* copy_to) {
    for (int m = F.bid * 8 + F.wave; m < M; m += F.G * 8) {
        const float* xr = src + (size_t)m * D;
        f32x4 v[4]; float ss = 0.f;
#pragma unroll
        for (int i = 0; i < 4; ++i) { v[i] = *(const f32x4*)(xr + F.lane * 4 + 256 * i); ss += v[i][0] * v[i][0] + v[i][1] * v[i][1] + v[i][2] * v[i][2] + v[i][3] * v[i][3]; }
        ss = red64(ss);
        const float rs = __builtin_amdgcn_rsqf(ss * (1.0f / D) + NORM_EPS);
#pragma unroll
        for (int i = 0; i < 4; ++i) {
            const int c = F.lane * 4 + 256 * i;
            if (copy_to) *(u32x2*)(copy_to + (size_t)m * D + c) = (u32x2){pk_bf16(v[i][0], v[i][1]), pk_bf16(v[i][2], v[i][3])};
            const f32x4 gg = *(const f32x4*)(g + c);
            u32x2 w; w.x = pk_bf16(v[i][0] * rs * gg[0], v[i][1] * rs * gg[1]); w.y = pk_bf16(v[i][2] * rs * gg[2], v[i][3] * rs * gg[3]);
            *(u32x2*)(H + (size_t)m * D + c) = w;
        }
    }
}
__device__ __forceinline__ void rmsnorm_rows_bf(const Frame& F, const bf16_t* Xb, const float* g, bf16_t* H) {
    for (int m = F.bid * 8 + F.wave; m < M; m += F.G * 8) {
        const bf16_t* xr = Xb + (size_t)m * D;
        u32x4 w[2]; float ss = 0.f;
#pragma unroll
        for (int i = 0; i < 2; ++i) { w[i] = *(const u32x4*)(xr + F.lane * 8 + 512 * i);
#pragma unroll
            for (int e = 0; e < 4; ++e) { const float a = bf_lo(w[i][e]), b = bf_hi(w[i][e]); ss += a * a + b * b; } }
        ss = red64(ss);
        const float rs = __builtin_amdgcn_rsqf(ss * (1.0f / D) + NORM_EPS);
#pragma unroll
        for (int i = 0; i < 2; ++i) {
            const int c = F.lane * 8 + 512 * i;
            const f32x4 g0 = *(const f32x4*)(g + c), g1 = *(const f32x4*)(g + c + 4);
            u32x4 o; o.x = pk_bf16(bf_lo(w[i].x) * rs * g0[0], bf_hi(w[i].x) * rs * g0[1]); o.y = pk_bf16(bf_lo(w[i].y) * rs * g0[2], bf_hi(w[i].y) * rs * g0[3]);
            o.z = pk_bf16(bf_lo(w[i].z) * rs * g1[0], bf_hi(w[i].z) * rs * g1[1]); o.w = pk_bf16(bf_lo(w[i].w) * rs * g1[2], bf_hi(w[i].w) * rs * g1[3]);
            *(u32x4*)(H + (size_t)m * D + c) = o;
        }
    }
}
__device__ __forceinline__ void final_norm(const Frame& F, const bf16_t* Xb) {
    const float* g = F.ap->in[21];
    for (int m = F.bid * 8 + F.wave; m < M; m += F.G * 8) {
        const bf16_t* xr = Xb + (size_t)m * D;
        u32x4 w[2]; float ss = 0.f;
#pragma unroll
        for (int i = 0; i < 2; ++i) { w[i] = *(const u32x4*)(xr + F.lane * 8 + 512 * i);
#pragma unroll
            for (int e = 0; e < 4; ++e) { const float a = bf_lo(w[i][e]), b = bf_hi(w[i][e]); ss += a * a + b * b; } }
        ss = red64(ss);
        const float rs = __builtin_amdgcn_rsqf(ss * (1.0f / D) + NORM_EPS);
#pragma unroll
        for (int i = 0; i < 2; ++i) {
            const int c = F.lane * 8 + 512 * i;
            const f32x4 g0 = *(const f32x4*)(g + c), g1 = *(const f32x4*)(g + c + 4);
            *(f32x4*)(F.X + (size_t)m * D + c) = (f32x4){bf_lo(w[i].x) * rs * g0[0], bf_hi(w[i].x) * rs * g0[1], bf_lo(w[i].y) * rs * g0[2], bf_hi(w[i].y) * rs * g0[3]};
            *(f32x4*)(F.X + (size_t)m * D + c + 4) = (f32x4){bf_lo(w[i].z) * rs * g1[0], bf_hi(w[i].z) * rs * g1[1], bf_lo(w[i].w) * rs * g1[2], bf_hi(w[i].w) * rs * g1[3]};
        }
    }
}
__device__ __forceinline__ void tw_phase(const Frame& F, int L) {
    const float* mu = F.ap->in[6] + (size_t)L * 3200;
    for (int it = F.bid * 512 + F.tid; it < M * 32; it += F.G * 512) {
        const int m = it >> 5, j = it & 31; u32x4 o = (u32x4){0u, 0u, 0u, 0u};
        if (j < 16) {
            const int c0 = 3072 + 8 * j, t = m & (SEQ - 1);
            const u32x4 cw = *(const u32x4*)(F.RAW + (size_t)m * RAWLD + c0);
            u32x4 pw = (u32x4){0u, 0u, 0u, 0u}; if (t > 0) pw = *(const u32x4*)(F.RAW + (size_t)(m - 1) * RAWLD + c0);
            const f32x4 m0 = *(const f32x4*)(mu + c0), m1 = *(const f32x4*)(mu + c0 + 4);
            float s[8];
#define SH(i, cwv, pwv, muv, hi) { const float c_ = hi ? bf_hi(cwv) : bf_lo(cwv), p_ = hi ? bf_hi(pwv) : bf_lo(pwv); s[i] = c_ + (muv) * (p_ - c_); }
            SH(0, cw.x, pw.x, m0[0], 0) SH(1, cw.x, pw.x, m0[1], 1) SH(2, cw.y, pw.y, m0[2], 0) SH(3, cw.y, pw.y, m0[3], 1)
            SH(4, cw.z, pw.z, m1[0], 0) SH(5, cw.z, pw.z, m1[1], 1) SH(6, cw.w, pw.w, m1[2], 0) SH(7, cw.w, pw.w, m1[3], 1)
#undef SH
            if (j < 8) {
#pragma unroll
                for (int i = 0; i < 8; ++i) s[i] = tanhf_(s[i]);
            }
            o.x = pk_bf16(s[0], s[1]); o.y = pk_bf16(s[2], s[3]); o.z = pk_bf16(s[4], s[5]); o.w = pk_bf16(s[6], s[7]);
        }
        *(u32x4*)(F.TW + (size_t)m * 256 + 8 * j) = o;
    }
}
__device__ __forceinline__ void vmix_phase(const Frame& F, int L) {
    const float* mu = F.ap->in[6] + (size_t)L * 3200 + 2048;
    const int tid = F.tid, c0 = 2 * tid;
    const f32x2 muv = *(const f32x2*)(mu + c0);
    LAS float* vsh = (LAS float*)F.lds;
    LAS float* part = (LAS float*)(F.lds + 16384);
    LAS float* midl = (LAS float*)(F.lds + 16384 + 8192);
    bf16_t* dst = (L == 0) ? F.VF : F.S3;
    float v1r[64]; f32x2 v2r[32]; f32x2 v0v = (f32x2){0.f, 0.f};
    const int jj = tid & 31, cs = tid >> 5;
    if (L > 0) {
        const float* V1 = F.ap->in[12] + (size_t)(L - 1) * D * 32; const float* V2 = F.ap->in[13] + (size_t)(L - 1) * 32 * D;
#pragma unroll
        for (int i = 0; i < 64; ++i) v1r[i] = V1[(size_t)(cs * 64 + i) * 32 + jj];
#pragma unroll
        for (int j = 0; j < 32; ++j) v2r[j] = *(const f32x2*)(V2 + (size_t)j * D + c0);
        v0v = *(const f32x2*)(F.ap->in[11] + (size_t)(L - 1) * D + c0);
    }
    for (int grp = F.bid; grp < M / 4; grp += F.G) {
        const int m0 = grp * 4, t0 = m0 & (SEQ - 1);
        unsigned rw[5];
        rw[0] = (t0 > 0) ? *(const unsigned*)(F.RAW + (size_t)(m0 - 1) * RAWLD + 2048 + c0) : 0u;
#pragma unroll
        for (int i = 0; i < 4; ++i) rw[i + 1] = *(const unsigned*)(F.RAW + (size_t)(m0 + i) * RAWLD + 2048 + c0);
        f32x2 vs[4];
#pragma unroll
        for (int i = 0; i < 4; ++i) { const float c_lo = bf_lo(rw[i + 1]), c_hi = bf_hi(rw[i + 1]), p_lo = bf_lo(rw[i]), p_hi = bf_hi(rw[i]);
            vs[i].x = c_lo + muv.x * (p_lo - c_lo); vs[i].y = c_hi + muv.y * (p_hi - c_hi); }
        if (L == 0) {
#pragma unroll
            for (int i = 0; i < 4; ++i) *(unsigned*)(dst + (size_t)(m0 + i) * D + c0) = pk_bf16(vs[i].x, vs[i].y);
            continue;
        }
#pragma unroll
        for (int i = 0; i < 4; ++i) *(LAS f32x2*)(vsh + i * 1024 + c0) = vs[i];
        __syncthreads();
#pragma unroll
        for (int i = 0; i < 4; ++i) {
            float p = 0.f;
#pragma unroll
            for (int k4 = 0; k4 < 16; ++k4) { const f32x4 x = *(const LAS f32x4*)(vsh + i * 1024 + cs * 64 + 4 * k4);
                p += x[0] * v1r[4 * k4] + x[1] * v1r[4 * k4 + 1] + x[2] * v1r[4 * k4 + 2] + x[3] * v1r[4 * k4 + 3]; }
            part[(i * 16 + cs) * 32 + jj] = p;
        }
        __syncthreads();
        if (tid < 128) { const int i = tid >> 5; float s = 0.f;
#pragma unroll
            for (int k = 0; k < 16; ++k) s += part[(i * 16 + k) * 32 + jj];
            midl[i * 32 + jj] = s; }
        __syncthreads();
#pragma unroll
        for (int i = 0; i < 4; ++i) {
            float z0 = v0v.x, z1 = v0v.y;
#pragma unroll
            for (int j4 = 0; j4 < 8; ++j4) { const f32x4 mm = *(const LAS f32x4*)(midl + i * 32 + 4 * j4);
#pragma unroll
                for (int e = 0; e < 4; ++e) { z0 += mm[e] * v2r[4 * j4 + e].x; z1 += mm[e] * v2r[4 * j4 + e].y; } }
            const float g0 = sigmoidf_(z0), g1 = sigmoidf_(z1);
            const unsigned fw = *(const unsigned*)(F.VF + (size_t)(m0 + i) * D + c0);
            const float o0 = vs[i].x + (bf_lo(fw) - vs[i].x) * g0, o1 = vs[i].y + (bf_hi(fw) - vs[i].y) * g1;
            *(unsigned*)(dst + (size_t)(m0 + i) * D + c0) = pk_bf16(o0, o1);
        }
        __syncthreads();
    }
}
__device__ __forceinline__ void poold_phase(const Frame& F, const bf16_t* PIN, bf16_t* SGIO, const float* scale) {
    for (int it = F.bid * 512 + F.tid; it < (M / 32) * 128; it += F.G * 512) {
        const int j = it & 127, m0 = (it >> 7) * 32, t0 = m0 & (SEQ - 1), w = 2 << (j >> 5);
        const bf16_t* col = PIN + 8 * j;
        const f32x4 sc0 = *(const f32x4*)(scale + 8 * j), sc1 = *(const f32x4*)(scale + 8 * j + 4);
        float s[8];
#pragma unroll
        for (int e = 0; e < 8; ++e) s[e] = 0.f;
        if (t0 > 0) {
            for (int i = 1; i < w; ++i) { const u32x4 x = *(const u32x4*)(col + (size_t)(m0 - i) * D);
                s[0] += bf_lo(x.x); s[1] += bf_hi(x.x); s[2] += bf_lo(x.y); s[3] += bf_hi(x.y); s[4] += bf_lo(x.z); s[5] += bf_hi(x.z); s[6] += bf_lo(x.w); s[7] += bf_hi(x.w); }
        }
        for (int i = 0; i < 32; ++i) {
            const int t = t0 + i; const size_t m = (size_t)(m0 + i);
            const u32x4 x = *(const u32x4*)(col + m * D);
            const float c[8] = {bf_lo(x.x), bf_hi(x.x), bf_lo(x.y), bf_hi(x.y), bf_lo(x.z), bf_hi(x.z), bf_lo(x.w), bf_hi(x.w)};
#pragma unroll
            for (int e = 0; e < 8; ++e) s[e] += c[e];
            if (t >= w && i > 0) { const u32x4 o = *(const u32x4*)(col + (m - w) * D);
                s[0] -= bf_lo(o.x); s[1] -= bf_hi(o.x); s[2] -= bf_lo(o.y); s[3] -= bf_hi(o.y); s[4] -= bf_lo(o.z); s[5] -= bf_hi(o.z); s[6] -= bf_lo(o.w); s[7] -= bf_hi(o.w); }
            const float inv = __builtin_amdgcn_rcpf((float)((t + 1 < w) ? (t + 1) : w));
            const u32x4 gw = *(const u32x4*)(SGIO + m * D + 8 * j);
            u32x4 r; r.x = pk_bf16((s[0] * inv - c[0]) * sc0[0] * bf_lo(gw.x), (s[1] * inv - c[1]) * sc0[1] * bf_hi(gw.x)); r.y = pk_bf16((s[2] * inv - c[2]) * sc0[2] * bf_lo(gw.y), (s[3] * inv - c[3]) * sc0[3] * bf_hi(gw.y));
            r.z = pk_bf16((s[4] * inv - c[4]) * sc1[0] * bf_lo(gw.z), (s[5] * inv - c[5]) * sc1[1] * bf_hi(gw.z)); r.w = pk_bf16((s[6] * inv - c[6]) * sc1[2] * bf_lo(gw.w), (s[7] * inv - c[7]) * sc1[3] * bf_hi(gw.w));
            *(u32x4*)(SGIO + m * D + 8 * j) = r;
        }
    }
}

constexpr int SC_T = 32;
constexpr int SC_ARR = SC_T * 64;
constexpr int SC_BUF_BYTES = 6 * SC_ARR * 4;
constexpr int SC_YS = 2 * SC_BUF_BYTES, SC_RAWR = SC_YS + SC_ARR * 4, SC_RAWK = SC_RAWR + SC_ARR * 4, SC_PREV = SC_RAWK + SC_ARR * 4;
static_assert(SC_PREV + 1024 <= 131072, "scan LDS");

#define QP(n) "quad_perm:[" #n "," #n "," #n "," #n "] row_mask:0xf bank_mask:0xf"
__device__ __forceinline__ void sc_matvec(float& o0, float& o1, const f32x2 x, const float (&S)[8]) {
    asm volatile("s_nop 1\n\t"
        "v_mul_f32_dpp %0, %2, %4 " QP(0) "\n\t"  "v_mul_f32_dpp %1, %3, %5 " QP(0) "\n\t"
        "v_fmac_f32_dpp %0, %2, %6 " QP(1) "\n\t" "v_fmac_f32_dpp %1, %3, %7 " QP(1) "\n\t"
        "v_fmac_f32_dpp %0, %2, %8 " QP(2) "\n\t" "v_fmac_f32_dpp %1, %3, %9 " QP(2) "\n\t"
        "v_fmac_f32_dpp %0, %2, %10 " QP(3) "\n\t" "v_fmac_f32_dpp %1, %3, %11 " QP(3)
        : "=&v"(o0), "=&v"(o1) : "v"(x.x), "v"(x.y), "v"(S[0]), "v"(S[1]), "v"(S[2]), "v"(S[3]), "v"(S[4]), "v"(S[5]), "v"(S[6]), "v"(S[7]));
}
__device__ __forceinline__ void sc_update(float (&S)[8], const f32x2 w, const f32x2 b, const f32x2 k, const float sa, const float vv) {
    asm volatile("s_nop 1\n\t"
        "v_mul_f32_dpp %0, %8, %0 " QP(0) "\n\t" "v_mul_f32_dpp %1, %9, %1 " QP(0) "\n\t"
        "v_mul_f32_dpp %2, %8, %2 " QP(1) "\n\t" "v_mul_f32_dpp %3, %9, %3 " QP(1) "\n\t"
        "v_mul_f32_dpp %4, %8, %4 " QP(2) "\n\t" "v_mul_f32_dpp %5, %9, %5 " QP(2) "\n\t"
        "v_mul_f32_dpp %6, %8, %6 " QP(3) "\n\t" "v_mul_f32_dpp %7, %9, %7 " QP(3) "\n\t"
        "v_fmac_f32_dpp %0, %10, %14 " QP(0) "\n\t" "v_fmac_f32_dpp %1, %11, %14 " QP(0) "\n\t"
        "v_fmac_f32_dpp %2, %10, %14 " QP(1) "\n\t" "v_fmac_f32_dpp %3, %11, %14 " QP(1) "\n\t"
        "v_fmac_f32_dpp %4, %10, %14 " QP(2) "\n\t" "v_fmac_f32_dpp %5, %11, %14 " QP(2) "\n\t"
        "v_fmac_f32_dpp %6, %10, %14 " QP(3) "\n\t" "v_fmac_f32_dpp %7, %11, %14 " QP(3) "\n\t"
        "v_fmac_f32_dpp %0, %12, %15 " QP(0) "\n\t" "v_fmac_f32_dpp %1, %13, %15 " QP(0) "\n\t"
        "v_fmac_f32_dpp %2, %12, %15 " QP(1) "\n\t" "v_fmac_f32_dpp %3, %13, %15 " QP(1) "\n\t"
        "v_fmac_f32_dpp %4, %12, %15 " QP(2) "\n\t" "v_fmac_f32_dpp %5, %13, %15 " QP(2) "\n\t"
        "v_fmac_f32_dpp %6, %12, %15 " QP(3) "\n\t" "v_fmac_f32_dpp %7, %13, %15 " QP(3)
        : "+v"(S[0]), "+v"(S[1]), "+v"(S[2]), "+v"(S[3]), "+v"(S[4]), "+v"(S[5]), "+v"(S[6]), "+v"(S[7])
        : "v"(w.x), "v"(w.y), "v"(b.x), "v"(b.y), "v"(k.x), "v"(k.y), "v"(sa), "v"(vv));
}
__device__ __forceinline__ float sc_red(float x) {
    asm volatile("s_nop 1\n\tv_add_f32_dpp %0, %0, %0 row_ror:4 row_mask:0xf bank_mask:0xf\n\ts_nop 1\n\tv_add_f32_dpp %0, %0, %0 row_ror:8 row_mask:0xf bank_mask:0xf" : "+v"(x));
    const auto r = __builtin_amdgcn_permlane32_swap(__float_as_uint(x), __float_as_uint(x), false, false);
    return __uint_as_float(r[0]) + __uint_as_float(r[1]);
}
#undef QP
struct ScanRegs { u32x2 rr, kr, ee, aa, vv; };
__device__ __forceinline__ void scan_phase(const Frame& F, int L, const bf16_t* VP) {
    const int tid = F.tid, lane = F.lane, wave = F.wave;
    LAS float* Ys = (LAS float*)(F.lds + SC_YS);
    LAS float* rawR = (LAS float*)(F.lds + SC_RAWR);
    LAS float* rawK = (LAS float*)(F.lds + SC_RAWK);
    LAS float* prevRK = (LAS float*)(F.lds + SC_PREV);
    const int tok = tid >> 4, q = tid & 15;
    const int kc = ((lane >> 5) << 2) | ((lane >> 2) & 3), row = wave * 8 + ((lane >> 4) & 1) * 4 + (lane & 3), koff = 8 * kc + 2 * (lane & 3);
    for (int unit = F.bid; unit < 256; unit += F.G) {
        const int b = unit >> 4, h = unit & 15, hc = h * 64 + 4 * q;
        const f32x4 kk4 = *(const f32x4*)(F.ap->in[14] + (size_t)L * D + hc), ka4 = *(const f32x4*)(F.ap->in[15] + (size_t)L * D + hc);
        const f32x4 rk4 = *(const f32x4*)(F.ap->in[16] + (size_t)L * D + hc);
        const f32x4 lw4 = *(const f32x4*)(F.ap->in[17] + (size_t)L * D + hc), lb4 = *(const f32x4*)(F.ap->in[18] + (size_t)L * D + hc);
        const f32x4 mur4 = *(const f32x4*)(F.ap->in[6] + (size_t)L * 3200 + hc), muk4 = *(const f32x4*)(F.ap->in[6] + (size_t)L * 3200 + 1024 + hc);
        const size_t mrow0 = (size_t)b * SEQ;
        float S[8];
#pragma unroll
        for (int j = 0; j < 8; ++j) S[j] = 0.f;
        ScanRegs R;
#define SC_LOAD(cidx) do { const size_t m_ = mrow0 + (size_t)(cidx) * SC_T + tok; \
            R.rr = *(const u32x2*)(F.RAW + m_ * RAWLD + hc); R.kr = *(const u32x2*)(F.RAW + m_ * RAWLD + 1024 + hc); \
            R.ee = *(const u32x2*)(F.S1 + m_ * D + hc); R.aa = *(const u32x2*)(F.S2 + m_ * D + hc); R.vv = *(const u32x2*)(VP + m_ * D + hc); } while (0)
#define SC_PREP(cidx) do { \
            const f32x4 rc = (f32x4){bf_lo(R.rr.x), bf_hi(R.rr.x), bf_lo(R.rr.y), bf_hi(R.rr.y)}; \
            const f32x4 kc = (f32x4){bf_lo(R.kr.x), bf_hi(R.kr.x), bf_lo(R.kr.y), bf_hi(R.kr.y)}; \
            *(LAS f32x4*)(rawR + tok * 64 + 4 * q) = rc; *(LAS f32x4*)(rawK + tok * 64 + 4 * q) = kc; \
            __syncthreads(); \
            f32x4 rp, kp; \
            if (tok > 0) { rp = *(const LAS f32x4*)(rawR + (tok - 1) * 64 + 4 * q); kp = *(const LAS f32x4*)(rawK + (tok - 1) * 64 + 4 * q); } \
            else if ((cidx) > 0) { rp = *(const LAS f32x4*)(prevRK + (((cidx) & 1) * 2 + 0) * 64 + 4 * q); kp = *(const LAS f32x4*)(prevRK + (((cidx) & 1) * 2 + 1) * 64 + 4 * q); } \
            else { rp = (f32x4){0.f, 0.f, 0.f, 0.f}; kp = rp; } \
            if (tok == SC_T - 1) { *(LAS f32x4*)(prevRK + ((((cidx) + 1) & 1) * 2 + 0) * 64 + 4 * q) = rc; *(LAS f32x4*)(prevRK + ((((cidx) + 1) & 1) * 2 + 1) * 64 + 4 * q) = kc; } \
            const f32x4 rs = rc + mur4 * (rp - rc), ks = kc + muk4 * (kp - kc); \
            const f32x4 ev = (f32x4){bf_lo(R.ee.x), bf_hi(R.ee.x), bf_lo(R.ee.y), bf_hi(R.ee.y)}; \
            const f32x4 av = (f32x4){bf_lo(R.aa.x), bf_hi(R.aa.x), bf_lo(R.aa.y), bf_hi(R.aa.y)}; \
            const f32x4 vv = (f32x4){bf_lo(R.vv.x), bf_hi(R.vv.x), bf_lo(R.vv.y), bf_hi(R.vv.y)}; \
            f32x4 kkv = ks * kk4; \
            float ss = kkv[0] * kkv[0] + kkv[1] * kkv[1] + kkv[2] * kkv[2] + kkv[3] * kkv[3]; ss = red16(ss); \
            const float inv = 1.0f / fmaxf(sqrtf(ss), 1e-12f); kkv = kkv * inv; \
            const f32x4 kmod = ks * (1.0f + (av - 1.0f) * ka4); \
            f32x4 wv; wv[0] = __expf(-ev[0]); wv[1] = __expf(-ev[1]); wv[2] = __expf(-ev[2]); wv[3] = __expf(-ev[3]); \
            LAS float* cb_ = (LAS float*)(F.lds + ((cidx) & 1) * SC_BUF_BYTES) + tok * 64 + 4 * q; \
            *(LAS f32x4*)(cb_ + 0 * SC_ARR) = rs; *(LAS f32x4*)(cb_ + 1 * SC_ARR) = wv; *(LAS f32x4*)(cb_ + 2 * SC_ARR) = kmod; \
            *(LAS f32x4*)(cb_ + 3 * SC_ARR) = -kkv; *(LAS f32x4*)(cb_ + 4 * SC_ARR) = kkv * av; *(LAS f32x4*)(cb_ + 5 * SC_ARR) = vv; } while (0)
        SC_LOAD(0);
        SC_PREP(0);
        __syncthreads();
        for (int c = 0; c < SEQ / SC_T; ++c) {
            if (c + 1 < SEQ / SC_T) SC_LOAD(c + 1);
            const LAS float* cb = (const LAS float*)(F.lds + (c & 1) * SC_BUF_BYTES);
            const LAS float* pin = cb + koff;
            const LAS float* pv = cb + 5 * SC_ARR + row;
#define SC_LD(dst, t_) do { dst##r = *(const LAS f32x2*)(pin + 0 * SC_ARR + (t_) * 64); dst##w = *(const LAS f32x2*)(pin + 1 * SC_ARR + (t_) * 64); dst##k = *(const LAS f32x2*)(pin + 2 * SC_ARR + (t_) * 64); \
                dst##a = *(const LAS f32x2*)(pin + 3 * SC_ARR + (t_) * 64); dst##b = *(const LAS f32x2*)(pin + 4 * SC_ARR + (t_) * 64); dst##v = pv[(t_) * 64]; } while (0)
#define SC_STEP(src, t_) do { float p0_, p1_; sc_matvec(p0_, p1_, src##a, S); const float sa_ = sc_red(p0_ + p1_); sc_update(S, src##w, src##b, src##k, sa_, src##v); \
                sc_matvec(p0_, p1_, src##r, S); const float y_ = sc_red(p0_ + p1_); if (kc == 0) Ys[(t_) * 64 + row] = y_; } while (0)
            f32x2 Ar, Aw, Ak, Aa, Ab, Br, Bw, Bk, Ba, Bb; float Av, Bv;
            SC_LD(A, 0);
            for (int t = 0; t < SC_T; t += 2) {
                SC_LD(B, t + 1);
                SC_STEP(A, t);
                if (t + 2 < SC_T) SC_LD(A, t + 2);
                SC_STEP(B, t + 1);
            }
#undef SC_LD
#undef SC_STEP
            __syncthreads();
            {
                const f32x4 y4 = *(const LAS f32x4*)(Ys + tok * 64 + 4 * q);
                const float mean = red16((y4[0] + y4[1]) + (y4[2] + y4[3])) * (1.0f / 64.0f);
                const f32x4 d = y4 - mean;
                const float var = red16((d[0] * d[0] + d[1] * d[1]) + (d[2] * d[2] + d[3] * d[3])) * (1.0f / 64.0f);
                const float rstd = __builtin_amdgcn_rsqf(var + LNX_EPS);
                const f32x4 rs = *(const LAS f32x4*)(cb + 0 * SC_ARR + tok * 64 + 4 * q), km = *(const LAS f32x4*)(cb + 2 * SC_ARR + tok * 64 + 4 * q), vv = *(const LAS f32x4*)(cb + 5 * SC_ARR + tok * 64 + 4 * q);
                const f32x4 pr = rs * km * rk4;
                const float bon = red16((pr[0] + pr[1]) + (pr[2] + pr[3]));
                const f32x4 z = d * rstd * lw4 + lb4 + bon * vv;
                u32x2 o; o.x = pk_bf16(z[0], z[1]); o.y = pk_bf16(z[2], z[3]);
                *(u32x2*)(F.RAW + (mrow0 + (size_t)c * SC_T + tok) * RAWLD + hc) = o;
            }
            if (c + 1 < SEQ / SC_T) SC_PREP(c + 1);
            __syncthreads();
        }
#undef SC_LOAD
#undef SC_PREP
    }
}


constexpr int C2_AT = 0, C2_RT = 2048, C2_BK = 4096, C2_VT = 8192, C2_NAK = 10240, C2_NRBK = 10752, C2_MT = 11776, C2_GTV = 12288, C2_BON = 12544, C2_CH = 12800;
constexpr int C2_YS = 8 * C2_CH;
constexpr int C2_PREV = C2_YS + 32768;
constexpr int C2_W2S = C2_PREV + 512, C2_A2S = C2_W2S + 8192;
constexpr int C2_V2S = C2_A2S + 8192;
static_assert(C2_V2S + 8192 <= 163776, "scan LDS");
typedef short s16x4 __attribute__((ext_vector_type(4)));
__device__ __forceinline__ u32x2 tr4(const LAS unsigned char* img, int k0, int lane) {
    return __builtin_bit_cast(u32x2, __builtin_amdgcn_ds_read_tr16_b64_v4i16((LAS s16x4*)(img + (k0 + ((lane & 15) >> 2)) * 32 + (lane & 3) * 8)));
}
__device__ __forceinline__ u32x2 tr4bk(const LAS unsigned char* img, int k0, int lane) {
    return __builtin_bit_cast(u32x2, __builtin_amdgcn_ds_read_tr16_b64_v4i16((LAS s16x4*)(img + (k0 + ((lane & 15) >> 2)) * 64 + (lane & 3) * 16)));
}
__device__ __forceinline__ void wr_row(LAS unsigned char* img, int lane, const unsigned (&w)[8]) {
    *(LAS u32x4*)(img + lane * 32) = (u32x4){w[0], w[1], w[2], w[3]}; *(LAS u32x4*)(img + lane * 32 + 16) = (u32x4){w[4], w[5], w[6], w[7]};
}
__device__ __forceinline__ bf16x8 mk_frag(u32x2 lo, u32x2 hi) { return __builtin_bit_cast(bf16x8, (u32x4){lo.x, lo.y, hi.x, hi.y}); }
__device__ __forceinline__ u32x2 pk4(const f32x4 a) { return (u32x2){pk_bf16(a[0], a[1]), pk_bf16(a[2], a[3])}; }
__device__ __forceinline__ float bf1(unsigned short v) { return __uint_as_float((unsigned)v << 16); }
__device__ __forceinline__ unsigned short f2bf(float x) { return (unsigned short)(pk_bf16(x, 0.f) & 0xffffu); }
__device__ __forceinline__ void st2(LAS unsigned char* p0, LAS unsigned char* p1, float a, float b) { const unsigned w = pk_bf16(a, b); *(LAS unsigned short*)p0 = (unsigned short)w; *(LAS unsigned short*)p1 = (unsigned short)(w >> 16); }
__device__ __forceinline__ void scan2_phase(const Frame& F, int L) {
    const int tid = F.tid, lane = F.lane, wave = F.wave, fr = lane & 15, fq = lane >> 4;
    LAS unsigned char* lds = F.lds;
    for (int unit = F.bid; unit < 256; unit += F.G) {
        const int b = unit >> 4, h = unit & 15, ch = h * 64 + lane;
        const size_t mrow0 = (size_t)b * SEQ;
        const float c_kk = F.ap->in[14][(size_t)L * D + ch], c_ka = F.ap->in[15][(size_t)L * D + ch], c_rk = F.ap->in[16][(size_t)L * D + ch];
        const float c_mur = F.ap->in[6][(size_t)L * 3200 + ch], c_muk = F.ap->in[6][(size_t)L * 3200 + 1024 + ch];
        const int ptok = tid >> 2, pj = tid & 3;
        f32x4 St[4];
#pragma unroll
        for (int i = 0; i < 4; ++i) St[i] = (f32x4){0.f, 0.f, 0.f, 0.f};
        int tid_u = tid; asm volatile("" : "+v"(tid_u));
        for (int i = tid_u; i < 1024; i += 512) { const int which = i >> 9, e = i & 511;
            *(LAS u32x4*)(lds + C2_W2S + which * 8192 + e * 16) = *(const u32x4*)(F.EAT + (size_t)which * 65536 + (size_t)h * 64 * 64 + e * 8); }
        if (L > 0) for (int e = tid_u; e < 512; e += 512) { const int chl = e >> 3, p = e & 7;
            *(LAS u32x4*)(lds + C2_V2S + e * 16) = *(const u32x4*)(F.EAT + 131072 + (size_t)(h * 64 + chl) * 32 + ((8 * p) & 31)); }
        const float c_muw = F.ap->in[6][(size_t)L * 3200 + 3072 + lane], c_mua = F.ap->in[6][(size_t)L * 3200 + 3136 + lane], c_muv = F.ap->in[6][(size_t)L * 3200 + 2048 + ch];
        float c_v0[4];
#pragma unroll
        for (int i = 0; i < 4; ++i) c_v0[i] = F.ap->in[11][(size_t)(L > 0 ? L - 1 : 0) * D + h * 64 + 16 * i + (lane & 15)];
        float c_w0[4], c_a0[4];
#pragma unroll
        for (int i = 0; i < 4; ++i) { c_w0[i] = F.ap->in[7][(size_t)L * D + h * 64 + 16 * i + (lane & 15)]; c_a0[i] = F.ap->in[9][(size_t)L * D + h * 64 + 16 * i + (lane & 15)]; }
        __syncthreads();
        const auto rs_raw = __builtin_amdgcn_make_buffer_rsrc((void*)F.RAW, 0, (int)((size_t)M * RAWLD * 2), 0x00020000);
        const auto rs_vf = __builtin_amdgcn_make_buffer_rsrc((void*)F.VF, 0, M * D * 2, 0x00020000);
        const int voh = ch * 32, vol = lane * 32;
#define LDQ(vofs, q, tb) __builtin_bit_cast(u32x4, __builtin_amdgcn_raw_buffer_load_b128(rs_raw, (vofs) + (q) * 16, (int)(tb) * (RAWLD * 32), 0))
#define LDP(vofs, tb) __builtin_amdgcn_raw_buffer_load_b16(rs_raw, (vofs) + 30, (int)(tb) * (RAWLD * 32), 0)
#define QF(q, t) (((t) & 1) ? bf_hi((q)[(t) >> 1]) : bf_lo((q)[(t) >> 1]))
#define QP(q, pv, i) (((i) == 0) ? bf1(pv) : QF(q, ((i) > 0 ? (i) - 1 : 0)))

        for (int g = 0; g < SEQ / 128; ++g) {
            {
                int lane_ = lane; asm volatile("" : "+v"(lane_));
                const int fr = lane_ & 15, fq = lane_ >> 4;
                const int m0 = (int)mrow0 + g * 128 + wave * 16;
                LAS unsigned char* cb = lds + wave * C2_CH;
                LAS unsigned char* scr = lds + C2_YS + wave * 4096;
                const int tb = m0 >> 4, tbp = (tb > 0) ? tb - 1 : 0;
                unsigned rrq[8], krq[8], aaq[8], eeq[8], vvp[8];
                unsigned vrq[8], xrq[8], mixq[8]; unsigned short vprev, xprev;
                {
                    unsigned wdq[8], adq[8]; unsigned short wprev, aprev;
                    const bool has_prev = (g > 0) || (wave > 0);
                    const unsigned short pm = has_prev ? (unsigned short)0xffffu : (unsigned short)0;
                    wprev = LDP(vol + 3072 * 32, tbp) & pm; aprev = LDP(vol + 3136 * 32, tbp) & pm;
#pragma unroll
                    for (int q = 0; q < 2; ++q) { const u32x4 w4 = LDQ(vol + 3072 * 32, q, tb), a4 = LDQ(vol + 3136 * 32, q, tb);
#pragma unroll
                        for (int e = 0; e < 4; ++e) { wdq[4 * q + e] = w4[e]; adq[4 * q + e] = a4[e]; } }
                    {
                        vprev = LDP(voh + 2048 * 32, tbp) & pm; xprev = LDP(vol + 3200 * 32, tbp) & pm;
#pragma unroll
                        for (int q = 0; q < 2; ++q) { const u32x4 v4 = LDQ(voh + 2048 * 32, q, tb), x4 = LDQ(vol + 3200 * 32, q, tb);
                            const u32x4 f4 = __builtin_bit_cast(u32x4, __builtin_amdgcn_raw_buffer_load_b128(rs_vf, voh + q * 16, tb * (D * 32), 0));
#pragma unroll
                            for (int e = 0; e < 4; ++e) { vrq[4 * q + e] = v4[e]; xrq[4 * q + e] = x4[e]; mixq[4 * q + e] = f4[e]; } }
                    }
                    __builtin_amdgcn_sched_barrier(0);
                    unsigned twp[8], adp[8];
#pragma unroll
                    for (int t = 0; t < 16; t += 2) {
                        const float w0_ = QP(wdq, wprev, t), w1_ = QP(wdq, wprev, t + 1), w2_ = QP(wdq, wprev, t + 2), a0_ = QP(adq, aprev, t), a1_ = QP(adq, aprev, t + 1), a2_ = QP(adq, aprev, t + 2);
                        twp[t >> 1] = pk_bf16(tanhf_(w1_ + c_muw * (w0_ - w1_)), tanhf_(w2_ + c_muw * (w1_ - w2_)));
                        adp[t >> 1] = pk_bf16(a1_ + c_mua * (a0_ - a1_), a2_ + c_mua * (a1_ - a2_));
                    }
                    wr_row(scr, lane, twp); wr_row(scr + 2048, lane, adp);
                    asm volatile("s_waitcnt lgkmcnt(0)" ::: "memory");
                    f32x4 le[4], la[4];
#pragma unroll
                    for (int i = 0; i < 4; ++i) { le[i] = (f32x4){0.f, 0.f, 0.f, 0.f}; la[i] = le[i]; }
#pragma unroll
                    for (int s2 = 0; s2 < 2; ++s2) {
                        const int k0 = 32 * s2 + 8 * fq;
                        const bf16x8 fw = mk_frag(tr4(scr, k0, lane), tr4(scr, k0 + 4, lane)), fa = mk_frag(tr4(scr + 2048, k0, lane), tr4(scr + 2048, k0 + 4, lane));
#pragma unroll
                        for (int i = 0; i < 4; ++i) {
                            le[i] = __builtin_amdgcn_mfma_f32_16x16x32_bf16(fw, *(const LAS bf16x8*)(lds + C2_W2S + (16 * i + fr) * 128 + (32 * s2 + 8 * fq) * 2), le[i], 0, 0, 0);
                            la[i] = __builtin_amdgcn_mfma_f32_16x16x32_bf16(fa, *(const LAS bf16x8*)(lds + C2_A2S + (16 * i + fr) * 128 + (32 * s2 + 8 * fq) * 2), la[i], 0, 0, 0);
                        }
                    }
#pragma unroll
                    for (int i = 0; i < 4; ++i)
                        {
                            *(LAS u32x2*)(scr + (16 * i + fr) * 32 + fq * 8) = (u32x2){pk_bf16(0.60653065971f * sigmoidf_(le[i][0] + c_w0[i]), 0.60653065971f * sigmoidf_(le[i][1] + c_w0[i])), pk_bf16(0.60653065971f * sigmoidf_(le[i][2] + c_w0[i]), 0.60653065971f * sigmoidf_(le[i][3] + c_w0[i]))};
                            *(LAS u32x2*)(scr + 2048 + (16 * i + fr) * 32 + fq * 8) = (u32x2){pk_bf16(sigmoidf_(la[i][0] + c_a0[i]), sigmoidf_(la[i][1] + c_a0[i])), pk_bf16(sigmoidf_(la[i][2] + c_a0[i]), sigmoidf_(la[i][3] + c_a0[i]))};
                        }
                    asm volatile("s_waitcnt lgkmcnt(0)" ::: "memory");
#pragma unroll
                    for (int q = 0; q < 2; ++q) { const u32x4 we = *(const LAS u32x4*)(scr + lane * 32 + q * 16), wa = *(const LAS u32x4*)(scr + 2048 + lane * 32 + q * 16);
#pragma unroll
                        for (int e = 0; e < 4; ++e) { eeq[4 * q + e] = we[e]; aaq[4 * q + e] = wa[e]; } }
                    asm volatile("s_waitcnt lgkmcnt(0)" ::: "memory");
                }
                unsigned tch[7];
                {   const int tbn = ((int)mrow0 + (g + 1 < SEQ / 128 ? g + 1 : g) * 128 + wave * 16) >> 4;
                    tch[0] = __builtin_amdgcn_raw_buffer_load_b32(rs_raw, vol + 3072 * 32, tbn * (RAWLD * 32), 0); tch[1] = __builtin_amdgcn_raw_buffer_load_b32(rs_raw, vol + 3136 * 32, tbn * (RAWLD * 32), 0);
                    tch[2] = __builtin_amdgcn_raw_buffer_load_b32(rs_raw, vol + 3200 * 32, tbn * (RAWLD * 32), 0); tch[3] = __builtin_amdgcn_raw_buffer_load_b32(rs_raw, voh, tbn * (RAWLD * 32), 0);
                    tch[4] = __builtin_amdgcn_raw_buffer_load_b32(rs_raw, voh + 1024 * 32, tbn * (RAWLD * 32), 0); tch[5] = __builtin_amdgcn_raw_buffer_load_b32(rs_raw, voh + 2048 * 32, tbn * (RAWLD * 32), 0);
                    tch[6] = __builtin_amdgcn_raw_buffer_load_b32(rs_vf, voh, tbn * (D * 32), 0); }
                {
                    __builtin_amdgcn_sched_barrier(0);
#pragma unroll
                    for (int q = 0; q < 2; ++q) { const u32x4 r4 = LDQ(voh, q, tb), k4 = LDQ(voh + 1024 * 32, q, tb);
#pragma unroll
                        for (int e = 0; e < 4; ++e) { rrq[4 * q + e] = r4[e]; krq[4 * q + e] = k4[e]; } }
                    __builtin_amdgcn_sched_barrier(0);
                    if (L > 0) {
                        unsigned xp[8];
#pragma unroll
                        for (int i = 0; i < 8; ++i) { const unsigned xs = (i == 0) ? ((unsigned)xprev | (xrq[0] << 16)) : __builtin_amdgcn_alignbit(xrq[i], xrq[i > 0 ? i - 1 : 0], 16);
                            xp[i] = (lane < 32) ? xrq[i] : xs; }
                        wr_row(scr, lane, xp);
                        asm volatile("s_waitcnt lgkmcnt(0)" ::: "memory");
                        f32x4 mx[4];
#pragma unroll
                        for (int i = 0; i < 4; ++i) mx[i] = (f32x4){0.f, 0.f, 0.f, 0.f};
#pragma unroll
                        for (int s2 = 0; s2 < 2; ++s2) { const bf16x8 fx = mk_frag(tr4(scr, 32 * s2 + 8 * fq, lane), tr4(scr, 32 * s2 + 8 * fq + 4, lane));
#pragma unroll
                            for (int i = 0; i < 4; ++i) mx[i] = __builtin_amdgcn_mfma_f32_16x16x32_bf16(fx, *(const LAS bf16x8*)(lds + C2_V2S + (16 * i + fr) * 128 + (32 * s2 + 8 * fq) * 2), mx[i], 0, 0, 0); }
#pragma unroll
                        for (int i = 0; i < 4; ++i)
                            *(LAS u32x2*)(scr + (16 * i + fr) * 32 + fq * 8) = (u32x2){pk_bf16(sigmoidf_(mx[i][0] + c_v0[i]), sigmoidf_(mx[i][1] + c_v0[i])), pk_bf16(sigmoidf_(mx[i][2] + c_v0[i]), sigmoidf_(mx[i][3] + c_v0[i]))};
                        asm volatile("s_waitcnt lgkmcnt(0)" ::: "memory");
                    }
                    if (L > 0) {
                        const u32x4 mw0 = *(const LAS u32x4*)(scr + lane * 32), mw1 = *(const LAS u32x4*)(scr + lane * 32 + 16);
#pragma unroll
                        for (int t = 0; t < 16; t += 2) {
                            const float v0_ = QP(vrq, vprev, t), v1_ = QP(vrq, vprev, t + 1), v2_ = QP(vrq, vprev, t + 2), vs0 = v1_ + c_muv * (v0_ - v1_), vs1 = v2_ + c_muv * (v1_ - v2_);
                            const unsigned mwp = (t < 8) ? mw0[t >> 1] : mw1[(t - 8) >> 1];
                            const float mix0 = bf_lo(mwp), mix1 = bf_hi(mwp);
                            vvp[t >> 1] = pk_bf16(vs0 + (QF(mixq, t) - vs0) * mix0, vs1 + (QF(mixq, t + 1) - vs1) * mix1);
                        }
                    } else {
#pragma unroll
                        for (int t = 0; t < 16; t += 2) {
                            const float v0_ = QP(vrq, vprev, t), v1_ = QP(vrq, vprev, t + 1), v2_ = QP(vrq, vprev, t + 2);
                            vvp[t >> 1] = pk_bf16(v1_ + c_muv * (v0_ - v1_), v2_ + c_muv * (v1_ - v2_));
                        }
#pragma unroll
                        for (int q = 0; q < 2; ++q) __builtin_amdgcn_raw_buffer_store_b128(__builtin_bit_cast(decltype(__builtin_amdgcn_raw_buffer_load_b128(rs_vf, 0, 0, 0)), (u32x4){vvp[4 * q], vvp[4 * q + 1], vvp[4 * q + 2], vvp[4 * q + 3]}), rs_vf, voh + q * 16, tb * (D * 32), 0);
                    }
                    asm volatile("s_waitcnt lgkmcnt(0)" ::: "memory");
                }
                float rprev = 0.f, kprev = 0.f;
                {
                    const float rp_g = bf1(LDP(voh, tbp)), kp_g = bf1(LDP(voh + 1024 * 32, tbp));
                    rprev = (wave > 0 || g > 0) ? rp_g : 0.f; kprev = (wave > 0 || g > 0) ? kp_g : 0.f;
                }
                const float rprev0 = rprev, kprev0 = kprev;
                float sql = 0.f, pbl = 0.f; unsigned sqp[4], pbp[4];
#pragma unroll
                for (int t = 0; t < 16; ++t) {
                    const float r_c = QF(rrq, t), k_c = QF(krq, t);
                    const float rs = r_c + c_mur * (rprev - r_c), ks = k_c + c_muk * (kprev - k_c); rprev = r_c; kprev = k_c;
                    const float al = QF(aaq, t), kmod = ks * (1.0f + (al - 1.0f) * c_ka), kkv = ks * c_kk;
                    if (t & 1) { sqp[(t >> 1) & 3] = pk_bf16(sql, kkv * kkv); pbp[(t >> 1) & 3] = pk_bf16(pbl, rs * kmod * c_rk); }
                    if ((t & 7) == 7) { *(LAS u32x4*)(scr + lane * 32 + (t >> 3) * 16) = (u32x4){sqp[0], sqp[1], sqp[2], sqp[3]}; *(LAS u32x4*)(scr + 2048 + lane * 32 + (t >> 3) * 16) = (u32x4){pbp[0], pbp[1], pbp[2], pbp[3]}; }
                    else { sql = kkv * kkv; pbl = rs * kmod * c_rk; }
                }
                asm volatile("s_waitcnt lgkmcnt(0)" ::: "memory");
                {
                    f32x4 sn = (f32x4){0.f, 0.f, 0.f, 0.f}, sb = sn;
                    const bf16x8 ones = __builtin_bit_cast(bf16x8, (u32x4){0x3f803f80u, 0x3f803f80u, 0x3f803f80u, 0x3f803f80u});
#pragma unroll
                    for (int s2 = 0; s2 < 2; ++s2) { const int k0 = 32 * s2 + 8 * fq;
                        sn = __builtin_amdgcn_mfma_f32_16x16x32_bf16(mk_frag(tr4(scr, k0, lane), tr4(scr, k0 + 4, lane)), ones, sn, 0, 0, 0);
                        sb = __builtin_amdgcn_mfma_f32_16x16x32_bf16(mk_frag(tr4(scr + 2048, k0, lane), tr4(scr + 2048, k0 + 4, lane)), ones, sb, 0, 0, 0); }
                    if (fr == 0) { *(LAS f32x4*)(cb + C2_BON + 64 + fq * 16) = sn; *(LAS f32x4*)(cb + C2_BON + fq * 16) = sb; }
                }
                asm volatile("s_waitcnt lgkmcnt(0)" ::: "memory");
                f32x4 n2v[4];
#pragma unroll
                for (int i = 0; i < 4; ++i) n2v[i] = *(const LAS f32x4*)(cb + C2_BON + 64 + i * 16);
#pragma unroll
                for (int i = 0; i < 7; ++i) asm volatile("" :: "v"(tch[i]));
                float lg = 0.f, gcarry = 1.0f;
                unsigned atp[4], rtp[4]; unsigned bkp[16];
                float btl = 0.f, ktl = 0.f, atl = 0.f, rtl = 0.f;
                rprev = rprev0; kprev = kprev0;
#pragma unroll
                for (int t = 0; t < 16; ++t) {
                    const float r_c = QF(rrq, t), k_c = QF(krq, t);
                    const float rs = r_c + c_mur * (rprev - r_c), ks = k_c + c_muk * (kprev - k_c); rprev = r_c; kprev = k_c;
                    const float al = QF(aaq, t), kmod = ks * (1.0f + (al - 1.0f) * c_ka), kkv = ks * c_kk;
                    const float kkn = kkv * __builtin_amdgcn_rsqf(fmaxf(n2v[t >> 2][t & 3], 1e-24f));
                    const float gprev = gcarry; lg -= QF(eeq, t);
                    const float gcur = __expf(lg), ginv = __builtin_amdgcn_rcpf(gcur); gcarry = gcur;
                    const float at = -kkn * gprev, rt = rs * gcur, bt = kkn * al * ginv, kt = kmod * ginv;
                    if (t & 1) {
                        atp[(t >> 1) & 3] = pk_bf16(atl, at); rtp[(t >> 1) & 3] = pk_bf16(rtl, rt); bkp[t >> 1] = pk_bf16(btl, bt); bkp[8 + (t >> 1)] = pk_bf16(ktl, kt);
                        if ((t & 7) == 7) { *(LAS u32x4*)(cb + C2_AT + lane * 32 + (t >> 3) * 16) = (u32x4){atp[0], atp[1], atp[2], atp[3]}; *(LAS u32x4*)(cb + C2_RT + lane * 32 + (t >> 3) * 16) = (u32x4){rtp[0], rtp[1], rtp[2], rtp[3]}; }
                    } else { btl = bt; ktl = kt; atl = at; rtl = rt; }
                }
                *(LAS float*)(cb + C2_GTV + lane * 4) = __expf(lg);
#pragma unroll
                for (int q = 0; q < 4; ++q) *(LAS u32x4*)(cb + C2_BK + lane * 64 + q * 16) = (u32x4){bkp[2 * q], bkp[2 * q + 1], bkp[8 + 2 * q], bkp[8 + 2 * q + 1]};
#pragma unroll
                for (int q = 0; q < 2; ++q) *(LAS u32x4*)(cb + C2_VT + lane * 32 + q * 16) = (u32x4){vvp[4 * q], vvp[4 * q + 1], vvp[4 * q + 2], vvp[4 * q + 3]};
                asm volatile("s_waitcnt lgkmcnt(0)" ::: "memory");
                f32x4 nab = (f32x4){0.f, 0.f, 0.f, 0.f}, nabT = nab, nakT = nab, nrbT = nab, nrkT = nab;
#pragma unroll
                for (int s2 = 0; s2 < 2; ++s2) {
                    const int k0 = 32 * s2 + 8 * fq;
                    const bf16x8 fa = mk_frag(tr4(cb + C2_AT, k0, lane), tr4(cb + C2_AT, k0 + 4, lane)), fr_ = mk_frag(tr4(cb + C2_RT, k0, lane), tr4(cb + C2_RT, k0 + 4, lane));
                    const bf16x8 fb = mk_frag(tr4bk(cb + C2_BK, k0, lane), tr4bk(cb + C2_BK, k0 + 4, lane)), fk = mk_frag(tr4bk(cb + C2_BK + 8, k0, lane), tr4bk(cb + C2_BK + 8, k0 + 4, lane));
                    nab = __builtin_amdgcn_mfma_f32_16x16x32_bf16(fa, fb, nab, 0, 0, 0); nabT = __builtin_amdgcn_mfma_f32_16x16x32_bf16(fb, fa, nabT, 0, 0, 0);
                    nakT = __builtin_amdgcn_mfma_f32_16x16x32_bf16(fk, fa, nakT, 0, 0, 0);
                    nrbT = __builtin_amdgcn_mfma_f32_16x16x32_bf16(fb, fr_, nrbT, 0, 0, 0); nrkT = __builtin_amdgcn_mfma_f32_16x16x32_bf16(fk, fr_, nrkT, 0, 0, 0);
                }
                const u32x2 z2 = (u32x2){0u, 0u};
                f32x4 dg;
#pragma unroll
                for (int r = 0; r < 4; ++r) {
                    const int c = 4 * fq + r;
                    dg[r] = (c == fr) ? 1.f : 0.f;
                    nakT[r] = (c < fr) ? nakT[r] : 0.f; nabT[r] = (c < fr) ? nabT[r] : 0.f; nab[r] = (fr < c) ? nab[r] : 0.f;
                    nrbT[r] = (c <= fr) ? nrbT[r] : 0.f; nrkT[r] = (c <= fr) ? nrkT[r] : 0.f;
                }
                *(LAS u32x2*)(cb + C2_NAK + fr * 32 + fq * 8) = pk4(nakT);
                { const u32x2 wb = pk4(nrbT), wk = pk4(nrkT); *(LAS u32x4*)(cb + C2_NRBK + fr * 64 + fq * 16) = (u32x4){wb.x, wb.y, wk.x, wk.y}; }
#define FRG(X) mk_frag(pk4(X), z2)
#define MM(X, Y) __builtin_amdgcn_mfma_f32_16x16x32_bf16(FRG(X), FRG(Y), (f32x4){0.f, 0.f, 0.f, 0.f}, 0, 0, 0)
                {
                    const f32x4 p2 = MM(nabT, nab), q2 = MM(nab, nabT);
                    const f32x4 p4 = MM(q2, p2), q4 = MM(p2, q2);
                    const f32x4 p8 = MM(q4, p4);
                    const f32x4 m1 = MM(nabT + dg, p2 + dg);
                    const f32x4 m2t = MM(p8 + dg, q4 + dg);
                    const f32x4 mt = MM(m1, m2t);
                    *(LAS u32x2*)(cb + C2_MT + fr * 32 + fq * 8) = pk4(mt);
                }
#undef FRG
#undef MM
            }
            __syncthreads();
            if (wave < 4) {
                const int vrow = 16 * wave + fr;
                const u32x2 z2 = (u32x2){0u, 0u};
#define CH_DECL(P) u32x2 P##nak, P##mt, P##vq; bf16x8 P##fa0, P##fa1, P##fr0, P##fr1, P##nrbk, P##bk0, P##bk1, P##bk2, P##bk3; f32x4 P##g0, P##g1, P##g2, P##g3;
#define CH_LOAD(P, c_) do { const LAS unsigned char* cb = lds + (c_) * C2_CH; \
                    P##vq = *(const LAS u32x2*)(cb + C2_VT + vrow * 32 + fq * 8); P##nak = *(const LAS u32x2*)(cb + C2_NAK + fr * 32 + fq * 8); P##mt = *(const LAS u32x2*)(cb + C2_MT + fr * 32 + fq * 8); \
                    P##fa0 = mk_frag(tr4(cb + C2_AT, 4 * fq, lane), tr4(cb + C2_AT, 16 + 4 * fq, lane)); P##fa1 = mk_frag(tr4(cb + C2_AT, 32 + 4 * fq, lane), tr4(cb + C2_AT, 48 + 4 * fq, lane)); \
                    P##fr0 = mk_frag(tr4(cb + C2_RT, 4 * fq, lane), tr4(cb + C2_RT, 16 + 4 * fq, lane)); P##fr1 = mk_frag(tr4(cb + C2_RT, 32 + 4 * fq, lane), tr4(cb + C2_RT, 48 + 4 * fq, lane)); \
                    P##nrbk = *(const LAS bf16x8*)(cb + C2_NRBK + fr * 64 + fq * 16); \
                    P##bk0 = *(const LAS bf16x8*)(cb + C2_BK + (fr) * 64 + fq * 16); P##bk1 = *(const LAS bf16x8*)(cb + C2_BK + (16 + fr) * 64 + fq * 16); \
                    P##bk2 = *(const LAS bf16x8*)(cb + C2_BK + (32 + fr) * 64 + fq * 16); P##bk3 = *(const LAS bf16x8*)(cb + C2_BK + (48 + fr) * 64 + fq * 16); \
                    P##g0 = *(const LAS f32x4*)(cb + C2_GTV + (4 * fq) * 4); P##g1 = *(const LAS f32x4*)(cb + C2_GTV + (16 + 4 * fq) * 4); \
                    P##g2 = *(const LAS f32x4*)(cb + C2_GTV + (32 + 4 * fq) * 4); P##g3 = *(const LAS f32x4*)(cb + C2_GTV + (48 + 4 * fq) * 4); } while (0)
#define CH_STEP(P, c_) do { \
                    const bf16x8 bs0 = mk_frag(pk4(St[0]), pk4(St[1])), bs1 = mk_frag(pk4(St[2]), pk4(St[3]));     \
                    f32x4 acc = (f32x4){0.f, 0.f, 0.f, 0.f}, y = acc, u = acc; \
                    acc = __builtin_amdgcn_mfma_f32_16x16x32_bf16(mk_frag(P##nak, z2), mk_frag(P##vq, z2), acc, 0, 0, 0); \
                    acc = __builtin_amdgcn_mfma_f32_16x16x32_bf16(P##fa0, bs0, acc, 0, 0, 0); \
                    acc = __builtin_amdgcn_mfma_f32_16x16x32_bf16(P##fa1, bs1, acc, 0, 0, 0); \
                    y = __builtin_amdgcn_mfma_f32_16x16x32_bf16(P##fr0, bs0, y, 0, 0, 0); \
                    y = __builtin_amdgcn_mfma_f32_16x16x32_bf16(P##fr1, bs1, y, 0, 0, 0); \
                    u = __builtin_amdgcn_mfma_f32_16x16x32_bf16(mk_frag(P##mt, z2), mk_frag(pk4(acc), z2), u, 0, 0, 0); \
                    const bf16x8 buv = mk_frag(pk4(u), P##vq); \
                    St[0] = __builtin_amdgcn_mfma_f32_16x16x32_bf16(P##bk0, buv, St[0], 0, 0, 0); St[1] = __builtin_amdgcn_mfma_f32_16x16x32_bf16(P##bk1, buv, St[1], 0, 0, 0); \
                    St[2] = __builtin_amdgcn_mfma_f32_16x16x32_bf16(P##bk2, buv, St[2], 0, 0, 0); St[3] = __builtin_amdgcn_mfma_f32_16x16x32_bf16(P##bk3, buv, St[3], 0, 0, 0); \
                    y = __builtin_amdgcn_mfma_f32_16x16x32_bf16(P##nrbk, buv, y, 0, 0, 0); \
                    St[0] = St[0] * P##g0; St[1] = St[1] * P##g1; St[2] = St[2] * P##g2; St[3] = St[3] * P##g3; \
                    _Pragma("unroll") for (int r = 0; r < 4; ++r) *(LAS float*)(lds + C2_YS + (size_t)(((c_) * 16 + 4 * fq + r) * 64 + vrow) * 4) = y[r]; } while (0)
                CH_DECL(A) CH_DECL(B)
                CH_LOAD(A, 0);
                for (int c = 0; c < 8; c += 2) {
                    CH_LOAD(B, c + 1);
                    CH_STEP(A, c);
                    if (c + 2 < 8) CH_LOAD(A, c + 2);
                    CH_STEP(B, c + 1);
                }
#undef CH_DECL
#undef CH_LOAD
#undef CH_STEP
            }
            __syncthreads();
            {
                const LAS unsigned char* cb = lds + (ptok >> 4) * C2_CH;
                f32x4 lw[4], lb[4];
#pragma unroll
                for (int i = 0; i < 4; ++i) { lw[i] = *(const f32x4*)(F.ap->in[17] + (size_t)L * D + h * 64 + 16 * pj + 4 * i); lb[i] = *(const f32x4*)(F.ap->in[18] + (size_t)L * D + h * 64 + 16 * pj + 4 * i); }
                f32x4 y4[4]; float sm = 0.f;
#pragma unroll
                for (int i = 0; i < 4; ++i) { y4[i] = *(const LAS f32x4*)(lds + C2_YS + (size_t)(ptok * 64 + 16 * pj + 4 * i) * 4); sm += (y4[i][0] + y4[i][1]) + (y4[i][2] + y4[i][3]); }
                sm += dppf<0xB1>(sm); sm += dppf<0x4E>(sm);
                const float mean = sm * (1.0f / 64.0f); float vs = 0.f;
#pragma unroll
                for (int i = 0; i < 4; ++i) { y4[i] = y4[i] - mean; vs += (y4[i][0] * y4[i][0] + y4[i][1] * y4[i][1]) + (y4[i][2] * y4[i][2] + y4[i][3] * y4[i][3]); }
                vs += dppf<0xB1>(vs); vs += dppf<0x4E>(vs);
                const float rstd = __builtin_amdgcn_rsqf(vs * (1.0f / 64.0f) + LNX_EPS);
                const float bon = *(const LAS float*)(cb + C2_BON + (ptok & 15) * 4);
                unsigned ow[8];
#pragma unroll
                for (int i = 0; i < 4; ++i) {
                    float z[4];
#pragma unroll
                    for (int e = 0; e < 4; ++e) { const float vvl = bf1(*(const LAS unsigned short*)(cb + C2_VT + (16 * pj + 4 * i + e) * 32 + (ptok & 15) * 2)); z[e] = y4[i][e] * rstd * lw[i][e] + lb[i][e] + bon * vvl; }
                    ow[2 * i] = pk_bf16(z[0], z[1]); ow[2 * i + 1] = pk_bf16(z[2], z[3]);
                }
                int ptok_ = ptok; asm volatile("" : "+v"(ptok_));
                bf16_t* zp = F.S2 + (mrow0 + (size_t)g * 128 + ptok_) * D + h * 64 + 16 * pj;
                *(u32x4*)zp = (u32x4){ow[0], ow[1], ow[2], ow[3]}; *(u32x4*)(zp + 8) = (u32x4){ow[4], ow[5], ow[6], ow[7]};
            }
            __syncthreads();
        }
    }
}

constexpr int LDS_BYTES = 163840;
constexpr int LDSCTL_OFF = 163776;
constexpr int PPL = 15;
constexpr int NPHASE = NLAYER * PPL + 1;

template <int PH> __device__ __forceinline__ void run_phase(Frame& F, int L) {
    using namespace pg8;
    { int t_ = threadIdx.x; asm volatile("" : "+v"(t_)); F.tid = t_; F.lane = t_ & 63; F.wave = __builtin_amdgcn_readfirstlane(t_ >> 6);
      int g_ = gridDim.x, b_ = blockIdx.x; asm volatile("" : "+s"(g_), "+s"(b_)); F.G = g_; F.bid = b_;
      ArgsP a_ = (ArgsP)__builtin_amdgcn_kernarg_segment_ptr(); asm volatile("" : "+s"(a_)); F.ap = a_; F.X = a_->out; set_ws(F, a_->ws); }
    if constexpr (PH == 0) {
        convert_weights(F, L);
        if (L == 0) rmsnorm_rows(F, F.ap->in[0], F.ap->in[1], F.S1, (bf16_t*)F.X);
        else rmsnorm_rows_bf(F, (const bf16_t*)F.X, F.ap->in[1] + (size_t)L * D, F.S1);
    } else if constexpr (PH == 1) {
        Gemm g{F.WinT + (size_t)R_RKV * D, F.S1, D, D, D, RAWLD / 256, M / 256, 0}; StaticOrder S; S.init(g.nM, g.nN, F.G, F.bid);
        EpiRawT E{F.RAW, RAWLD};
        gemm_phase(F.lds, g, S, E);
    } else if constexpr (PH == 2) {
    } else if constexpr (PH == 3) {
    } else if constexpr (PH == 4) {
        scan2_phase(F, L);
    } else if constexpr (PH == 5) {
    } else if constexpr (PH == 6) {
        Gemm g{F.S1, F.WinT, D, D, D, M / 256, 20, 0}; StaticOrder S; S.init(g.nM, g.nN, F.G, F.bid);
        EpiG<ACT_NONE, ACT_SILU, ACT_SILU, ACT_SIGMOID, ACT_SIGMOID> E{{F.RAW, D, nullptr, nullptr, nullptr, 0, nullptr, 0}, {F.RAWB, D, nullptr, nullptr, nullptr, 0, nullptr, 0}, 1024, {F.S2, D, nullptr, nullptr, F.S2, D, nullptr, 0}, 2048,
            {F.S3, D, nullptr, nullptr, nullptr, 0, nullptr, 0}, 3072, {F.RAW + (size_t)2 * M * D, D, nullptr, nullptr, nullptr, 0, nullptr, 0}, 4096};
        gemm_phase(F.lds, g, S, E);
    } else if constexpr (PH == 7) {
        Gemm g{F.S2, F.WrpT, D, D, D, M / 256, 4, 0}; StaticOrder S; S.init(g.nM, g.nN, F.G, F.bid);
        EpiG<ACT_NONE, ACT_NONE> E{{F.S3, D, nullptr, nullptr, F.S3, D, nullptr, 0}, {}, 1 << 30};
        gemm_phase(F.lds, g, S, E);
    } else if constexpr (PH == 8) {
    } else if constexpr (PH == 9) {
    } else if constexpr (PH == 10) {
        poold_phase(F, F.RAW, F.RAWB, F.ap->in[4] + (size_t)L * D);
    } else if constexpr (PH == 11) {
    } else if constexpr (PH == 12) {
        Gemm g{F.RAWB, F.WppT, D, D, D, M / 256, 4, 0}; StaticOrder S; S.init(g.nM, g.nN, F.G, F.bid);
        EpiG<ACT_NONE, ACT_NONE> E{{F.RAW, D, nullptr, nullptr, F.RAW + (size_t)2 * M * D, D, F.S3, D}, {}, 1 << 30};
        gemm_phase(F.lds, g, S, E);
    } else if constexpr (PH == 13) {
    } else if constexpr (PH == 14) {
        Gemm g{F.RAW, F.WoutT, D, D, D, M / 256, 4, 0}; StaticOrder S; S.init(g.nM, g.nN, F.G, F.bid);
        EpiG<ACT_NONE, ACT_NONE> E{{L == NLAYER - 1 ? F.S2 : (bf16_t*)F.X, D, nullptr, nullptr, nullptr, 0, (const bf16_t*)F.X, D}, {}, 1 << 30};
        gemm_phase(F.lds, g, S, E);
    } else {
        final_norm(F, F.S2);
    }
}
__device__ __forceinline__ void frame_init(Frame& F, unsigned char* lds_raw) {
    F.lds = (LAS unsigned char*)lds_raw;
    F.tid = threadIdx.x; F.lane = F.tid & 63; F.wave = __builtin_amdgcn_readfirstlane(F.tid >> 6); F.G = gridDim.x; F.bid = blockIdx.x;
    F.ap = (ArgsP)__builtin_amdgcn_kernarg_segment_ptr();
    F.X = F.ap->out;
    set_ws(F, F.ap->ws);
}
#ifndef PROBE_STAGE
#define PROBE_STAGE -1
#endif
#if MK_PER_PHASE
__global__ void __launch_bounds__(512, 2) mk_dump(Args args, size_t ws_off, int ld, int rowmask) {
    const bf16_t* src = (const bf16_t*)(args.ws + ws_off);
    for (size_t it = (size_t)blockIdx.x * 512 + threadIdx.x; it < (size_t)M * 512; it += (size_t)gridDim.x * 512) {
        const size_t m = it >> 9; const int c = (int)(it & 511) * 2; const unsigned w = *(const unsigned*)(src + (m & (size_t)rowmask) * ld + (ld == 256 ? (c & 255) : c));
        args.out[m * D + c] = 1000.f * bf_lo(w); args.out[m * D + c + 1] = 1000.f * bf_hi(w);
    }
}
template <int PH> __global__ void __launch_bounds__(512, 2) mk_phase(Args args) {
    extern __shared__ __attribute__((aligned(16))) unsigned char lds_raw[];
    Frame F; frame_init(F, lds_raw);
    run_phase<PH>(F, F.ap->ph_lo);
}
#else
__global__ void __launch_bounds__(512, 2) mk_fwd(Args args) {
    extern __shared__ __attribute__((aligned(16))) unsigned char lds_raw[];
    Frame F; frame_init(F, lds_raw);
    volatile LAS unsigned* ctlw = (volatile LAS unsigned*)(F.lds + LDSCTL_OFF);
    if (F.tid < 16) ctlw[F.tid] = 0u;
    __syncthreads();
    XcdBarrier bar = xcd_barrier_post((unsigned*)(F.ws + WS_CTL), ctlw);
    for (int L = 0; L < NLAYER; ++L) {
        run_phase<0>(F, L); xcd_barrier(bar);
        run_phase<1>(F, L); xcd_barrier(bar);
        run_phase<4>(F, L); xcd_barrier(bar);
        run_phase<6>(F, L); xcd_barrier(bar);
        run_phase<7>(F, L); xcd_barrier(bar);
        run_phase<10>(F, L); xcd_barrier(bar);
        run_phase<12>(F, L); xcd_barrier(bar);
        run_phase<14>(F, L); xcd_barrier(bar);
    }
    run_phase<15>(F, 0);
}
#endif

#if MK_PER_PHASE
template <int PH> static void launch_phase(int grid, hipStream_t stream, Args a, int L) { if (PH == 2 || PH == 3 || PH == 5 || PH == 11) return; a.ph_lo = L; a.ph_hi = PH; hipLaunchKernelGGL(mk_phase<PH>, dim3(grid), dim3(512), LDS_BYTES, stream, a); }
template <int PH> static bool set_lds() { return hipFuncSetAttribute((const void*)mk_phase<PH>, hipFuncAttributeMaxDynamicSharedMemorySize, LDS_BYTES) == hipSuccess; }
#endif
extern "C" void kernel_launch(void* const* d_in, const int* in_sizes, int n_in, void* d_out, int out_size, void* d_ws, size_t ws_size, hipStream_t stream) {
    static int grid = 0;
    if (grid == 0) {
        if (n_in != 22 || in_sizes[0] != M * D || out_size != M * D || ws_size < WS_END) { fprintf(stderr, "kernel_launch: unexpected shapes / workspace (%d inputs, ws %zu)\n", n_in, ws_size); grid = -1; return; }
        int dev = 0, cus = 0;
        if (hipGetDevice(&dev) != hipSuccess || hipDeviceGetAttribute(&cus, hipDeviceAttributeMultiprocessorCount, dev) != hipSuccess) { grid = -1; return; }
#if MK_PER_PHASE
        bool ok = set_lds<0>() && set_lds<1>() && set_lds<2>() && set_lds<3>() && set_lds<4>() && set_lds<5>() && set_lds<6>() && set_lds<7>() && set_lds<8>() && set_lds<9>() && set_lds<10>() && set_lds<11>()
               && set_lds<12>() && set_lds<13>() && set_lds<14>() && set_lds<15>();
        if (!ok) { fprintf(stderr, "kernel_launch: hipFuncSetAttribute failed\n"); grid = -1; return; }
#else
        int per_cu = 0;
        if (hipFuncSetAttribute((const void*)mk_fwd, hipFuncAttributeMaxDynamicSharedMemorySize, LDS_BYTES) != hipSuccess) { fprintf(stderr, "kernel_launch: hipFuncSetAttribute failed\n"); grid = -1; return; }
        if (hipOccupancyMaxActiveBlocksPerMultiprocessor(&per_cu, (const void*)mk_fwd, 512, LDS_BYTES) != hipSuccess || per_cu < 1) { fprintf(stderr, "kernel_launch: occupancy query says %d\n", per_cu); }
#endif
        (void)hipGetLastError();
        grid = cus;
    }
    if (grid < 0) return;
    Args a{};
    for (int i = 0; i < 22; ++i) a.in[i] = (const float*)d_in[i];
    a.out = (float*)d_out; a.ws = (unsigned char*)d_ws;
#if MK_PER_PHASE
    if (PROBE_STAGE >= 0) {
        const int L = 0;
        launch_phase<0>(grid, stream, a, L); launch_phase<1>(grid, stream, a, L);
        if (PROBE_STAGE >= 2) launch_phase<2>(grid, stream, a, L);
        if (PROBE_STAGE >= 3) launch_phase<3>(grid, stream, a, L);
        if (PROBE_STAGE >= 4) launch_phase<4>(grid, stream, a, L);
        if (PROBE_STAGE >= 5) launch_phase<5>(grid, stream, a, L);
        if (PROBE_STAGE >= 6) launch_phase<6>(grid, stream, a, L);
        if (PROBE_STAGE >= 7) launch_phase<7>(grid, stream, a, L);
        if (PROBE_STAGE >= 8) launch_phase<8>(grid, stream, a, L);
        if (PROBE_STAGE >= 9) launch_phase<9>(grid, stream, a, L);
        if (PROBE_STAGE >= 10) launch_phase<10>(grid, stream, a, L);
        if (PROBE_STAGE >= 11) launch_phase<11>(grid, stream, a, L);
        if (PROBE_STAGE >= 12) launch_phase<12>(grid, stream, a, L);
        if (PROBE_STAGE >= 13) launch_phase<13>(grid, stream, a, L);
        size_t off = WS_RAW; int ld = RAWLD; int rowmask = 0x7fffffff;
        if (PROBE_STAGE == 2) { off = WS_VFIRST; ld = D; }
        if (PROBE_STAGE == 3) { off = WS_S1; ld = D; }
        if (PROBE_STAGE == 5) { off = WS_S1; ld = D; }
#if defined(PROBE_ALT) || defined(PROBE_SWAP)
        if (PROBE_STAGE == 3) { off = WS_S2; ld = D; }
        if (PROBE_STAGE == 2) { off = WS_EAT; ld = 256; rowmask = 2047; }
        if (PROBE_STAGE == 1) { off = WS_RAW + 4608; ld = RAWLD; }
#endif
        if (PROBE_STAGE == 6) { off = WS_S2; ld = D; }
        if (PROBE_STAGE == 7 || PROBE_STAGE == 8) { off = WS_S3; ld = D; }
        if (PROBE_STAGE == 9) { off = WS_S2; ld = D; }
        if (PROBE_STAGE == 10) { off = WS_RAWB; ld = D; }
        if (PROBE_STAGE == 11) { off = WS_S2; ld = D; }
        if (PROBE_STAGE == 12 || PROBE_STAGE == 13) { off = WS_RAW; ld = D; }
        hipLaunchKernelGGL(mk_dump, dim3(grid), dim3(512), 0, stream, a, off, ld, rowmask);
        return;
    }
    for (int L = 0; L < NLAYER; ++L) {
        launch_phase<0>(grid, stream, a, L); launch_phase<1>(grid, stream, a, L); launch_phase<2>(grid, stream, a, L); launch_phase<3>(grid, stream, a, L);
        launch_phase<4>(grid, stream, a, L); launch_phase<5>(grid, stream, a, L); launch_phase<6>(grid, stream, a, L); launch_phase<7>(grid, stream, a, L);
        launch_phase<8>(grid, stream, a, L); launch_phase<9>(grid, stream, a, L); launch_phase<10>(grid, stream, a, L); launch_phase<11>(grid, stream, a, L);
        launch_phase<12>(grid, stream, a, L); launch_phase<13>(grid, stream, a, L); launch_phase<14>(grid, stream, a, L);
    }
    launch_phase<15>(grid, stream, a, 0);
#else
    (void)hipMemsetAsync((char*)d_ws + WS_CTL, 0, CTL_ZERO_BYTES, stream);
    a.ph_lo = 0; a.ph_hi = 0;
    hipLaunchKernelGGL(mk_fwd, dim3(grid), dim3(512), LDS_BYTES, stream, a);
#endif
}
```

```cpp
#include <hip/hip_runtime.h>
#include <cstdio>
#include <cstdint>

#define LAS __attribute__((address_space(3)))
typedef unsigned short bf16_t;
typedef short bf16x8 __attribute__((ext_vector_type(8)));
typedef float f32x4 __attribute__((ext_vector_type(4)));
typedef float f32x2 __attribute__((ext_vector_type(2)));
typedef unsigned u32x4 __attribute__((ext_vector_type(4)));
typedef unsigned u32x2 __attribute__((ext_vector_type(2)));

#define SCAN_DUP 0
#ifndef SCAN_DUP
#define SCAN_DUP 0
#endif
#ifndef MK_PER_PHASE
#define MK_PER_PHASE 0
#endif

constexpr int M = 32768, D = 1024, SEQ = 2048, NLAYER = 4, INW = 8320, NHEAD = 16;
constexpr int RAWLD = 3328;
constexpr float NORM_EPS = 1e-6f, LNX_EPS = 64e-5f;

constexpr size_t MiB = 1u << 20;
constexpr size_t WS_CTL = 0, CTL_ZERO_BYTES = 16384;
constexpr size_t WS_WINT = 1 * MiB;
constexpr size_t WS_WPP = WS_WINT + (size_t)(INW + 128) * D * 2;
constexpr size_t WS_WRP = WS_WPP + 2 * MiB;
constexpr size_t WS_WOUT = WS_WRP + 2 * MiB;
constexpr size_t WS_LINT = WS_WOUT + 2 * MiB;
constexpr size_t WS_EAT = WS_LINT + MiB / 2;
constexpr size_t WS_VFIRST = 25 * MiB;
constexpr size_t WS_RAW = 89 * MiB;
constexpr size_t WS_RAWB = 153 * MiB;
constexpr size_t WS_S1 = 297 * MiB, WS_S2 = 361 * MiB, WS_S3 = 425 * MiB;
constexpr size_t WS_TW = 489 * MiB;
constexpr size_t WS_END = 505 * MiB;
static_assert(WS_EAT + MiB <= WS_VFIRST, "weights fit");
constexpr int R_RGATE = 2048, R_GRWKV = 3072, R_GPOOL = 4096, R_RKV = 5120, R_FOLD = 8320;

#define XB_TMO      128
#define XB_XCNT(j)  (256  + 64 * (j))
#define XB_XSUB(j)  (1280 + 64 * (j))
#define XB_XGEN(j)  (2304 + 64 * (j))
#define XB_TOP      3328
#define XB_TOPGEN   3392
#define XCD_BAR_WORDS 3456
#define XB_SPIN_CAP (1u << 18)

__device__ __forceinline__ unsigned xb_ld(unsigned* p)              { return __hip_atomic_load(p, __ATOMIC_RELAXED, __HIP_MEMORY_SCOPE_AGENT); }
__device__ __forceinline__ unsigned xb_add(unsigned* p, unsigned v) { return __hip_atomic_fetch_add(p, v, __ATOMIC_RELAXED, __HIP_MEMORY_SCOPE_AGENT); }
__device__ __forceinline__ unsigned xb_xcc_id() { return (unsigned)__builtin_amdgcn_s_getreg((3 << 11) | 20) & 0xFu; }
#define XB_SPIN(cond, bar) do { unsigned _sp = 0; while (cond) { __builtin_amdgcn_s_sleep(1); \
    if ((++_sp & 255u) == 0u) { if (xb_ld(&(bar)[XB_TMO])) break; if (_sp > XB_SPIN_CAP) { atomicAdd(&(bar)[XB_TMO], 1u); break; } } } } while (0)

struct XcdBarrier { unsigned* bar; unsigned x; volatile LAS unsigned* st; };

__device__ __forceinline__ XcdBarrier xcd_barrier_post(unsigned* bar, volatile LAS unsigned* st) {
    XcdBarrier b; b.bar = bar; b.x = xb_xcc_id(); b.st = st;
    if (threadIdx.x == 0) (void)xb_add(&bar[XB_XCNT(b.x)], 1u);
    return b;
}
__device__ __forceinline__ void xcd_barrier_complete(unsigned* bar, unsigned x, unsigned& nloc, unsigned& nx) {
    const unsigned G = gridDim.x * gridDim.y * gridDim.z;
    unsigned sum, cnt, mine, sp = 0u;
    for (;;) {
        sum = 0u; cnt = 0u; mine = 0u;
#pragma unroll
        for (unsigned j = 0; j < 16; ++j) { const unsigned c = xb_ld(&bar[XB_XCNT(j)]); sum += c; cnt += (c > 0u) ? 1u : 0u; }
        if (sum == G) { mine = xb_ld(&bar[XB_XCNT(x)]); break; }
        __builtin_amdgcn_s_sleep(1);
        if ((++sp & 255u) == 0u) { if (xb_ld(&bar[XB_TMO])) { mine = xb_ld(&bar[XB_XCNT(x)]); break; } if (sp > XB_SPIN_CAP) { atomicAdd(&bar[XB_TMO], 1u); mine = xb_ld(&bar[XB_XCNT(x)]); break; } }
    }
    nloc = mine > 0u ? mine : 1u; nx = cnt > 0u ? cnt : 1u;
}
__device__ __forceinline__ void xcd_barrier(const XcdBarrier& b) {
    asm volatile("s_waitcnt vmcnt(0)" ::: "memory");
    __syncthreads();
    if (threadIdx.x == 0) {
        unsigned* bar = b.bar; asm volatile("" : "+s"(bar));
        __builtin_amdgcn_s_waitcnt(0);
        unsigned nloc = b.st[0], nx = b.st[1];
        if (nloc == 0u) { xcd_barrier_complete(bar, b.x, nloc, nx); b.st[0] = nloc; b.st[1] = nx; }
        const unsigned old = xb_add(&bar[XB_XSUB(b.x)], 1u);
        const unsigned gen = old / nloc;
        if (old + 1u == (gen + 1u) * nloc) {
            __builtin_amdgcn_fence(__ATOMIC_RELEASE, "agent");
            asm volatile("s_waitcnt vmcnt(0)" ::: "memory");
            const unsigned og = xb_add(&bar[XB_TOP], 1u);
            const unsigned tg = og / nx;
            if (og + 1u == (tg + 1u) * nx) xb_add(&bar[XB_TOPGEN], 1u);
            else XB_SPIN(xb_ld(&bar[XB_TOPGEN]) == tg, bar);
            __builtin_amdgcn_fence(__ATOMIC_ACQUIRE, "agent");
            xb_add(&bar[XB_XGEN(b.x)], 1u);
            asm volatile("s_waitcnt vmcnt(0)" ::: "memory");
        } else {
            XB_SPIN(xb_ld(&bar[XB_XGEN(b.x)]) == gen, bar);
            __builtin_amdgcn_fence(__ATOMIC_ACQUIRE, "agent");
            asm volatile("s_waitcnt vmcnt(0)" ::: "memory");
        }
    }
    __syncthreads();
}

__device__ __forceinline__ float bf_lo(unsigned w) { return __uint_as_float(w << 16); }
__device__ __forceinline__ float bf_hi(unsigned w) { return __uint_as_float(w & 0xffff0000u); }
typedef __bf16 bf16x2_t __attribute__((ext_vector_type(2)));
__device__ __forceinline__ unsigned pk_bf16(float lo, float hi) { bf16x2_t v; v[0] = (__bf16)lo; v[1] = (__bf16)hi; return __builtin_bit_cast(unsigned, v); }
__device__ __forceinline__ unsigned short f2bf_s(float x) { return (unsigned short)(pk_bf16(x, 0.f) & 0xffffu); }
__device__ __forceinline__ float sigmoidf_(float x) { return __builtin_amdgcn_rcpf(1.0f + __expf(-x)); }
__device__ __forceinline__ float tanhf_(float x) { return 1.0f - 2.0f * __builtin_amdgcn_rcpf(1.0f + __expf(2.0f * x)); }
template <int CTRL> __device__ __forceinline__ float dppf(float x) { return __int_as_float(__builtin_amdgcn_update_dpp(0, __float_as_int(x), CTRL, 0xf, 0xf, true)); }
__device__ __forceinline__ float red8(float x) {
    x += dppf<0xB1>(x);
    x += dppf<0x4E>(x);
    x += dppf<0x141>(x);
    return x;
}
__device__ __forceinline__ float red16(float x) {
    x += dppf<0xB1>(x);
    x += dppf<0x4E>(x);
    x += dppf<0x141>(x);
    x += dppf<0x140>(x);
    return x;
}
__device__ __forceinline__ float red64(float x) {
    x = red16(x);
    return __int_as_float(__builtin_amdgcn_readlane(__float_as_int(x), 0)) + __int_as_float(__builtin_amdgcn_readlane(__float_as_int(x), 16)) +
           __int_as_float(__builtin_amdgcn_readlane(__float_as_int(x), 32)) + __int_as_float(__builtin_amdgcn_readlane(__float_as_int(x), 48));
}

namespace pg8 {
constexpr int BM = 256, BK = 64, HALF = 128, HTB = HALF * BK * 2, STAGE_BYTES = 8 * HTB, NXCD = 8, WGM = 8;
__host__ __device__ __forceinline__ int lds_byte(int r, int c) { const int st = (r >> 4) * 2 + (c >> 5), rr = r & 15, cc = c & 31, ob = rr * 64 + cc * 2; return st * 1024 + (ob ^ (((ob >> 9) & 1) << 5)); }
__host__ __device__ __forceinline__ void stage_rc(int b, int& R, int& C) { const int st = b / 1024, sb = b % 1024, swz = sb ^ (((sb >> 9) & 1) << 5); R = (st >> 1) * 16 + swz / 64; C = (st & 1) * 32 + (swz % 64) / 2; }
__host__ __device__ __forceinline__ int perm32(int rho) { const int n = rho >> 4, i = rho & 15; return 8 * (i >> 2) + 4 * n + (i & 3); }

struct Unit { int pm, pn; };
struct Gemm { const bf16_t* A; const bf16_t* Bt; int lda, ldb, K, nM, nN, a_pn_bytes; };

struct StaticOrder {
    int nM, nN, nwg, G, c;
    __device__ void init(int nM_, int nN_, int G_, int c_) { nM = nM_; nN = nN_; nwg = nM * nN; G = G_; c = c_; }
    __device__ bool next(int i, Unit& u) const {
        const long L = (long)i * G + c; if (L >= nwg) return false;
        int wgid = (int)L; { const int q = nwg / NXCD, r = nwg % NXCD, xcd = wgid % NXCD, off = wgid / NXCD; wgid = (xcd < r ? xcd * (q + 1) : r * (q + 1) + (xcd - r) * q) + off; }
        const int nig = WGM * nN, gid = wgid / nig, fm = gid * WGM, gsz = (nM - fm) < WGM ? (nM - fm) : WGM;
        u.pm = fm + ((wgid % nig) % gsz); u.pn = (wgid % nig) / gsz; return true;
    }
};

template <class Epi, bool ALIGN_EPI = true, bool SP2 = true>
__device__ __forceinline__ void gemm_phase(LAS unsigned char* lds, const Gemm g, const StaticOrder& S, const Epi& E) {
    int tid_ = threadIdx.x; asm volatile("" : "+v"(tid_));
    const int tid = tid_, wid = __builtin_amdgcn_readfirstlane(tid >> 6), lane = tid & 63, wr = wid >> 2, wc = wid & 3, fr = lane & 15, fq = lane >> 4;
    int K_ = g.K; asm volatile("" : "+s"(K_));
    const int K = K_, nt = K / BK;
    unsigned voffA[2], voffB[2];
#pragma unroll
    for (int i = 0; i < 2; ++i) { int R, C; stage_rc(tid * 16 + i * 8192, R, C); const int Rb = Epi::PERM ? ((R & ~31) + perm32(R & 31)) : R;
        voffA[i] = (unsigned)(R * g.lda + C) * 2u; voffB[i] = (unsigned)(Rb * g.ldb + C) * 2u; }
    const size_t kstep = (size_t)(BK * 2);
    const size_t hstepA = (size_t)HALF * g.lda * 2, hstepB = (size_t)HALF * g.ldb * 2;
    const size_t tstepA = 2 * hstepA, tstepB = 2 * hstepB;
    const unsigned ldsw = (unsigned)wid * 1024u;
    const int aoff = lds_byte(wr * 64 + fr, fq * 8), boff = lds_byte(wc * 32 + fr, fq * 8);
#define PG8_SA(b, h) (((b) * 2 + (h)) * HTB)
#define PG8_SB(b, h) ((4 + (b) * 2 + (h)) * HTB)
#define PG8_STAGE(bufoff, gbase, voff) do { _Pragma("unroll") for (int _i = 0; _i < 2; ++_i) \
        __builtin_amdgcn_global_load_lds((const unsigned*)((const char*)(gbase) + (voff)[_i]), (LAS unsigned*)(lds + (bufoff) + ldsw + _i * 8192), 16, 0, 0); } while (0)
#define PG8_LDA(dst, b, h) do { _Pragma("unroll") for (int m = 0; m < 4; ++m) _Pragma("unroll") for (int k = 0; k < 2; ++k) dst[m][k] = *(const LAS bf16x8*)(lds + PG8_SA(b, h) + aoff + m * 2048 + k * 1024); } while (0)
#define PG8_LDB(dst, b, h) do { _Pragma("unroll") for (int n = 0; n < 2; ++n) _Pragma("unroll") for (int k = 0; k < 2; ++k) dst[n][k] = *(const LAS bf16x8*)(lds + PG8_SB(b, h) + boff + n * 2048 + k * 1024); } while (0)
#define PG8_MMA(ai, bj, At, Bt) do { __builtin_amdgcn_s_setprio(1); _Pragma("unroll") for (int m = 0; m < 4; ++m) _Pragma("unroll") for (int n = 0; n < 2; ++n) _Pragma("unroll") for (int k = 0; k < 2; ++k) \
        acc[ai][bj][m][n] = __builtin_amdgcn_mfma_f32_16x16x32_bf16(Bt[n][k], At[m][k], acc[ai][bj][m][n], 0, 0, 0); __builtin_amdgcn_s_setprio(0); } while (0)
#define PG8_WAIT_V(n) asm volatile("s_waitcnt vmcnt(" #n ")" ::: "memory")
#define PG8_WAIT_L(n) asm volatile("s_waitcnt lgkmcnt(" #n ")" ::: "memory")
#define PG8_BAR __builtin_amdgcn_s_barrier()
#define PG8_SCHED __builtin_amdgcn_sched_barrier(0)
    Unit cur, nxt; int ui = 0;
    if (!S.next(0, cur)) return;
    f32x4 acc[2][2][4][2];
#pragma unroll
    for (int a = 0; a < 2; ++a)
#pragma unroll
        for (int b = 0; b < 2; ++b)
#pragma unroll
            for (int m = 0; m < 4; ++m)
#pragma unroll
                for (int n = 0; n < 2; ++n) acc[a][b][m][n] = (f32x4){0.f, 0.f, 0.f, 0.f};
    bf16x8 At[4][2], B0[2][2], B1[2][2];
    const char* cA = (const char*)g.A + (size_t)cur.pm * tstepA + (size_t)cur.pn * g.a_pn_bytes; const char* cB = (const char*)g.Bt + (size_t)cur.pn * tstepB;
    if constexpr (SP2) {
        PG8_STAGE(PG8_SB(0, 0), cB, voffB); PG8_STAGE(PG8_SB(0, 1), cB + hstepB, voffB); PG8_STAGE(PG8_SA(0, 0), cA, voffA); PG8_STAGE(PG8_SA(0, 1), cA + hstepA, voffA);
        if (wr == 1) PG8_BAR;
        PG8_WAIT_V(2); PG8_BAR;
        PG8_STAGE(PG8_SB(1, 0), cB + kstep, voffB); PG8_STAGE(PG8_SA(1, 0), cA + kstep, voffA); PG8_STAGE(PG8_SB(1, 1), cB + hstepB + kstep, voffB);
        PG8_WAIT_V(6); PG8_BAR;
    } else {
        PG8_STAGE(PG8_SB(0, 0), cB, voffB); PG8_STAGE(PG8_SA(0, 0), cA, voffA); PG8_STAGE(PG8_SB(0, 1), cB + hstepB, voffB); PG8_STAGE(PG8_SA(0, 1), cA + hstepA, voffA);
        if (wr == 1) PG8_BAR;
        PG8_WAIT_V(4); PG8_BAR;
        PG8_STAGE(PG8_SB(1, 0), cB + kstep, voffB); PG8_STAGE(PG8_SA(1, 0), cA + kstep, voffA); PG8_STAGE(PG8_SB(1, 1), cB + hstepB + kstep, voffB);
        PG8_WAIT_V(6); PG8_BAR;
    }
    for (;;) {
        const bool has_next = S.next(ui + 1, nxt);
        const char* nA = has_next ? (const char*)g.A + (size_t)nxt.pm * tstepA + (size_t)nxt.pn * g.a_pn_bytes : cA; const char* nB = has_next ? (const char*)g.Bt + (size_t)nxt.pn * tstepB : cB;
        for (int t = 0; t < nt; t += 2) {
            const bool last = (t == nt - 2);
            const char* a1 = cA + (size_t)(t + 1) * kstep;
            const char* a2 = last ? nA : cA + (size_t)(t + 2) * kstep; const char* b2 = last ? nB : cB + (size_t)(t + 2) * kstep;
            const char* a3 = a2 + kstep; const char* b3 = b2 + kstep;
            if constexpr (SP2) {
            PG8_LDB(B0, 0, 0); PG8_LDB(B1, 0, 1); PG8_SCHED; PG8_LDA(At, 0, 0); PG8_STAGE(PG8_SA(1, 1), a1 + hstepA, voffA);
            PG8_WAIT_V(8); PG8_WAIT_L(0); PG8_BAR; PG8_MMA(0, 0, At, B0); PG8_MMA(0, 1, At, B1); PG8_BAR; PG8_SCHED;
            PG8_LDA(At, 0, 1); PG8_STAGE(PG8_SB(0, 0), b2, voffB); PG8_STAGE(PG8_SB(0, 1), b2 + hstepB, voffB); PG8_STAGE(PG8_SA(0, 0), a2, voffA);
            PG8_WAIT_V(8); PG8_WAIT_L(0); PG8_BAR; PG8_MMA(1, 0, At, B0); PG8_MMA(1, 1, At, B1); PG8_BAR; PG8_SCHED;
            PG8_LDB(B0, 1, 0); PG8_LDB(B1, 1, 1); PG8_SCHED; PG8_LDA(At, 1, 0); PG8_STAGE(PG8_SA(0, 1), a2 + hstepA, voffA);
            PG8_WAIT_V(8); PG8_WAIT_L(0); PG8_BAR; PG8_MMA(0, 0, At, B0); PG8_MMA(0, 1, At, B1); PG8_BAR; PG8_SCHED;
            PG8_LDA(At, 1, 1); PG8_STAGE(PG8_SB(1, 0), b3, voffB); PG8_STAGE(PG8_SB(1, 1), b3 + hstepB, voffB); PG8_STAGE(PG8_SA(1, 0), a3, voffA);
            PG8_WAIT_V(8); PG8_WAIT_L(0); PG8_BAR; PG8_MMA(1, 0, At, B0); PG8_MMA(1, 1, At, B1); PG8_BAR; PG8_SCHED;
            } else {
            PG8_LDB(B0, 0, 0); PG8_SCHED; PG8_LDA(At, 0, 0); PG8_STAGE(PG8_SA(1, 1), a1 + hstepA, voffA);
            PG8_WAIT_L(8); PG8_BAR; PG8_WAIT_L(0); PG8_MMA(0, 0, At, B0); PG8_BAR; PG8_SCHED;
            PG8_LDB(B1, 0, 1); PG8_STAGE(PG8_SB(0, 0), b2, voffB);
            PG8_BAR; PG8_WAIT_L(0); PG8_MMA(0, 1, At, B1); PG8_BAR;
            PG8_LDA(At, 0, 1); PG8_STAGE(PG8_SA(0, 0), a2, voffA);
            PG8_BAR; PG8_WAIT_L(0); PG8_MMA(1, 0, At, B0); PG8_BAR; PG8_SCHED;
            PG8_STAGE(PG8_SB(0, 1), b2 + hstepB, voffB);
            PG8_WAIT_V(6); PG8_BAR; PG8_MMA(1, 1, At, B1); PG8_BAR;
            PG8_LDB(B0, 1, 0); PG8_SCHED; PG8_LDA(At, 1, 0); PG8_STAGE(PG8_SA(0, 1), a2 + hstepA, voffA);
            PG8_WAIT_L(8); PG8_BAR; PG8_WAIT_L(0); PG8_MMA(0, 0, At, B0); PG8_BAR; PG8_SCHED;
            PG8_LDB(B1, 1, 1); PG8_STAGE(PG8_SB(1, 0), b3, voffB);
            PG8_BAR; PG8_WAIT_L(0); PG8_MMA(0, 1, At, B1); PG8_BAR;
            PG8_LDA(At, 1, 1); PG8_STAGE(PG8_SA(1, 0), a3, voffA);
            PG8_BAR; PG8_WAIT_L(0); PG8_MMA(1, 0, At, B0); PG8_BAR; PG8_SCHED;
            PG8_STAGE(PG8_SB(1, 1), b3 + hstepB, voffB);
            PG8_WAIT_V(6); PG8_BAR; PG8_MMA(1, 1, At, B1); PG8_BAR;
            }
        }
        if constexpr (ALIGN_EPI) { if (wr == 0) PG8_BAR; }
        E(acc, cur, wr, wc, fr, fq);
        if (!has_next) break;
#pragma unroll
        for (int a = 0; a < 2; ++a)
#pragma unroll
            for (int b = 0; b < 2; ++b)
#pragma unroll
                for (int m = 0; m < 4; ++m)
#pragma unroll
                    for (int n = 0; n < 2; ++n) acc[a][b][m][n] = (f32x4){0.f, 0.f, 0.f, 0.f};
        cur = nxt; cA = nA; cB = nB; ++ui;
        if constexpr (ALIGN_EPI) { if (wr == 1) PG8_BAR; }
    }
    PG8_WAIT_V(0);
    if constexpr (!ALIGN_EPI) { if (wr == 0) PG8_BAR; }
    PG8_BAR;
#undef PG8_SA
#undef PG8_SB
#undef PG8_STAGE
#undef PG8_LDA
#undef PG8_LDB
#undef PG8_MMA
#undef PG8_WAIT_V
#undef PG8_WAIT_L
#undef PG8_BAR
#undef PG8_SCHED
}

enum { ACT_NONE = 0, ACT_SILU = 1, ACT_SIGMOID = 2, ACT_DECAY = 3 };
template <int ACT> __device__ __forceinline__ float actf(float v) {
    if (ACT == ACT_SILU) return v * sigmoidf_(v);
    if (ACT == ACT_SIGMOID) return sigmoidf_(v);
    if (ACT == ACT_DECAY) return 0.60653065971f * sigmoidf_(v);
    return v;
}
struct EpiCfg {
    bf16_t* out; int ldo;
    const float* bias;
    const float* cscale;
    const bf16_t* in1; int ld1;
    const bf16_t* in2; int ld2;
};
template <int ACT_A, int ACT_B, int ACT_C = ACT_NONE, int ACT_D = ACT_NONE, int ACT_E = ACT_NONE> struct EpiG {
    static constexpr bool PERM = true;
    EpiCfg a, b; int split; EpiCfg c = {}; int split2 = 1 << 30; EpiCfg d = {}; int split3 = 1 << 30; EpiCfg e = {}; int split4 = 1 << 30;
    template <int ACT> __device__ __forceinline__ void run(const EpiCfg& c, int colt, const f32x4 (&acc)[2][2][4][2], const Unit& u, int wr, int wc, int fr, int fq) const {
        const int row0 = u.pm * BM + wr * 64 + fr, col0 = colt + wc * 32 + 8 * fq;
        f32x4 bv[2][2], sv[2][2];
#pragma unroll
        for (int bj = 0; bj < 2; ++bj)
#pragma unroll
            for (int n = 0; n < 2; ++n) {
                bv[bj][n] = c.bias ? *(const f32x4*)(c.bias + col0 + bj * HALF + 4 * n) : (f32x4){0.f, 0.f, 0.f, 0.f};
                sv[bj][n] = c.cscale ? *(const f32x4*)(c.cscale + col0 + bj * HALF + 4 * n) : (f32x4){1.f, 1.f, 1.f, 1.f};
            }
#pragma unroll
        for (int ai = 0; ai < 2; ++ai)
#pragma unroll
            for (int m = 0; m < 4; ++m) {
                const size_t row = (size_t)(row0 + ai * HALF + m * 16);
#pragma unroll
                for (int bj = 0; bj < 2; ++bj) {
                    const int cc = col0 + bj * HALF;
                    f32x4 v0 = acc[ai][bj][m][0] + bv[bj][0], v1 = acc[ai][bj][m][1] + bv[bj][1];
#pragma unroll
                    for (int j = 0; j < 4; ++j) { v0[j] = actf<ACT>(v0[j]); v1[j] = actf<ACT>(v1[j]); }
                    if (c.in1) { const u32x4 w = *(const u32x4*)(c.in1 + row * c.ld1 + cc);
                        v0[0] *= bf_lo(w.x); v0[1] *= bf_hi(w.x); v0[2] *= bf_lo(w.y); v0[3] *= bf_hi(w.y);
                        v1[0] *= bf_lo(w.z); v1[1] *= bf_hi(w.z); v1[2] *= bf_lo(w.w); v1[3] *= bf_hi(w.w); }
                    if (c.cscale) { v0 *= sv[bj][0]; v1 *= sv[bj][1]; }
                    if (c.in2) { const u32x4 w = *(const u32x4*)(c.in2 + row * c.ld2 + cc);
                        v0[0] += bf_lo(w.x); v0[1] += bf_hi(w.x); v0[2] += bf_lo(w.y); v0[3] += bf_hi(w.y);
                        v1[0] += bf_lo(w.z); v1[1] += bf_hi(w.z); v1[2] += bf_lo(w.w); v1[3] += bf_hi(w.w); }
                    u32x4 w; w.x = pk_bf16(v0[0], v0[1]); w.y = pk_bf16(v0[2], v0[3]); w.z = pk_bf16(v1[0], v1[1]); w.w = pk_bf16(v1[2], v1[3]);
                    *(u32x4*)(c.out + row * c.ldo + cc) = w;
                }
            }
    }
    __device__ __forceinline__ void operator()(const f32x4 (&acc)[2][2][4][2], const Unit& u, int wr, int wc, int fr, int fq) const {
        const int colt = u.pn * BM;
        if (colt >= split4) run<ACT_E>(e, colt - split4, acc, u, wr, wc, fr, fq);
        else if (colt >= split3) run<ACT_D>(d, colt - split3, acc, u, wr, wc, fr, fq);
        else if (colt >= split2) run<ACT_C>(c, colt - split2, acc, u, wr, wc, fr, fq);
        else if (colt >= split) run<ACT_B>(b, colt - split, acc, u, wr, wc, fr, fq);
        else run<ACT_A>(a, colt, acc, u, wr, wc, fr, fq);
    }
};
struct EpiRawT {
    static constexpr bool PERM = true;
    bf16_t* out; int ncols;
    __device__ __forceinline__ void operator()(const f32x4 (&acc)[2][2][4][2], const Unit& u, int wr, int wc, int fr, int fq) const {
        const int ch0 = u.pm * BM + wr * 64 + fr, tok0 = u.pn * BM + wc * 32 + 8 * fq;
#pragma unroll
        for (int ai = 0; ai < 2; ++ai)
#pragma unroll
            for (int m = 0; m < 4; ++m) {
                const int ch = ch0 + ai * HALF + m * 16;
#pragma unroll
                for (int bj = 0; bj < 2; ++bj) {
                    const int tok = tok0 + bj * HALF;
                    const f32x4 v0 = acc[ai][bj][m][0], v1 = acc[ai][bj][m][1];
                    u32x4 w; w.x = pk_bf16(v0[0], v0[1]); w.y = pk_bf16(v0[2], v0[3]); w.z = pk_bf16(v1[0], v1[1]); w.w = pk_bf16(v1[2], v1[3]);
                    *(u32x4*)(out + ((size_t)(tok >> 4) * ncols + ch) * 16 + (tok & 15)) = w;
                }
            }
    }
};
struct EpiResid {
    static constexpr bool PERM = false;
    float* X; int ldc; const float* Xin;
    __device__ __forceinline__ void operator()(const f32x4 (&acc)[2][2][4][2], const Unit& u, int wr, int wc, int fr, int fq) const {
        const int row0 = u.pm * BM + wr * 64 + fr, col0 = u.pn * BM + wc * 32 + 4 * fq;
#pragma unroll
        for (int ai = 0; ai < 2; ++ai)
#pragma unroll
            for (int m = 0; m < 4; ++m) { float* rowp = X + (size_t)(row0 + ai * HALF + m * 16) * ldc + col0;
#pragma unroll
                for (int bj = 0; bj < 2; ++bj)
#pragma unroll
                    for (int n = 0; n < 2; ++n) { f32x4* p = (f32x4*)(rowp + bj * HALF + n * 16); *p = *(const f32x4*)(Xin + (p - (f32x4*)X) * 4) + acc[ai][bj][m][n]; } }
    }
};
}

struct Args {
    const float* in[22];
    float* out; unsigned char* ws;
    int ph_lo, ph_hi;
};
typedef const Args __attribute__((address_space(4)))* ArgsP;
struct Frame {
    LAS unsigned char* lds;
    int tid, lane, wave, G, bid;
    ArgsP ap;
    float* X; unsigned char* ws;
    bf16_t *WinT, *WppT, *WrpT, *WoutT, *LinT, *EAT, *VF, *RAW, *RAWB, *S1, *S2, *S3, *TW;
};

__device__ __forceinline__ void set_ws(Frame& F, unsigned char* ws) {
    F.ws = ws;
    F.WinT = (bf16_t*)(ws + WS_WINT); F.WppT = (bf16_t*)(ws + WS_WPP); F.WrpT = (bf16_t*)(ws + WS_WRP); F.WoutT = (bf16_t*)(ws + WS_WOUT);
    F.LinT = (bf16_t*)(ws + WS_LINT); F.EAT = (bf16_t*)(ws + WS_EAT); F.VF = (bf16_t*)(ws + WS_VFIRST);
    F.RAW = (bf16_t*)(ws + WS_RAW); F.RAWB = (bf16_t*)(ws + WS_RAWB); F.S1 = (bf16_t*)(ws + WS_S1); F.S2 = (bf16_t*)(ws + WS_S2); F.S3 = (bf16_t*)(ws + WS_S3);
    F.TW = (bf16_t*)(ws + WS_TW);
}
__device__ __forceinline__ void transpose_cvt(const Frame& F, const float* src, int ldn, int K, int N, bf16_t* dst, int ldk) {
    LAS float* tile = (LAS float*)F.lds;
    const int tilesK = K / 64, ntile = tilesK * (N / 64);
    for (int tl = F.bid; tl < ntile; tl += F.G) {
        const int k0 = (tl % tilesK) * 64, n0 = (tl / tilesK) * 64;
#pragma unroll
        for (int i = 0; i < 8; ++i) { const int idx = F.tid + 512 * i, r = idx >> 6, c = idx & 63; tile[r * 65 + c] = src[(size_t)(k0 + r) * ldn + n0 + c]; }
        __syncthreads();
#pragma unroll
        for (int i = 0; i < 4; ++i) { const int idx = F.tid + 512 * i, n = idx >> 5, kp = idx & 31;
            *(unsigned*)(dst + (size_t)(n0 + n) * ldk + k0 + 2 * kp) = pk_bf16(tile[(2 * kp) * 65 + n], tile[(2 * kp + 1) * 65 + n]); }
        __syncthreads();
    }
}
__device__ __forceinline__ void fold_weights(const Frame& F, int L) {
    const int fr = F.lane & 15, fq = F.lane >> 4;
    LAS float* red = (LAS float*)F.lds;
    for (int tl = F.bid; tl < 64 * 4; tl += F.G) {
        const int k0 = (tl >> 2) * 16, j0 = (tl & 3) * 16, jj = j0 + fr;
        f32x4 acc = (f32x4){0.f, 0.f, 0.f, 0.f};
        if (L > 0) {
            const int cw = F.wave * 128 + 32 * fq;
            const float* arow = F.ap->in[2] + (size_t)L * D * INW + 4096 + (size_t)(k0 + fr) * INW + cw;
            const float* mu = F.ap->in[6] + (size_t)L * 3200 + 2048 + cw;
            const float* V1 = F.ap->in[12] + (size_t)(L - 1) * D * 32 + (size_t)cw * 32 + (jj & 31);
#pragma unroll
            for (int s4 = 0; s4 < 8; ++s4) {
                const f32x4 a4 = *(const f32x4*)(arow + 4 * s4), m4 = *(const f32x4*)(mu + 4 * s4);
#pragma unroll
                for (int e = 0; e < 4; ++e) acc = __builtin_amdgcn_mfma_f32_16x16x4f32(a4[e], V1[(size_t)(4 * s4 + e) * 32] * ((jj < 32) ? (1.0f - m4[e]) : m4[e]), acc, 0, 0, 0);
            }
        }
        *(LAS f32x4*)(red + (F.wave * 64 + F.lane) * 4) = acc;
        __syncthreads();
        if (F.wave == 0) {
            f32x4 t = acc;
#pragma unroll
            for (int w = 1; w < 8; ++w) t += *(const LAS f32x4*)(red + (w * 64 + F.lane) * 4);
            *(u32x2*)(F.WinT + (size_t)(R_FOLD + jj) * D + k0 + 4 * fq) = (u32x2){pk_bf16(t[0], t[1]), pk_bf16(t[2], t[3])};
            unsigned zz = 0u; asm volatile("" : "+v"(zz));
            *(u32x2*)(F.WinT + (size_t)(R_FOLD + 64 + jj) * D + k0 + 4 * fq) = (u32x2){zz, zz};
        }
        __syncthreads();
    }
    if (L > 0) { const float* V2 = F.ap->in[13] + (size_t)(L - 1) * 32 * D;
        for (int idx = F.bid * 512 + F.tid; idx < D * 32; idx += F.G * 512) { const int n = idx >> 5, j = idx & 31; F.EAT[131072 + idx] = f2bf_s(V2[(size_t)j * D + n]); } }
}
__device__ __forceinline__ void fold_pool_lin(const Frame& F, int L) {
    const float* win = F.ap->in[2] + (size_t)L * D * INW;
    const int fr = F.lane & 15, fq = F.lane >> 4;
    for (int tl = F.bid * 8 + F.wave; tl < 4 * 64 * 16; tl += F.G * 8) {
        const int g = tl >> 10, k0 = ((tl >> 4) & 63) * 16, d0 = (tl & 15) * 16;
        const float* arow = win + (size_t)(k0 + fr) * INW + 256 * g + 64 * fq;
        const float* bcol = F.ap->in[3] + ((size_t)(L * 4 + g) * 256 + 64 * fq) * 256 + d0 + fr;
        f32x4 acc = (f32x4){0.f, 0.f, 0.f, 0.f};
#pragma unroll 4
        for (int s4 = 0; s4 < 16; ++s4) {
            const f32x4 a4 = *(const f32x4*)(arow + 4 * s4);
#pragma unroll
            for (int e = 0; e < 4; ++e) acc = __builtin_amdgcn_mfma_f32_16x16x4f32(a4[e], bcol[(size_t)(4 * s4 + e) * 256], acc, 0, 0, 0);
        }
        *(u32x2*)(F.WinT + (size_t)(256 * g + d0 + fr) * D + k0 + 4 * fq) = (u32x2){pk_bf16(acc[0], acc[1]), pk_bf16(acc[2], acc[3])};
    }
}
__device__ __forceinline__ void convert_weights(const Frame& F, int L) {
    transpose_cvt(F, F.ap->in[2] + (size_t)L * D * INW + 1024, INW, D, 1024, F.WinT + (size_t)1024 * D, D);
    transpose_cvt(F, F.ap->in[2] + (size_t)L * D * INW + 2048, INW, D, 3200, F.WinT + (size_t)R_RKV * D, D);
    fold_pool_lin(F, L);
    transpose_cvt(F, F.ap->in[2] + (size_t)L * D * INW + 5248, INW, D, 1024, F.WinT + (size_t)R_RGATE * D, D);
    transpose_cvt(F, F.ap->in[2] + (size_t)L * D * INW + 6272, INW, D, 1024, F.WinT + (size_t)R_GPOOL * D, D);
    transpose_cvt(F, F.ap->in[2] + (size_t)L * D * INW + 7296, INW, D, 1024, F.WinT + (size_t)R_GRWKV * D, D);
    fold_weights(F, L);
    transpose_cvt(F, F.ap->in[5] + (size_t)L * D * D, D, D, D, F.WppT, D);
    transpose_cvt(F, F.ap->in[19] + (size_t)L * D * D, D, D, D, F.WrpT, D);
    transpose_cvt(F, F.ap->in[20] + (size_t)L * D * D, D, D, D, F.WoutT, D);
    transpose_cvt(F, F.ap->in[8] + (size_t)L * 64 * D, D, 64, D, F.EAT, 64);
    transpose_cvt(F, F.ap->in[10] + (size_t)L * 64 * D, D, 64, D, F.EAT + 65536, 64);
}
__device__ __forceinline__ void rmsnorm_rows(const Frame& F, const float* src, const float* g, bf16_t* H, bf16_t* copy_to) {
    for (int m = F.bid * 8 + F.wave; m < M; m += F.G * 8) {
        const float* xr = src + (size_t)m * D;
        f32x4 v[4]; float ss = 0.f;
#pragma unroll
        for (int i = 0; i < 4; ++i) { v[i] = *(const f32x4*)(xr + F.lane * 4 + 256 * i); ss += v[i][0] * v[i][0] + v[i][1] * v[i][1] + v[i][2] * v[i][2] + v[i][3] * v[i][3]; }
        ss = red64(ss);
        const float rs = __builtin_amdgcn_rsqf(ss * (1.0f / D) + NORM_EPS);
#pragma unroll
        for (int i = 0; i < 4; ++i) {
            const int c = F.lane * 4 + 256 * i;
            if (copy_to) *(u32x2*)(copy_to + (size_t)m * D + c) = (u32x2){pk_bf16(v[i][0], v[i][1]), pk_bf16(v[i][2], v[i][3])};
            const f32x4 gg = *(const f32x4*)(g + c);
            u32x2 w; w.x = pk_bf16(v[i][0] * rs * gg[0], v[i][1] * rs * gg[1]); w.y = pk_bf16(v[i][2] * rs * gg[2], v[i][3] * rs * gg[3]);
            *(u32x2*)(H + (size_t)m * D + c) = w;
        }
    }
}
__device__ __forceinline__ void rmsnorm_rows_bf(const Frame& F, const bf16_t* Xb, const float* g, bf16_t* H) {
    for (int m = F.bid * 8 + F.wave; m < M; m += F.G * 8) {
        const bf16_t* xr = Xb + (size_t)m * D;
        u32x4 w[2]; float ss = 0.f;
#pragma unroll
        for (int i = 0; i < 2; ++i) { w[i] = *(const u32x4*)(xr + F.lane * 8 + 512 * i);
#pragma unroll
            for (int e = 0; e < 4; ++e) { const float a = bf_lo(w[i][e]), b = bf_hi(w[i][e]); ss += a * a + b * b; } }
        ss = red64(ss);
        const float rs = __builtin_amdgcn_rsqf(ss * (1.0f / D) + NORM_EPS);
#pragma unroll
        for (int i = 0; i < 2; ++i) {
            const int c = F.lane * 8 + 512 * i;
            const f32x4 g0 = *(const f32x4*)(g + c), g1 = *(const f32x4*)(g + c + 4);
            u32x4 o; o.x = pk_bf16(bf_lo(w[i].x) * rs * g0[0], bf_hi(w[i].x) * rs * g0[1]); o.y = pk_bf16(bf_lo(w[i].y) * rs * g0[2], bf_hi(w[i].y) * rs * g0[3]);
            o.z = pk_bf16(bf_lo(w[i].z) * rs * g1[0], bf_hi(w[i].z) * rs * g1[1]); o.w = pk_bf16(bf_lo(w[i].w) * rs * g1[2], bf_hi(w[i].w) * rs * g1[3]);
            *(u32x4*)(H + (size_t)m * D + c) = o;
        }
    }
}
__device__ __forceinline__ void final_norm(const Frame& F, const bf16_t* Xb) {
    const float* g = F.ap->in[21];
    for (int m = F.bid * 8 + F.wave; m < M; m += F.G * 8) {
        const bf16_t* xr = Xb + (size_t)m * D;
        u32x4 w[2]; float ss = 0.f;
#pragma unroll
        for (int i = 0; i < 2; ++i) { w[i] = *(const u32x4*)(xr + F.lane * 8 + 512 * i);
#pragma unroll
            for (int e = 0; e < 4; ++e) { const float a = bf_lo(w[i][e]), b = bf_hi(w[i][e]); ss += a * a + b * b; } }
        ss = red64(ss);
        const float rs = __builtin_amdgcn_rsqf(ss * (1.0f / D) + NORM_EPS);
#pragma unroll
        for (int i = 0; i < 2; ++i) {
            const int c = F.lane * 8 + 512 * i;
            const f32x4 g0 = *(const f32x4*)(g + c), g1 = *(const f32x4*)(g + c + 4);
            *(f32x4*)(F.X + (size_t)m * D + c) = (f32x4){bf_lo(w[i].x) * rs * g0[0], bf_hi(w[i].x) * rs * g0[1], bf_lo(w[i].y) * rs * g0[2], bf_hi(w[i].y) * rs * g0[3]};
            *(f32x4*)(F.X + (size_t)m * D + c + 4) = (f32x4){bf_lo(w[i].z) * rs * g1[0], bf_hi(w[i].z) * rs * g1[1], bf_lo(w[i].w) * rs * g1[2], bf_hi(w[i].w) * rs * g1[3]};
        }
    }
}
__device__ __forceinline__ void tw_phase(const Frame& F, int L) {
    const float* mu = F.ap->in[6] + (size_t)L * 3200;
    for (int it = F.bid * 512 + F.tid; it < M * 32; it += F.G * 512) {
        const int m = it >> 5, j = it & 31; u32x4 o = (u32x4){0u, 0u, 0u, 0u};
        if (j < 16) {
            const int c0 = 3072 + 8 * j, t = m & (SEQ - 1);
            const u32x4 cw = *(const u32x4*)(F.RAW + (size_t)m * RAWLD + c0);
            u32x4 pw = (u32x4){0u, 0u, 0u, 0u}; if (t > 0) pw = *(const u32x4*)(F.RAW + (size_t)(m - 1) * RAWLD + c0);
            const f32x4 m0 = *(const f32x4*)(mu + c0), m1 = *(const f32x4*)(mu + c0 + 4);
            float s[8];
#define SH(i, cwv, pwv, muv, hi) { const float c_ = hi ? bf_hi(cwv) : bf_lo(cwv), p_ = hi ? bf_hi(pwv) : bf_lo(pwv); s[i] = c_ + (muv) * (p_ - c_); }
            SH(0, cw.x, pw.x, m0[0], 0) SH(1, cw.x, pw.x, m0[1], 1) SH(2, cw.y, pw.y, m0[2], 0) SH(3, cw.y, pw.y, m0[3], 1)
            SH(4, cw.z, pw.z, m1[0], 0) SH(5, cw.z, pw.z, m1[1], 1) SH(6, cw.w, pw.w, m1[2], 0) SH(7, cw.w, pw.w, m1[3], 1)
#undef SH
            if (j < 8) {
#pragma unroll
                for (int i = 0; i < 8; ++i) s[i] = tanhf_(s[i]);
            }
            o.x = pk_bf16(s[0], s[1]); o.y = pk_bf16(s[2], s[3]); o.z = pk_bf16(s[4], s[5]); o.w = pk_bf16(s[6], s[7]);
        }
        *(u32x4*)(F.TW + (size_t)m * 256 + 8 * j) = o;
    }
}
__device__ __forceinline__ void vmix_phase(const Frame& F, int L) {
    const float* mu = F.ap->in[6] + (size_t)L * 3200 + 2048;
    const int tid = F.tid, c0 = 2 * tid;
    const f32x2 muv = *(const f32x2*)(mu + c0);
    LAS float* vsh = (LAS float*)F.lds;
    LAS float* part = (LAS float*)(F.lds + 16384);
    LAS float* midl = (LAS float*)(F.lds + 16384 + 8192);
    bf16_t* dst = (L == 0) ? F.VF : F.S3;
    float v1r[64]; f32x2 v2r[32]; f32x2 v0v = (f32x2){0.f, 0.f};
    const int jj = tid & 31, cs = tid >> 5;
    if (L > 0) {
        const float* V1 = F.ap->in[12] + (size_t)(L - 1) * D * 32; const float* V2 = F.ap->in[13] + (size_t)(L - 1) * 32 * D;
#pragma unroll
        for (int i = 0; i < 64; ++i) v1r[i] = V1[(size_t)(cs * 64 + i) * 32 + jj];
#pragma unroll
        for (int j = 0; j < 32; ++j) v2r[j] = *(const f32x2*)(V2 + (size_t)j * D + c0);
        v0v = *(const f32x2*)(F.ap->in[11] + (size_t)(L - 1) * D + c0);
    }
    for (int grp = F.bid; grp < M / 4; grp += F.G) {
        const int m0 = grp * 4, t0 = m0 & (SEQ - 1);
        unsigned rw[5];
        rw[0] = (t0 > 0) ? *(const unsigned*)(F.RAW + (size_t)(m0 - 1) * RAWLD + 2048 + c0) : 0u;
#pragma unroll
        for (int i = 0; i < 4; ++i) rw[i + 1] = *(const unsigned*)(F.RAW + (size_t)(m0 + i) * RAWLD + 2048 + c0);
        f32x2 vs[4];
#pragma unroll
        for (int i = 0; i < 4; ++i) { const float c_lo = bf_lo(rw[i + 1]), c_hi = bf_hi(rw[i + 1]), p_lo = bf_lo(rw[i]), p_hi = bf_hi(rw[i]);
            vs[i].x = c_lo + muv.x * (p_lo - c_lo); vs[i].y = c_hi + muv.y * (p_hi - c_hi); }
        if (L == 0) {
#pragma unroll
            for (int i = 0; i < 4; ++i) *(unsigned*)(dst + (size_t)(m0 + i) * D + c0) = pk_bf16(vs[i].x, vs[i].y);
            continue;
        }
#pragma unroll
        for (int i = 0; i < 4; ++i) *(LAS f32x2*)(vsh + i * 1024 + c0) = vs[i];
        __syncthreads();
#pragma unroll
        for (int i = 0; i < 4; ++i) {
            float p = 0.f;
#pragma unroll
            for (int k4 = 0; k4 < 16; ++k4) { const f32x4 x = *(const LAS f32x4*)(vsh + i * 1024 + cs * 64 + 4 * k4);
                p += x[0] * v1r[4 * k4] + x[1] * v1r[4 * k4 + 1] + x[2] * v1r[4 * k4 + 2] + x[3] * v1r[4 * k4 + 3]; }
            part[(i * 16 + cs) * 32 + jj] = p;
        }
        __syncthreads();
        if (tid < 128) { const int i = tid >> 5; float s = 0.f;
#pragma unroll
            for (int k = 0; k < 16; ++k) s += part[(i * 16 + k) * 32 + jj];
            midl[i * 32 + jj] = s; }
        __syncthreads();
#pragma unroll
        for (int i = 0; i < 4; ++i) {
            float z0 = v0v.x, z1 = v0v.y;
#pragma unroll
            for (int j4 = 0; j4 < 8; ++j4) { const f32x4 mm = *(const LAS f32x4*)(midl + i * 32 + 4 * j4);
#pragma unroll
                for (int e = 0; e < 4; ++e) { z0 += mm[e] * v2r[4 * j4 + e].x; z1 += mm[e] * v2r[4 * j4 + e].y; } }
            const float g0 = sigmoidf_(z0), g1 = sigmoidf_(z1);
            const unsigned fw = *(const unsigned*)(F.VF + (size_t)(m0 + i) * D + c0);
            const float o0 = vs[i].x + (bf_lo(fw) - vs[i].x) * g0, o1 = vs[i].y + (bf_hi(fw) - vs[i].y) * g1;
            *(unsigned*)(dst + (size_t)(m0 + i) * D + c0) = pk_bf16(o0, o1);
        }
        __syncthreads();
    }
}
__device__ __forceinline__ void poold_phase(const Frame& F, const bf16_t* __restrict__ PIN, bf16_t* __restrict__ SGIO, const float* __restrict__ scale) {
    for (int it = F.bid * 512 + F.tid; it < (M / 32) * 128; it += F.G * 512) {
        const int j = it & 127, m0 = (it >> 7) * 32, t0 = m0 & (SEQ - 1), w = 2 << (j >> 5);
        const bf16_t* col = PIN + 8 * j;
        const f32x4 sc0 = *(const f32x4*)(scale + 8 * j), sc1 = *(const f32x4*)(scale + 8 * j + 4);
        float s[8];
#pragma unroll
        for (int e = 0; e < 8; ++e) s[e] = 0.f;
        if (t0 > 0) {
            for (int i = 1; i < w; ++i) { const u32x4 x = *(const u32x4*)(col + (size_t)(m0 - i) * D);
                s[0] += bf_lo(x.x); s[1] += bf_hi(x.x); s[2] += bf_lo(x.y); s[3] += bf_hi(x.y); s[4] += bf_lo(x.z); s[5] += bf_hi(x.z); s[6] += bf_lo(x.w); s[7] += bf_hi(x.w); }
        }
        for (int sb = 0; sb < 4; ++sb) {
            u32x4 xv[8], ov[8], gv[8];
#pragma unroll
            for (int i = 0; i < 8; ++i) {
                const int ii = sb * 8 + i, t = t0 + ii; const size_t m = (size_t)(m0 + ii);
                const bool sub = (t >= w) && (ii > 0);
                xv[i] = *(const u32x4*)(col + m * D);
                ov[i] = *(const u32x4*)(col + (sub ? m - w : m) * D);
                gv[i] = *(const u32x4*)(SGIO + m * D + 8 * j);
            }
#pragma unroll
            for (int i = 0; i < 8; ++i) {
                const int ii = sb * 8 + i, t = t0 + ii; const size_t m = (size_t)(m0 + ii);
                const float fs = ((t >= w) && (ii > 0)) ? 1.0f : 0.0f;
                const u32x4 x = xv[i], o = ov[i], gw = gv[i];
                const float c[8] = {bf_lo(x.x), bf_hi(x.x), bf_lo(x.y), bf_hi(x.y), bf_lo(x.z), bf_hi(x.z), bf_lo(x.w), bf_hi(x.w)};
                const float d[8] = {bf_lo(o.x), bf_hi(o.x), bf_lo(o.y), bf_hi(o.y), bf_lo(o.z), bf_hi(o.z), bf_lo(o.w), bf_hi(o.w)};
#pragma unroll
                for (int e = 0; e < 8; ++e) s[e] += c[e] - fs * d[e];
                const float inv = __builtin_amdgcn_rcpf((float)((t + 1 < w) ? (t + 1) : w));
                u32x4 r; r.x = pk_bf16((s[0] * inv - c[0]) * sc0[0] * bf_lo(gw.x), (s[1] * inv - c[1]) * sc0[1] * bf_hi(gw.x)); r.y = pk_bf16((s[2] * inv - c[2]) * sc0[2] * bf_lo(gw.y), (s[3] * inv - c[3]) * sc0[3] * bf_hi(gw.y));
                r.z = pk_bf16((s[4] * inv - c[4]) * sc1[0] * bf_lo(gw.z), (s[5] * inv - c[5]) * sc1[1] * bf_hi(gw.z)); r.w = pk_bf16((s[6] * inv - c[6]) * sc1[2] * bf_lo(gw.w), (s[7] * inv - c[7]) * sc1[3] * bf_hi(gw.w));
                *(u32x4*)(SGIO + m * D + 8 * j) = r;
            }
        }
    }
}

constexpr int SC_T = 32;
constexpr int SC_ARR = SC_T * 64;
constexpr int SC_BUF_BYTES = 6 * SC_ARR * 4;
constexpr int SC_YS = 2 * SC_BUF_BYTES, SC_RAWR = SC_YS + SC_ARR * 4, SC_RAWK = SC_RAWR + SC_ARR * 4, SC_PREV = SC_RAWK + SC_ARR * 4;
static_assert(SC_PREV + 1024 <= 131072, "scan LDS");

#define QP(n) "quad_perm:[" #n "," #n "," #n "," #n "] row_mask:0xf bank_mask:0xf"
__device__ __forceinline__ void sc_matvec(float& o0, float& o1, const f32x2 x, const float (&S)[8]) {
    asm volatile("s_nop 1\n\t"
        "v_mul_f32_dpp %0, %2, %4 " QP(0) "\n\t"  "v_mul_f32_dpp %1, %3, %5 " QP(0) "\n\t"
        "v_fmac_f32_dpp %0, %2, %6 " QP(1) "\n\t" "v_fmac_f32_dpp %1, %3, %7 " QP(1) "\n\t"
        "v_fmac_f32_dpp %0, %2, %8 " QP(2) "\n\t" "v_fmac_f32_dpp %1, %3, %9 " QP(2) "\n\t"
        "v_fmac_f32_dpp %0, %2, %10 " QP(3) "\n\t" "v_fmac_f32_dpp %1, %3, %11 " QP(3)
        : "=&v"(o0), "=&v"(o1) : "v"(x.x), "v"(x.y), "v"(S[0]), "v"(S[1]), "v"(S[2]), "v"(S[3]), "v"(S[4]), "v"(S[5]), "v"(S[6]), "v"(S[7]));
}
__device__ __forceinline__ void sc_update(float (&S)[8], const f32x2 w, const f32x2 b, const f32x2 k, const float sa, const float vv) {
    asm volatile("s_nop 1\n\t"
        "v_mul_f32_dpp %0, %8, %0 " QP(0) "\n\t" "v_mul_f32_dpp %1, %9, %1 " QP(0) "\n\t"
        "v_mul_f32_dpp %2, %8, %2 " QP(1) "\n\t" "v_mul_f32_dpp %3, %9, %3 " QP(1) "\n\t"
        "v_mul_f32_dpp %4, %8, %4 " QP(2) "\n\t" "v_mul_f32_dpp %5, %9, %5 " QP(2) "\n\t"
        "v_mul_f32_dpp %6, %8, %6 " QP(3) "\n\t" "v_mul_f32_dpp %7, %9, %7 " QP(3) "\n\t"
        "v_fmac_f32_dpp %0, %10, %14 " QP(0) "\n\t" "v_fmac_f32_dpp %1, %11, %14 " QP(0) "\n\t"
        "v_fmac_f32_dpp %2, %10, %14 " QP(1) "\n\t" "v_fmac_f32_dpp %3, %11, %14 " QP(1) "\n\t"
        "v_fmac_f32_dpp %4, %10, %14 " QP(2) "\n\t" "v_fmac_f32_dpp %5, %11, %14 " QP(2) "\n\t"
        "v_fmac_f32_dpp %6, %10, %14 " QP(3) "\n\t" "v_fmac_f32_dpp %7, %11, %14 " QP(3) "\n\t"
        "v_fmac_f32_dpp %0, %12, %15 " QP(0) "\n\t" "v_fmac_f32_dpp %1, %13, %15 " QP(0) "\n\t"
        "v_fmac_f32_dpp %2, %12, %15 " QP(1) "\n\t" "v_fmac_f32_dpp %3, %13, %15 " QP(1) "\n\t"
        "v_fmac_f32_dpp %4, %12, %15 " QP(2) "\n\t" "v_fmac_f32_dpp %5, %13, %15 " QP(2) "\n\t"
        "v_fmac_f32_dpp %6, %12, %15 " QP(3) "\n\t" "v_fmac_f32_dpp %7, %13, %15 " QP(3)
        : "+v"(S[0]), "+v"(S[1]), "+v"(S[2]), "+v"(S[3]), "+v"(S[4]), "+v"(S[5]), "+v"(S[6]), "+v"(S[7])
        : "v"(w.x), "v"(w.y), "v"(b.x), "v"(b.y), "v"(k.x), "v"(k.y), "v"(sa), "v"(vv));
}
__device__ __forceinline__ float sc_red(float x) {
    asm volatile("s_nop 1\n\tv_add_f32_dpp %0, %0, %0 row_ror:4 row_mask:0xf bank_mask:0xf\n\ts_nop 1\n\tv_add_f32_dpp %0, %0, %0 row_ror:8 row_mask:0xf bank_mask:0xf" : "+v"(x));
    const auto r = __builtin_amdgcn_permlane32_swap(__float_as_uint(x), __float_as_uint(x), false, false);
    return __uint_as_float(r[0]) + __uint_as_float(r[1]);
}
#undef QP
struct ScanRegs { u32x2 rr, kr, ee, aa, vv; };
__device__ __forceinline__ void scan_phase(const Frame& F, int L, const bf16_t* VP) {
    const int tid = F.tid, lane = F.lane, wave = F.wave;
    LAS float* Ys = (LAS float*)(F.lds + SC_YS);
    LAS float* rawR = (LAS float*)(F.lds + SC_RAWR);
    LAS float* rawK = (LAS float*)(F.lds + SC_RAWK);
    LAS float* prevRK = (LAS float*)(F.lds + SC_PREV);
    const int tok = tid >> 4, q = tid & 15;
    const int kc = ((lane >> 5) << 2) | ((lane >> 2) & 3), row = wave * 8 + ((lane >> 4) & 1) * 4 + (lane & 3), koff = 8 * kc + 2 * (lane & 3);
    for (int unit = F.bid; unit < 256; unit += F.G) {
        const int b = unit >> 4, h = unit & 15, hc = h * 64 + 4 * q;
        const f32x4 kk4 = *(const f32x4*)(F.ap->in[14] + (size_t)L * D + hc), ka4 = *(const f32x4*)(F.ap->in[15] + (size_t)L * D + hc);
        const f32x4 rk4 = *(const f32x4*)(F.ap->in[16] + (size_t)L * D + hc);
        const f32x4 lw4 = *(const f32x4*)(F.ap->in[17] + (size_t)L * D + hc), lb4 = *(const f32x4*)(F.ap->in[18] + (size_t)L * D + hc);
        const f32x4 mur4 = *(const f32x4*)(F.ap->in[6] + (size_t)L * 3200 + hc), muk4 = *(const f32x4*)(F.ap->in[6] + (size_t)L * 3200 + 1024 + hc);
        const size_t mrow0 = (size_t)b * SEQ;
        float S[8];
#pragma unroll
        for (int j = 0; j < 8; ++j) S[j] = 0.f;
        ScanRegs R;
#define SC_LOAD(cidx) do { const size_t m_ = mrow0 + (size_t)(cidx) * SC_T + tok; \
            R.rr = *(const u32x2*)(F.RAW + m_ * RAWLD + hc); R.kr = *(const u32x2*)(F.RAW + m_ * RAWLD + 1024 + hc); \
            R.ee = *(const u32x2*)(F.S1 + m_ * D + hc); R.aa = *(const u32x2*)(F.S2 + m_ * D + hc); R.vv = *(const u32x2*)(VP + m_ * D + hc); } while (0)
#define SC_PREP(cidx) do { \
            const f32x4 rc = (f32x4){bf_lo(R.rr.x), bf_hi(R.rr.x), bf_lo(R.rr.y), bf_hi(R.rr.y)}; \
            const f32x4 kc = (f32x4){bf_lo(R.kr.x), bf_hi(R.kr.x), bf_lo(R.kr.y), bf_hi(R.kr.y)}; \
            *(LAS f32x4*)(rawR + tok * 64 + 4 * q) = rc; *(LAS f32x4*)(rawK + tok * 64 + 4 * q) = kc; \
            __syncthreads(); \
            f32x4 rp, kp; \
            if (tok > 0) { rp = *(const LAS f32x4*)(rawR + (tok - 1) * 64 + 4 * q); kp = *(const LAS f32x4*)(rawK + (tok - 1) * 64 + 4 * q); } \
            else if ((cidx) > 0) { rp = *(const LAS f32x4*)(prevRK + (((cidx) & 1) * 2 + 0) * 64 + 4 * q); kp = *(const LAS f32x4*)(prevRK + (((cidx) & 1) * 2 + 1) * 64 + 4 * q); } \
            else { rp = (f32x4){0.f, 0.f, 0.f, 0.f}; kp = rp; } \
            if (tok == SC_T - 1) { *(LAS f32x4*)(prevRK + ((((cidx) + 1) & 1) * 2 + 0) * 64 + 4 * q) = rc; *(LAS f32x4*)(prevRK + ((((cidx) + 1) & 1) * 2 + 1) * 64 + 4 * q) = kc; } \
            const f32x4 rs = rc + mur4 * (rp - rc), ks = kc + muk4 * (kp - kc); \
            const f32x4 ev = (f32x4){bf_lo(R.ee.x), bf_hi(R.ee.x), bf_lo(R.ee.y), bf_hi(R.ee.y)}; \
            const f32x4 av = (f32x4){bf_lo(R.aa.x), bf_hi(R.aa.x), bf_lo(R.aa.y), bf_hi(R.aa.y)}; \
            const f32x4 vv = (f32x4){bf_lo(R.vv.x), bf_hi(R.vv.x), bf_lo(R.vv.y), bf_hi(R.vv.y)}; \
            f32x4 kkv = ks * kk4; \
            float ss = kkv[0] * kkv[0] + kkv[1] * kkv[1] + kkv[2] * kkv[2] + kkv[3] * kkv[3]; ss = red16(ss); \
            const float inv = 1.0f / fmaxf(sqrtf(ss), 1e-12f); kkv = kkv * inv; \
            const f32x4 kmod = ks * (1.0f + (av - 1.0f) * ka4); \
            f32x4 wv; wv[0] = __expf(-ev[0]); wv[1] = __expf(-ev[1]); wv[2] = __expf(-ev[2]); wv[3] = __expf(-ev[3]); \
            LAS float* cb_ = (LAS float*)(F.lds + ((cidx) & 1) * SC_BUF_BYTES) + tok * 64 + 4 * q; \
            *(LAS f32x4*)(cb_ + 0 * SC_ARR) = rs; *(LAS f32x4*)(cb_ + 1 * SC_ARR) = wv; *(LAS f32x4*)(cb_ + 2 * SC_ARR) = kmod; \
            *(LAS f32x4*)(cb_ + 3 * SC_ARR) = -kkv; *(LAS f32x4*)(cb_ + 4 * SC_ARR) = kkv * av; *(LAS f32x4*)(cb_ + 5 * SC_ARR) = vv; } while (0)
        SC_LOAD(0);
        SC_PREP(0);
        __syncthreads();
        for (int c = 0; c < SEQ / SC_T; ++c) {
            if (c + 1 < SEQ / SC_T) SC_LOAD(c + 1);
            const LAS float* cb = (const LAS float*)(F.lds + (c & 1) * SC_BUF_BYTES);
            const LAS float* pin = cb + koff;
            const LAS float* pv = cb + 5 * SC_ARR + row;
#define SC_LD(dst, t_) do { dst##r = *(const LAS f32x2*)(pin + 0 * SC_ARR + (t_) * 64); dst##w = *(const LAS f32x2*)(pin + 1 * SC_ARR + (t_) * 64); dst##k = *(const LAS f32x2*)(pin + 2 * SC_ARR + (t_) * 64); \
                dst##a = *(const LAS f32x2*)(pin + 3 * SC_ARR + (t_) * 64); dst##b = *(const LAS f32x2*)(pin + 4 * SC_ARR + (t_) * 64); dst##v = pv[(t_) * 64]; } while (0)
#define SC_STEP(src, t_) do { float p0_, p1_; sc_matvec(p0_, p1_, src##a, S); const float sa_ = sc_red(p0_ + p1_); sc_update(S, src##w, src##b, src##k, sa_, src##v); \
                sc_matvec(p0_, p1_, src##r, S); const float y_ = sc_red(p0_ + p1_); if (kc == 0) Ys[(t_) * 64 + row] = y_; } while (0)
            f32x2 Ar, Aw, Ak, Aa, Ab, Br, Bw, Bk, Ba, Bb; float Av, Bv;
            SC_LD(A, 0);
            for (int t = 0; t < SC_T; t += 2) {
                SC_LD(B, t + 1);
                SC_STEP(A, t);
                if (t + 2 < SC_T) SC_LD(A, t + 2);
                SC_STEP(B, t + 1);
            }
#undef SC_LD
#undef SC_STEP
            __syncthreads();
            {
                const f32x4 y4 = *(const LAS f32x4*)(Ys + tok * 64 + 4 * q);
                const float mean = red16((y4[0] + y4[1]) + (y4[2] + y4[3])) * (1.0f / 64.0f);
                const f32x4 d = y4 - mean;
                const float var = red16((d[0] * d[0] + d[1] * d[1]) + (d[2] * d[2] + d[3] * d[3])) * (1.0f / 64.0f);
                const float rstd = __builtin_amdgcn_rsqf(var + LNX_EPS);
                const f32x4 rs = *(const LAS f32x4*)(cb + 0 * SC_ARR + tok * 64 + 4 * q), km = *(const LAS f32x4*)(cb + 2 * SC_ARR + tok * 64 + 4 * q), vv = *(const LAS f32x4*)(cb + 5 * SC_ARR + tok * 64 + 4 * q);
                const f32x4 pr = rs * km * rk4;
                const float bon = red16((pr[0] + pr[1]) + (pr[2] + pr[3]));
                const f32x4 z = d * rstd * lw4 + lb4 + bon * vv;
                u32x2 o; o.x = pk_bf16(z[0], z[1]); o.y = pk_bf16(z[2], z[3]);
                *(u32x2*)(F.RAW + (mrow0 + (size_t)c * SC_T + tok) * RAWLD + hc) = o;
            }
            if (c + 1 < SEQ / SC_T) SC_PREP(c + 1);
            __syncthreads();
        }
#undef SC_LOAD
#undef SC_PREP
    }
}


constexpr int C2_AT = 0, C2_RT = 2048, C2_BK = 4096, C2_VT = 8192, C2_NAK = 10240, C2_NRBK = 10752, C2_MT = 11776, C2_GTV = 12288, C2_BON = 12544, C2_CH = 12800;
constexpr int C2_YS = 8 * C2_CH;
constexpr int C2_PREV = C2_YS + 32768;
constexpr int C2_W2S = C2_PREV + 512, C2_A2S = C2_W2S + 8192;
constexpr int C2_V2S = C2_A2S + 8192;
static_assert(C2_V2S + 8192 <= 163776, "scan LDS");
typedef short s16x4 __attribute__((ext_vector_type(4)));
__device__ __forceinline__ u32x2 tr4(const LAS unsigned char* img, int k0, int lane) {
    return __builtin_bit_cast(u32x2, __builtin_amdgcn_ds_read_tr16_b64_v4i16((LAS s16x4*)(img + (k0 + ((lane & 15) >> 2)) * 32 + (lane & 3) * 8)));
}
__device__ __forceinline__ u32x2 tr4bk(const LAS unsigned char* img, int k0, int lane) {
    return __builtin_bit_cast(u32x2, __builtin_amdgcn_ds_read_tr16_b64_v4i16((LAS s16x4*)(img + (k0 + ((lane & 15) >> 2)) * 64 + (lane & 3) * 16)));
}
__device__ __forceinline__ void wr_row(LAS unsigned char* img, int lane, const unsigned (&w)[8]) {
    *(LAS u32x4*)(img + lane * 32) = (u32x4){w[0], w[1], w[2], w[3]}; *(LAS u32x4*)(img + lane * 32 + 16) = (u32x4){w[4], w[5], w[6], w[7]};
}
__device__ __forceinline__ bf16x8 mk_frag(u32x2 lo, u32x2 hi) { return __builtin_bit_cast(bf16x8, (u32x4){lo.x, lo.y, hi.x, hi.y}); }
__device__ __forceinline__ u32x2 pk4(const f32x4 a) { return (u32x2){pk_bf16(a[0], a[1]), pk_bf16(a[2], a[3])}; }
__device__ __forceinline__ float bf1(unsigned short v) { return __uint_as_float((unsigned)v << 16); }
__device__ __forceinline__ unsigned short f2bf(float x) { return (unsigned short)(pk_bf16(x, 0.f) & 0xffffu); }
__device__ __forceinline__ void st2(LAS unsigned char* p0, LAS unsigned char* p1, float a, float b) { const unsigned w = pk_bf16(a, b); *(LAS unsigned short*)p0 = (unsigned short)w; *(LAS unsigned short*)p1 = (unsigned short)(w >> 16); }
__device__ __forceinline__ void scan2_phase(const Frame& F, int L) {
    const int tid = F.tid, lane = F.lane, wave = F.wave, fr = lane & 15, fq = lane >> 4;
    LAS unsigned char* lds = F.lds;
    for (int unit = F.bid; unit < 256; unit += F.G) {
        const int b = unit >> 4, h = unit & 15, ch = h * 64 + lane;
        const size_t mrow0 = (size_t)b * SEQ;
        const float c_kk = F.ap->in[14][(size_t)L * D + ch], c_ka = F.ap->in[15][(size_t)L * D + ch], c_rk = F.ap->in[16][(size_t)L * D + ch];
        const float c_mur = F.ap->in[6][(size_t)L * 3200 + ch], c_muk = F.ap->in[6][(size_t)L * 3200 + 1024 + ch];
        const int ptok = tid >> 2, pj = tid & 3;
        f32x4 St[4];
#pragma unroll
        for (int i = 0; i < 4; ++i) St[i] = (f32x4){0.f, 0.f, 0.f, 0.f};
        int tid_u = tid; asm volatile("" : "+v"(tid_u));
        for (int i = tid_u; i < 1024; i += 512) { const int which = i >> 9, e = i & 511;
            *(LAS u32x4*)(lds + C2_W2S + which * 8192 + e * 16) = *(const u32x4*)(F.EAT + (size_t)which * 65536 + (size_t)h * 64 * 64 + e * 8); }
        if (L > 0) for (int e = tid_u; e < 512; e += 512) { const int chl = e >> 3, p = e & 7;
            *(LAS u32x4*)(lds + C2_V2S + e * 16) = *(const u32x4*)(F.EAT + 131072 + (size_t)(h * 64 + chl) * 32 + ((8 * p) & 31)); }
        const float c_muw = F.ap->in[6][(size_t)L * 3200 + 3072 + lane], c_mua = F.ap->in[6][(size_t)L * 3200 + 3136 + lane], c_muv = F.ap->in[6][(size_t)L * 3200 + 2048 + ch];
        float c_v0[4];
#pragma unroll
        for (int i = 0; i < 4; ++i) c_v0[i] = F.ap->in[11][(size_t)(L > 0 ? L - 1 : 0) * D + h * 64 + 16 * i + (lane & 15)];
        float c_w0[4], c_a0[4];
#pragma unroll
        for (int i = 0; i < 4; ++i) { c_w0[i] = F.ap->in[7][(size_t)L * D + h * 64 + 16 * i + (lane & 15)]; c_a0[i] = F.ap->in[9][(size_t)L * D + h * 64 + 16 * i + (lane & 15)]; }
        __syncthreads();
        const auto rs_raw = __builtin_amdgcn_make_buffer_rsrc((void*)F.RAW, 0, (int)((size_t)M * RAWLD * 2), 0x00020000);
        const auto rs_vf = __builtin_amdgcn_make_buffer_rsrc((void*)F.VF, 0, M * D * 2, 0x00020000);
        const int voh = ch * 32, vol = lane * 32;
#define LDQ(vofs, q, tb) __builtin_bit_cast(u32x4, __builtin_amdgcn_raw_buffer_load_b128(rs_raw, (vofs) + (q) * 16, (int)(tb) * (RAWLD * 32), 0))
#define LDP(vofs, tb) __builtin_amdgcn_raw_buffer_load_b16(rs_raw, (vofs) + 30, (int)(tb) * (RAWLD * 32), 0)
#define QF(q, t) (((t) & 1) ? bf_hi((q)[(t) >> 1]) : bf_lo((q)[(t) >> 1]))
#define QP(q, pv, i) (((i) == 0) ? bf1(pv) : QF(q, ((i) > 0 ? (i) - 1 : 0)))

        for (int g = 0; g < SEQ / 128; ++g) {
            {
                int lane_ = lane; asm volatile("" : "+v"(lane_));
                const int fr = lane_ & 15, fq = lane_ >> 4;
                const int m0 = (int)mrow0 + g * 128 + wave * 16;
                LAS unsigned char* cb = lds + wave * C2_CH;
                LAS unsigned char* scr = lds + C2_YS + wave * 4096;
                const int tb = m0 >> 4, tbp = (tb > 0) ? tb - 1 : 0;
                unsigned rrq[8], krq[8], aaq[8], eeq[8], vvp[8];
                unsigned vrq[8], xrq[8], mixq[8]; unsigned short vprev, xprev;
                {
                    unsigned wdq[8], adq[8]; unsigned short wprev, aprev;
                    const bool has_prev = (g > 0) || (wave > 0);
                    const unsigned short pm = has_prev ? (unsigned short)0xffffu : (unsigned short)0;
                    wprev = LDP(vol + 3072 * 32, tbp) & pm; aprev = LDP(vol + 3136 * 32, tbp) & pm;
#pragma unroll
                    for (int q = 0; q < 2; ++q) { const u32x4 w4 = LDQ(vol + 3072 * 32, q, tb), a4 = LDQ(vol + 3136 * 32, q, tb);
#pragma unroll
                        for (int e = 0; e < 4; ++e) { wdq[4 * q + e] = w4[e]; adq[4 * q + e] = a4[e]; } }
                    {
                        vprev = LDP(voh + 2048 * 32, tbp) & pm; xprev = LDP(vol + 3200 * 32, tbp) & pm;
#pragma unroll
                        for (int q = 0; q < 2; ++q) { const u32x4 v4 = LDQ(voh + 2048 * 32, q, tb), x4 = LDQ(vol + 3200 * 32, q, tb);
                            const u32x4 f4 = __builtin_bit_cast(u32x4, __builtin_amdgcn_raw_buffer_load_b128(rs_vf, voh + q * 16, tb * (D * 32), 0));
#pragma unroll
                            for (int e = 0; e < 4; ++e) { vrq[4 * q + e] = v4[e]; xrq[4 * q + e] = x4[e]; mixq[4 * q + e] = f4[e]; } }
                    }
                    __builtin_amdgcn_sched_barrier(0);
                    unsigned twp[8], adp[8];
#pragma unroll
                    for (int t = 0; t < 16; t += 2) {
                        const float w0_ = QP(wdq, wprev, t), w1_ = QP(wdq, wprev, t + 1), w2_ = QP(wdq, wprev, t + 2), a0_ = QP(adq, aprev, t), a1_ = QP(adq, aprev, t + 1), a2_ = QP(adq, aprev, t + 2);
                        twp[t >> 1] = pk_bf16(tanhf_(w1_ + c_muw * (w0_ - w1_)), tanhf_(w2_ + c_muw * (w1_ - w2_)));
                        adp[t >> 1] = pk_bf16(a1_ + c_mua * (a0_ - a1_), a2_ + c_mua * (a1_ - a2_));
                    }
                    wr_row(scr, lane, twp); wr_row(scr + 2048, lane, adp);
                    asm volatile("s_waitcnt lgkmcnt(0)" ::: "memory");
                    f32x4 le[4], la[4];
#pragma unroll
                    for (int i = 0; i < 4; ++i) { le[i] = (f32x4){0.f, 0.f, 0.f, 0.f}; la[i] = le[i]; }
#pragma unroll
                    for (int s2 = 0; s2 < 2; ++s2) {
                        const int k0 = 32 * s2 + 8 * fq;
                        const bf16x8 fw = mk_frag(tr4(scr, k0, lane), tr4(scr, k0 + 4, lane)), fa = mk_frag(tr4(scr + 2048, k0, lane), tr4(scr + 2048, k0 + 4, lane));
#pragma unroll
                        for (int i = 0; i < 4; ++i) {
                            le[i] = __builtin_amdgcn_mfma_f32_16x16x32_bf16(fw, *(const LAS bf16x8*)(lds + C2_W2S + (16 * i + fr) * 128 + (32 * s2 + 8 * fq) * 2), le[i], 0, 0, 0);
                            la[i] = __builtin_amdgcn_mfma_f32_16x16x32_bf16(fa, *(const LAS bf16x8*)(lds + C2_A2S + (16 * i + fr) * 128 + (32 * s2 + 8 * fq) * 2), la[i], 0, 0, 0);
                        }
                    }
#pragma unroll
                    for (int i = 0; i < 4; ++i)
                        {
                            *(LAS u32x2*)(scr + (16 * i + fr) * 32 + fq * 8) = (u32x2){pk_bf16(0.60653065971f * sigmoidf_(le[i][0] + c_w0[i]), 0.60653065971f * sigmoidf_(le[i][1] + c_w0[i])), pk_bf16(0.60653065971f * sigmoidf_(le[i][2] + c_w0[i]), 0.60653065971f * sigmoidf_(le[i][3] + c_w0[i]))};
                            *(LAS u32x2*)(scr + 2048 + (16 * i + fr) * 32 + fq * 8) = (u32x2){pk_bf16(sigmoidf_(la[i][0] + c_a0[i]), sigmoidf_(la[i][1] + c_a0[i])), pk_bf16(sigmoidf_(la[i][2] + c_a0[i]), sigmoidf_(la[i][3] + c_a0[i]))};
                        }
                    asm volatile("s_waitcnt lgkmcnt(0)" ::: "memory");
#pragma unroll
                    for (int q = 0; q < 2; ++q) { const u32x4 we = *(const LAS u32x4*)(scr + lane * 32 + q * 16), wa = *(const LAS u32x4*)(scr + 2048 + lane * 32 + q * 16);
#pragma unroll
                        for (int e = 0; e < 4; ++e) { eeq[4 * q + e] = we[e]; aaq[4 * q + e] = wa[e]; } }
                    asm volatile("s_waitcnt lgkmcnt(0)" ::: "memory");
                }
                unsigned tch[7];
                {   const int tbn = ((int)mrow0 + (g + 1 < SEQ / 128 ? g + 1 : g) * 128 + wave * 16) >> 4;
                    tch[0] = __builtin_amdgcn_raw_buffer_load_b32(rs_raw, vol + 3072 * 32, tbn * (RAWLD * 32), 0); tch[1] = __builtin_amdgcn_raw_buffer_load_b32(rs_raw, vol + 3136 * 32, tbn * (RAWLD * 32), 0);
                    tch[2] = __builtin_amdgcn_raw_buffer_load_b32(rs_raw, vol + 3200 * 32, tbn * (RAWLD * 32), 0); tch[3] = __builtin_amdgcn_raw_buffer_load_b32(rs_raw, voh, tbn * (RAWLD * 32), 0);
                    tch[4] = __builtin_amdgcn_raw_buffer_load_b32(rs_raw, voh + 1024 * 32, tbn * (RAWLD * 32), 0); tch[5] = __builtin_amdgcn_raw_buffer_load_b32(rs_raw, voh + 2048 * 32, tbn * (RAWLD * 32), 0);
                    tch[6] = __builtin_amdgcn_raw_buffer_load_b32(rs_vf, voh, tbn * (D * 32), 0); }
                {
                    __builtin_amdgcn_sched_barrier(0);
#pragma unroll
                    for (int q = 0; q < 2; ++q) { const u32x4 r4 = LDQ(voh, q, tb), k4 = LDQ(voh + 1024 * 32, q, tb);
#pragma unroll
                        for (int e = 0; e < 4; ++e) { rrq[4 * q + e] = r4[e]; krq[4 * q + e] = k4[e]; } }
                    __builtin_amdgcn_sched_barrier(0);
                    if (L > 0) {
                        unsigned xp[8];
#pragma unroll
                        for (int i = 0; i < 8; ++i) { const unsigned xs = (i == 0) ? ((unsigned)xprev | (xrq[0] << 16)) : __builtin_amdgcn_alignbit(xrq[i], xrq[i > 0 ? i - 1 : 0], 16);
                            xp[i] = (lane < 32) ? xrq[i] : xs; }
                        wr_row(scr, lane, xp);
                        asm volatile("s_waitcnt lgkmcnt(0)" ::: "memory");
                        f32x4 mx[4];
#pragma unroll
                        for (int i = 0; i < 4; ++i) mx[i] = (f32x4){0.f, 0.f, 0.f, 0.f};
#pragma unroll
                        for (int s2 = 0; s2 < 2; ++s2) { const bf16x8 fx = mk_frag(tr4(scr, 32 * s2 + 8 * fq, lane), tr4(scr, 32 * s2 + 8 * fq + 4, lane));
#pragma unroll
                            for (int i = 0; i < 4; ++i) mx[i] = __builtin_amdgcn_mfma_f32_16x16x32_bf16(fx, *(const LAS bf16x8*)(lds + C2_V2S + (16 * i + fr) * 128 + (32 * s2 + 8 * fq) * 2), mx[i], 0, 0, 0); }
#pragma unroll
                        for (int i = 0; i < 4; ++i)
                            *(LAS u32x2*)(scr + (16 * i + fr) * 32 + fq * 8) = (u32x2){pk_bf16(sigmoidf_(mx[i][0] + c_v0[i]), sigmoidf_(mx[i][1] + c_v0[i])), pk_bf16(sigmoidf_(mx[i][2] + c_v0[i]), sigmoidf_(mx[i][3] + c_v0[i]))};
                        asm volatile("s_waitcnt lgkmcnt(0)" ::: "memory");
                    }
                    if (L > 0) {
                        const u32x4 mw0 = *(const LAS u32x4*)(scr + lane * 32), mw1 = *(const LAS u32x4*)(scr + lane * 32 + 16);
#pragma unroll
                        for (int t = 0; t < 16; t += 2) {
                            const float v0_ = QP(vrq, vprev, t), v1_ = QP(vrq, vprev, t + 1), v2_ = QP(vrq, vprev, t + 2), vs0 = v1_ + c_muv * (v0_ - v1_), vs1 = v2_ + c_muv * (v1_ - v2_);
                            const unsigned mwp = (t < 8) ? mw0[t >> 1] : mw1[(t - 8) >> 1];
                            const float mix0 = bf_lo(mwp), mix1 = bf_hi(mwp);
                            vvp[t >> 1] = pk_bf16(vs0 + (QF(mixq, t) - vs0) * mix0, vs1 + (QF(mixq, t + 1) - vs1) * mix1);
                        }
                    } else {
#pragma unroll
                        for (int t = 0; t < 16; t += 2) {
                            const float v0_ = QP(vrq, vprev, t), v1_ = QP(vrq, vprev, t + 1), v2_ = QP(vrq, vprev, t + 2);
                            vvp[t >> 1] = pk_bf16(v1_ + c_muv * (v0_ - v1_), v2_ + c_muv * (v1_ - v2_));
                        }
#pragma unroll
                        for (int q = 0; q < 2; ++q) __builtin_amdgcn_raw_buffer_store_b128(__builtin_bit_cast(decltype(__builtin_amdgcn_raw_buffer_load_b128(rs_vf, 0, 0, 0)), (u32x4){vvp[4 * q], vvp[4 * q + 1], vvp[4 * q + 2], vvp[4 * q + 3]}), rs_vf, voh + q * 16, tb * (D * 32), 0);
                    }
                    asm volatile("s_waitcnt lgkmcnt(0)" ::: "memory");
                }
                float rprev = 0.f, kprev = 0.f;
                {
                    const float rp_g = bf1(LDP(voh, tbp)), kp_g = bf1(LDP(voh + 1024 * 32, tbp));
                    rprev = (wave > 0 || g > 0) ? rp_g : 0.f; kprev = (wave > 0 || g > 0) ? kp_g : 0.f;
                }
                const float rprev0 = rprev, kprev0 = kprev;
                float sql = 0.f, pbl = 0.f; unsigned sqp[4], pbp[4];
#pragma unroll
                for (int t = 0; t < 16; ++t) {
                    const float r_c = QF(rrq, t), k_c = QF(krq, t);
                    const float rs = r_c + c_mur * (rprev - r_c), ks = k_c + c_muk * (kprev - k_c); rprev = r_c; kprev = k_c;
                    const float al = QF(aaq, t), kmod = ks * (1.0f + (al - 1.0f) * c_ka), kkv = ks * c_kk;
                    if (t & 1) { sqp[(t >> 1) & 3] = pk_bf16(sql, kkv * kkv); pbp[(t >> 1) & 3] = pk_bf16(pbl, rs * kmod * c_rk); }
                    if ((t & 7) == 7) { *(LAS u32x4*)(scr + lane * 32 + (t >> 3) * 16) = (u32x4){sqp[0], sqp[1], sqp[2], sqp[3]}; *(LAS u32x4*)(scr + 2048 + lane * 32 + (t >> 3) * 16) = (u32x4){pbp[0], pbp[1], pbp[2], pbp[3]}; }
                    else { sql = kkv * kkv; pbl = rs * kmod * c_rk; }
                }
                asm volatile("s_waitcnt lgkmcnt(0)" ::: "memory");
                {
                    f32x4 sn = (f32x4){0.f, 0.f, 0.f, 0.f}, sb = sn;
                    const bf16x8 ones = __builtin_bit_cast(bf16x8, (u32x4){0x3f803f80u, 0x3f803f80u, 0x3f803f80u, 0x3f803f80u});
#pragma unroll
                    for (int s2 = 0; s2 < 2; ++s2) { const int k0 = 32 * s2 + 8 * fq;
                        sn = __builtin_amdgcn_mfma_f32_16x16x32_bf16(mk_frag(tr4(scr, k0, lane), tr4(scr, k0 + 4, lane)), ones, sn, 0, 0, 0);
                        sb = __builtin_amdgcn_mfma_f32_16x16x32_bf16(mk_frag(tr4(scr + 2048, k0, lane), tr4(scr + 2048, k0 + 4, lane)), ones, sb, 0, 0, 0); }
                    if (fr == 0) { *(LAS f32x4*)(cb + C2_BON + 64 + fq * 16) = sn; *(LAS f32x4*)(cb + C2_BON + fq * 16) = sb; }
                }
                asm volatile("s_waitcnt lgkmcnt(0)" ::: "memory");
                f32x4 n2v[4];
#pragma unroll
                for (int i = 0; i < 4; ++i) n2v[i] = *(const LAS f32x4*)(cb + C2_BON + 64 + i * 16);
#pragma unroll
                for (int i = 0; i < 7; ++i) asm volatile("" :: "v"(tch[i]));
                float lg = 0.f, gcarry = 1.0f;
                unsigned atp[4], rtp[4]; unsigned bkp[16];
                float btl = 0.f, ktl = 0.f, atl = 0.f, rtl = 0.f;
                rprev = rprev0; kprev = kprev0;
#pragma unroll
                for (int t = 0; t < 16; ++t) {
                    const float r_c = QF(rrq, t), k_c = QF(krq, t);
                    const float rs = r_c + c_mur * (rprev - r_c), ks = k_c + c_muk * (kprev - k_c); rprev = r_c; kprev = k_c;
                    const float al = QF(aaq, t), kmod = ks * (1.0f + (al - 1.0f) * c_ka), kkv = ks * c_kk;
                    const float kkn = kkv * __builtin_amdgcn_rsqf(fmaxf(n2v[t >> 2][t & 3], 1e-24f));
                    const float gprev = gcarry; lg -= QF(eeq, t);
                    const float gcur = __expf(lg), ginv = __builtin_amdgcn_rcpf(gcur); gcarry = gcur;
                    const float at = -kkn * gprev, rt = rs * gcur, bt = kkn * al * ginv, kt = kmod * ginv;
                    if (t & 1) {
                        atp[(t >> 1) & 3] = pk_bf16(atl, at); rtp[(t >> 1) & 3] = pk_bf16(rtl, rt); bkp[t >> 1] = pk_bf16(btl, bt); bkp[8 + (t >> 1)] = pk_bf16(ktl, kt);
                        if ((t & 7) == 7) { *(LAS u32x4*)(cb + C2_AT + lane * 32 + (t >> 3) * 16) = (u32x4){atp[0], atp[1], atp[2], atp[3]}; *(LAS u32x4*)(cb + C2_RT + lane * 32 + (t >> 3) * 16) = (u32x4){rtp[0], rtp[1], rtp[2], rtp[3]}; }
                    } else { btl = bt; ktl = kt; atl = at; rtl = rt; }
                }
                *(LAS float*)(cb + C2_GTV + lane * 4) = __expf(lg);
#pragma unroll
                for (int q = 0; q < 4; ++q) *(LAS u32x4*)(cb + C2_BK + lane * 64 + q * 16) = (u32x4){bkp[2 * q], bkp[2 * q + 1], bkp[8 + 2 * q], bkp[8 + 2 * q + 1]};
#pragma unroll
                for (int q = 0; q < 2; ++q) *(LAS u32x4*)(cb + C2_VT + lane * 32 + q * 16) = (u32x4){vvp[4 * q], vvp[4 * q + 1], vvp[4 * q + 2], vvp[4 * q + 3]};
                asm volatile("s_waitcnt lgkmcnt(0)" ::: "memory");
                f32x4 nab = (f32x4){0.f, 0.f, 0.f, 0.f}, nabT = nab, nakT = nab, nrbT = nab, nrkT = nab;
#pragma unroll
                for (int s2 = 0; s2 < 2; ++s2) {
                    const int k0 = 32 * s2 + 8 * fq;
                    const bf16x8 fa = mk_frag(tr4(cb + C2_AT, k0, lane), tr4(cb + C2_AT, k0 + 4, lane)), fr_ = mk_frag(tr4(cb + C2_RT, k0, lane), tr4(cb + C2_RT, k0 + 4, lane));
                    const bf16x8 fb = mk_frag(tr4bk(cb + C2_BK, k0, lane), tr4bk(cb + C2_BK, k0 + 4, lane)), fk = mk_frag(tr4bk(cb + C2_BK + 8, k0, lane), tr4bk(cb + C2_BK + 8, k0 + 4, lane));
                    nab = __builtin_amdgcn_mfma_f32_16x16x32_bf16(fa, fb, nab, 0, 0, 0); nabT = __builtin_amdgcn_mfma_f32_16x16x32_bf16(fb, fa, nabT, 0, 0, 0);
                    nakT = __builtin_amdgcn_mfma_f32_16x16x32_bf16(fk, fa, nakT, 0, 0, 0);
                    nrbT = __builtin_amdgcn_mfma_f32_16x16x32_bf16(fb, fr_, nrbT, 0, 0, 0); nrkT = __builtin_amdgcn_mfma_f32_16x16x32_bf16(fk, fr_, nrkT, 0, 0, 0);
                }
                const u32x2 z2 = (u32x2){0u, 0u};
                f32x4 dg;
#pragma unroll
                for (int r = 0; r < 4; ++r) {
                    const int c = 4 * fq + r;
                    dg[r] = (c == fr) ? 1.f : 0.f;
                    nakT[r] = (c < fr) ? nakT[r] : 0.f; nabT[r] = (c < fr) ? nabT[r] : 0.f; nab[r] = (fr < c) ? nab[r] : 0.f;
                    nrbT[r] = (c <= fr) ? nrbT[r] : 0.f; nrkT[r] = (c <= fr) ? nrkT[r] : 0.f;
                }
                *(LAS u32x2*)(cb + C2_NAK + fr * 32 + fq * 8) = pk4(nakT);
                { const u32x2 wb = pk4(nrbT), wk = pk4(nrkT); *(LAS u32x4*)(cb + C2_NRBK + fr * 64 + fq * 16) = (u32x4){wb.x, wb.y, wk.x, wk.y}; }
#define FRG(X) mk_frag(pk4(X), z2)
#define MM(X, Y) __builtin_amdgcn_mfma_f32_16x16x32_bf16(FRG(X), FRG(Y), (f32x4){0.f, 0.f, 0.f, 0.f}, 0, 0, 0)
                {
                    const f32x4 p2 = MM(nabT, nab), q2 = MM(nab, nabT);
                    const f32x4 p4 = MM(q2, p2), q4 = MM(p2, q2);
                    const f32x4 p8 = MM(q4, p4);
                    const f32x4 m1 = MM(nabT + dg, p2 + dg);
                    const f32x4 m2t = MM(p8 + dg, q4 + dg);
                    const f32x4 mt = MM(m1, m2t);
                    *(LAS u32x2*)(cb + C2_MT + fr * 32 + fq * 8) = pk4(mt);
                }
#undef FRG
#undef MM
            }
            __syncthreads();
            if (wave < 4) {
                const int vrow = 16 * wave + fr;
                const u32x2 z2 = (u32x2){0u, 0u};
#define CH_DECL(P) u32x2 P##nak, P##mt, P##vq; bf16x8 P##fa0, P##fa1, P##fr0, P##fr1, P##nrbk, P##bk0, P##bk1, P##bk2, P##bk3; f32x4 P##g0, P##g1, P##g2, P##g3;
#define CH_LOAD(P, c_) do { const LAS unsigned char* cb = lds + (c_) * C2_CH; \
                    P##vq = *(const LAS u32x2*)(cb + C2_VT + vrow * 32 + fq * 8); P##nak = *(const LAS u32x2*)(cb + C2_NAK + fr * 32 + fq * 8); P##mt = *(const LAS u32x2*)(cb + C2_MT + fr * 32 + fq * 8); \
                    P##fa0 = mk_frag(tr4(cb + C2_AT, 4 * fq, lane), tr4(cb + C2_AT, 16 + 4 * fq, lane)); P##fa1 = mk_frag(tr4(cb + C2_AT, 32 + 4 * fq, lane), tr4(cb + C2_AT, 48 + 4 * fq, lane)); \
                    P##fr0 = mk_frag(tr4(cb + C2_RT, 4 * fq, lane), tr4(cb + C2_RT, 16 + 4 * fq, lane)); P##fr1 = mk_frag(tr4(cb + C2_RT, 32 + 4 * fq, lane), tr4(cb + C2_RT, 48 + 4 * fq, lane)); \
                    P##nrbk = *(const LAS bf16x8*)(cb + C2_NRBK + fr * 64 + fq * 16); \
                    P##bk0 = *(const LAS bf16x8*)(cb + C2_BK + (fr) * 64 + fq * 16); P##bk1 = *(const LAS bf16x8*)(cb + C2_BK + (16 + fr) * 64 + fq * 16); \
                    P##bk2 = *(const LAS bf16x8*)(cb + C2_BK + (32 + fr) * 64 + fq * 16); P##bk3 = *(const LAS bf16x8*)(cb + C2_BK + (48 + fr) * 64 + fq * 16); \
                    P##g0 = *(const LAS f32x4*)(cb + C2_GTV + (4 * fq) * 4); P##g1 = *(const LAS f32x4*)(cb + C2_GTV + (16 + 4 * fq) * 4); \
                    P##g2 = *(const LAS f32x4*)(cb + C2_GTV + (32 + 4 * fq) * 4); P##g3 = *(const LAS f32x4*)(cb + C2_GTV + (48 + 4 * fq) * 4); } while (0)
#define CH_STEP(P, c_) do { \
                    const bf16x8 bs0 = mk_frag(pk4(St[0]), pk4(St[1])), bs1 = mk_frag(pk4(St[2]), pk4(St[3]));     \
                    f32x4 acc = (f32x4){0.f, 0.f, 0.f, 0.f}, y = acc, u = acc; \
                    acc = __builtin_amdgcn_mfma_f32_16x16x32_bf16(mk_frag(P##nak, z2), mk_frag(P##vq, z2), acc, 0, 0, 0); \
                    acc = __builtin_amdgcn_mfma_f32_16x16x32_bf16(P##fa0, bs0, acc, 0, 0, 0); \
                    acc = __builtin_amdgcn_mfma_f32_16x16x32_bf16(P##fa1, bs1, acc, 0, 0, 0); \
                    y = __builtin_amdgcn_mfma_f32_16x16x32_bf16(P##fr0, bs0, y, 0, 0, 0); \
                    y = __builtin_amdgcn_mfma_f32_16x16x32_bf16(P##fr1, bs1, y, 0, 0, 0); \
                    u = __builtin_amdgcn_mfma_f32_16x16x32_bf16(mk_frag(P##mt, z2), mk_frag(pk4(acc), z2), u, 0, 0, 0); \
                    const bf16x8 buv = mk_frag(pk4(u), P##vq); \
                    St[0] = __builtin_amdgcn_mfma_f32_16x16x32_bf16(P##bk0, buv, St[0], 0, 0, 0); St[1] = __builtin_amdgcn_mfma_f32_16x16x32_bf16(P##bk1, buv, St[1], 0, 0, 0); \
                    St[2] = __builtin_amdgcn_mfma_f32_16x16x32_bf16(P##bk2, buv, St[2], 0, 0, 0); St[3] = __builtin_amdgcn_mfma_f32_16x16x32_bf16(P##bk3, buv, St[3], 0, 0, 0); \
                    y = __builtin_amdgcn_mfma_f32_16x16x32_bf16(P##nrbk, buv, y, 0, 0, 0); \
                    St[0] = St[0] * P##g0; St[1] = St[1] * P##g1; St[2] = St[2] * P##g2; St[3] = St[3] * P##g3; \
                    _Pragma("unroll") for (int r = 0; r < 4; ++r) *(LAS float*)(lds + C2_YS + (size_t)(((c_) * 16 + 4 * fq + r) * 64 + vrow) * 4) = y[r]; } while (0)
                CH_DECL(A) CH_DECL(B)
                CH_LOAD(A, 0);
                for (int c = 0; c < 8; c += 2) {
                    CH_LOAD(B, c + 1);
                    CH_STEP(A, c);
                    if (c + 2 < 8) CH_LOAD(A, c + 2);
                    CH_STEP(B, c + 1);
                }
#undef CH_DECL
#undef CH_LOAD
#undef CH_STEP
            }
            __syncthreads();
            {
                const LAS unsigned char* cb = lds + (ptok >> 4) * C2_CH;
                f32x4 lw[4], lb[4];
#pragma unroll
                for (int i = 0; i < 4; ++i) { lw[i] = *(const f32x4*)(F.ap->in[17] + (size_t)L * D + h * 64 + 16 * pj + 4 * i); lb[i] = *(const f32x4*)(F.ap->in[18] + (size_t)L * D + h * 64 + 16 * pj + 4 * i); }
                f32x4 y4[4]; float sm = 0.f;
#pragma unroll
                for (int i = 0; i < 4; ++i) { y4[i] = *(const LAS f32x4*)(lds + C2_YS + (size_t)(ptok * 64 + 16 * pj + 4 * i) * 4); sm += (y4[i][0] + y4[i][1]) + (y4[i][2] + y4[i][3]); }
                sm += dppf<0xB1>(sm); sm += dppf<0x4E>(sm);
                const float mean = sm * (1.0f / 64.0f); float vs = 0.f;
#pragma unroll
                for (int i = 0; i < 4; ++i) { y4[i] = y4[i] - mean; vs += (y4[i][0] * y4[i][0] + y4[i][1] * y4[i][1]) + (y4[i][2] * y4[i][2] + y4[i][3] * y4[i][3]); }
                vs += dppf<0xB1>(vs); vs += dppf<0x4E>(vs);
                const float rstd = __builtin_amdgcn_rsqf(vs * (1.0f / 64.0f) + LNX_EPS);
                const float bon = *(const LAS float*)(cb + C2_BON + (ptok & 15) * 4);
                unsigned ow[8];
#pragma unroll
                for (int i = 0; i < 4; ++i) {
                    float z[4];
#pragma unroll
                    for (int e = 0; e < 4; ++e) { const float vvl = bf1(*(const LAS unsigned short*)(cb + C2_VT + (16 * pj + 4 * i + e) * 32 + (ptok & 15) * 2)); z[e] = y4[i][e] * rstd * lw[i][e] + lb[i][e] + bon * vvl; }
                    ow[2 * i] = pk_bf16(z[0], z[1]); ow[2 * i + 1] = pk_bf16(z[2], z[3]);
                }
                int ptok_ = ptok; asm volatile("" : "+v"(ptok_));
                bf16_t* zp = F.S2 + (mrow0 + (size_t)g * 128 + ptok_) * D + h * 64 + 16 * pj;
                *(u32x4*)zp = (u32x4){ow[0], ow[1], ow[2], ow[3]}; *(u32x4*)(zp + 8) = (u32x4){ow[4], ow[5], ow[6], ow[7]};
            }
            __syncthreads();
        }
    }
}

constexpr int LDS_BYTES = 163840;
constexpr int LDSCTL_OFF = 163776;
constexpr int PPL = 15;
constexpr int NPHASE = NLAYER * PPL + 1;

template <int PH> __device__ __forceinline__ void run_phase(Frame& F, int L) {
    using namespace pg8;
    { int t_ = threadIdx.x; asm volatile("" : "+v"(t_)); F.tid = t_; F.lane = t_ & 63; F.wave = __builtin_amdgcn_readfirstlane(t_ >> 6);
      int g_ = gridDim.x, b_ = blockIdx.x; asm volatile("" : "+s"(g_), "+s"(b_)); F.G = g_; F.bid = b_;
      ArgsP a_ = (ArgsP)__builtin_amdgcn_kernarg_segment_ptr(); asm volatile("" : "+s"(a_)); F.ap = a_; F.X = a_->out; set_ws(F, a_->ws); }
    if constexpr (PH == 0) {
        convert_weights(F, L);
        if (L == 0) rmsnorm_rows(F, F.ap->in[0], F.ap->in[1], F.S1, (bf16_t*)F.X);
        else rmsnorm_rows_bf(F, (const bf16_t*)F.X, F.ap->in[1] + (size_t)L * D, F.S1);
    } else if constexpr (PH == 1) {
        Gemm g{F.WinT + (size_t)R_RKV * D, F.S1, D, D, D, RAWLD / 256, M / 256, 0}; StaticOrder S; S.init(g.nM, g.nN, F.G, F.bid);
        EpiRawT E{F.RAW, RAWLD};
        gemm_phase(F.lds, g, S, E);
    } else if constexpr (PH == 2) {
    } else if constexpr (PH == 3) {
    } else if constexpr (PH == 4) {
        scan2_phase(F, L);
    } else if constexpr (PH == 5) {
    } else if constexpr (PH == 6) {
        Gemm g{F.S1, F.WinT, D, D, D, M / 256, 20, 0}; StaticOrder S; S.init(g.nM, g.nN, F.G, F.bid);
        EpiG<ACT_NONE, ACT_SILU, ACT_SILU, ACT_SIGMOID, ACT_SIGMOID> E{{F.RAW, D, nullptr, nullptr, nullptr, 0, nullptr, 0}, {F.RAWB, D, nullptr, nullptr, nullptr, 0, nullptr, 0}, 1024, {F.S2, D, nullptr, nullptr, F.S2, D, nullptr, 0}, 2048,
            {F.S3, D, nullptr, nullptr, nullptr, 0, nullptr, 0}, 3072, {F.RAW + (size_t)2 * M * D, D, nullptr, nullptr, nullptr, 0, nullptr, 0}, 4096};
        gemm_phase(F.lds, g, S, E);
    } else if constexpr (PH == 7) {
        Gemm g{F.S2, F.WrpT, D, D, D, M / 256, 4, 0}; StaticOrder S; S.init(g.nM, g.nN, F.G, F.bid);
        EpiG<ACT_NONE, ACT_NONE> E{{F.S3, D, nullptr, nullptr, F.S3, D, nullptr, 0}, {}, 1 << 30};
        gemm_phase(F.lds, g, S, E);
    } else if constexpr (PH == 8) {
    } else if constexpr (PH == 9) {
    } else if constexpr (PH == 10) {
        poold_phase(F, F.RAW, F.RAWB, F.ap->in[4] + (size_t)L * D);
    } else if constexpr (PH == 11) {
    } else if constexpr (PH == 12) {
        Gemm g{F.RAWB, F.WppT, D, D, D, M / 256, 4, 0}; StaticOrder S; S.init(g.nM, g.nN, F.G, F.bid);
        EpiG<ACT_NONE, ACT_NONE> E{{F.RAW, D, nullptr, nullptr, F.RAW + (size_t)2 * M * D, D, F.S3, D}, {}, 1 << 30};
        gemm_phase(F.lds, g, S, E);
    } else if constexpr (PH == 13) {
    } else if constexpr (PH == 14) {
        Gemm g{F.RAW, F.WoutT, D, D, D, M / 256, 4, 0}; StaticOrder S; S.init(g.nM, g.nN, F.G, F.bid);
        EpiG<ACT_NONE, ACT_NONE> E{{L == NLAYER - 1 ? F.S2 : (bf16_t*)F.X, D, nullptr, nullptr, nullptr, 0, (const bf16_t*)F.X, D}, {}, 1 << 30};
        gemm_phase(F.lds, g, S, E);
    } else {
        final_norm(F, F.S2);
    }
}
__device__ __forceinline__ void frame_init(Frame& F, unsigned char* lds_raw) {
    F.lds = (LAS unsigned char*)lds_raw;
    F.tid = threadIdx.x; F.lane = F.tid & 63; F.wave = __builtin_amdgcn_readfirstlane(F.tid >> 6); F.G = gridDim.x; F.bid = blockIdx.x;
    F.ap = (ArgsP)__builtin_amdgcn_kernarg_segment_ptr();
    F.X = F.ap->out;
    set_ws(F, F.ap->ws);
}
#ifndef PROBE_STAGE
#define PROBE_STAGE -1
#endif
#if MK_PER_PHASE
__global__ void __launch_bounds__(512, 2) mk_dump(Args args, size_t ws_off, int ld, int rowmask) {
    const bf16_t* src = (const bf16_t*)(args.ws + ws_off);
    for (size_t it = (size_t)blockIdx.x * 512 + threadIdx.x; it < (size_t)M * 512; it += (size_t)gridDim.x * 512) {
        const size_t m = it >> 9; const int c = (int)(it & 511) * 2; const unsigned w = *(const unsigned*)(src + (m & (size_t)rowmask) * ld + (ld == 256 ? (c & 255) : c));
        args.out[m * D + c] = 1000.f * bf_lo(w); args.out[m * D + c + 1] = 1000.f * bf_hi(w);
    }
}
template <int PH> __global__ void __launch_bounds__(512, 2) mk_phase(Args args) {
    extern __shared__ __attribute__((aligned(16))) unsigned char lds_raw[];
    Frame F; frame_init(F, lds_raw);
    run_phase<PH>(F, F.ap->ph_lo);
}
#else
__global__ void __launch_bounds__(512, 2) mk_fwd(Args args) {
    extern __shared__ __attribute__((aligned(16))) unsigned char lds_raw[];
    Frame F; frame_init(F, lds_raw);
    volatile LAS unsigned* ctlw = (volatile LAS unsigned*)(F.lds + LDSCTL_OFF);
    if (F.tid < 16) ctlw[F.tid] = 0u;
    __syncthreads();
    XcdBarrier bar = xcd_barrier_post((unsigned*)(F.ws + WS_CTL), ctlw);
    for (int L = 0; L < NLAYER; ++L) {
        run_phase<0>(F, L); xcd_barrier(bar);
        run_phase<1>(F, L); xcd_barrier(bar);
        run_phase<4>(F, L); xcd_barrier(bar);
        run_phase<6>(F, L); xcd_barrier(bar);
        run_phase<7>(F, L); xcd_barrier(bar);
        run_phase<10>(F, L); xcd_barrier(bar);
        run_phase<12>(F, L); xcd_barrier(bar);
        run_phase<14>(F, L); xcd_barrier(bar);
    }
    run_phase<15>(F, 0);
}
#endif

#if MK_PER_PHASE
template <int PH> static void launch_phase(int grid, hipStream_t stream, Args a, int L) { if (PH == 2 || PH == 3 || PH == 5 || PH == 11) return; a.ph_lo = L; a.ph_hi = PH; hipLaunchKernelGGL(mk_phase<PH>, dim3(grid), dim3(512), LDS_BYTES, stream, a); }
template <int PH> static bool set_lds() { return hipFuncSetAttribute((const void*)mk_phase<PH>, hipFuncAttributeMaxDynamicSharedMemorySize, LDS_BYTES) == hipSuccess; }
#endif
extern "C" void kernel_launch(void* const* d_in, const int* in_sizes, int n_in, void* d_out, int out_size, void* d_ws, size_t ws_size, hipStream_t stream) {
    static int grid = 0;
    if (grid == 0) {
        if (n_in != 22 || in_sizes[0] != M * D || out_size != M * D || ws_size < WS_END) { fprintf(stderr, "kernel_launch: unexpected shapes / workspace (%d inputs, ws %zu)\n", n_in, ws_size); grid = -1; return; }
        int dev = 0, cus = 0;
        if (hipGetDevice(&dev) != hipSuccess || hipDeviceGetAttribute(&cus, hipDeviceAttributeMultiprocessorCount, dev) != hipSuccess) { grid = -1; return; }
#if MK_PER_PHASE
        bool ok = set_lds<0>() && set_lds<1>() && set_lds<2>() && set_lds<3>() && set_lds<4>() && set_lds<5>() && set_lds<6>() && set_lds<7>() && set_lds<8>() && set_lds<9>() && set_lds<10>() && set_lds<11>()
               && set_lds<12>() && set_lds<13>() && set_lds<14>() && set_lds<15>();
        if (!ok) { fprintf(stderr, "kernel_launch: hipFuncSetAttribute failed\n"); grid = -1; return; }
#else
        int per_cu = 0;
        if (hipFuncSetAttribute((const void*)mk_fwd, hipFuncAttributeMaxDynamicSharedMemorySize, LDS_BYTES) != hipSuccess) { fprintf(stderr, "kernel_launch: hipFuncSetAttribute failed\n"); grid = -1; return; }
        if (hipOccupancyMaxActiveBlocksPerMultiprocessor(&per_cu, (const void*)mk_fwd, 512, LDS_BYTES) != hipSuccess || per_cu < 1) { fprintf(stderr, "kernel_launch: occupancy query says %d\n", per_cu); }
#endif
        (void)hipGetLastError();
        grid = cus;
    }
    if (grid < 0) return;
    Args a{};
    for (int i = 0; i < 22; ++i) a.in[i] = (const float*)d_in[i];
    a.out = (float*)d_out; a.ws = (unsigned char*)d_ws;
#if MK_PER_PHASE
    if (PROBE_STAGE >= 0) {
        const int L = 0;
        launch_phase<0>(grid, stream, a, L); launch_phase<1>(grid, stream, a, L);
        if (PROBE_STAGE >= 2) launch_phase<2>(grid, stream, a, L);
        if (PROBE_STAGE >= 3) launch_phase<3>(grid, stream, a, L);
        if (PROBE_STAGE >= 4) launch_phase<4>(grid, stream, a, L);
        if (PROBE_STAGE >= 5) launch_phase<5>(grid, stream, a, L);
        if (PROBE_STAGE >= 6) launch_phase<6>(grid, stream, a, L);
        if (PROBE_STAGE >= 7) launch_phase<7>(grid, stream, a, L);
        if (PROBE_STAGE >= 8) launch_phase<8>(grid, stream, a, L);
        if (PROBE_STAGE >= 9) launch_phase<9>(grid, stream, a, L);
        if (PROBE_STAGE >= 10) launch_phase<10>(grid, stream, a, L);
        if (PROBE_STAGE >= 11) launch_phase<11>(grid, stream, a, L);
        if (PROBE_STAGE >= 12) launch_phase<12>(grid, stream, a, L);
        if (PROBE_STAGE >= 13) launch_phase<13>(grid, stream, a, L);
        size_t off = WS_RAW; int ld = RAWLD; int rowmask = 0x7fffffff;
        if (PROBE_STAGE == 2) { off = WS_VFIRST; ld = D; }
        if (PROBE_STAGE == 3) { off = WS_S1; ld = D; }
        if (PROBE_STAGE == 5) { off = WS_S1; ld = D; }
#if defined(PROBE_ALT) || defined(PROBE_SWAP)
        if (PROBE_STAGE == 3) { off = WS_S2; ld = D; }
        if (PROBE_STAGE == 2) { off = WS_EAT; ld = 256; rowmask = 2047; }
        if (PROBE_STAGE == 1) { off = WS_RAW + 4608; ld = RAWLD; }
#endif
        if (PROBE_STAGE == 6) { off = WS_S2; ld = D; }
        if (PROBE_STAGE == 7 || PROBE_STAGE == 8) { off = WS_S3; ld = D; }
        if (PROBE_STAGE == 9) { off = WS_S2; ld = D; }
        if (PROBE_STAGE == 10) { off = WS_RAWB; ld = D; }
        if (PROBE_STAGE == 11) { off = WS_S2; ld = D; }
        if (PROBE_STAGE == 12 || PROBE_STAGE == 13) { off = WS_RAW; ld = D; }
        hipLaunchKernelGGL(mk_dump, dim3(grid), dim3(512), 0, stream, a, off, ld, rowmask);
        return;
    }
    for (int L = 0; L < NLAYER; ++L) {
        launch_phase<0>(grid, stream, a, L); launch_phase<1>(grid, stream, a, L); launch_phase<2>(grid, stream, a, L); launch_phase<3>(grid, stream, a, L);
        launch_phase<4>(grid, stream, a, L); launch_phase<5>(grid, stream, a, L); launch_phase<6>(grid, stream, a, L); launch_phase<7>(grid, stream, a, L);
        launch_phase<8>(grid, stream, a, L); launch_phase<9>(grid, stream, a, L); launch_phase<10>(grid, stream, a, L); launch_phase<11>(grid, stream, a, L);
        launch_phase<12>(grid, stream, a, L); launch_phase<13>(grid, stream, a, L); launch_phase<14>(grid, stream, a, L);
    }
    launch_phase<15>(grid, stream, a, 0);
#else
    (void)hipMemsetAsync((char*)d_ws + WS_CTL, 0, CTL_ZERO_BYTES, stream);
    a.ph_lo = 0; a.ph_hi = 0;
    hipLaunchKernelGGL(mk_fwd, dim3(grid), dim3(512), LDS_BYTES, stream, a);
#endif
}
```

```cpp
#include <hip/hip_runtime.h>
#include <cstdio>
#include <cstdint>

#define LAS __attribute__((address_space(3)))
typedef unsigned short bf16_t;
typedef short bf16x8 __attribute__((ext_vector_type(8)));
typedef float f32x4 __attribute__((ext_vector_type(4)));
typedef float f32x2 __attribute__((ext_vector_type(2)));
typedef unsigned u32x4 __attribute__((ext_vector_type(4)));
typedef unsigned u32x2 __attribute__((ext_vector_type(2)));

#define SCAN_DUP 0
#ifndef SCAN_DUP
#define SCAN_DUP 0
#endif
#ifndef MK_PER_PHASE
#define MK_PER_PHASE 0
#endif

constexpr int M = 32768, D = 1024, SEQ = 2048, NLAYER = 4, INW = 8320, NHEAD = 16;
constexpr int RAWLD = 3328;
constexpr float NORM_EPS = 1e-6f, LNX_EPS = 64e-5f;

constexpr size_t MiB = 1u << 20;
constexpr size_t WS_CTL = 0, CTL_ZERO_BYTES = 16384;
constexpr size_t WS_WINT = 1 * MiB;
constexpr size_t WS_WPP = WS_WINT + (size_t)(INW + 128) * D * 2;
constexpr size_t WS_WRP = WS_WPP + 2 * MiB;
constexpr size_t WS_WOUT = WS_WRP + 2 * MiB;
constexpr size_t WS_LINT = WS_WOUT + 2 * MiB;
constexpr size_t WS_EAT = WS_LINT + MiB / 2;
constexpr size_t WS_VFIRST = 25 * MiB;
constexpr size_t WS_RAW = 89 * MiB;
constexpr size_t WS_RAWB = 153 * MiB;
constexpr size_t WS_S1 = 297 * MiB, WS_S2 = 361 * MiB, WS_S3 = 425 * MiB;
constexpr size_t WS_TW = 489 * MiB;
constexpr size_t WS_END = 505 * MiB;
static_assert(WS_EAT + MiB <= WS_VFIRST, "weights fit");
constexpr int R_RGATE = 2048, R_GRWKV = 3072, R_GPOOL = 4096, R_RKV = 5120, R_FOLD = 8320;

#define XB_TMO      128
#define XB_XCNT(j)  (256  + 64 * (j))
#define XB_XSUB(j)  (1280 + 64 * (j))
#define XB_XGEN(j)  (2304 + 64 * (j))
#define XB_TOP      3328
#define XB_TOPGEN   3392
#define XCD_BAR_WORDS 3456
#define XB_SPIN_CAP (1u << 18)

__device__ __forceinline__ unsigned xb_ld(unsigned* p)              { return __hip_atomic_load(p, __ATOMIC_RELAXED, __HIP_MEMORY_SCOPE_AGENT); }
__device__ __forceinline__ unsigned xb_add(unsigned* p, unsigned v) { return __hip_atomic_fetch_add(p, v, __ATOMIC_RELAXED, __HIP_MEMORY_SCOPE_AGENT); }
__device__ __forceinline__ unsigned xb_xcc_id() { return (unsigned)__builtin_amdgcn_s_getreg((3 << 11) | 20) & 0xFu; }
#define XB_SPIN(cond, bar) do { unsigned _sp = 0; while (cond) { __builtin_amdgcn_s_sleep(1); \
    if ((++_sp & 255u) == 0u) { if (xb_ld(&(bar)[XB_TMO])) break; if (_sp > XB_SPIN_CAP) { atomicAdd(&(bar)[XB_TMO], 1u); break; } } } } while (0)

struct XcdBarrier { unsigned* bar; unsigned x; volatile LAS unsigned* st; };

__device__ __forceinline__ XcdBarrier xcd_barrier_post(unsigned* bar, volatile LAS unsigned* st) {
    XcdBarrier b; b.bar = bar; b.x = xb_xcc_id(); b.st = st;
    if (threadIdx.x == 0) (void)xb_add(&bar[XB_XCNT(b.x)], 1u);
    return b;
}
__device__ __forceinline__ void xcd_barrier_complete(unsigned* bar, unsigned x, unsigned& nloc, unsigned& nx) {
    const unsigned G = gridDim.x * gridDim.y * gridDim.z;
    unsigned sum, cnt, mine, sp = 0u;
    for (;;) {
        sum = 0u; cnt = 0u; mine = 0u;
#pragma unroll
        for (unsigned j = 0; j < 16; ++j) { const unsigned c = xb_ld(&bar[XB_XCNT(j)]); sum += c; cnt += (c > 0u) ? 1u : 0u; }
        if (sum == G) { mine = xb_ld(&bar[XB_XCNT(x)]); break; }
        __builtin_amdgcn_s_sleep(1);
        if ((++sp & 255u) == 0u) { if (xb_ld(&bar[XB_TMO])) { mine = xb_ld(&bar[XB_XCNT(x)]); break; } if (sp > XB_SPIN_CAP) { atomicAdd(&bar[XB_TMO], 1u); mine = xb_ld(&bar[XB_XCNT(x)]); break; } }
    }
    nloc = mine > 0u ? mine : 1u; nx = cnt > 0u ? cnt : 1u;
}
__device__ __forceinline__ void xcd_barrier(const XcdBarrier& b) {
    asm volatile("s_waitcnt vmcnt(0)" ::: "memory");
    __syncthreads();
    if (threadIdx.x == 0) {
        unsigned* bar = b.bar; asm volatile("" : "+s"(bar));
        __builtin_amdgcn_s_waitcnt(0);
        unsigned nloc = b.st[0], nx = b.st[1];
        if (nloc == 0u) { xcd_barrier_complete(bar, b.x, nloc, nx); b.st[0] = nloc; b.st[1] = nx; }
        const unsigned old = xb_add(&bar[XB_XSUB(b.x)], 1u);
        const unsigned gen = old / nloc;
        if (old + 1u == (gen + 1u) * nloc) {
            __builtin_amdgcn_fence(__ATOMIC_RELEASE, "agent");
            asm volatile("s_waitcnt vmcnt(0)" ::: "memory");
            const unsigned og = xb_add(&bar[XB_TOP], 1u);
            const unsigned tg = og / nx;
            if (og + 1u == (tg + 1u) * nx) xb_add(&bar[XB_TOPGEN], 1u);
            else XB_SPIN(xb_ld(&bar[XB_TOPGEN]) == tg, bar);
            __builtin_amdgcn_fence(__ATOMIC_ACQUIRE, "agent");
            xb_add(&bar[XB_XGEN(b.x)], 1u);
            asm volatile("s_waitcnt vmcnt(0)" ::: "memory");
        } else {
            XB_SPIN(xb_ld(&bar[XB_XGEN(b.x)]) == gen, bar);
            __builtin_amdgcn_fence(__ATOMIC_ACQUIRE, "agent");
            asm volatile("s_waitcnt vmcnt(0)" ::: "memory");
        }
    }
    __syncthreads();
}

typedef decltype(__builtin_amdgcn_make_buffer_rsrc((void*)nullptr, (short)0, 0, 0)) rsrc_t;
__device__ __forceinline__ rsrc_t wt_rsrc(const void* base) { return __builtin_amdgcn_make_buffer_rsrc((void*)base, 0, 0x7fffffff, 0x00020000); }
#define ST16_WT(rs, byteoff, v) __builtin_amdgcn_raw_buffer_store_b128(__builtin_bit_cast(decltype(__builtin_amdgcn_raw_buffer_load_b128(rs, 0, 0, 0)), (v)), rs, (int)(byteoff), 0, 16)
__device__ __forceinline__ float bf_lo(unsigned w) { return __uint_as_float(w << 16); }
__device__ __forceinline__ float bf_hi(unsigned w) { return __uint_as_float(w & 0xffff0000u); }
typedef __bf16 bf16x2_t __attribute__((ext_vector_type(2)));
__device__ __forceinline__ unsigned pk_bf16(float lo, float hi) { bf16x2_t v; v[0] = (__bf16)lo; v[1] = (__bf16)hi; return __builtin_bit_cast(unsigned, v); }
__device__ __forceinline__ unsigned short f2bf_s(float x) { return (unsigned short)(pk_bf16(x, 0.f) & 0xffffu); }
__device__ __forceinline__ float sigmoidf_(float x) { return __builtin_amdgcn_rcpf(1.0f + __expf(-x)); }
__device__ __forceinline__ float tanhf_(float x) { return 1.0f - 2.0f * __builtin_amdgcn_rcpf(1.0f + __expf(2.0f * x)); }
template <int CTRL> __device__ __forceinline__ float dppf(float x) { return __int_as_float(__builtin_amdgcn_update_dpp(0, __float_as_int(x), CTRL, 0xf, 0xf, true)); }
__device__ __forceinline__ float red8(float x) {
    x += dppf<0xB1>(x);
    x += dppf<0x4E>(x);
    x += dppf<0x141>(x);
    return x;
}
__device__ __forceinline__ float red16(float x) {
    x += dppf<0xB1>(x);
    x += dppf<0x4E>(x);
    x += dppf<0x141>(x);
    x += dppf<0x140>(x);
    return x;
}
__device__ __forceinline__ float red64(float x) {
    x = red16(x);
    return __int_as_float(__builtin_amdgcn_readlane(__float_as_int(x), 0)) + __int_as_float(__builtin_amdgcn_readlane(__float_as_int(x), 16)) +
           __int_as_float(__builtin_amdgcn_readlane(__float_as_int(x), 32)) + __int_as_float(__builtin_amdgcn_readlane(__float_as_int(x), 48));
}

namespace pg8 {
constexpr int BM = 256, BK = 64, HALF = 128, HTB = HALF * BK * 2, STAGE_BYTES = 8 * HTB, NXCD = 8, WGM = 8;
__host__ __device__ __forceinline__ int lds_byte(int r, int c) { const int st = (r >> 4) * 2 + (c >> 5), rr = r & 15, cc = c & 31, ob = rr * 64 + cc * 2; return st * 1024 + (ob ^ (((ob >> 9) & 1) << 5)); }
__host__ __device__ __forceinline__ void stage_rc(int b, int& R, int& C) { const int st = b / 1024, sb = b % 1024, swz = sb ^ (((sb >> 9) & 1) << 5); R = (st >> 1) * 16 + swz / 64; C = (st & 1) * 32 + (swz % 64) / 2; }
__host__ __device__ __forceinline__ int perm32(int rho) { const int n = rho >> 4, i = rho & 15; return 8 * (i >> 2) + 4 * n + (i & 3); }

struct Unit { int pm, pn; };
struct Gemm { const bf16_t* A; const bf16_t* Bt; int lda, ldb, K, nM, nN, a_pn_bytes; };

struct StaticOrder {
    int nM, nN, nwg, G, c;
    __device__ void init(int nM_, int nN_, int G_, int c_) { nM = nM_; nN = nN_; nwg = nM * nN; G = G_; c = c_; }
    __device__ bool next(int i, Unit& u) const {
        const long L = (long)i * G + c; if (L >= nwg) return false;
        int wgid = (int)L; { const int q = nwg / NXCD, r = nwg % NXCD, xcd = wgid % NXCD, off = wgid / NXCD; wgid = (xcd < r ? xcd * (q + 1) : r * (q + 1) + (xcd - r) * q) + off; }
        const int nig = WGM * nN, gid = wgid / nig, fm = gid * WGM, gsz = (nM - fm) < WGM ? (nM - fm) : WGM;
        u.pm = fm + ((wgid % nig) % gsz); u.pn = (wgid % nig) / gsz; return true;
    }
};

template <class Epi, bool ALIGN_EPI = true, bool SP2 = true>
__device__ __forceinline__ void gemm_phase(LAS unsigned char* lds, const Gemm g, const StaticOrder& S, const Epi& E) {
    int tid_ = threadIdx.x; asm volatile("" : "+v"(tid_));
    const int tid = tid_, wid = __builtin_amdgcn_readfirstlane(tid >> 6), lane = tid & 63, wr = wid >> 2, wc = wid & 3, fr = lane & 15, fq = lane >> 4;
    int K_ = g.K; asm volatile("" : "+s"(K_));
    const int K = K_, nt = K / BK;
    unsigned voffA[2], voffB[2];
#pragma unroll
    for (int i = 0; i < 2; ++i) { int R, C; stage_rc(tid * 16 + i * 8192, R, C); const int Rb = Epi::PERM ? ((R & ~31) + perm32(R & 31)) : R;
        voffA[i] = (unsigned)(R * g.lda + C) * 2u; voffB[i] = (unsigned)(Rb * g.ldb + C) * 2u; }
    const size_t kstep = (size_t)(BK * 2);
    const size_t hstepA = (size_t)HALF * g.lda * 2, hstepB = (size_t)HALF * g.ldb * 2;
    const size_t tstepA = 2 * hstepA, tstepB = 2 * hstepB;
    const unsigned ldsw = (unsigned)wid * 1024u;
    const int aoff = lds_byte(wr * 64 + fr, fq * 8), boff = lds_byte(wc * 32 + fr, fq * 8);
#define PG8_SA(b, h) (((b) * 2 + (h)) * HTB)
#define PG8_SB(b, h) ((4 + (b) * 2 + (h)) * HTB)
#define PG8_STAGE(bufoff, gbase, voff) do { _Pragma("unroll") for (int _i = 0; _i < 2; ++_i) \
        __builtin_amdgcn_global_load_lds((const unsigned*)((const char*)(gbase) + (voff)[_i]), (LAS unsigned*)(lds + (bufoff) + ldsw + _i * 8192), 16, 0, 0); } while (0)
#define PG8_LDA(dst, b, h) do { _Pragma("unroll") for (int m = 0; m < 4; ++m) _Pragma("unroll") for (int k = 0; k < 2; ++k) dst[m][k] = *(const LAS bf16x8*)(lds + PG8_SA(b, h) + aoff + m * 2048 + k * 1024); } while (0)
#define PG8_LDB(dst, b, h) do { _Pragma("unroll") for (int n = 0; n < 2; ++n) _Pragma("unroll") for (int k = 0; k < 2; ++k) dst[n][k] = *(const LAS bf16x8*)(lds + PG8_SB(b, h) + boff + n * 2048 + k * 1024); } while (0)
#define PG8_MMA(ai, bj, At, Bt) do { __builtin_amdgcn_s_setprio(1); _Pragma("unroll") for (int m = 0; m < 4; ++m) _Pragma("unroll") for (int n = 0; n < 2; ++n) _Pragma("unroll") for (int k = 0; k < 2; ++k) \
        acc[ai][bj][m][n] = __builtin_amdgcn_mfma_f32_16x16x32_bf16(Bt[n][k], At[m][k], acc[ai][bj][m][n], 0, 0, 0); __builtin_amdgcn_s_setprio(0); } while (0)
#define PG8_WAIT_V(n) asm volatile("s_waitcnt vmcnt(" #n ")" ::: "memory")
#define PG8_WAIT_L(n) asm volatile("s_waitcnt lgkmcnt(" #n ")" ::: "memory")
#define PG8_BAR __builtin_amdgcn_s_barrier()
#define PG8_SCHED __builtin_amdgcn_sched_barrier(0)
    Unit cur, nxt; int ui = 0;
    if (!S.next(0, cur)) return;
    f32x4 acc[2][2][4][2];
#pragma unroll
    for (int a = 0; a < 2; ++a)
#pragma unroll
        for (int b = 0; b < 2; ++b)
#pragma unroll
            for (int m = 0; m < 4; ++m)
#pragma unroll
                for (int n = 0; n < 2; ++n) acc[a][b][m][n] = (f32x4){0.f, 0.f, 0.f, 0.f};
    bf16x8 At[4][2], B0[2][2], B1[2][2];
    const char* cA = (const char*)g.A + (size_t)cur.pm * tstepA + (size_t)cur.pn * g.a_pn_bytes; const char* cB = (const char*)g.Bt + (size_t)cur.pn * tstepB;
    if constexpr (SP2) {
        PG8_STAGE(PG8_SB(0, 0), cB, voffB); PG8_STAGE(PG8_SB(0, 1), cB + hstepB, voffB); PG8_STAGE(PG8_SA(0, 0), cA, voffA); PG8_STAGE(PG8_SA(0, 1), cA + hstepA, voffA);
        if (wr == 1) PG8_BAR;
        PG8_WAIT_V(2); PG8_BAR;
        PG8_STAGE(PG8_SB(1, 0), cB + kstep, voffB); PG8_STAGE(PG8_SA(1, 0), cA + kstep, voffA); PG8_STAGE(PG8_SB(1, 1), cB + hstepB + kstep, voffB);
        PG8_WAIT_V(6); PG8_BAR;
    } else {
        PG8_STAGE(PG8_SB(0, 0), cB, voffB); PG8_STAGE(PG8_SA(0, 0), cA, voffA); PG8_STAGE(PG8_SB(0, 1), cB + hstepB, voffB); PG8_STAGE(PG8_SA(0, 1), cA + hstepA, voffA);
        if (wr == 1) PG8_BAR;
        PG8_WAIT_V(4); PG8_BAR;
        PG8_STAGE(PG8_SB(1, 0), cB + kstep, voffB); PG8_STAGE(PG8_SA(1, 0), cA + kstep, voffA); PG8_STAGE(PG8_SB(1, 1), cB + hstepB + kstep, voffB);
        PG8_WAIT_V(6); PG8_BAR;
    }
    for (;;) {
        const bool has_next = S.next(ui + 1, nxt);
        const char* nA = has_next ? (const char*)g.A + (size_t)nxt.pm * tstepA + (size_t)nxt.pn * g.a_pn_bytes : cA; const char* nB = has_next ? (const char*)g.Bt + (size_t)nxt.pn * tstepB : cB;
        for (int t = 0; t < nt; t += 2) {
            const bool last = (t == nt - 2);
            const char* a1 = cA + (size_t)(t + 1) * kstep;
            const char* a2 = last ? nA : cA + (size_t)(t + 2) * kstep; const char* b2 = last ? nB : cB + (size_t)(t + 2) * kstep;
            const char* a3 = a2 + kstep; const char* b3 = b2 + kstep;
            if constexpr (SP2) {
            PG8_LDB(B0, 0, 0); PG8_LDB(B1, 0, 1); PG8_SCHED; PG8_LDA(At, 0, 0); PG8_STAGE(PG8_SA(1, 1), a1 + hstepA, voffA);
            PG8_WAIT_V(8); PG8_WAIT_L(0); PG8_BAR; PG8_MMA(0, 0, At, B0); PG8_MMA(0, 1, At, B1); PG8_BAR; PG8_SCHED;
            PG8_LDA(At, 0, 1); PG8_STAGE(PG8_SB(0, 0), b2, voffB); PG8_STAGE(PG8_SB(0, 1), b2 + hstepB, voffB); PG8_STAGE(PG8_SA(0, 0), a2, voffA);
            PG8_WAIT_V(8); PG8_WAIT_L(0); PG8_BAR; PG8_MMA(1, 0, At, B0); PG8_MMA(1, 1, At, B1); PG8_BAR; PG8_SCHED;
            PG8_LDB(B0, 1, 0); PG8_LDB(B1, 1, 1); PG8_SCHED; PG8_LDA(At, 1, 0); PG8_STAGE(PG8_SA(0, 1), a2 + hstepA, voffA);
            PG8_WAIT_V(8); PG8_WAIT_L(0); PG8_BAR; PG8_MMA(0, 0, At, B0); PG8_MMA(0, 1, At, B1); PG8_BAR; PG8_SCHED;
            PG8_LDA(At, 1, 1); PG8_STAGE(PG8_SB(1, 0), b3, voffB); PG8_STAGE(PG8_SB(1, 1), b3 + hstepB, voffB); PG8_STAGE(PG8_SA(1, 0), a3, voffA);
            PG8_WAIT_V(8); PG8_WAIT_L(0); PG8_BAR; PG8_MMA(1, 0, At, B0); PG8_MMA(1, 1, At, B1); PG8_BAR; PG8_SCHED;
            } else {
            PG8_LDB(B0, 0, 0); PG8_SCHED; PG8_LDA(At, 0, 0); PG8_STAGE(PG8_SA(1, 1), a1 + hstepA, voffA);
            PG8_WAIT_L(8); PG8_BAR; PG8_WAIT_L(0); PG8_MMA(0, 0, At, B0); PG8_BAR; PG8_SCHED;
            PG8_LDB(B1, 0, 1); PG8_STAGE(PG8_SB(0, 0), b2, voffB);
            PG8_BAR; PG8_WAIT_L(0); PG8_MMA(0, 1, At, B1); PG8_BAR;
            PG8_LDA(At, 0, 1); PG8_STAGE(PG8_SA(0, 0), a2, voffA);
            PG8_BAR; PG8_WAIT_L(0); PG8_MMA(1, 0, At, B0); PG8_BAR; PG8_SCHED;
            PG8_STAGE(PG8_SB(0, 1), b2 + hstepB, voffB);
            PG8_WAIT_V(6); PG8_BAR; PG8_MMA(1, 1, At, B1); PG8_BAR;
            PG8_LDB(B0, 1, 0); PG8_SCHED; PG8_LDA(At, 1, 0); PG8_STAGE(PG8_SA(0, 1), a2 + hstepA, voffA);
            PG8_WAIT_L(8); PG8_BAR; PG8_WAIT_L(0); PG8_MMA(0, 0, At, B0); PG8_BAR; PG8_SCHED;
            PG8_LDB(B1, 1, 1); PG8_STAGE(PG8_SB(1, 0), b3, voffB);
            PG8_BAR; PG8_WAIT_L(0); PG8_MMA(0, 1, At, B1); PG8_BAR;
            PG8_LDA(At, 1, 1); PG8_STAGE(PG8_SA(1, 0), a3, voffA);
            PG8_BAR; PG8_WAIT_L(0); PG8_MMA(1, 0, At, B0); PG8_BAR; PG8_SCHED;
            PG8_STAGE(PG8_SB(1, 1), b3 + hstepB, voffB);
            PG8_WAIT_V(6); PG8_BAR; PG8_MMA(1, 1, At, B1); PG8_BAR;
            }
        }
        if constexpr (ALIGN_EPI) { if (wr == 0) PG8_BAR; }
        E(acc, cur, wr, wc, fr, fq);
        if (!has_next) break;
#pragma unroll
        for (int a = 0; a < 2; ++a)
#pragma unroll
            for (int b = 0; b < 2; ++b)
#pragma unroll
                for (int m = 0; m < 4; ++m)
#pragma unroll
                    for (int n = 0; n < 2; ++n) acc[a][b][m][n] = (f32x4){0.f, 0.f, 0.f, 0.f};
        cur = nxt; cA = nA; cB = nB; ++ui;
        if constexpr (ALIGN_EPI) { if (wr == 1) PG8_BAR; }
    }
    PG8_WAIT_V(0);
    if constexpr (!ALIGN_EPI) { if (wr == 0) PG8_BAR; }
    PG8_BAR;
#undef PG8_SA
#undef PG8_SB
#undef PG8_STAGE
#undef PG8_LDA
#undef PG8_LDB
#undef PG8_MMA
#undef PG8_WAIT_V
#undef PG8_WAIT_L
#undef PG8_BAR
#undef PG8_SCHED
}

enum { ACT_NONE = 0, ACT_SILU = 1, ACT_SIGMOID = 2, ACT_DECAY = 3 };
template <int ACT> __device__ __forceinline__ float actf(float v) {
    if (ACT == ACT_SILU) return v * sigmoidf_(v);
    if (ACT == ACT_SIGMOID) return sigmoidf_(v);
    if (ACT == ACT_DECAY) return 0.60653065971f * sigmoidf_(v);
    return v;
}
struct EpiCfg {
    bf16_t* out; int ldo;
    const float* bias;
    const float* cscale;
    const bf16_t* in1; int ld1;
    const bf16_t* in2; int ld2;
};
template <int ACT_A, int ACT_B, int ACT_C = ACT_NONE, int ACT_D = ACT_NONE, int ACT_E = ACT_NONE> struct EpiG {
    static constexpr bool PERM = true;
    EpiCfg a, b; int split; EpiCfg c = {}; int split2 = 1 << 30; EpiCfg d = {}; int split3 = 1 << 30; EpiCfg e = {}; int split4 = 1 << 30;
    template <int ACT> __device__ __forceinline__ void run(const EpiCfg& c, int colt, const f32x4 (&acc)[2][2][4][2], const Unit& u, int wr, int wc, int fr, int fq) const {
        const int row0 = u.pm * BM + wr * 64 + fr, col0 = colt + wc * 32 + 8 * fq;
        f32x4 bv[2][2], sv[2][2];
#pragma unroll
        for (int bj = 0; bj < 2; ++bj)
#pragma unroll
            for (int n = 0; n < 2; ++n) {
                bv[bj][n] = c.bias ? *(const f32x4*)(c.bias + col0 + bj * HALF + 4 * n) : (f32x4){0.f, 0.f, 0.f, 0.f};
                sv[bj][n] = c.cscale ? *(const f32x4*)(c.cscale + col0 + bj * HALF + 4 * n) : (f32x4){1.f, 1.f, 1.f, 1.f};
            }
#pragma unroll
        for (int ai = 0; ai < 2; ++ai)
#pragma unroll
            for (int m = 0; m < 4; ++m) {
                const size_t row = (size_t)(row0 + ai * HALF + m * 16);
#pragma unroll
                for (int bj = 0; bj < 2; ++bj) {
                    const int cc = col0 + bj * HALF;
                    f32x4 v0 = acc[ai][bj][m][0] + bv[bj][0], v1 = acc[ai][bj][m][1] + bv[bj][1];
#pragma unroll
                    for (int j = 0; j < 4; ++j) { v0[j] = actf<ACT>(v0[j]); v1[j] = actf<ACT>(v1[j]); }
                    if (c.in1) { const u32x4 w = *(const u32x4*)(c.in1 + row * c.ld1 + cc);
                        v0[0] *= bf_lo(w.x); v0[1] *= bf_hi(w.x); v0[2] *= bf_lo(w.y); v0[3] *= bf_hi(w.y);
                        v1[0] *= bf_lo(w.z); v1[1] *= bf_hi(w.z); v1[2] *= bf_lo(w.w); v1[3] *= bf_hi(w.w); }
                    if (c.cscale) { v0 *= sv[bj][0]; v1 *= sv[bj][1]; }
                    if (c.in2) { const u32x4 w = *(const u32x4*)(c.in2 + row * c.ld2 + cc);
                        v0[0] += bf_lo(w.x); v0[1] += bf_hi(w.x); v0[2] += bf_lo(w.y); v0[3] += bf_hi(w.y);
                        v1[0] += bf_lo(w.z); v1[1] += bf_hi(w.z); v1[2] += bf_lo(w.w); v1[3] += bf_hi(w.w); }
                    u32x4 w; w.x = pk_bf16(v0[0], v0[1]); w.y = pk_bf16(v0[2], v0[3]); w.z = pk_bf16(v1[0], v1[1]); w.w = pk_bf16(v1[2], v1[3]);
                    *(u32x4*)(c.out + row * c.ldo + cc) = w;
                }
            }
    }
    __device__ __forceinline__ void operator()(const f32x4 (&acc)[2][2][4][2], const Unit& u, int wr, int wc, int fr, int fq) const {
        const int colt = u.pn * BM;
        if (colt >= split4) run<ACT_E>(e, colt - split4, acc, u, wr, wc, fr, fq);
        else if (colt >= split3) run<ACT_D>(d, colt - split3, acc, u, wr, wc, fr, fq);
        else if (colt >= split2) run<ACT_C>(c, colt - split2, acc, u, wr, wc, fr, fq);
        else if (colt >= split) run<ACT_B>(b, colt - split, acc, u, wr, wc, fr, fq);
        else run<ACT_A>(a, colt, acc, u, wr, wc, fr, fq);
    }
};
struct EpiRawT {
    static constexpr bool PERM = true;
    bf16_t* out; int ncols;
    __device__ __forceinline__ void operator()(const f32x4 (&acc)[2][2][4][2], const Unit& u, int wr, int wc, int fr, int fq) const {
        const int ch0 = u.pm * BM + wr * 64 + fr, tok0 = u.pn * BM + wc * 32 + 8 * fq;
#pragma unroll
        for (int ai = 0; ai < 2; ++ai)
#pragma unroll
            for (int m = 0; m < 4; ++m) {
                const int ch = ch0 + ai * HALF + m * 16;
#pragma unroll
                for (int bj = 0; bj < 2; ++bj) {
                    const int tok = tok0 + bj * HALF;
                    const f32x4 v0 = acc[ai][bj][m][0], v1 = acc[ai][bj][m][1];
                    u32x4 w; w.x = pk_bf16(v0[0], v0[1]); w.y = pk_bf16(v0[2], v0[3]); w.z = pk_bf16(v1[0], v1[1]); w.w = pk_bf16(v1[2], v1[3]);
                    *(u32x4*)(out + ((size_t)(tok >> 4) * ncols + ch) * 16 + (tok & 15)) = w;
                }
            }
    }
};
struct EpiResid {
    static constexpr bool PERM = false;
    float* X; int ldc; const float* Xin;
    __device__ __forceinline__ void operator()(const f32x4 (&acc)[2][2][4][2], const Unit& u, int wr, int wc, int fr, int fq) const {
        const int row0 = u.pm * BM + wr * 64 + fr, col0 = u.pn * BM + wc * 32 + 4 * fq;
#pragma unroll
        for (int ai = 0; ai < 2; ++ai)
#pragma unroll
            for (int m = 0; m < 4; ++m) { float* rowp = X + (size_t)(row0 + ai * HALF + m * 16) * ldc + col0;
#pragma unroll
                for (int bj = 0; bj < 2; ++bj)
#pragma unroll
                    for (int n = 0; n < 2; ++n) { f32x4* p = (f32x4*)(rowp + bj * HALF + n * 16); *p = *(const f32x4*)(Xin + (p - (f32x4*)X) * 4) + acc[ai][bj][m][n]; } }
    }
};
}

struct Args {
    const float* in[22];
    float* out; unsigned char* ws;
    int ph_lo, ph_hi;
};
typedef const Args __attribute__((address_space(4)))* ArgsP;
struct Frame {
    LAS unsigned char* lds;
    int tid, lane, wave, G, bid;
    ArgsP ap;
    float* X; unsigned char* ws;
    bf16_t *WinT, *WppT, *WrpT, *WoutT, *LinT, *EAT, *VF, *RAW, *RAWB, *S1, *S2, *S3, *TW;
};

__device__ __forceinline__ void set_ws(Frame& F, unsigned char* ws) {
    F.ws = ws;
    F.WinT = (bf16_t*)(ws + WS_WINT); F.WppT = (bf16_t*)(ws + WS_WPP); F.WrpT = (bf16_t*)(ws + WS_WRP); F.WoutT = (bf16_t*)(ws + WS_WOUT);
    F.LinT = (bf16_t*)(ws + WS_LINT); F.EAT = (bf16_t*)(ws + WS_EAT); F.VF = (bf16_t*)(ws + WS_VFIRST);
    F.RAW = (bf16_t*)(ws + WS_RAW); F.RAWB = (bf16_t*)(ws + WS_RAWB); F.S1 = (bf16_t*)(ws + WS_S1); F.S2 = (bf16_t*)(ws + WS_S2); F.S3 = (bf16_t*)(ws + WS_S3);
    F.TW = (bf16_t*)(ws + WS_TW);
}
__device__ __forceinline__ void transpose_cvt(const Frame& F, const float* src, int ldn, int K, int N, bf16_t* dst, int ldk) {
    LAS float* tile = (LAS float*)F.lds;
    const int tilesK = K / 64, ntile = tilesK * (N / 64);
    for (int tl = F.bid; tl < ntile; tl += F.G) {
        const int k0 = (tl % tilesK) * 64, n0 = (tl / tilesK) * 64;
#pragma unroll
        for (int i = 0; i < 8; ++i) { const int idx = F.tid + 512 * i, r = idx >> 6, c = idx & 63; tile[r * 65 + c] = src[(size_t)(k0 + r) * ldn + n0 + c]; }
        __syncthreads();
#pragma unroll
        for (int i = 0; i < 4; ++i) { const int idx = F.tid + 512 * i, n = idx >> 5, kp = idx & 31;
            *(unsigned*)(dst + (size_t)(n0 + n) * ldk + k0 + 2 * kp) = pk_bf16(tile[(2 * kp) * 65 + n], tile[(2 * kp + 1) * 65 + n]); }
        __syncthreads();
    }
}
__device__ __forceinline__ void fold_weights(const Frame& F, int L) {
    const int fr = F.lane & 15, fq = F.lane >> 4;
    LAS float* red = (LAS float*)F.lds;
    for (int tl = F.bid; tl < 64 * 4; tl += F.G) {
        const int k0 = (tl >> 2) * 16, j0 = (tl & 3) * 16, jj = j0 + fr;
        f32x4 acc = (f32x4){0.f, 0.f, 0.f, 0.f};
        if (L > 0) {
            const int cw = F.wave * 128 + 32 * fq;
            const float* arow = F.ap->in[2] + (size_t)L * D * INW + 4096 + (size_t)(k0 + fr) * INW + cw;
            const float* mu = F.ap->in[6] + (size_t)L * 3200 + 2048 + cw;
            const float* V1 = F.ap->in[12] + (size_t)(L - 1) * D * 32 + (size_t)cw * 32 + (jj & 31);
#pragma unroll
            for (int s4 = 0; s4 < 8; ++s4) {
                const f32x4 a4 = *(const f32x4*)(arow + 4 * s4), m4 = *(const f32x4*)(mu + 4 * s4);
#pragma unroll
                for (int e = 0; e < 4; ++e) acc = __builtin_amdgcn_mfma_f32_16x16x4f32(a4[e], V1[(size_t)(4 * s4 + e) * 32] * ((jj < 32) ? (1.0f - m4[e]) : m4[e]), acc, 0, 0, 0);
            }
        }
        *(LAS f32x4*)(red + (F.wave * 64 + F.lane) * 4) = acc;
        __syncthreads();
        if (F.wave == 0) {
            f32x4 t = acc;
#pragma unroll
            for (int w = 1; w < 8; ++w) t += *(const LAS f32x4*)(red + (w * 64 + F.lane) * 4);
            *(u32x2*)(F.WinT + (size_t)(R_FOLD + jj) * D + k0 + 4 * fq) = (u32x2){pk_bf16(t[0], t[1]), pk_bf16(t[2], t[3])};
            unsigned zz = 0u; asm volatile("" : "+v"(zz));
            *(u32x2*)(F.WinT + (size_t)(R_FOLD + 64 + jj) * D + k0 + 4 * fq) = (u32x2){zz, zz};
        }
        __syncthreads();
    }
    if (L > 0) { const float* V2 = F.ap->in[13] + (size_t)(L - 1) * 32 * D;
        for (int idx = F.bid * 512 + F.tid; idx < D * 32; idx += F.G * 512) { const int n = idx >> 5, j = idx & 31; F.EAT[131072 + idx] = f2bf_s(V2[(size_t)j * D + n]); } }
}
__device__ __forceinline__ void fold_pool_lin(const Frame& F, int L) {
    const float* win = F.ap->in[2] + (size_t)L * D * INW;
    const int fr = F.lane & 15, fq = F.lane >> 4;
    for (int tl = F.bid * 8 + F.wave; tl < 4 * 64 * 16; tl += F.G * 8) {
        const int g = tl >> 10, k0 = ((tl >> 4) & 63) * 16, d0 = (tl & 15) * 16;
        const float* arow = win + (size_t)(k0 + fr) * INW + 256 * g + 64 * fq;
        const float* bcol = F.ap->in[3] + ((size_t)(L * 4 + g) * 256 + 64 * fq) * 256 + d0 + fr;
        f32x4 acc = (f32x4){0.f, 0.f, 0.f, 0.f};
#pragma unroll 4
        for (int s4 = 0; s4 < 16; ++s4) {
            const f32x4 a4 = *(const f32x4*)(arow + 4 * s4);
#pragma unroll
            for (int e = 0; e < 4; ++e) acc = __builtin_amdgcn_mfma_f32_16x16x4f32(a4[e], bcol[(size_t)(4 * s4 + e) * 256], acc, 0, 0, 0);
        }
        *(u32x2*)(F.WinT + (size_t)(256 * g + d0 + fr) * D + k0 + 4 * fq) = (u32x2){pk_bf16(acc[0], acc[1]), pk_bf16(acc[2], acc[3])};
    }
}
__device__ __forceinline__ void convert_weights(const Frame& F, int L) {
    transpose_cvt(F, F.ap->in[2] + (size_t)L * D * INW + 1024, INW, D, 1024, F.WinT + (size_t)1024 * D, D);
    transpose_cvt(F, F.ap->in[2] + (size_t)L * D * INW + 2048, INW, D, 3200, F.WinT + (size_t)R_RKV * D, D);
    fold_pool_lin(F, L);
    transpose_cvt(F, F.ap->in[2] + (size_t)L * D * INW + 5248, INW, D, 1024, F.WinT + (size_t)R_RGATE * D, D);
    transpose_cvt(F, F.ap->in[2] + (size_t)L * D * INW + 6272, INW, D, 1024, F.WinT + (size_t)R_GPOOL * D, D);
    transpose_cvt(F, F.ap->in[2] + (size_t)L * D * INW + 7296, INW, D, 1024, F.WinT + (size_t)R_GRWKV * D, D);
    fold_weights(F, L);
    transpose_cvt(F, F.ap->in[5] + (size_t)L * D * D, D, D, D, F.WppT, D);
    transpose_cvt(F, F.ap->in[19] + (size_t)L * D * D, D, D, D, F.WrpT, D);
    transpose_cvt(F, F.ap->in[20] + (size_t)L * D * D, D, D, D, F.WoutT, D);
    transpose_cvt(F, F.ap->in[8] + (size_t)L * 64 * D, D, 64, D, F.EAT, 64);
    transpose_cvt(F, F.ap->in[10] + (size_t)L * 64 * D, D, 64, D, F.EAT + 65536, 64);
}
__device__ __forceinline__ void rmsnorm_rows(const Frame& F, const float* src, const float* g, bf16_t* H, bf16_t* copy_to) {
    for (int m = F.bid * 8 + F.wave; m < M; m += F.G * 8) {
        const float* xr = src + (size_t)m * D;
        f32x4 v[4]; float ss = 0.f;
#pragma unroll
        for (int i = 0; i < 4; ++i) { v[i] = *(const f32x4*)(xr + F.lane * 4 + 256 * i); ss += v[i][0] * v[i][0] + v[i][1] * v[i][1] + v[i][2] * v[i][2] + v[i][3] * v[i][3]; }
        ss = red64(ss);
        const float rs = __builtin_amdgcn_rsqf(ss * (1.0f / D) + NORM_EPS);
#pragma unroll
        for (int i = 0; i < 4; ++i) {
            const int c = F.lane * 4 + 256 * i;
            if (copy_to) *(u32x2*)(copy_to + (size_t)m * D + c) = (u32x2){pk_bf16(v[i][0], v[i][1]), pk_bf16(v[i][2], v[i][3])};
            const f32x4 gg = *(const f32x4*)(g + c);
            u32x2 w; w.x = pk_bf16(v[i][0] * rs * gg[0], v[i][1] * rs * gg[1]); w.y = pk_bf16(v[i][2] * rs * gg[2], v[i][3] * rs * gg[3]);
            *(u32x2*)(H + (size_t)m * D + c) = w;
        }
    }
}
__device__ __forceinline__ void rmsnorm_rows_bf(const Frame& F, const bf16_t* Xb, const float* g, bf16_t* H) {
    for (int m = F.bid * 8 + F.wave; m < M; m += F.G * 8) {
        const bf16_t* xr = Xb + (size_t)m * D;
        u32x4 w[2]; float ss = 0.f;
#pragma unroll
        for (int i = 0; i < 2; ++i) { w[i] = *(const u32x4*)(xr + F.lane * 8 + 512 * i);
#pragma unroll
            for (int e = 0; e < 4; ++e) { const float a = bf_lo(w[i][e]), b = bf_hi(w[i][e]); ss += a * a + b * b; } }
        ss = red64(ss);
        const float rs = __builtin_amdgcn_rsqf(ss * (1.0f / D) + NORM_EPS);
#pragma unroll
        for (int i = 0; i < 2; ++i) {
            const int c = F.lane * 8 + 512 * i;
            const f32x4 g0 = *(const f32x4*)(g + c), g1 = *(const f32x4*)(g + c + 4);
            u32x4 o; o.x = pk_bf16(bf_lo(w[i].x) * rs * g0[0], bf_hi(w[i].x) * rs * g0[1]); o.y = pk_bf16(bf_lo(w[i].y) * rs * g0[2], bf_hi(w[i].y) * rs * g0[3]);
            o.z = pk_bf16(bf_lo(w[i].z) * rs * g1[0], bf_hi(w[i].z) * rs * g1[1]); o.w = pk_bf16(bf_lo(w[i].w) * rs * g1[2], bf_hi(w[i].w) * rs * g1[3]);
            *(u32x4*)(H + (size_t)m * D + c) = o;
        }
    }
}
__device__ __forceinline__ void final_norm(const Frame& F, const bf16_t* Xb) {
    const float* g = F.ap->in[21];
    for (int m = F.bid * 8 + F.wave; m < M; m += F.G * 8) {
        const bf16_t* xr = Xb + (size_t)m * D;
        u32x4 w[2]; float ss = 0.f;
#pragma unroll
        for (int i = 0; i < 2; ++i) { w[i] = *(const u32x4*)(xr + F.lane * 8 + 512 * i);
#pragma unroll
            for (int e = 0; e < 4; ++e) { const float a = bf_lo(w[i][e]), b = bf_hi(w[i][e]); ss += a * a + b * b; } }
        ss = red64(ss);
        const float rs = __builtin_amdgcn_rsqf(ss * (1.0f / D) + NORM_EPS);
#pragma unroll
        for (int i = 0; i < 2; ++i) {
            const int c = F.lane * 8 + 512 * i;
            const f32x4 g0 = *(const f32x4*)(g + c), g1 = *(const f32x4*)(g + c + 4);
            *(f32x4*)(F.X + (size_t)m * D + c) = (f32x4){bf_lo(w[i].x) * rs * g0[0], bf_hi(w[i].x) * rs * g0[1], bf_lo(w[i].y) * rs * g0[2], bf_hi(w[i].y) * rs * g0[3]};
            *(f32x4*)(F.X + (size_t)m * D + c + 4) = (f32x4){bf_lo(w[i].z) * rs * g1[0], bf_hi(w[i].z) * rs * g1[1], bf_lo(w[i].w) * rs * g1[2], bf_hi(w[i].w) * rs * g1[3]};
        }
    }
}
__device__ __forceinline__ void tw_phase(const Frame& F, int L) {
    const float* mu = F.ap->in[6] + (size_t)L * 3200;
    for (int it = F.bid * 512 + F.tid; it < M * 32; it += F.G * 512) {
        const int m = it >> 5, j = it & 31; u32x4 o = (u32x4){0u, 0u, 0u, 0u};
        if (j < 16) {
            const int c0 = 3072 + 8 * j, t = m & (SEQ - 1);
            const u32x4 cw = *(const u32x4*)(F.RAW + (size_t)m * RAWLD + c0);
            u32x4 pw = (u32x4){0u, 0u, 0u, 0u}; if (t > 0) pw = *(const u32x4*)(F.RAW + (size_t)(m - 1) * RAWLD + c0);
            const f32x4 m0 = *(const f32x4*)(mu + c0), m1 = *(const f32x4*)(mu + c0 + 4);
            float s[8];
#define SH(i, cwv, pwv, muv, hi) { const float c_ = hi ? bf_hi(cwv) : bf_lo(cwv), p_ = hi ? bf_hi(pwv) : bf_lo(pwv); s[i] = c_ + (muv) * (p_ - c_); }
            SH(0, cw.x, pw.x, m0[0], 0) SH(1, cw.x, pw.x, m0[1], 1) SH(2, cw.y, pw.y, m0[2], 0) SH(3, cw.y, pw.y, m0[3], 1)
            SH(4, cw.z, pw.z, m1[0], 0) SH(5, cw.z, pw.z, m1[1], 1) SH(6, cw.w, pw.w, m1[2], 0) SH(7, cw.w, pw.w, m1[3], 1)
#undef SH
            if (j < 8) {
#pragma unroll
                for (int i = 0; i < 8; ++i) s[i] = tanhf_(s[i]);
            }
            o.x = pk_bf16(s[0], s[1]); o.y = pk_bf16(s[2], s[3]); o.z = pk_bf16(s[4], s[5]); o.w = pk_bf16(s[6], s[7]);
        }
        *(u32x4*)(F.TW + (size_t)m * 256 + 8 * j) = o;
    }
}
__device__ __forceinline__ void vmix_phase(const Frame& F, int L) {
    const float* mu = F.ap->in[6] + (size_t)L * 3200 + 2048;
    const int tid = F.tid, c0 = 2 * tid;
    const f32x2 muv = *(const f32x2*)(mu + c0);
    LAS float* vsh = (LAS float*)F.lds;
    LAS float* part = (LAS float*)(F.lds + 16384);
    LAS float* midl = (LAS float*)(F.lds + 16384 + 8192);
    bf16_t* dst = (L == 0) ? F.VF : F.S3;
    float v1r[64]; f32x2 v2r[32]; f32x2 v0v = (f32x2){0.f, 0.f};
    const int jj = tid & 31, cs = tid >> 5;
    if (L > 0) {
        const float* V1 = F.ap->in[12] + (size_t)(L - 1) * D * 32; const float* V2 = F.ap->in[13] + (size_t)(L - 1) * 32 * D;
#pragma unroll
        for (int i = 0; i < 64; ++i) v1r[i] = V1[(size_t)(cs * 64 + i) * 32 + jj];
#pragma unroll
        for (int j = 0; j < 32; ++j) v2r[j] = *(const f32x2*)(V2 + (size_t)j * D + c0);
        v0v = *(const f32x2*)(F.ap->in[11] + (size_t)(L - 1) * D + c0);
    }
    for (int grp = F.bid; grp < M / 4; grp += F.G) {
        const int m0 = grp * 4, t0 = m0 & (SEQ - 1);
        unsigned rw[5];
        rw[0] = (t0 > 0) ? *(const unsigned*)(F.RAW + (size_t)(m0 - 1) * RAWLD + 2048 + c0) : 0u;
#pragma unroll
        for (int i = 0; i < 4; ++i) rw[i + 1] = *(const unsigned*)(F.RAW + (size_t)(m0 + i) * RAWLD + 2048 + c0);
        f32x2 vs[4];
#pragma unroll
        for (int i = 0; i < 4; ++i) { const float c_lo = bf_lo(rw[i + 1]), c_hi = bf_hi(rw[i + 1]), p_lo = bf_lo(rw[i]), p_hi = bf_hi(rw[i]);
            vs[i].x = c_lo + muv.x * (p_lo - c_lo); vs[i].y = c_hi + muv.y * (p_hi - c_hi); }
        if (L == 0) {
#pragma unroll
            for (int i = 0; i < 4; ++i) *(unsigned*)(dst + (size_t)(m0 + i) * D + c0) = pk_bf16(vs[i].x, vs[i].y);
            continue;
        }
#pragma unroll
        for (int i = 0; i < 4; ++i) *(LAS f32x2*)(vsh + i * 1024 + c0) = vs[i];
        __syncthreads();
#pragma unroll
        for (int i = 0; i < 4; ++i) {
            float p = 0.f;
#pragma unroll
            for (int k4 = 0; k4 < 16; ++k4) { const f32x4 x = *(const LAS f32x4*)(vsh + i * 1024 + cs * 64 + 4 * k4);
                p += x[0] * v1r[4 * k4] + x[1] * v1r[4 * k4 + 1] + x[2] * v1r[4 * k4 + 2] + x[3] * v1r[4 * k4 + 3]; }
            part[(i * 16 + cs) * 32 + jj] = p;
        }
        __syncthreads();
        if (tid < 128) { const int i = tid >> 5; float s = 0.f;
#pragma unroll
            for (int k = 0; k < 16; ++k) s += part[(i * 16 + k) * 32 + jj];
            midl[i * 32 + jj] = s; }
        __syncthreads();
#pragma unroll
        for (int i = 0; i < 4; ++i) {
            float z0 = v0v.x, z1 = v0v.y;
#pragma unroll
            for (int j4 = 0; j4 < 8; ++j4) { const f32x4 mm = *(const LAS f32x4*)(midl + i * 32 + 4 * j4);
#pragma unroll
                for (int e = 0; e < 4; ++e) { z0 += mm[e] * v2r[4 * j4 + e].x; z1 += mm[e] * v2r[4 * j4 + e].y; } }
            const float g0 = sigmoidf_(z0), g1 = sigmoidf_(z1);
            const unsigned fw = *(const unsigned*)(F.VF + (size_t)(m0 + i) * D + c0);
            const float o0 = vs[i].x + (bf_lo(fw) - vs[i].x) * g0, o1 = vs[i].y + (bf_hi(fw) - vs[i].y) * g1;
            *(unsigned*)(dst + (size_t)(m0 + i) * D + c0) = pk_bf16(o0, o1);
        }
        __syncthreads();
    }
}
__device__ __forceinline__ void poold_phase(const Frame& F, const bf16_t* __restrict__ PIN, bf16_t* __restrict__ SGIO, const float* __restrict__ scale) {
    const rsrc_t rs_out = wt_rsrc(SGIO);
    for (int it = F.bid * 512 + F.tid; it < (M / 32) * 128; it += F.G * 512) {
        const int j = it & 127, m0 = (it >> 7) * 32, t0 = m0 & (SEQ - 1), w = 2 << (j >> 5);
        const bf16_t* col = PIN + 8 * j;
        const f32x4 sc0 = *(const f32x4*)(scale + 8 * j), sc1 = *(const f32x4*)(scale + 8 * j + 4);
        float s[8];
#pragma unroll
        for (int e = 0; e < 8; ++e) s[e] = 0.f;
        if (t0 > 0) {
            for (int i = 1; i < w; ++i) { const u32x4 x = *(const u32x4*)(col + (size_t)(m0 - i) * D);
                s[0] += bf_lo(x.x); s[1] += bf_hi(x.x); s[2] += bf_lo(x.y); s[3] += bf_hi(x.y); s[4] += bf_lo(x.z); s[5] += bf_hi(x.z); s[6] += bf_lo(x.w); s[7] += bf_hi(x.w); }
        }
        for (int sb = 0; sb < 4; ++sb) {
            u32x4 xv[8], ov[8], gv[8];
#pragma unroll
            for (int i = 0; i < 8; ++i) {
                const int ii = sb * 8 + i, t = t0 + ii; const size_t m = (size_t)(m0 + ii);
                const bool sub = (t >= w) && (ii > 0);
                xv[i] = *(const u32x4*)(col + m * D);
                ov[i] = *(const u32x4*)(col + (sub ? m - w : m) * D);
                gv[i] = *(const u32x4*)(SGIO + m * D + 8 * j);
            }
#pragma unroll
            for (int i = 0; i < 8; ++i) {
                const int ii = sb * 8 + i, t = t0 + ii; const size_t m = (size_t)(m0 + ii);
                const float fs = ((t >= w) && (ii > 0)) ? 1.0f : 0.0f;
                const u32x4 x = xv[i], o = ov[i], gw = gv[i];
                const float c[8] = {bf_lo(x.x), bf_hi(x.x), bf_lo(x.y), bf_hi(x.y), bf_lo(x.z), bf_hi(x.z), bf_lo(x.w), bf_hi(x.w)};
                const float d[8] = {bf_lo(o.x), bf_hi(o.x), bf_lo(o.y), bf_hi(o.y), bf_lo(o.z), bf_hi(o.z), bf_lo(o.w), bf_hi(o.w)};
#pragma unroll
                for (int e = 0; e < 8; ++e) s[e] += c[e] - fs * d[e];
                const float inv = __builtin_amdgcn_rcpf((float)((t + 1 < w) ? (t + 1) : w));
                u32x4 r; r.x = pk_bf16((s[0] * inv - c[0]) * sc0[0] * bf_lo(gw.x), (s[1] * inv - c[1]) * sc0[1] * bf_hi(gw.x)); r.y = pk_bf16((s[2] * inv - c[2]) * sc0[2] * bf_lo(gw.y), (s[3] * inv - c[3]) * sc0[3] * bf_hi(gw.y));
                r.z = pk_bf16((s[4] * inv - c[4]) * sc1[0] * bf_lo(gw.z), (s[5] * inv - c[5]) * sc1[1] * bf_hi(gw.z)); r.w = pk_bf16((s[6] * inv - c[6]) * sc1[2] * bf_lo(gw.w), (s[7] * inv - c[7]) * sc1[3] * bf_hi(gw.w));
                ST16_WT(rs_out, (m * D + 8 * j) * 2, r);
            }
        }
    }
}

constexpr int SC_T = 32;
constexpr int SC_ARR = SC_T * 64;
constexpr int SC_BUF_BYTES = 6 * SC_ARR * 4;
constexpr int SC_YS = 2 * SC_BUF_BYTES, SC_RAWR = SC_YS + SC_ARR * 4, SC_RAWK = SC_RAWR + SC_ARR * 4, SC_PREV = SC_RAWK + SC_ARR * 4;
static_assert(SC_PREV + 1024 <= 131072, "scan LDS");

#define QP(n) "quad_perm:[" #n "," #n "," #n "," #n "] row_mask:0xf bank_mask:0xf"
__device__ __forceinline__ void sc_matvec(float& o0, float& o1, const f32x2 x, const float (&S)[8]) {
    asm volatile("s_nop 1\n\t"
        "v_mul_f32_dpp %0, %2, %4 " QP(0) "\n\t"  "v_mul_f32_dpp %1, %3, %5 " QP(0) "\n\t"
        "v_fmac_f32_dpp %0, %2, %6 " QP(1) "\n\t" "v_fmac_f32_dpp %1, %3, %7 " QP(1) "\n\t"
        "v_fmac_f32_dpp %0, %2, %8 " QP(2) "\n\t" "v_fmac_f32_dpp %1, %3, %9 " QP(2) "\n\t"
        "v_fmac_f32_dpp %0, %2, %10 " QP(3) "\n\t" "v_fmac_f32_dpp %1, %3, %11 " QP(3)
        : "=&v"(o0), "=&v"(o1) : "v"(x.x), "v"(x.y), "v"(S[0]), "v"(S[1]), "v"(S[2]), "v"(S[3]), "v"(S[4]), "v"(S[5]), "v"(S[6]), "v"(S[7]));
}
__device__ __forceinline__ void sc_update(float (&S)[8], const f32x2 w, const f32x2 b, const f32x2 k, const float sa, const float vv) {
    asm volatile("s_nop 1\n\t"
        "v_mul_f32_dpp %0, %8, %0 " QP(0) "\n\t" "v_mul_f32_dpp %1, %9, %1 " QP(0) "\n\t"
        "v_mul_f32_dpp %2, %8, %2 " QP(1) "\n\t" "v_mul_f32_dpp %3, %9, %3 " QP(1) "\n\t"
        "v_mul_f32_dpp %4, %8, %4 " QP(2) "\n\t" "v_mul_f32_dpp %5, %9, %5 " QP(2) "\n\t"
        "v_mul_f32_dpp %6, %8, %6 " QP(3) "\n\t" "v_mul_f32_dpp %7, %9, %7 " QP(3) "\n\t"
        "v_fmac_f32_dpp %0, %10, %14 " QP(0) "\n\t" "v_fmac_f32_dpp %1, %11, %14 " QP(0) "\n\t"
        "v_fmac_f32_dpp %2, %10, %14 " QP(1) "\n\t" "v_fmac_f32_dpp %3, %11, %14 " QP(1) "\n\t"
        "v_fmac_f32_dpp %4, %10, %14 " QP(2) "\n\t" "v_fmac_f32_dpp %5, %11, %14 " QP(2) "\n\t"
        "v_fmac_f32_dpp %6, %10, %14 " QP(3) "\n\t" "v_fmac_f32_dpp %7, %11, %14 " QP(3) "\n\t"
        "v_fmac_f32_dpp %0, %12, %15 " QP(0) "\n\t" "v_fmac_f32_dpp %1, %13, %15 " QP(0) "\n\t"
        "v_fmac_f32_dpp %2, %12, %15 " QP(1) "\n\t" "v_fmac_f32_dpp %3, %13, %15 " QP(1) "\n\t"
        "v_fmac_f32_dpp %4, %12, %15 " QP(2) "\n\t" "v_fmac_f32_dpp %5, %13, %15 " QP(2) "\n\t"
        "v_fmac_f32_dpp %6, %12, %15 " QP(3) "\n\t" "v_fmac_f32_dpp %7, %13, %15 " QP(3)
        : "+v"(S[0]), "+v"(S[1]), "+v"(S[2]), "+v"(S[3]), "+v"(S[4]), "+v"(S[5]), "+v"(S[6]), "+v"(S[7])
        : "v"(w.x), "v"(w.y), "v"(b.x), "v"(b.y), "v"(k.x), "v"(k.y), "v"(sa), "v"(vv));
}
__device__ __forceinline__ float sc_red(float x) {
    asm volatile("s_nop 1\n\tv_add_f32_dpp %0, %0, %0 row_ror:4 row_mask:0xf bank_mask:0xf\n\ts_nop 1\n\tv_add_f32_dpp %0, %0, %0 row_ror:8 row_mask:0xf bank_mask:0xf" : "+v"(x));
    const auto r = __builtin_amdgcn_permlane32_swap(__float_as_uint(x), __float_as_uint(x), false, false);
    return __uint_as_float(r[0]) + __uint_as_float(r[1]);
}
#undef QP
struct ScanRegs { u32x2 rr, kr, ee, aa, vv; };
__device__ __forceinline__ void scan_phase(const Frame& F, int L, const bf16_t* VP) {
    const int tid = F.tid, lane = F.lane, wave = F.wave;
    LAS float* Ys = (LAS float*)(F.lds + SC_YS);
    LAS float* rawR = (LAS float*)(F.lds + SC_RAWR);
    LAS float* rawK = (LAS float*)(F.lds + SC_RAWK);
    LAS float* prevRK = (LAS float*)(F.lds + SC_PREV);
    const int tok = tid >> 4, q = tid & 15;
    const int kc = ((lane >> 5) << 2) | ((lane >> 2) & 3), row = wave * 8 + ((lane >> 4) & 1) * 4 + (lane & 3), koff = 8 * kc + 2 * (lane & 3);
    for (int unit = F.bid; unit < 256; unit += F.G) {
        const int b = unit >> 4, h = unit & 15, hc = h * 64 + 4 * q;
        const f32x4 kk4 = *(const f32x4*)(F.ap->in[14] + (size_t)L * D + hc), ka4 = *(const f32x4*)(F.ap->in[15] + (size_t)L * D + hc);
        const f32x4 rk4 = *(const f32x4*)(F.ap->in[16] + (size_t)L * D + hc);
        const f32x4 lw4 = *(const f32x4*)(F.ap->in[17] + (size_t)L * D + hc), lb4 = *(const f32x4*)(F.ap->in[18] + (size_t)L * D + hc);
        const f32x4 mur4 = *(const f32x4*)(F.ap->in[6] + (size_t)L * 3200 + hc), muk4 = *(const f32x4*)(F.ap->in[6] + (size_t)L * 3200 + 1024 + hc);
        const size_t mrow0 = (size_t)b * SEQ;
        float S[8];
#pragma unroll
        for (int j = 0; j < 8; ++j) S[j] = 0.f;
        ScanRegs R;
#define SC_LOAD(cidx) do { const size_t m_ = mrow0 + (size_t)(cidx) * SC_T + tok; \
            R.rr = *(const u32x2*)(F.RAW + m_ * RAWLD + hc); R.kr = *(const u32x2*)(F.RAW + m_ * RAWLD + 1024 + hc); \
            R.ee = *(const u32x2*)(F.S1 + m_ * D + hc); R.aa = *(const u32x2*)(F.S2 + m_ * D + hc); R.vv = *(const u32x2*)(VP + m_ * D + hc); } while (0)
#define SC_PREP(cidx) do { \
            const f32x4 rc = (f32x4){bf_lo(R.rr.x), bf_hi(R.rr.x), bf_lo(R.rr.y), bf_hi(R.rr.y)}; \
            const f32x4 kc = (f32x4){bf_lo(R.kr.x), bf_hi(R.kr.x), bf_lo(R.kr.y), bf_hi(R.kr.y)}; \
            *(LAS f32x4*)(rawR + tok * 64 + 4 * q) = rc; *(LAS f32x4*)(rawK + tok * 64 + 4 * q) = kc; \
            __syncthreads(); \
            f32x4 rp, kp; \
            if (tok > 0) { rp = *(const LAS f32x4*)(rawR + (tok - 1) * 64 + 4 * q); kp = *(const LAS f32x4*)(rawK + (tok - 1) * 64 + 4 * q); } \
            else if ((cidx) > 0) { rp = *(const LAS f32x4*)(prevRK + (((cidx) & 1) * 2 + 0) * 64 + 4 * q); kp = *(const LAS f32x4*)(prevRK + (((cidx) & 1) * 2 + 1) * 64 + 4 * q); } \
            else { rp = (f32x4){0.f, 0.f, 0.f, 0.f}; kp = rp; } \
            if (tok == SC_T - 1) { *(LAS f32x4*)(prevRK + ((((cidx) + 1) & 1) * 2 + 0) * 64 + 4 * q) = rc; *(LAS f32x4*)(prevRK + ((((cidx) + 1) & 1) * 2 + 1) * 64 + 4 * q) = kc; } \
            const f32x4 rs = rc + mur4 * (rp - rc), ks = kc + muk4 * (kp - kc); \
            const f32x4 ev = (f32x4){bf_lo(R.ee.x), bf_hi(R.ee.x), bf_lo(R.ee.y), bf_hi(R.ee.y)}; \
            const f32x4 av = (f32x4){bf_lo(R.aa.x), bf_hi(R.aa.x), bf_lo(R.aa.y), bf_hi(R.aa.y)}; \
            const f32x4 vv = (f32x4){bf_lo(R.vv.x), bf_hi(R.vv.x), bf_lo(R.vv.y), bf_hi(R.vv.y)}; \
            f32x4 kkv = ks * kk4; \
            float ss = kkv[0] * kkv[0] + kkv[1] * kkv[1] + kkv[2] * kkv[2] + kkv[3] * kkv[3]; ss = red16(ss); \
            const float inv = 1.0f / fmaxf(sqrtf(ss), 1e-12f); kkv = kkv * inv; \
            const f32x4 kmod = ks * (1.0f + (av - 1.0f) * ka4); \
            f32x4 wv; wv[0] = __expf(-ev[0]); wv[1] = __expf(-ev[1]); wv[2] = __expf(-ev[2]); wv[3] = __expf(-ev[3]); \
            LAS float* cb_ = (LAS float*)(F.lds + ((cidx) & 1) * SC_BUF_BYTES) + tok * 64 + 4 * q; \
            *(LAS f32x4*)(cb_ + 0 * SC_ARR) = rs; *(LAS f32x4*)(cb_ + 1 * SC_ARR) = wv; *(LAS f32x4*)(cb_ + 2 * SC_ARR) = kmod; \
            *(LAS f32x4*)(cb_ + 3 * SC_ARR) = -kkv; *(LAS f32x4*)(cb_ + 4 * SC_ARR) = kkv * av; *(LAS f32x4*)(cb_ + 5 * SC_ARR) = vv; } while (0)
        SC_LOAD(0);
        SC_PREP(0);
        __syncthreads();
        for (int c = 0; c < SEQ / SC_T; ++c) {
            if (c + 1 < SEQ / SC_T) SC_LOAD(c + 1);
            const LAS float* cb = (const LAS float*)(F.lds + (c & 1) * SC_BUF_BYTES);
            const LAS float* pin = cb + koff;
            const LAS float* pv = cb + 5 * SC_ARR + row;
#define SC_LD(dst, t_) do { dst##r = *(const LAS f32x2*)(pin + 0 * SC_ARR + (t_) * 64); dst##w = *(const LAS f32x2*)(pin + 1 * SC_ARR + (t_) * 64); dst##k = *(const LAS f32x2*)(pin + 2 * SC_ARR + (t_) * 64); \
                dst##a = *(const LAS f32x2*)(pin + 3 * SC_ARR + (t_) * 64); dst##b = *(const LAS f32x2*)(pin + 4 * SC_ARR + (t_) * 64); dst##v = pv[(t_) * 64]; } while (0)
#define SC_STEP(src, t_) do { float p0_, p1_; sc_matvec(p0_, p1_, src##a, S); const float sa_ = sc_red(p0_ + p1_); sc_update(S, src##w, src##b, src##k, sa_, src##v); \
                sc_matvec(p0_, p1_, src##r, S); const float y_ = sc_red(p0_ + p1_); if (kc == 0) Ys[(t_) * 64 + row] = y_; } while (0)
            f32x2 Ar, Aw, Ak, Aa, Ab, Br, Bw, Bk, Ba, Bb; float Av, Bv;
            SC_LD(A, 0);
            for (int t = 0; t < SC_T; t += 2) {
                SC_LD(B, t + 1);
                SC_STEP(A, t);
                if (t + 2 < SC_T) SC_LD(A, t + 2);
                SC_STEP(B, t + 1);
            }
#undef SC_LD
#undef SC_STEP
            __syncthreads();
            {
                const f32x4 y4 = *(const LAS f32x4*)(Ys + tok * 64 + 4 * q);
                const float mean = red16((y4[0] + y4[1]) + (y4[2] + y4[3])) * (1.0f / 64.0f);
                const f32x4 d = y4 - mean;
                const float var = red16((d[0] * d[0] + d[1] * d[1]) + (d[2] * d[2] + d[3] * d[3])) * (1.0f / 64.0f);
                const float rstd = __builtin_amdgcn_rsqf(var + LNX_EPS);
                const f32x4 rs = *(const LAS f32x4*)(cb + 0 * SC_ARR + tok * 64 + 4 * q), km = *(const LAS f32x4*)(cb + 2 * SC_ARR + tok * 64 + 4 * q), vv = *(const LAS f32x4*)(cb + 5 * SC_ARR + tok * 64 + 4 * q);
                const f32x4 pr = rs * km * rk4;
                const float bon = red16((pr[0] + pr[1]) + (pr[2] + pr[3]));
                const f32x4 z = d * rstd * lw4 + lb4 + bon * vv;
                u32x2 o; o.x = pk_bf16(z[0], z[1]); o.y = pk_bf16(z[2], z[3]);
                *(u32x2*)(F.RAW + (mrow0 + (size_t)c * SC_T + tok) * RAWLD + hc) = o;
            }
            if (c + 1 < SEQ / SC_T) SC_PREP(c + 1);
            __syncthreads();
        }
#undef SC_LOAD
#undef SC_PREP
    }
}


constexpr int C2_AT = 0, C2_RT = 2048, C2_BK = 4096, C2_VT = 8192, C2_NAK = 10240, C2_NRBK = 10752, C2_MT = 11776, C2_GTV = 12288, C2_BON = 12544, C2_CH = 12800;
constexpr int C2_YS = 8 * C2_CH;
constexpr int C2_PREV = C2_YS + 32768;
constexpr int C2_W2S = C2_PREV + 512, C2_A2S = C2_W2S + 8192;
constexpr int C2_V2S = C2_A2S + 8192;
static_assert(C2_V2S + 8192 <= 163776, "scan LDS");
typedef short s16x4 __attribute__((ext_vector_type(4)));
__device__ __forceinline__ u32x2 tr4(const LAS unsigned char* img, int k0, int lane) {
    return __builtin_bit_cast(u32x2, __builtin_amdgcn_ds_read_tr16_b64_v4i16((LAS s16x4*)(img + (k0 + ((lane & 15) >> 2)) * 32 + (lane & 3) * 8)));
}
__device__ __forceinline__ u32x2 tr4bk(const LAS unsigned char* img, int k0, int lane) {
    return __builtin_bit_cast(u32x2, __builtin_amdgcn_ds_read_tr16_b64_v4i16((LAS s16x4*)(img + (k0 + ((lane & 15) >> 2)) * 64 + (lane & 3) * 16)));
}
__device__ __forceinline__ void wr_row(LAS unsigned char* img, int lane, const unsigned (&w)[8]) {
    *(LAS u32x4*)(img + lane * 32) = (u32x4){w[0], w[1], w[2], w[3]}; *(LAS u32x4*)(img + lane * 32 + 16) = (u32x4){w[4], w[5], w[6], w[7]};
}
__device__ __forceinline__ bf16x8 mk_frag(u32x2 lo, u32x2 hi) { return __builtin_bit_cast(bf16x8, (u32x4){lo.x, lo.y, hi.x, hi.y}); }
__device__ __forceinline__ u32x2 pk4(const f32x4 a) { return (u32x2){pk_bf16(a[0], a[1]), pk_bf16(a[2], a[3])}; }
__device__ __forceinline__ float bf1(unsigned short v) { return __uint_as_float((unsigned)v << 16); }
__device__ __forceinline__ unsigned short f2bf(float x) { return (unsigned short)(pk_bf16(x, 0.f) & 0xffffu); }
__device__ __forceinline__ void st2(LAS unsigned char* p0, LAS unsigned char* p1, float a, float b) { const unsigned w = pk_bf16(a, b); *(LAS unsigned short*)p0 = (unsigned short)w; *(LAS unsigned short*)p1 = (unsigned short)(w >> 16); }
__device__ __forceinline__ void scan2_phase(const Frame& F, int L) {
    const int tid = F.tid, lane = F.lane, wave = F.wave, fr = lane & 15, fq = lane >> 4;
    LAS unsigned char* lds = F.lds;
    for (int unit = F.bid; unit < 256; unit += F.G) {
        int lane_u = lane; asm volatile("" : "+v"(lane_u));
        const int b = unit >> 4, h = unit & 15, ch = h * 64 + lane_u;
        const size_t mrow0 = (size_t)b * SEQ;
        const float c_kk = F.ap->in[14][(size_t)L * D + ch], c_ka = F.ap->in[15][(size_t)L * D + ch], c_rk = F.ap->in[16][(size_t)L * D + ch];
        const float c_mur = F.ap->in[6][(size_t)L * 3200 + ch], c_muk = F.ap->in[6][(size_t)L * 3200 + 1024 + ch];
        f32x4 St[4];
#pragma unroll
        for (int i = 0; i < 4; ++i) St[i] = (f32x4){0.f, 0.f, 0.f, 0.f};
        int tid_u = tid; asm volatile("" : "+v"(tid_u));
        for (int i = tid_u; i < 1024; i += 512) { const int which = i >> 9, e = i & 511;
            *(LAS u32x4*)(lds + C2_W2S + which * 8192 + e * 16) = *(const u32x4*)(F.EAT + (size_t)which * 65536 + (size_t)h * 64 * 64 + e * 8); }
        if (L > 0) for (int e = tid_u; e < 512; e += 512) { const int chl = e >> 3, p = e & 7;
            *(LAS u32x4*)(lds + C2_V2S + e * 16) = *(const u32x4*)(F.EAT + 131072 + (size_t)(h * 64 + chl) * 32 + ((8 * p) & 31)); }
        const float c_muw = F.ap->in[6][(size_t)L * 3200 + 3072 + lane_u], c_mua = F.ap->in[6][(size_t)L * 3200 + 3136 + lane_u], c_muv = F.ap->in[6][(size_t)L * 3200 + 2048 + ch];
        float c_v0[4];
#pragma unroll
        for (int i = 0; i < 4; ++i) c_v0[i] = F.ap->in[11][(size_t)(L > 0 ? L - 1 : 0) * D + h * 64 + 16 * i + (lane_u & 15)];
        float c_w0[4], c_a0[4];
#pragma unroll
        for (int i = 0; i < 4; ++i) { c_w0[i] = F.ap->in[7][(size_t)L * D + h * 64 + 16 * i + (lane_u & 15)]; c_a0[i] = F.ap->in[9][(size_t)L * D + h * 64 + 16 * i + (lane_u & 15)]; }
        __syncthreads();
        const auto rs_raw = __builtin_amdgcn_make_buffer_rsrc((void*)F.RAW, 0, (int)((size_t)M * RAWLD * 2), 0x00020000);
        const auto rs_vf = __builtin_amdgcn_make_buffer_rsrc((void*)F.VF, 0, M * D * 2, 0x00020000);
        const int voh = ch * 32, vol = lane * 32;
#define LDQ(vofs, q, tb) __builtin_bit_cast(u32x4, __builtin_amdgcn_raw_buffer_load_b128(rs_raw, (vofs) + (q) * 16, (int)(tb) * (RAWLD * 32), 0))
#define LDP(vofs, tb) __builtin_amdgcn_raw_buffer_load_b16(rs_raw, (vofs) + 30, (int)(tb) * (RAWLD * 32), 0)
#define QF(q, t) (((t) & 1) ? bf_hi((q)[(t) >> 1]) : bf_lo((q)[(t) >> 1]))
#define QP(q, pv, i) (((i) == 0) ? bf1(pv) : QF(q, ((i) > 0 ? (i) - 1 : 0)))

        for (int g = 0; g < SEQ / 128; ++g) {
            if (tid < 8) *(volatile LAS unsigned*)(lds + C2_PREV + tid * 4) = 0u;
            {
                int lane_ = lane; asm volatile("" : "+v"(lane_));
                const int fr = lane_ & 15, fq = lane_ >> 4;
                const int m0 = (int)mrow0 + g * 128 + wave * 16;
                LAS unsigned char* cb = lds + wave * C2_CH;
                LAS unsigned char* scr = lds + C2_YS + wave * 4096;
                const int tb = m0 >> 4, tbp = (tb > 0) ? tb - 1 : 0;
                unsigned rrq[8], krq[8], aaq[8], eeq[8], vvp[8];
                unsigned vrq[8], xrq[8], mixq[8]; unsigned short vprev, xprev;
                {
                    unsigned wdq[8], adq[8]; unsigned short wprev, aprev;
                    const bool has_prev = (g > 0) || (wave > 0);
                    const unsigned short pm = has_prev ? (unsigned short)0xffffu : (unsigned short)0;
                    wprev = LDP(vol + 3072 * 32, tbp) & pm; aprev = LDP(vol + 3136 * 32, tbp) & pm;
#pragma unroll
                    for (int q = 0; q < 2; ++q) { const u32x4 w4 = LDQ(vol + 3072 * 32, q, tb), a4 = LDQ(vol + 3136 * 32, q, tb);
#pragma unroll
                        for (int e = 0; e < 4; ++e) { wdq[4 * q + e] = w4[e]; adq[4 * q + e] = a4[e]; } }
                    {
                        vprev = LDP(voh + 2048 * 32, tbp) & pm; xprev = LDP(vol + 3200 * 32, tbp) & pm;
#pragma unroll
                        for (int q = 0; q < 2; ++q) { const u32x4 v4 = LDQ(voh + 2048 * 32, q, tb), x4 = LDQ(vol + 3200 * 32, q, tb);
                            const u32x4 f4 = __builtin_bit_cast(u32x4, __builtin_amdgcn_raw_buffer_load_b128(rs_vf, voh + q * 16, tb * (D * 32), 0));
#pragma unroll
                            for (int e = 0; e < 4; ++e) { vrq[4 * q + e] = v4[e]; xrq[4 * q + e] = x4[e]; mixq[4 * q + e] = f4[e]; } }
                    }
                    __builtin_amdgcn_sched_barrier(0);
                    unsigned twp[8], adp[8];
#pragma unroll
                    for (int t = 0; t < 16; t += 2) {
                        const float w0_ = QP(wdq, wprev, t), w1_ = QP(wdq, wprev, t + 1), w2_ = QP(wdq, wprev, t + 2), a0_ = QP(adq, aprev, t), a1_ = QP(adq, aprev, t + 1), a2_ = QP(adq, aprev, t + 2);
                        twp[t >> 1] = pk_bf16(tanhf_(w1_ + c_muw * (w0_ - w1_)), tanhf_(w2_ + c_muw * (w1_ - w2_)));
                        adp[t >> 1] = pk_bf16(a1_ + c_mua * (a0_ - a1_), a2_ + c_mua * (a1_ - a2_));
                    }
                    wr_row(scr, lane, twp); wr_row(scr + 2048, lane, adp);
                    asm volatile("s_waitcnt lgkmcnt(0)" ::: "memory");
                    f32x4 le[4], la[4];
#pragma unroll
                    for (int i = 0; i < 4; ++i) { le[i] = (f32x4){0.f, 0.f, 0.f, 0.f}; la[i] = le[i]; }
#pragma unroll
                    for (int s2 = 0; s2 < 2; ++s2) {
                        const int k0 = 32 * s2 + 8 * fq;
                        const bf16x8 fw = mk_frag(tr4(scr, k0, lane), tr4(scr, k0 + 4, lane)), fa = mk_frag(tr4(scr + 2048, k0, lane), tr4(scr + 2048, k0 + 4, lane));
#pragma unroll
                        for (int i = 0; i < 4; ++i) {
                            le[i] = __builtin_amdgcn_mfma_f32_16x16x32_bf16(fw, *(const LAS bf16x8*)(lds + C2_W2S + (16 * i + fr) * 128 + (32 * s2 + 8 * fq) * 2), le[i], 0, 0, 0);
                            la[i] = __builtin_amdgcn_mfma_f32_16x16x32_bf16(fa, *(const LAS bf16x8*)(lds + C2_A2S + (16 * i + fr) * 128 + (32 * s2 + 8 * fq) * 2), la[i], 0, 0, 0);
                        }
                    }
#pragma unroll
                    for (int i = 0; i < 4; ++i)
                        {
                            *(LAS u32x2*)(scr + (16 * i + fr) * 32 + fq * 8) = (u32x2){pk_bf16(0.60653065971f * sigmoidf_(le[i][0] + c_w0[i]), 0.60653065971f * sigmoidf_(le[i][1] + c_w0[i])), pk_bf16(0.60653065971f * sigmoidf_(le[i][2] + c_w0[i]), 0.60653065971f * sigmoidf_(le[i][3] + c_w0[i]))};
                            *(LAS u32x2*)(scr + 2048 + (16 * i + fr) * 32 + fq * 8) = (u32x2){pk_bf16(sigmoidf_(la[i][0] + c_a0[i]), sigmoidf_(la[i][1] + c_a0[i])), pk_bf16(sigmoidf_(la[i][2] + c_a0[i]), sigmoidf_(la[i][3] + c_a0[i]))};
                        }
                    asm volatile("s_waitcnt lgkmcnt(0)" ::: "memory");
#pragma unroll
                    for (int q = 0; q < 2; ++q) { const u32x4 we = *(const LAS u32x4*)(scr + lane * 32 + q * 16), wa = *(const LAS u32x4*)(scr + 2048 + lane * 32 + q * 16);
#pragma unroll
                        for (int e = 0; e < 4; ++e) { eeq[4 * q + e] = we[e]; aaq[4 * q + e] = wa[e]; } }
                    asm volatile("s_waitcnt lgkmcnt(0)" ::: "memory");
                }
                unsigned tch[7];
                {   const int tbn = ((int)mrow0 + (g + 1 < SEQ / 128 ? g + 1 : g) * 128 + wave * 16) >> 4;
                    tch[0] = __builtin_amdgcn_raw_buffer_load_b32(rs_raw, vol + 3072 * 32, tbn * (RAWLD * 32), 0); tch[1] = __builtin_amdgcn_raw_buffer_load_b32(rs_raw, vol + 3136 * 32, tbn * (RAWLD * 32), 0);
                    tch[2] = __builtin_amdgcn_raw_buffer_load_b32(rs_raw, vol + 3200 * 32, tbn * (RAWLD * 32), 0); tch[3] = __builtin_amdgcn_raw_buffer_load_b32(rs_raw, voh, tbn * (RAWLD * 32), 0);
                    tch[4] = __builtin_amdgcn_raw_buffer_load_b32(rs_raw, voh + 1024 * 32, tbn * (RAWLD * 32), 0); tch[5] = __builtin_amdgcn_raw_buffer_load_b32(rs_raw, voh + 2048 * 32, tbn * (RAWLD * 32), 0);
                    tch[6] = __builtin_amdgcn_raw_buffer_load_b32(rs_vf, voh, tbn * (D * 32), 0); }
                {
                    __builtin_amdgcn_sched_barrier(0);
#pragma unroll
                    for (int q = 0; q < 2; ++q) { const u32x4 r4 = LDQ(voh, q, tb), k4 = LDQ(voh + 1024 * 32, q, tb);
#pragma unroll
                        for (int e = 0; e < 4; ++e) { rrq[4 * q + e] = r4[e]; krq[4 * q + e] = k4[e]; } }
                    __builtin_amdgcn_sched_barrier(0);
                    if (L > 0) {
                        unsigned xp[8];
#pragma unroll
                        for (int i = 0; i < 8; ++i) { const unsigned xs = (i == 0) ? ((unsigned)xprev | (xrq[0] << 16)) : __builtin_amdgcn_alignbit(xrq[i], xrq[i > 0 ? i - 1 : 0], 16);
                            xp[i] = (lane < 32) ? xrq[i] : xs; }
                        wr_row(scr, lane, xp);
                        asm volatile("s_waitcnt lgkmcnt(0)" ::: "memory");
                        f32x4 mx[4];
#pragma unroll
                        for (int i = 0; i < 4; ++i) mx[i] = (f32x4){0.f, 0.f, 0.f, 0.f};
#pragma unroll
                        for (int s2 = 0; s2 < 2; ++s2) { const bf16x8 fx = mk_frag(tr4(scr, 32 * s2 + 8 * fq, lane), tr4(scr, 32 * s2 + 8 * fq + 4, lane));
#pragma unroll
                            for (int i = 0; i < 4; ++i) mx[i] = __builtin_amdgcn_mfma_f32_16x16x32_bf16(fx, *(const LAS bf16x8*)(lds + C2_V2S + (16 * i + fr) * 128 + (32 * s2 + 8 * fq) * 2), mx[i], 0, 0, 0); }
#pragma unroll
                        for (int i = 0; i < 4; ++i)
                            *(LAS u32x2*)(scr + (16 * i + fr) * 32 + fq * 8) = (u32x2){pk_bf16(sigmoidf_(mx[i][0] + c_v0[i]), sigmoidf_(mx[i][1] + c_v0[i])), pk_bf16(sigmoidf_(mx[i][2] + c_v0[i]), sigmoidf_(mx[i][3] + c_v0[i]))};
                        asm volatile("s_waitcnt lgkmcnt(0)" ::: "memory");
                    }
                    if (L > 0) {
                        const u32x4 mw0 = *(const LAS u32x4*)(scr + lane * 32), mw1 = *(const LAS u32x4*)(scr + lane * 32 + 16);
#pragma unroll
                        for (int t = 0; t < 16; t += 2) {
                            const float v0_ = QP(vrq, vprev, t), v1_ = QP(vrq, vprev, t + 1), v2_ = QP(vrq, vprev, t + 2), vs0 = v1_ + c_muv * (v0_ - v1_), vs1 = v2_ + c_muv * (v1_ - v2_);
                            const unsigned mwp = (t < 8) ? mw0[t >> 1] : mw1[(t - 8) >> 1];
                            const float mix0 = bf_lo(mwp), mix1 = bf_hi(mwp);
                            vvp[t >> 1] = pk_bf16(vs0 + (QF(mixq, t) - vs0) * mix0, vs1 + (QF(mixq, t + 1) - vs1) * mix1);
                        }
                    } else {
#pragma unroll
                        for (int t = 0; t < 16; t += 2) {
                            const float v0_ = QP(vrq, vprev, t), v1_ = QP(vrq, vprev, t + 1), v2_ = QP(vrq, vprev, t + 2);
                            vvp[t >> 1] = pk_bf16(v1_ + c_muv * (v0_ - v1_), v2_ + c_muv * (v1_ - v2_));
                        }
#pragma unroll
                        for (int q = 0; q < 2; ++q) __builtin_amdgcn_raw_buffer_store_b128(__builtin_bit_cast(decltype(__builtin_amdgcn_raw_buffer_load_b128(rs_vf, 0, 0, 0)), (u32x4){vvp[4 * q], vvp[4 * q + 1], vvp[4 * q + 2], vvp[4 * q + 3]}), rs_vf, voh + q * 16, tb * (D * 32), 0);
                    }
                    asm volatile("s_waitcnt lgkmcnt(0)" ::: "memory");
                }
                float rprev = 0.f, kprev = 0.f;
                {
                    const float rp_g = bf1(LDP(voh, tbp)), kp_g = bf1(LDP(voh + 1024 * 32, tbp));
                    rprev = (wave > 0 || g > 0) ? rp_g : 0.f; kprev = (wave > 0 || g > 0) ? kp_g : 0.f;
                }
                const float rprev0 = rprev, kprev0 = kprev;
                float sql = 0.f, pbl = 0.f; unsigned sqp[4], pbp[4];
#pragma unroll
                for (int t = 0; t < 16; ++t) {
                    const float r_c = QF(rrq, t), k_c = QF(krq, t);
                    const float rs = r_c + c_mur * (rprev - r_c), ks = k_c + c_muk * (kprev - k_c); rprev = r_c; kprev = k_c;
                    const float al = QF(aaq, t), kmod = ks * (1.0f + (al - 1.0f) * c_ka), kkv = ks * c_kk;
                    if (t & 1) { sqp[(t >> 1) & 3] = pk_bf16(sql, kkv * kkv); pbp[(t >> 1) & 3] = pk_bf16(pbl, rs * kmod * c_rk); }
                    if ((t & 7) == 7) { *(LAS u32x4*)(scr + lane * 32 + (t >> 3) * 16) = (u32x4){sqp[0], sqp[1], sqp[2], sqp[3]}; *(LAS u32x4*)(scr + 2048 + lane * 32 + (t >> 3) * 16) = (u32x4){pbp[0], pbp[1], pbp[2], pbp[3]}; }
                    else { sql = kkv * kkv; pbl = rs * kmod * c_rk; }
                }
                asm volatile("s_waitcnt lgkmcnt(0)" ::: "memory");
                {
                    f32x4 sn = (f32x4){0.f, 0.f, 0.f, 0.f}, sb = sn;
                    const bf16x8 ones = __builtin_bit_cast(bf16x8, (u32x4){0x3f803f80u, 0x3f803f80u, 0x3f803f80u, 0x3f803f80u});
#pragma unroll
                    for (int s2 = 0; s2 < 2; ++s2) { const int k0 = 32 * s2 + 8 * fq;
                        sn = __builtin_amdgcn_mfma_f32_16x16x32_bf16(mk_frag(tr4(scr, k0, lane), tr4(scr, k0 + 4, lane)), ones, sn, 0, 0, 0);
                        sb = __builtin_amdgcn_mfma_f32_16x16x32_bf16(mk_frag(tr4(scr + 2048, k0, lane), tr4(scr + 2048, k0 + 4, lane)), ones, sb, 0, 0, 0); }
                    if (fr == 0) { *(LAS f32x4*)(cb + C2_BON + 64 + fq * 16) = sn; *(LAS f32x4*)(cb + C2_BON + fq * 16) = sb; }
                }
                asm volatile("s_waitcnt lgkmcnt(0)" ::: "memory");
                f32x4 n2v[4];
#pragma unroll
                for (int i = 0; i < 4; ++i) n2v[i] = *(const LAS f32x4*)(cb + C2_BON + 64 + i * 16);
#pragma unroll
                for (int i = 0; i < 7; ++i) asm volatile("" :: "v"(tch[i]));
                float lg = 0.f, gcarry = 1.0f;
                unsigned atp[4], rtp[4]; unsigned bkp[16];
                float btl = 0.f, ktl = 0.f, atl = 0.f, rtl = 0.f;
                rprev = rprev0; kprev = kprev0;
#pragma unroll
                for (int t = 0; t < 16; ++t) {
                    const float r_c = QF(rrq, t), k_c = QF(krq, t);
                    const float rs = r_c + c_mur * (rprev - r_c), ks = k_c + c_muk * (kprev - k_c); rprev = r_c; kprev = k_c;
                    const float al = QF(aaq, t), kmod = ks * (1.0f + (al - 1.0f) * c_ka), kkv = ks * c_kk;
                    const float kkn = kkv * __builtin_amdgcn_rsqf(fmaxf(n2v[t >> 2][t & 3], 1e-24f));
                    const float gprev = gcarry; lg -= QF(eeq, t);
                    const float gcur = __expf(lg), ginv = __builtin_amdgcn_rcpf(gcur); gcarry = gcur;
                    const float at = -kkn * gprev, rt = rs * gcur, bt = kkn * al * ginv, kt = kmod * ginv;
                    if (t & 1) {
                        atp[(t >> 1) & 3] = pk_bf16(atl, at); rtp[(t >> 1) & 3] = pk_bf16(rtl, rt); bkp[t >> 1] = pk_bf16(btl, bt); bkp[8 + (t >> 1)] = pk_bf16(ktl, kt);
                        if ((t & 7) == 7) { *(LAS u32x4*)(cb + C2_AT + lane * 32 + (t >> 3) * 16) = (u32x4){atp[0], atp[1], atp[2], atp[3]}; *(LAS u32x4*)(cb + C2_RT + lane * 32 + (t >> 3) * 16) = (u32x4){rtp[0], rtp[1], rtp[2], rtp[3]}; }
                    } else { btl = bt; ktl = kt; atl = at; rtl = rt; }
                }
                *(LAS float*)(cb + C2_GTV + lane * 4) = __expf(lg);
#pragma unroll
                for (int q = 0; q < 4; ++q) *(LAS u32x4*)(cb + C2_BK + lane * 64 + q * 16) = (u32x4){bkp[2 * q], bkp[2 * q + 1], bkp[8 + 2 * q], bkp[8 + 2 * q + 1]};
#pragma unroll
                for (int q = 0; q < 2; ++q) *(LAS u32x4*)(cb + C2_VT + lane * 32 + q * 16) = (u32x4){vvp[4 * q], vvp[4 * q + 1], vvp[4 * q + 2], vvp[4 * q + 3]};
                asm volatile("s_waitcnt lgkmcnt(0)" ::: "memory");
                f32x4 nab = (f32x4){0.f, 0.f, 0.f, 0.f}, nabT = nab, nakT = nab, nrbT = nab, nrkT = nab;
#pragma unroll
                for (int s2 = 0; s2 < 2; ++s2) {
                    const int k0 = 32 * s2 + 8 * fq;
                    const bf16x8 fa = mk_frag(tr4(cb + C2_AT, k0, lane), tr4(cb + C2_AT, k0 + 4, lane)), fr_ = mk_frag(tr4(cb + C2_RT, k0, lane), tr4(cb + C2_RT, k0 + 4, lane));
                    const bf16x8 fb = mk_frag(tr4bk(cb + C2_BK, k0, lane), tr4bk(cb + C2_BK, k0 + 4, lane)), fk = mk_frag(tr4bk(cb + C2_BK + 8, k0, lane), tr4bk(cb + C2_BK + 8, k0 + 4, lane));
                    nab = __builtin_amdgcn_mfma_f32_16x16x32_bf16(fa, fb, nab, 0, 0, 0); nabT = __builtin_amdgcn_mfma_f32_16x16x32_bf16(fb, fa, nabT, 0, 0, 0);
                    nakT = __builtin_amdgcn_mfma_f32_16x16x32_bf16(fk, fa, nakT, 0, 0, 0);
                    nrbT = __builtin_amdgcn_mfma_f32_16x16x32_bf16(fb, fr_, nrbT, 0, 0, 0); nrkT = __builtin_amdgcn_mfma_f32_16x16x32_bf16(fk, fr_, nrkT, 0, 0, 0);
                }
                const u32x2 z2 = (u32x2){0u, 0u};
                f32x4 dg;
#pragma unroll
                for (int r = 0; r < 4; ++r) {
                    const int c = 4 * fq + r;
                    dg[r] = (c == fr) ? 1.f : 0.f;
                    nakT[r] = (c < fr) ? nakT[r] : 0.f; nabT[r] = (c < fr) ? nabT[r] : 0.f; nab[r] = (fr < c) ? nab[r] : 0.f;
                    nrbT[r] = (c <= fr) ? nrbT[r] : 0.f; nrkT[r] = (c <= fr) ? nrkT[r] : 0.f;
                }
                *(LAS u32x2*)(cb + C2_NAK + fr * 32 + fq * 8) = pk4(nakT);
                { const u32x2 wb = pk4(nrbT), wk = pk4(nrkT); *(LAS u32x4*)(cb + C2_NRBK + fr * 64 + fq * 16) = (u32x4){wb.x, wb.y, wk.x, wk.y}; }
#define FRG(X) mk_frag(pk4(X), z2)
#define MM(X, Y) __builtin_amdgcn_mfma_f32_16x16x32_bf16(FRG(X), FRG(Y), (f32x4){0.f, 0.f, 0.f, 0.f}, 0, 0, 0)
                {
                    const f32x4 p2 = MM(nabT, nab), q2 = MM(nab, nabT);
                    const f32x4 p4 = MM(q2, p2), q4 = MM(p2, q2);
                    const f32x4 p8 = MM(q4, p4);
                    const f32x4 m1 = MM(nabT + dg, p2 + dg);
                    const f32x4 m2t = MM(p8 + dg, q4 + dg);
                    const f32x4 mt = MM(m1, m2t);
                    *(LAS u32x2*)(cb + C2_MT + fr * 32 + fq * 8) = pk4(mt);
                }
#undef FRG
#undef MM
            }
            __syncthreads();
            if (wave < 4) {
                const int vrow = 16 * wave + fr;
                const u32x2 z2 = (u32x2){0u, 0u};
#define CH_DECL(P) u32x2 P##nak, P##mt, P##vq; bf16x8 P##fa0, P##fa1, P##fr0, P##fr1, P##nrbk, P##bk0, P##bk1, P##bk2, P##bk3; f32x4 P##g0, P##g1, P##g2, P##g3;
#define CH_LOAD(P, c_) do { const LAS unsigned char* cb = lds + (c_) * C2_CH; \
                    P##vq = *(const LAS u32x2*)(cb + C2_VT + vrow * 32 + fq * 8); P##nak = *(const LAS u32x2*)(cb + C2_NAK + fr * 32 + fq * 8); P##mt = *(const LAS u32x2*)(cb + C2_MT + fr * 32 + fq * 8); \
                    P##fa0 = mk_frag(tr4(cb + C2_AT, 4 * fq, lane), tr4(cb + C2_AT, 16 + 4 * fq, lane)); P##fa1 = mk_frag(tr4(cb + C2_AT, 32 + 4 * fq, lane), tr4(cb + C2_AT, 48 + 4 * fq, lane)); \
                    P##fr0 = mk_frag(tr4(cb + C2_RT, 4 * fq, lane), tr4(cb + C2_RT, 16 + 4 * fq, lane)); P##fr1 = mk_frag(tr4(cb + C2_RT, 32 + 4 * fq, lane), tr4(cb + C2_RT, 48 + 4 * fq, lane)); \
                    P##nrbk = *(const LAS bf16x8*)(cb + C2_NRBK + fr * 64 + fq * 16); \
                    P##bk0 = *(const LAS bf16x8*)(cb + C2_BK + (fr) * 64 + fq * 16); P##bk1 = *(const LAS bf16x8*)(cb + C2_BK + (16 + fr) * 64 + fq * 16); \
                    P##bk2 = *(const LAS bf16x8*)(cb + C2_BK + (32 + fr) * 64 + fq * 16); P##bk3 = *(const LAS bf16x8*)(cb + C2_BK + (48 + fr) * 64 + fq * 16); \
                    P##g0 = *(const LAS f32x4*)(cb + C2_GTV + (4 * fq) * 4); P##g1 = *(const LAS f32x4*)(cb + C2_GTV + (16 + 4 * fq) * 4); \
                    P##g2 = *(const LAS f32x4*)(cb + C2_GTV + (32 + 4 * fq) * 4); P##g3 = *(const LAS f32x4*)(cb + C2_GTV + (48 + 4 * fq) * 4); } while (0)
#define CH_STEP(P, c_) do { \
                    const bf16x8 bs0 = mk_frag(pk4(St[0]), pk4(St[1])), bs1 = mk_frag(pk4(St[2]), pk4(St[3]));     \
                    f32x4 acc = (f32x4){0.f, 0.f, 0.f, 0.f}, y = acc, u = acc; \
                    acc = __builtin_amdgcn_mfma_f32_16x16x32_bf16(mk_frag(P##nak, z2), mk_frag(P##vq, z2), acc, 0, 0, 0); \
                    acc = __builtin_amdgcn_mfma_f32_16x16x32_bf16(P##fa0, bs0, acc, 0, 0, 0); \
                    acc = __builtin_amdgcn_mfma_f32_16x16x32_bf16(P##fa1, bs1, acc, 0, 0, 0); \
                    y = __builtin_amdgcn_mfma_f32_16x16x32_bf16(P##fr0, bs0, y, 0, 0, 0); \
                    y = __builtin_amdgcn_mfma_f32_16x16x32_bf16(P##fr1, bs1, y, 0, 0, 0); \
                    u = __builtin_amdgcn_mfma_f32_16x16x32_bf16(mk_frag(P##mt, z2), mk_frag(pk4(acc), z2), u, 0, 0, 0); \
                    const bf16x8 buv = mk_frag(pk4(u), P##vq); \
                    St[0] = __builtin_amdgcn_mfma_f32_16x16x32_bf16(P##bk0, buv, St[0], 0, 0, 0); St[1] = __builtin_amdgcn_mfma_f32_16x16x32_bf16(P##bk1, buv, St[1], 0, 0, 0); \
                    St[2] = __builtin_amdgcn_mfma_f32_16x16x32_bf16(P##bk2, buv, St[2], 0, 0, 0); St[3] = __builtin_amdgcn_mfma_f32_16x16x32_bf16(P##bk3, buv, St[3], 0, 0, 0); \
                    y = __builtin_amdgcn_mfma_f32_16x16x32_bf16(P##nrbk, buv, y, 0, 0, 0); \
                    St[0] = St[0] * P##g0; St[1] = St[1] * P##g1; St[2] = St[2] * P##g2; St[3] = St[3] * P##g3; \
                    _Pragma("unroll") for (int r = 0; r < 4; ++r) *(LAS float*)(lds + C2_YS + (size_t)(((c_) * 16 + 4 * fq + r) * 64 + vrow) * 4) = y[r]; \
                    if (lane == 0) asm volatile("ds_add_u32 %0, %1" :: "v"((unsigned)(size_t)(lds + C2_PREV + (c_) * 4)), "v"(1u) : "memory");     } while (0)
                CH_DECL(A) CH_DECL(B)
                CH_LOAD(A, 0);
                for (int c = 0; c < 8; c += 2) {
                    CH_LOAD(B, c + 1);
                    CH_STEP(A, c);
                    if (c + 2 < 8) CH_LOAD(A, c + 2);
                    CH_STEP(B, c + 1);
                }
#undef CH_DECL
#undef CH_LOAD
#undef CH_STEP
            } else {
                int lane_p = lane; asm volatile("" : "+v"(lane_p));
                const int pj = lane_p & 3;
                f32x4 lw[4], lb[4];
#pragma unroll
                for (int i = 0; i < 4; ++i) { lw[i] = *(const f32x4*)(F.ap->in[17] + (size_t)L * D + h * 64 + 16 * pj + 4 * i); lb[i] = *(const f32x4*)(F.ap->in[18] + (size_t)L * D + h * 64 + 16 * pj + 4 * i); }
                for (int cc = wave - 4; cc < 8; cc += 4) {
                    const LAS unsigned char* cb = lds + cc * C2_CH;
                    const int tl = lane_p >> 2, ptok = cc * 16 + tl;
                    while (*(volatile LAS unsigned*)(lds + C2_PREV + cc * 4) < 4u) __builtin_amdgcn_s_sleep(1);
                    f32x4 y4[4]; float sm = 0.f;
#pragma unroll
                    for (int i = 0; i < 4; ++i) { y4[i] = *(const volatile LAS f32x4*)(lds + C2_YS + (size_t)(ptok * 64 + 16 * pj + 4 * i) * 4); sm += (y4[i][0] + y4[i][1]) + (y4[i][2] + y4[i][3]); }
                    sm += dppf<0xB1>(sm); sm += dppf<0x4E>(sm);
                    const float mean = sm * (1.0f / 64.0f); float vs = 0.f;
#pragma unroll
                    for (int i = 0; i < 4; ++i) { y4[i] = y4[i] - mean; vs += (y4[i][0] * y4[i][0] + y4[i][1] * y4[i][1]) + (y4[i][2] * y4[i][2] + y4[i][3] * y4[i][3]); }
                    vs += dppf<0xB1>(vs); vs += dppf<0x4E>(vs);
                    const float rstd = __builtin_amdgcn_rsqf(vs * (1.0f / 64.0f) + LNX_EPS);
                    const float bon = *(const LAS float*)(cb + C2_BON + tl * 4);
                    unsigned ow[8];
#pragma unroll
                    for (int i = 0; i < 4; ++i) {
                        float z[4];
#pragma unroll
                        for (int e = 0; e < 4; ++e) { const float vvl = bf1(*(const LAS unsigned short*)(cb + C2_VT + (16 * pj + 4 * i + e) * 32 + tl * 2)); z[e] = y4[i][e] * rstd * lw[i][e] + lb[i][e] + bon * vvl; }
                        ow[2 * i] = pk_bf16(z[0], z[1]); ow[2 * i + 1] = pk_bf16(z[2], z[3]);
                    }
                    bf16_t* zp = F.S2 + (mrow0 + (size_t)g * 128 + ptok) * D + h * 64 + 16 * pj;
                    *(u32x4*)zp = (u32x4){ow[0], ow[1], ow[2], ow[3]}; *(u32x4*)(zp + 8) = (u32x4){ow[4], ow[5], ow[6], ow[7]};
                }
            }
            __syncthreads();
        }
    }
}

constexpr int LDS_BYTES = 163840;
constexpr int LDSCTL_OFF = 163776;
constexpr int PPL = 15;
constexpr int NPHASE = NLAYER * PPL + 1;

template <int PH> __device__ __forceinline__ void run_phase(Frame& F, int L) {
    using namespace pg8;
    { int t_ = threadIdx.x; asm volatile("" : "+v"(t_)); F.tid = t_; F.lane = t_ & 63; F.wave = __builtin_amdgcn_readfirstlane(t_ >> 6);
      int g_ = gridDim.x, b_ = blockIdx.x; asm volatile("" : "+s"(g_), "+s"(b_)); F.G = g_; F.bid = b_;
      ArgsP a_ = (ArgsP)__builtin_amdgcn_kernarg_segment_ptr(); asm volatile("" : "+s"(a_)); F.ap = a_; F.X = a_->out; set_ws(F, a_->ws); }
    if constexpr (PH == 0) {
        convert_weights(F, L);
        if (L == 0) rmsnorm_rows(F, F.ap->in[0], F.ap->in[1], F.S1, (bf16_t*)F.X);
        else rmsnorm_rows_bf(F, (const bf16_t*)F.X, F.ap->in[1] + (size_t)L * D, F.S1);
    } else if constexpr (PH == 1) {
        Gemm g{F.WinT + (size_t)R_RKV * D, F.S1, D, D, D, RAWLD / 256, M / 256, 0}; StaticOrder S; S.init(g.nM, g.nN, F.G, F.bid);
        EpiRawT E{F.RAW, RAWLD};
        gemm_phase(F.lds, g, S, E);
    } else if constexpr (PH == 2) {
    } else if constexpr (PH == 3) {
    } else if constexpr (PH == 4) {
        scan2_phase(F, L);
    } else if constexpr (PH == 5) {
    } else if constexpr (PH == 6) {
        Gemm g{F.S1, F.WinT, D, D, D, M / 256, 20, 0}; StaticOrder S; S.init(g.nM, g.nN, F.G, F.bid);
        EpiG<ACT_NONE, ACT_SILU, ACT_SILU, ACT_SIGMOID, ACT_SIGMOID> E{{F.RAW, D, nullptr, nullptr, nullptr, 0, nullptr, 0}, {F.RAWB, D, nullptr, nullptr, nullptr, 0, nullptr, 0}, 1024, {F.S2, D, nullptr, nullptr, F.S2, D, nullptr, 0}, 2048,
            {F.S3, D, nullptr, nullptr, nullptr, 0, nullptr, 0}, 3072, {F.RAW + (size_t)2 * M * D, D, nullptr, nullptr, nullptr, 0, nullptr, 0}, 4096};
        gemm_phase(F.lds, g, S, E);
    } else if constexpr (PH == 7) {
        Gemm g{F.S2, F.WrpT, D, D, D, M / 256, 4, 0}; StaticOrder S; S.init(g.nM, g.nN, F.G, F.bid);
        EpiG<ACT_NONE, ACT_NONE> E{{F.S3, D, nullptr, nullptr, F.S3, D, nullptr, 0}, {}, 1 << 30};
        gemm_phase(F.lds, g, S, E);
    } else if constexpr (PH == 8) {
    } else if constexpr (PH == 9) {
    } else if constexpr (PH == 10) {
        poold_phase(F, F.RAW, F.RAWB, F.ap->in[4] + (size_t)L * D);
    } else if constexpr (PH == 11) {
    } else if constexpr (PH == 12) {
        Gemm g{F.RAWB, F.WppT, D, D, D, M / 256, 4, 0}; StaticOrder S; S.init(g.nM, g.nN, F.G, F.bid);
        EpiG<ACT_NONE, ACT_NONE> E{{F.RAW, D, nullptr, nullptr, F.RAW + (size_t)2 * M * D, D, F.S3, D}, {}, 1 << 30};
        gemm_phase(F.lds, g, S, E);
    } else if constexpr (PH == 13) {
    } else if constexpr (PH == 14) {
        Gemm g{F.RAW, F.WoutT, D, D, D, M / 256, 4, 0}; StaticOrder S; S.init(g.nM, g.nN, F.G, F.bid);
        EpiG<ACT_NONE, ACT_NONE> E{{L == NLAYER - 1 ? F.S2 : (bf16_t*)F.X, D, nullptr, nullptr, nullptr, 0, (const bf16_t*)F.X, D}, {}, 1 << 30};
        gemm_phase(F.lds, g, S, E);
    } else {
        final_norm(F, F.S2);
    }
}
__device__ __forceinline__ void frame_init(Frame& F, unsigned char* lds_raw) {
    F.lds = (LAS unsigned char*)lds_raw;
    F.tid = threadIdx.x; F.lane = F.tid & 63; F.wave = __builtin_amdgcn_readfirstlane(F.tid >> 6); F.G = gridDim.x; F.bid = blockIdx.x;
    F.ap = (ArgsP)__builtin_amdgcn_kernarg_segment_ptr();
    F.X = F.ap->out;
    set_ws(F, F.ap->ws);
}
#ifndef PROBE_STAGE
#define PROBE_STAGE -1
#endif
#if MK_PER_PHASE
__global__ void __launch_bounds__(512, 2) mk_dump(Args args, size_t ws_off, int ld, int rowmask) {
    const bf16_t* src = (const bf16_t*)(args.ws + ws_off);
    for (size_t it = (size_t)blockIdx.x * 512 + threadIdx.x; it < (size_t)M * 512; it += (size_t)gridDim.x * 512) {
        const size_t m = it >> 9; const int c = (int)(it & 511) * 2; const unsigned w = *(const unsigned*)(src + (m & (size_t)rowmask) * ld + (ld == 256 ? (c & 255) : c));
        args.out[m * D + c] = 1000.f * bf_lo(w); args.out[m * D + c + 1] = 1000.f * bf_hi(w);
    }
}
template <int PH> __global__ void __launch_bounds__(512, 2) mk_phase(Args args) {
    extern __shared__ __attribute__((aligned(16))) unsigned char lds_raw[];
    Frame F; frame_init(F, lds_raw);
    run_phase<PH>(F, F.ap->ph_lo);
}
#else
__global__ void __launch_bounds__(512, 2) mk_fwd(Args args) {
    extern __shared__ __attribute__((aligned(16))) unsigned char lds_raw[];
    Frame F; frame_init(F, lds_raw);
    volatile LAS unsigned* ctlw = (volatile LAS unsigned*)(F.lds + LDSCTL_OFF);
    if (F.tid < 16) ctlw[F.tid] = 0u;
    __syncthreads();
    XcdBarrier bar = xcd_barrier_post((unsigned*)(F.ws + WS_CTL), ctlw);
    for (int L = 0; L < NLAYER; ++L) {
        run_phase<0>(F, L); xcd_barrier(bar);
        run_phase<1>(F, L); xcd_barrier(bar);
        run_phase<4>(F, L); xcd_barrier(bar);
        run_phase<6>(F, L); xcd_barrier(bar);
        run_phase<7>(F, L); xcd_barrier(bar);
        run_phase<10>(F, L); xcd_barrier(bar);
        run_phase<12>(F, L); xcd_barrier(bar);
        run_phase<14>(F, L); xcd_barrier(bar);
    }
    run_phase<15>(F, 0);
}
#endif

#if MK_PER_PHASE
template <int PH> static void launch_phase(int grid, hipStream_t stream, Args a, int L) { if (PH == 2 || PH == 3 || PH == 5 || PH == 11) return; a.ph_lo = L; a.ph_hi = PH; hipLaunchKernelGGL(mk_phase<PH>, dim3(grid), dim3(512), LDS_BYTES, stream, a); }
template <int PH> static bool set_lds() { return hipFuncSetAttribute((const void*)mk_phase<PH>, hipFuncAttributeMaxDynamicSharedMemorySize, LDS_BYTES) == hipSuccess; }
#endif
extern "C" void kernel_launch(void* const* d_in, const int* in_sizes, int n_in, void* d_out, int out_size, void* d_ws, size_t ws_size, hipStream_t stream) {
    static int grid = 0;
    if (grid == 0) {
        if (n_in != 22 || in_sizes[0] != M * D || out_size != M * D || ws_size < WS_END) { fprintf(stderr, "kernel_launch: unexpected shapes / workspace (%d inputs, ws %zu)\n", n_in, ws_size); grid = -1; return; }
        int dev = 0, cus = 0;
        if (hipGetDevice(&dev) != hipSuccess || hipDeviceGetAttribute(&cus, hipDeviceAttributeMultiprocessorCount, dev) != hipSuccess) { grid = -1; return; }
#if MK_PER_PHASE
        bool ok = set_lds<0>() && set_lds<1>() && set_lds<2>() && set_lds<3>() && set_lds<4>() && set_lds<5>() && set_lds<6>() && set_lds<7>() && set_lds<8>() && set_lds<9>() && set_lds<10>() && set_lds<11>()
               && set_lds<12>() && set_lds<13>() && set_lds<14>() && set_lds<15>();
        if (!ok) { fprintf(stderr, "kernel_launch: hipFuncSetAttribute failed\n"); grid = -1; return; }
#else
        int per_cu = 0;
        if (hipFuncSetAttribute((const void*)mk_fwd, hipFuncAttributeMaxDynamicSharedMemorySize, LDS_BYTES) != hipSuccess) { fprintf(stderr, "kernel_launch: hipFuncSetAttribute failed\n"); grid = -1; return; }
        if (hipOccupancyMaxActiveBlocksPerMultiprocessor(&per_cu, (const void*)mk_fwd, 512, LDS_BYTES) != hipSuccess || per_cu < 1) { fprintf(stderr, "kernel_launch: occupancy query says %d\n", per_cu); }
#endif
        (void)hipGetLastError();
        grid = cus;
    }
    if (grid < 0) return;
    Args a{};
    for (int i = 0; i < 22; ++i) a.in[i] = (const float*)d_in[i];
    a.out = (float*)d_out; a.ws = (unsigned char*)d_ws;
#if MK_PER_PHASE
    if (PROBE_STAGE >= 0) {
        const int L = 0;
        launch_phase<0>(grid, stream, a, L); launch_phase<1>(grid, stream, a, L);
        if (PROBE_STAGE >= 2) launch_phase<2>(grid, stream, a, L);
        if (PROBE_STAGE >= 3) launch_phase<3>(grid, stream, a, L);
        if (PROBE_STAGE >= 4) launch_phase<4>(grid, stream, a, L);
        if (PROBE_STAGE >= 5) launch_phase<5>(grid, stream, a, L);
        if (PROBE_STAGE >= 6) launch_phase<6>(grid, stream, a, L);
        if (PROBE_STAGE >= 7) launch_phase<7>(grid, stream, a, L);
        if (PROBE_STAGE >= 8) launch_phase<8>(grid, stream, a, L);
        if (PROBE_STAGE >= 9) launch_phase<9>(grid, stream, a, L);
        if (PROBE_STAGE >= 10) launch_phase<10>(grid, stream, a, L);
        if (PROBE_STAGE >= 11) launch_phase<11>(grid, stream, a, L);
        if (PROBE_STAGE >= 12) launch_phase<12>(grid, stream, a, L);
        if (PROBE_STAGE >= 13) launch_phase<13>(grid, stream, a, L);
        size_t off = WS_RAW; int ld = RAWLD; int rowmask = 0x7fffffff;
        if (PROBE_STAGE == 2) { off = WS_VFIRST; ld = D; }
        if (PROBE_STAGE == 3) { off = WS_S1; ld = D; }
        if (PROBE_STAGE == 5) { off = WS_S1; ld = D; }
#if defined(PROBE_ALT) || defined(PROBE_SWAP)
        if (PROBE_STAGE == 3) { off = WS_S2; ld = D; }
        if (PROBE_STAGE == 2) { off = WS_EAT; ld = 256; rowmask = 2047; }
        if (PROBE_STAGE == 1) { off = WS_RAW + 4608; ld = RAWLD; }
#endif
        if (PROBE_STAGE == 6) { off = WS_S2; ld = D; }
        if (PROBE_STAGE == 7 || PROBE_STAGE == 8) { off = WS_S3; ld = D; }
        if (PROBE_STAGE == 9) { off = WS_S2; ld = D; }
        if (PROBE_STAGE == 10) { off = WS_RAWB; ld = D; }
        if (PROBE_STAGE == 11) { off = WS_S2; ld = D; }
        if (PROBE_STAGE == 12 || PROBE_STAGE == 13) { off = WS_RAW; ld = D; }
        hipLaunchKernelGGL(mk_dump, dim3(grid), dim3(512), 0, stream, a, off, ld, rowmask);
        return;
    }
    for (int L = 0; L < NLAYER; ++L) {
        launch_phase<0>(grid, stream, a, L); launch_phase<1>(grid, stream, a, L); launch_phase<2>(grid, stream, a, L); launch_phase<3>(grid, stream, a, L);
        launch_phase<4>(grid, stream, a, L); launch_phase<5>(grid, stream, a, L); launch_phase<6>(grid, stream, a, L); launch_phase<7>(grid, stream, a, L);
        launch_phase<8>(grid, stream, a, L); launch_phase<9>(grid, stream, a, L); launch_phase<10>(grid, stream, a, L); launch_phase<11>(grid, stream, a, L);
        launch_phase<12>(grid, stream, a, L); launch_phase<13>(grid, stream, a, L); launch_phase<14>(grid, stream, a, L);
    }
    launch_phase<15>(grid, stream, a, 0);
#else
    (void)hipMemsetAsync((char*)d_ws + WS_CTL, 0, CTL_ZERO_BYTES, stream);
    a.ph_lo = 0; a.ph_hi = 0;
    hipLaunchKernelGGL(mk_fwd, dim3(grid), dim3(512), LDS_BYTES, stream, a);
#endif
}
```

```cpp
#include <hip/hip_runtime.h>
#include <cstdio>
#include <cstdint>

#define LAS __attribute__((address_space(3)))
typedef unsigned short bf16_t;
typedef short bf16x8 __attribute__((ext_vector_type(8)));
typedef float f32x4 __attribute__((ext_vector_type(4)));
typedef float f32x2 __attribute__((ext_vector_type(2)));
typedef unsigned u32x4 __attribute__((ext_vector_type(4)));
typedef unsigned u32x2 __attribute__((ext_vector_type(2)));

#define SCAN_DUP 0
#ifndef SCAN_DUP
#define SCAN_DUP 0
#endif
#ifndef MK_PER_PHASE
#define MK_PER_PHASE 0
#endif

constexpr int M = 32768, D = 1024, SEQ = 2048, NLAYER = 4, INW = 8320, NHEAD = 16;
constexpr int RAWLD = 3328;
constexpr float NORM_EPS = 1e-6f, LNX_EPS = 64e-5f;

constexpr size_t MiB = 1u << 20;
constexpr size_t WS_CTL = 0, CTL_ZERO_BYTES = 16384;
constexpr size_t WS_WINT = 1 * MiB;
constexpr size_t WS_WPP = WS_WINT + (size_t)(INW + 128) * D * 2;
constexpr size_t WS_WRP = WS_WPP + 2 * MiB;
constexpr size_t WS_WOUT = WS_WRP + 2 * MiB;
constexpr size_t WS_LINT = WS_WOUT + 2 * MiB;
constexpr size_t WS_EAT = WS_LINT + MiB / 2;
constexpr size_t WS_VFIRST = 25 * MiB;
constexpr size_t WS_RAW = 89 * MiB;
constexpr size_t WS_RAWB = 153 * MiB;
constexpr size_t WS_S1 = 297 * MiB, WS_S2 = 361 * MiB, WS_S3 = 425 * MiB;
constexpr size_t WS_TW = 489 * MiB;
constexpr size_t WS_END = 505 * MiB;
static_assert(WS_EAT + MiB <= WS_VFIRST, "weights fit");
constexpr int R_RGATE = 2048, R_GRWKV = 3072, R_GPOOL = 4096, R_RKV = 5120, R_FOLD = 8320;

#define XB_TMO      128
#define XB_XCNT(j)  (256  + 64 * (j))
#define XB_XSUB(j)  (1280 + 64 * (j))
#define XB_XGEN(j)  (2304 + 64 * (j))
#define XB_TOP      3328
#define XB_TOPGEN   3392
#define XCD_BAR_WORDS 3456
#define XB_SPIN_CAP (1u << 18)

__device__ __forceinline__ unsigned xb_ld(unsigned* p)              { return __hip_atomic_load(p, __ATOMIC_RELAXED, __HIP_MEMORY_SCOPE_AGENT); }
__device__ __forceinline__ unsigned xb_add(unsigned* p, unsigned v) { return __hip_atomic_fetch_add(p, v, __ATOMIC_RELAXED, __HIP_MEMORY_SCOPE_AGENT); }
__device__ __forceinline__ unsigned xb_xcc_id() { return (unsigned)__builtin_amdgcn_s_getreg((3 << 11) | 20) & 0xFu; }
#define XB_SPIN(cond, bar) do { unsigned _sp = 0; while (cond) { __builtin_amdgcn_s_sleep(1); \
    if ((++_sp & 255u) == 0u) { if (xb_ld(&(bar)[XB_TMO])) break; if (_sp > XB_SPIN_CAP) { atomicAdd(&(bar)[XB_TMO], 1u); break; } } } } while (0)

struct XcdBarrier { unsigned* bar; unsigned x; volatile LAS unsigned* st; };

__device__ __forceinline__ XcdBarrier xcd_barrier_post(unsigned* bar, volatile LAS unsigned* st) {
    XcdBarrier b; b.bar = bar; b.x = xb_xcc_id(); b.st = st;
    if (threadIdx.x == 0) (void)xb_add(&bar[XB_XCNT(b.x)], 1u);
    return b;
}
__device__ __forceinline__ void xcd_barrier_complete(unsigned* bar, unsigned x, unsigned& nloc, unsigned& nx) {
    const unsigned G = gridDim.x * gridDim.y * gridDim.z;
    unsigned sum, cnt, mine, sp = 0u;
    for (;;) {
        sum = 0u; cnt = 0u; mine = 0u;
#pragma unroll
        for (unsigned j = 0; j < 16; ++j) { const unsigned c = xb_ld(&bar[XB_XCNT(j)]); sum += c; cnt += (c > 0u) ? 1u : 0u; }
        if (sum == G) { mine = xb_ld(&bar[XB_XCNT(x)]); break; }
        __builtin_amdgcn_s_sleep(1);
        if ((++sp & 255u) == 0u) { if (xb_ld(&bar[XB_TMO])) { mine = xb_ld(&bar[XB_XCNT(x)]); break; } if (sp > XB_SPIN_CAP) { atomicAdd(&bar[XB_TMO], 1u); mine = xb_ld(&bar[XB_XCNT(x)]); break; } }
    }
    nloc = mine > 0u ? mine : 1u; nx = cnt > 0u ? cnt : 1u;
}
__device__ __forceinline__ void xcd_barrier(const XcdBarrier& b) {
    asm volatile("s_waitcnt vmcnt(0)" ::: "memory");
    __syncthreads();
    if (threadIdx.x == 0) {
        unsigned* bar = b.bar; asm volatile("" : "+s"(bar));
        __builtin_amdgcn_s_waitcnt(0);
        unsigned nloc = b.st[0], nx = b.st[1];
        if (nloc == 0u) { xcd_barrier_complete(bar, b.x, nloc, nx); b.st[0] = nloc; b.st[1] = nx; }
        const unsigned old = xb_add(&bar[XB_XSUB(b.x)], 1u);
        const unsigned gen = old / nloc;
        if (old + 1u == (gen + 1u) * nloc) {
            __builtin_amdgcn_fence(__ATOMIC_RELEASE, "agent");
            asm volatile("s_waitcnt vmcnt(0)" ::: "memory");
            const unsigned og = xb_add(&bar[XB_TOP], 1u);
            const unsigned tg = og / nx;
            if (og + 1u == (tg + 1u) * nx) xb_add(&bar[XB_TOPGEN], 1u);
            else XB_SPIN(xb_ld(&bar[XB_TOPGEN]) == tg, bar);
            __builtin_amdgcn_fence(__ATOMIC_ACQUIRE, "agent");
            xb_add(&bar[XB_XGEN(b.x)], 1u);
            asm volatile("s_waitcnt vmcnt(0)" ::: "memory");
        } else {
            XB_SPIN(xb_ld(&bar[XB_XGEN(b.x)]) == gen, bar);
            __builtin_amdgcn_fence(__ATOMIC_ACQUIRE, "agent");
            asm volatile("s_waitcnt vmcnt(0)" ::: "memory");
        }
    }
    __syncthreads();
}

typedef decltype(__builtin_amdgcn_make_buffer_rsrc((void*)nullptr, (short)0, 0, 0)) rsrc_t;
__device__ __forceinline__ rsrc_t wt_rsrc(const void* base) { return __builtin_amdgcn_make_buffer_rsrc((void*)base, 0, 0x7fffffff, 0x00020000); }
#define ST16_WT(rs, byteoff, v) __builtin_amdgcn_raw_buffer_store_b128(__builtin_bit_cast(decltype(__builtin_amdgcn_raw_buffer_load_b128(rs, 0, 0, 0)), (v)), rs, (int)(byteoff), 0, 16)
__device__ __forceinline__ float bf_lo(unsigned w) { return __uint_as_float(w << 16); }
__device__ __forceinline__ float bf_hi(unsigned w) { return __uint_as_float(w & 0xffff0000u); }
typedef __bf16 bf16x2_t __attribute__((ext_vector_type(2)));
__device__ __forceinline__ unsigned pk_bf16(float lo, float hi) { bf16x2_t v; v[0] = (__bf16)lo; v[1] = (__bf16)hi; return __builtin_bit_cast(unsigned, v); }
__device__ __forceinline__ unsigned short f2bf_s(float x) { return (unsigned short)(pk_bf16(x, 0.f) & 0xffffu); }
__device__ __forceinline__ float sigmoidf_(float x) { return __builtin_amdgcn_rcpf(1.0f + __expf(-x)); }
__device__ __forceinline__ float tanhf_(float x) { return 1.0f - 2.0f * __builtin_amdgcn_rcpf(1.0f + __expf(2.0f * x)); }
template <int CTRL> __device__ __forceinline__ float dppf(float x) { return __int_as_float(__builtin_amdgcn_update_dpp(0, __float_as_int(x), CTRL, 0xf, 0xf, true)); }
__device__ __forceinline__ float red8(float x) {
    x += dppf<0xB1>(x);
    x += dppf<0x4E>(x);
    x += dppf<0x141>(x);
    return x;
}
__device__ __forceinline__ float red16(float x) {
    x += dppf<0xB1>(x);
    x += dppf<0x4E>(x);
    x += dppf<0x141>(x);
    x += dppf<0x140>(x);
    return x;
}
__device__ __forceinline__ float red64(float x) {
    x = red16(x);
    return __int_as_float(__builtin_amdgcn_readlane(__float_as_int(x), 0)) + __int_as_float(__builtin_amdgcn_readlane(__float_as_int(x), 16)) +
           __int_as_float(__builtin_amdgcn_readlane(__float_as_int(x), 32)) + __int_as_float(__builtin_amdgcn_readlane(__float_as_int(x), 48));
}

namespace pg8 {
constexpr int BM = 256, BK = 64, HALF = 128, HTB = HALF * BK * 2, STAGE_BYTES = 8 * HTB, NXCD = 8, WGM = 8;
__host__ __device__ __forceinline__ int lds_byte(int r, int c) { const int st = (r >> 4) * 2 + (c >> 5), rr = r & 15, cc = c & 31, ob = rr * 64 + cc * 2; return st * 1024 + (ob ^ (((ob >> 9) & 1) << 5)); }
__host__ __device__ __forceinline__ void stage_rc(int b, int& R, int& C) { const int st = b / 1024, sb = b % 1024, swz = sb ^ (((sb >> 9) & 1) << 5); R = (st >> 1) * 16 + swz / 64; C = (st & 1) * 32 + (swz % 64) / 2; }
__host__ __device__ __forceinline__ int perm32(int rho) { const int n = rho >> 4, i = rho & 15; return 8 * (i >> 2) + 4 * n + (i & 3); }

struct Unit { int pm, pn; };
struct Gemm { const bf16_t* A; const bf16_t* Bt; int lda, ldb, K, nM, nN, a_pn_bytes; };

struct StaticOrder {
    int nM, nN, nwg, G, c;
    __device__ void init(int nM_, int nN_, int G_, int c_) { nM = nM_; nN = nN_; nwg = nM * nN; G = G_; c = c_; }
    __device__ bool next(int i, Unit& u) const {
        const long L = (long)i * G + c; if (L >= nwg) return false;
        int wgid = (int)L; { const int q = nwg / NXCD, r = nwg % NXCD, xcd = wgid % NXCD, off = wgid / NXCD; wgid = (xcd < r ? xcd * (q + 1) : r * (q + 1) + (xcd - r) * q) + off; }
        const int nig = WGM * nN, gid = wgid / nig, fm = gid * WGM, gsz = (nM - fm) < WGM ? (nM - fm) : WGM;
        u.pm = fm + ((wgid % nig) % gsz); u.pn = (wgid % nig) / gsz; return true;
    }
};

template <class Epi, bool ALIGN_EPI = true, bool SP2 = true>
__device__ __forceinline__ void gemm_phase(LAS unsigned char* lds, const Gemm g, const StaticOrder& S, const Epi& E) {
    int tid_ = threadIdx.x; asm volatile("" : "+v"(tid_));
    const int tid = tid_, wid = __builtin_amdgcn_readfirstlane(tid >> 6), lane = tid & 63, wr = wid >> 2, wc = wid & 3, fr = lane & 15, fq = lane >> 4;
    int K_ = g.K; asm volatile("" : "+s"(K_));
    const int K = K_, nt = K / BK;
    unsigned voffA[2], voffB[2];
#pragma unroll
    for (int i = 0; i < 2; ++i) { int R, C; stage_rc(tid * 16 + i * 8192, R, C); const int Rb = Epi::PERM ? ((R & ~31) + perm32(R & 31)) : R;
        voffA[i] = (unsigned)(R * g.lda + C) * 2u; voffB[i] = (unsigned)(Rb * g.ldb + C) * 2u; }
    const size_t kstep = (size_t)(BK * 2);
    const size_t hstepA = (size_t)HALF * g.lda * 2, hstepB = (size_t)HALF * g.ldb * 2;
    const size_t tstepA = 2 * hstepA, tstepB = 2 * hstepB;
    const unsigned ldsw = (unsigned)wid * 1024u;
    const int aoff = lds_byte(wr * 64 + fr, fq * 8), boff = lds_byte(wc * 32 + fr, fq * 8);
#define PG8_SA(b, h) (((b) * 2 + (h)) * HTB)
#define PG8_SB(b, h) ((4 + (b) * 2 + (h)) * HTB)
#define PG8_STAGE(bufoff, gbase, voff) do { _Pragma("unroll") for (int _i = 0; _i < 2; ++_i) \
        __builtin_amdgcn_global_load_lds((const unsigned*)((const char*)(gbase) + (voff)[_i]), (LAS unsigned*)(lds + (bufoff) + ldsw + _i * 8192), 16, 0, 0); } while (0)
#define PG8_LDA(dst, b, h) do { _Pragma("unroll") for (int m = 0; m < 4; ++m) _Pragma("unroll") for (int k = 0; k < 2; ++k) dst[m][k] = *(const LAS bf16x8*)(lds + PG8_SA(b, h) + aoff + m * 2048 + k * 1024); } while (0)
#define PG8_LDB(dst, b, h) do { _Pragma("unroll") for (int n = 0; n < 2; ++n) _Pragma("unroll") for (int k = 0; k < 2; ++k) dst[n][k] = *(const LAS bf16x8*)(lds + PG8_SB(b, h) + boff + n * 2048 + k * 1024); } while (0)
#define PG8_MMA(ai, bj, At, Bt) do { __builtin_amdgcn_s_setprio(1); _Pragma("unroll") for (int m = 0; m < 4; ++m) _Pragma("unroll") for (int n = 0; n < 2; ++n) _Pragma("unroll") for (int k = 0; k < 2; ++k) \
        acc[ai][bj][m][n] = __builtin_amdgcn_mfma_f32_16x16x32_bf16(Bt[n][k], At[m][k], acc[ai][bj][m][n], 0, 0, 0); __builtin_amdgcn_s_setprio(0); } while (0)
#define PG8_WAIT_V(n) asm volatile("s_waitcnt vmcnt(" #n ")" ::: "memory")
#define PG8_WAIT_L(n) asm volatile("s_waitcnt lgkmcnt(" #n ")" ::: "memory")
#define PG8_BAR __builtin_amdgcn_s_barrier()
#define PG8_SCHED __builtin_amdgcn_sched_barrier(0)
    Unit cur, nxt; int ui = 0;
    if (!S.next(0, cur)) return;
    f32x4 acc[2][2][4][2];
#pragma unroll
    for (int a = 0; a < 2; ++a)
#pragma unroll
        for (int b = 0; b < 2; ++b)
#pragma unroll
            for (int m = 0; m < 4; ++m)
#pragma unroll
                for (int n = 0; n < 2; ++n) acc[a][b][m][n] = (f32x4){0.f, 0.f, 0.f, 0.f};
    bf16x8 At[4][2], B0[2][2], B1[2][2];
    const char* cA = (const char*)g.A + (size_t)cur.pm * tstepA + (size_t)cur.pn * g.a_pn_bytes; const char* cB = (const char*)g.Bt + (size_t)cur.pn * tstepB;
    if constexpr (SP2) {
        PG8_STAGE(PG8_SB(0, 0), cB, voffB); PG8_STAGE(PG8_SB(0, 1), cB + hstepB, voffB); PG8_STAGE(PG8_SA(0, 0), cA, voffA); PG8_STAGE(PG8_SA(0, 1), cA + hstepA, voffA);
        if (wr == 1) PG8_BAR;
        PG8_WAIT_V(2); PG8_BAR;
        PG8_STAGE(PG8_SB(1, 0), cB + kstep, voffB); PG8_STAGE(PG8_SA(1, 0), cA + kstep, voffA); PG8_STAGE(PG8_SB(1, 1), cB + hstepB + kstep, voffB);
        PG8_WAIT_V(6); PG8_BAR;
    } else {
        PG8_STAGE(PG8_SB(0, 0), cB, voffB); PG8_STAGE(PG8_SA(0, 0), cA, voffA); PG8_STAGE(PG8_SB(0, 1), cB + hstepB, voffB); PG8_STAGE(PG8_SA(0, 1), cA + hstepA, voffA);
        if (wr == 1) PG8_BAR;
        PG8_WAIT_V(4); PG8_BAR;
        PG8_STAGE(PG8_SB(1, 0), cB + kstep, voffB); PG8_STAGE(PG8_SA(1, 0), cA + kstep, voffA); PG8_STAGE(PG8_SB(1, 1), cB + hstepB + kstep, voffB);
        PG8_WAIT_V(6); PG8_BAR;
    }
    for (;;) {
        const bool has_next = S.next(ui + 1, nxt);
        const char* nA = has_next ? (const char*)g.A + (size_t)nxt.pm * tstepA + (size_t)nxt.pn * g.a_pn_bytes : cA; const char* nB = has_next ? (const char*)g.Bt + (size_t)nxt.pn * tstepB : cB;
        for (int t = 0; t < nt; t += 2) {
            const bool last = (t == nt - 2);
            const char* a1 = cA + (size_t)(t + 1) * kstep;
            const char* a2 = last ? nA : cA + (size_t)(t + 2) * kstep; const char* b2 = last ? nB : cB + (size_t)(t + 2) * kstep;
            const char* a3 = a2 + kstep; const char* b3 = b2 + kstep;
            if constexpr (SP2) {
            PG8_LDB(B0, 0, 0); PG8_LDB(B1, 0, 1); PG8_SCHED; PG8_LDA(At, 0, 0); PG8_STAGE(PG8_SA(1, 1), a1 + hstepA, voffA);
            PG8_WAIT_V(8); PG8_WAIT_L(0); PG8_BAR; PG8_MMA(0, 0, At, B0); PG8_MMA(0, 1, At, B1); PG8_BAR; PG8_SCHED;
            PG8_LDA(At, 0, 1); PG8_STAGE(PG8_SB(0, 0), b2, voffB); PG8_STAGE(PG8_SB(0, 1), b2 + hstepB, voffB); PG8_STAGE(PG8_SA(0, 0), a2, voffA);
            PG8_WAIT_V(8); PG8_WAIT_L(0); PG8_BAR; PG8_MMA(1, 0, At, B0); PG8_MMA(1, 1, At, B1); PG8_BAR; PG8_SCHED;
            PG8_LDB(B0, 1, 0); PG8_LDB(B1, 1, 1); PG8_SCHED; PG8_LDA(At, 1, 0); PG8_STAGE(PG8_SA(0, 1), a2 + hstepA, voffA);
            PG8_WAIT_V(8); PG8_WAIT_L(0); PG8_BAR; PG8_MMA(0, 0, At, B0); PG8_MMA(0, 1, At, B1); PG8_BAR; PG8_SCHED;
            PG8_LDA(At, 1, 1); PG8_STAGE(PG8_SB(1, 0), b3, voffB); PG8_STAGE(PG8_SB(1, 1), b3 + hstepB, voffB); PG8_STAGE(PG8_SA(1, 0), a3, voffA);
            PG8_WAIT_V(8); PG8_WAIT_L(0); PG8_BAR; PG8_MMA(1, 0, At, B0); PG8_MMA(1, 1, At, B1); PG8_BAR; PG8_SCHED;
            } else {
            PG8_LDB(B0, 0, 0); PG8_SCHED; PG8_LDA(At, 0, 0); PG8_STAGE(PG8_SA(1, 1), a1 + hstepA, voffA);
            PG8_WAIT_L(8); PG8_BAR; PG8_WAIT_L(0); PG8_MMA(0, 0, At, B0); PG8_BAR; PG8_SCHED;
            PG8_LDB(B1, 0, 1); PG8_STAGE(PG8_SB(0, 0), b2, voffB);
            PG8_BAR; PG8_WAIT_L(0); PG8_MMA(0, 1, At, B1); PG8_BAR;
            PG8_LDA(At, 0, 1); PG8_STAGE(PG8_SA(0, 0), a2, voffA);
            PG8_BAR; PG8_WAIT_L(0); PG8_MMA(1, 0, At, B0); PG8_BAR; PG8_SCHED;
            PG8_STAGE(PG8_SB(0, 1), b2 + hstepB, voffB);
            PG8_WAIT_V(6); PG8_BAR; PG8_MMA(1, 1, At, B1); PG8_BAR;
            PG8_LDB(B0, 1, 0); PG8_SCHED; PG8_LDA(At, 1, 0); PG8_STAGE(PG8_SA(0, 1), a2 + hstepA, voffA);
            PG8_WAIT_L(8); PG8_BAR; PG8_WAIT_L(0); PG8_MMA(0, 0, At, B0); PG8_BAR; PG8_SCHED;
            PG8_LDB(B1, 1, 1); PG8_STAGE(PG8_SB(1, 0), b3, voffB);
            PG8_BAR; PG8_WAIT_L(0); PG8_MMA(0, 1, At, B1); PG8_BAR;
            PG8_LDA(At, 1, 1); PG8_STAGE(PG8_SA(1, 0), a3, voffA);
            PG8_BAR; PG8_WAIT_L(0); PG8_MMA(1, 0, At, B0); PG8_BAR; PG8_SCHED;
            PG8_STAGE(PG8_SB(1, 1), b3 + hstepB, voffB);
            PG8_WAIT_V(6); PG8_BAR; PG8_MMA(1, 1, At, B1); PG8_BAR;
            }
        }
        if constexpr (ALIGN_EPI) { if (wr == 0) PG8_BAR; }
        E(acc, cur, wr, wc, fr, fq);
        if (!has_next) break;
#pragma unroll
        for (int a = 0; a < 2; ++a)
#pragma unroll
            for (int b = 0; b < 2; ++b)
#pragma unroll
                for (int m = 0; m < 4; ++m)
#pragma unroll
                    for (int n = 0; n < 2; ++n) acc[a][b][m][n] = (f32x4){0.f, 0.f, 0.f, 0.f};
        cur = nxt; cA = nA; cB = nB; ++ui;
        if constexpr (ALIGN_EPI) { if (wr == 1) PG8_BAR; }
    }
    PG8_WAIT_V(0);
    if constexpr (!ALIGN_EPI) { if (wr == 0) PG8_BAR; }
    PG8_BAR;
#undef PG8_SA
#undef PG8_SB
#undef PG8_STAGE
#undef PG8_LDA
#undef PG8_LDB
#undef PG8_MMA
#undef PG8_WAIT_V
#undef PG8_WAIT_L
#undef PG8_BAR
#undef PG8_SCHED
}

enum { ACT_NONE = 0, ACT_SILU = 1, ACT_SIGMOID = 2, ACT_DECAY = 3 };
template <int ACT> __device__ __forceinline__ float actf(float v) {
    if (ACT == ACT_SILU) return v * sigmoidf_(v);
    if (ACT == ACT_SIGMOID) return sigmoidf_(v);
    if (ACT == ACT_DECAY) return 0.60653065971f * sigmoidf_(v);
    return v;
}
struct EpiCfg {
    bf16_t* out; int ldo;
    const float* bias;
    const float* cscale;
    const bf16_t* in1; int ld1;
    const bf16_t* in2; int ld2;
};
template <int ACT_A, int ACT_B, int ACT_C = ACT_NONE, int ACT_D = ACT_NONE, int ACT_E = ACT_NONE> struct EpiG {
    static constexpr bool PERM = true;
    EpiCfg a, b; int split; EpiCfg c = {}; int split2 = 1 << 30; EpiCfg d = {}; int split3 = 1 << 30; EpiCfg e = {}; int split4 = 1 << 30;
    template <int ACT> __device__ __forceinline__ void run(const EpiCfg& c, int colt, const f32x4 (&acc)[2][2][4][2], const Unit& u, int wr, int wc, int fr, int fq) const {
        const int row0 = u.pm * BM + wr * 64 + fr, col0 = colt + wc * 32 + 8 * fq;
        f32x4 bv[2][2], sv[2][2];
#pragma unroll
        for (int bj = 0; bj < 2; ++bj)
#pragma unroll
            for (int n = 0; n < 2; ++n) {
                bv[bj][n] = c.bias ? *(const f32x4*)(c.bias + col0 + bj * HALF + 4 * n) : (f32x4){0.f, 0.f, 0.f, 0.f};
                sv[bj][n] = c.cscale ? *(const f32x4*)(c.cscale + col0 + bj * HALF + 4 * n) : (f32x4){1.f, 1.f, 1.f, 1.f};
            }
#pragma unroll
        for (int ai = 0; ai < 2; ++ai) {
            u32x4 w1[4][2], w2[4][2];
            if (c.in1) {
#pragma unroll
                for (int m = 0; m < 4; ++m)
#pragma unroll
                    for (int bj = 0; bj < 2; ++bj) w1[m][bj] = *(const u32x4*)(c.in1 + (size_t)(row0 + ai * HALF + m * 16) * c.ld1 + col0 + bj * HALF);
            }
            if (c.in2) {
#pragma unroll
                for (int m = 0; m < 4; ++m)
#pragma unroll
                    for (int bj = 0; bj < 2; ++bj) w2[m][bj] = *(const u32x4*)(c.in2 + (size_t)(row0 + ai * HALF + m * 16) * c.ld2 + col0 + bj * HALF);
            }
            asm volatile("" ::: "memory");
#pragma unroll
            for (int m = 0; m < 4; ++m) {
                const size_t row = (size_t)(row0 + ai * HALF + m * 16);
#pragma unroll
                for (int bj = 0; bj < 2; ++bj) {
                    const int cc = col0 + bj * HALF;
                    f32x4 v0 = acc[ai][bj][m][0] + bv[bj][0], v1 = acc[ai][bj][m][1] + bv[bj][1];
#pragma unroll
                    for (int j = 0; j < 4; ++j) { v0[j] = actf<ACT>(v0[j]); v1[j] = actf<ACT>(v1[j]); }
                    if (c.in1) { const u32x4 w = w1[m][bj];
                        v0[0] *= bf_lo(w.x); v0[1] *= bf_hi(w.x); v0[2] *= bf_lo(w.y); v0[3] *= bf_hi(w.y);
                        v1[0] *= bf_lo(w.z); v1[1] *= bf_hi(w.z); v1[2] *= bf_lo(w.w); v1[3] *= bf_hi(w.w); }
                    if (c.cscale) { v0 *= sv[bj][0]; v1 *= sv[bj][1]; }
                    if (c.in2) { const u32x4 w = w2[m][bj];
                        v0[0] += bf_lo(w.x); v0[1] += bf_hi(w.x); v0[2] += bf_lo(w.y); v0[3] += bf_hi(w.y);
                        v1[0] += bf_lo(w.z); v1[1] += bf_hi(w.z); v1[2] += bf_lo(w.w); v1[3] += bf_hi(w.w); }
                    u32x4 w; w.x = pk_bf16(v0[0], v0[1]); w.y = pk_bf16(v0[2], v0[3]); w.z = pk_bf16(v1[0], v1[1]); w.w = pk_bf16(v1[2], v1[3]);
                    *(u32x4*)(c.out + row * c.ldo + cc) = w;
                }
            }
        }
    }
    __device__ __forceinline__ void operator()(const f32x4 (&acc)[2][2][4][2], const Unit& u, int wr, int wc, int fr, int fq) const {
        const int colt = u.pn * BM;
        if (colt >= split4) run<ACT_E>(e, colt - split4, acc, u, wr, wc, fr, fq);
        else if (colt >= split3) run<ACT_D>(d, colt - split3, acc, u, wr, wc, fr, fq);
        else if (colt >= split2) run<ACT_C>(c, colt - split2, acc, u, wr, wc, fr, fq);
        else if (colt >= split) run<ACT_B>(b, colt - split, acc, u, wr, wc, fr, fq);
        else run<ACT_A>(a, colt, acc, u, wr, wc, fr, fq);
    }
};
struct EpiRawT {
    static constexpr bool PERM = true;
    bf16_t* out; int ncols;
    __device__ __forceinline__ void operator()(const f32x4 (&acc)[2][2][4][2], const Unit& u, int wr, int wc, int fr, int fq) const {
        const int ch0 = u.pm * BM + wr * 64 + fr, tok0 = u.pn * BM + wc * 32 + 8 * fq;
#pragma unroll
        for (int ai = 0; ai < 2; ++ai)
#pragma unroll
            for (int m = 0; m < 4; ++m) {
                const int ch = ch0 + ai * HALF + m * 16;
#pragma unroll
                for (int bj = 0; bj < 2; ++bj) {
                    const int tok = tok0 + bj * HALF;
                    const f32x4 v0 = acc[ai][bj][m][0], v1 = acc[ai][bj][m][1];
                    u32x4 w; w.x = pk_bf16(v0[0], v0[1]); w.y = pk_bf16(v0[2], v0[3]); w.z = pk_bf16(v1[0], v1[1]); w.w = pk_bf16(v1[2], v1[3]);
                    *(u32x4*)(out + ((size_t)(tok >> 4) * ncols + ch) * 16 + (tok & 15)) = w;
                }
            }
    }
};
struct EpiResid {
    static constexpr bool PERM = false;
    float* X; int ldc; const float* Xin;
    __device__ __forceinline__ void operator()(const f32x4 (&acc)[2][2][4][2], const Unit& u, int wr, int wc, int fr, int fq) const {
        const int row0 = u.pm * BM + wr * 64 + fr, col0 = u.pn * BM + wc * 32 + 4 * fq;
#pragma unroll
        for (int ai = 0; ai < 2; ++ai)
#pragma unroll
            for (int m = 0; m < 4; ++m) { float* rowp = X + (size_t)(row0 + ai * HALF + m * 16) * ldc + col0;
#pragma unroll
                for (int bj = 0; bj < 2; ++bj)
#pragma unroll
                    for (int n = 0; n < 2; ++n) { f32x4* p = (f32x4*)(rowp + bj * HALF + n * 16); *p = *(const f32x4*)(Xin + (p - (f32x4*)X) * 4) + acc[ai][bj][m][n]; } }
    }
};
}

struct Args {
    const float* in[22];
    float* out; unsigned char* ws;
    int ph_lo, ph_hi;
};
typedef const Args __attribute__((address_space(4)))* ArgsP;
struct Frame {
    LAS unsigned char* lds;
    int tid, lane, wave, G, bid;
    ArgsP ap;
    float* X; unsigned char* ws;
    bf16_t *WinT, *WppT, *WrpT, *WoutT, *LinT, *EAT, *VF, *RAW, *RAWB, *S1, *S2, *S3, *TW;
};

__device__ __forceinline__ void set_ws(Frame& F, unsigned char* ws) {
    F.ws = ws;
    F.WinT = (bf16_t*)(ws + WS_WINT); F.WppT = (bf16_t*)(ws + WS_WPP); F.WrpT = (bf16_t*)(ws + WS_WRP); F.WoutT = (bf16_t*)(ws + WS_WOUT);
    F.LinT = (bf16_t*)(ws + WS_LINT); F.EAT = (bf16_t*)(ws + WS_EAT); F.VF = (bf16_t*)(ws + WS_VFIRST);
    F.RAW = (bf16_t*)(ws + WS_RAW); F.RAWB = (bf16_t*)(ws + WS_RAWB); F.S1 = (bf16_t*)(ws + WS_S1); F.S2 = (bf16_t*)(ws + WS_S2); F.S3 = (bf16_t*)(ws + WS_S3);
    F.TW = (bf16_t*)(ws + WS_TW);
}
__device__ __forceinline__ void transpose_cvt(const Frame& F, const float* src, int ldn, int K, int N, bf16_t* dst, int ldk) {
    LAS float* tile = (LAS float*)F.lds;
    const int tilesK = K / 64, ntile = tilesK * (N / 64);
    for (int tl = F.bid; tl < ntile; tl += F.G) {
        const int k0 = (tl % tilesK) * 64, n0 = (tl / tilesK) * 64;
#pragma unroll
        for (int i = 0; i < 8; ++i) { const int idx = F.tid + 512 * i, r = idx >> 6, c = idx & 63; tile[r * 65 + c] = src[(size_t)(k0 + r) * ldn + n0 + c]; }
        __syncthreads();
#pragma unroll
        for (int i = 0; i < 4; ++i) { const int idx = F.tid + 512 * i, n = idx >> 5, kp = idx & 31;
            *(unsigned*)(dst + (size_t)(n0 + n) * ldk + k0 + 2 * kp) = pk_bf16(tile[(2 * kp) * 65 + n], tile[(2 * kp + 1) * 65 + n]); }
        __syncthreads();
    }
}
__device__ __forceinline__ void fold_weights(const Frame& F, int L) {
    const int fr = F.lane & 15, fq = F.lane >> 4;
    LAS float* red = (LAS float*)F.lds;
    for (int tl = F.bid; tl < 64 * 4; tl += F.G) {
        const int k0 = (tl >> 2) * 16, j0 = (tl & 3) * 16, jj = j0 + fr;
        f32x4 acc = (f32x4){0.f, 0.f, 0.f, 0.f};
        if (L > 0) {
            const int cw = F.wave * 128 + 32 * fq;
            const float* arow = F.ap->in[2] + (size_t)L * D * INW + 4096 + (size_t)(k0 + fr) * INW + cw;
            const float* mu = F.ap->in[6] + (size_t)L * 3200 + 2048 + cw;
            const float* V1 = F.ap->in[12] + (size_t)(L - 1) * D * 32 + (size_t)cw * 32 + (jj & 31);
#pragma unroll
            for (int s4 = 0; s4 < 8; ++s4) {
                const f32x4 a4 = *(const f32x4*)(arow + 4 * s4), m4 = *(const f32x4*)(mu + 4 * s4);
#pragma unroll
                for (int e = 0; e < 4; ++e) acc = __builtin_amdgcn_mfma_f32_16x16x4f32(a4[e], V1[(size_t)(4 * s4 + e) * 32] * ((jj < 32) ? (1.0f - m4[e]) : m4[e]), acc, 0, 0, 0);
            }
        }
        *(LAS f32x4*)(red + (F.wave * 64 + F.lane) * 4) = acc;
        __syncthreads();
        if (F.wave == 0) {
            f32x4 t = acc;
#pragma unroll
            for (int w = 1; w < 8; ++w) t += *(const LAS f32x4*)(red + (w * 64 + F.lane) * 4);
            *(u32x2*)(F.WinT + (size_t)(R_FOLD + jj) * D + k0 + 4 * fq) = (u32x2){pk_bf16(t[0], t[1]), pk_bf16(t[2], t[3])};
            unsigned zz = 0u; asm volatile("" : "+v"(zz));
            *(u32x2*)(F.WinT + (size_t)(R_FOLD + 64 + jj) * D + k0 + 4 * fq) = (u32x2){zz, zz};
        }
        __syncthreads();
    }
    if (L > 0) { const float* V2 = F.ap->in[13] + (size_t)(L - 1) * 32 * D;
        for (int idx = F.bid * 512 + F.tid; idx < D * 32; idx += F.G * 512) { const int n = idx >> 5, j = idx & 31; F.EAT[131072 + idx] = f2bf_s(V2[(size_t)j * D + n]); } }
}
__device__ __forceinline__ void fold_pool_lin(const Frame& F, int L) {
    const float* win = F.ap->in[2] + (size_t)L * D * INW;
    const int fr = F.lane & 15, fq = F.lane >> 4;
    for (int tl = F.bid * 8 + F.wave; tl < 4 * 64 * 16; tl += F.G * 8) {
        const int g = tl >> 10, k0 = ((tl >> 4) & 63) * 16, d0 = (tl & 15) * 16;
        const float* arow = win + (size_t)(k0 + fr) * INW + 256 * g + 64 * fq;
        const float* bcol = F.ap->in[3] + ((size_t)(L * 4 + g) * 256 + 64 * fq) * 256 + d0 + fr;
        f32x4 acc = (f32x4){0.f, 0.f, 0.f, 0.f};
#pragma unroll 4
        for (int s4 = 0; s4 < 16; ++s4) {
            const f32x4 a4 = *(const f32x4*)(arow + 4 * s4);
#pragma unroll
            for (int e = 0; e < 4; ++e) acc = __builtin_amdgcn_mfma_f32_16x16x4f32(a4[e], bcol[(size_t)(4 * s4 + e) * 256], acc, 0, 0, 0);
        }
        *(u32x2*)(F.WinT + (size_t)(256 * g + d0 + fr) * D + k0 + 4 * fq) = (u32x2){pk_bf16(acc[0], acc[1]), pk_bf16(acc[2], acc[3])};
    }
}
__device__ __forceinline__ void convert_weights(const Frame& F, int L) {
    transpose_cvt(F, F.ap->in[2] + (size_t)L * D * INW + 1024, INW, D, 1024, F.WinT + (size_t)1024 * D, D);
    transpose_cvt(F, F.ap->in[2] + (size_t)L * D * INW + 2048, INW, D, 3200, F.WinT + (size_t)R_RKV * D, D);
    fold_pool_lin(F, L);
    transpose_cvt(F, F.ap->in[2] + (size_t)L * D * INW + 5248, INW, D, 1024, F.WinT + (size_t)R_RGATE * D, D);
    transpose_cvt(F, F.ap->in[2] + (size_t)L * D * INW + 6272, INW, D, 1024, F.WinT + (size_t)R_GPOOL * D, D);
    transpose_cvt(F, F.ap->in[2] + (size_t)L * D * INW + 7296, INW, D, 1024, F.WinT + (size_t)R_GRWKV * D, D);
    fold_weights(F, L);
    transpose_cvt(F, F.ap->in[5] + (size_t)L * D * D, D, D, D, F.WppT, D);
    transpose_cvt(F, F.ap->in[19] + (size_t)L * D * D, D, D, D, F.WrpT, D);
    transpose_cvt(F, F.ap->in[20] + (size_t)L * D * D, D, D, D, F.WoutT, D);
    transpose_cvt(F, F.ap->in[8] + (size_t)L * 64 * D, D, 64, D, F.EAT, 64);
    transpose_cvt(F, F.ap->in[10] + (size_t)L * 64 * D, D, 64, D, F.EAT + 65536, 64);
}
__device__ __forceinline__ void rmsnorm_rows(const Frame& F, const float* src, const float* g, bf16_t* H, bf16_t* copy_to) {
    for (int m = F.bid * 8 + F.wave; m < M; m += F.G * 8) {
        const float* xr = src + (size_t)m * D;
        f32x4 v[4]; float ss = 0.f;
#pragma unroll
        for (int i = 0; i < 4; ++i) { v[i] = *(const f32x4*)(xr + F.lane * 4 + 256 * i); ss += v[i][0] * v[i][0] + v[i][1] * v[i][1] + v[i][2] * v[i][2] + v[i][3] * v[i][3]; }
        ss = red64(ss);
        const float rs = __builtin_amdgcn_rsqf(ss * (1.0f / D) + NORM_EPS);
#pragma unroll
        for (int i = 0; i < 4; ++i) {
            const int c = F.lane * 4 + 256 * i;
            if (copy_to) *(u32x2*)(copy_to + (size_t)m * D + c) = (u32x2){pk_bf16(v[i][0], v[i][1]), pk_bf16(v[i][2], v[i][3])};
            const f32x4 gg = *(const f32x4*)(g + c);
            u32x2 w; w.x = pk_bf16(v[i][0] * rs * gg[0], v[i][1] * rs * gg[1]); w.y = pk_bf16(v[i][2] * rs * gg[2], v[i][3] * rs * gg[3]);
            *(u32x2*)(H + (size_t)m * D + c) = w;
        }
    }
}
__device__ __forceinline__ void rmsnorm_rows_bf(const Frame& F, const bf16_t* Xb, const float* g, bf16_t* H) {
    for (int m = F.bid * 8 + F.wave; m < M; m += F.G * 8) {
        const bf16_t* xr = Xb + (size_t)m * D;
        u32x4 w[2]; float ss = 0.f;
#pragma unroll
        for (int i = 0; i < 2; ++i) { w[i] = *(const u32x4*)(xr + F.lane * 8 + 512 * i);
#pragma unroll
            for (int e = 0; e < 4; ++e) { const float a = bf_lo(w[i][e]), b = bf_hi(w[i][e]); ss += a * a + b * b; } }
        ss = red64(ss);
        const float rs = __builtin_amdgcn_rsqf(ss * (1.0f / D) + NORM_EPS);
#pragma unroll
        for (int i = 0; i < 2; ++i) {
            const int c = F.lane * 8 + 512 * i;
            const f32x4 g0 = *(const f32x4*)(g + c), g1 = *(const f32x4*)(g + c + 4);
            u32x4 o; o.x = pk_bf16(bf_lo(w[i].x) * rs * g0[0], bf_hi(w[i].x) * rs * g0[1]); o.y = pk_bf16(bf_lo(w[i].y) * rs * g0[2], bf_hi(w[i].y) * rs * g0[3]);
            o.z = pk_bf16(bf_lo(w[i].z) * rs * g1[0], bf_hi(w[i].z) * rs * g1[1]); o.w = pk_bf16(bf_lo(w[i].w) * rs * g1[2], bf_hi(w[i].w) * rs * g1[3]);
            *(u32x4*)(H + (size_t)m * D + c) = o;
        }
    }
}
__device__ __forceinline__ void final_norm(const Frame& F, const bf16_t* Xb) {
    const float* g = F.ap->in[21];
    for (int m = F.bid * 8 + F.wave; m < M; m += F.G * 8) {
        const bf16_t* xr = Xb + (size_t)m * D;
        u32x4 w[2]; float ss = 0.f;
#pragma unroll
        for (int i = 0; i < 2; ++i) { w[i] = *(const u32x4*)(xr + F.lane * 8 + 512 * i);
#pragma unroll
            for (int e = 0; e < 4; ++e) { const float a = bf_lo(w[i][e]), b = bf_hi(w[i][e]); ss += a * a + b * b; } }
        ss = red64(ss);
        const float rs = __builtin_amdgcn_rsqf(ss * (1.0f / D) + NORM_EPS);
#pragma unroll
        for (int i = 0; i < 2; ++i) {
            const int c = F.lane * 8 + 512 * i;
            const f32x4 g0 = *(const f32x4*)(g + c), g1 = *(const f32x4*)(g + c + 4);
            *(f32x4*)(F.X + (size_t)m * D + c) = (f32x4){bf_lo(w[i].x) * rs * g0[0], bf_hi(w[i].x) * rs * g0[1], bf_lo(w[i].y) * rs * g0[2], bf_hi(w[i].y) * rs * g0[3]};
            *(f32x4*)(F.X + (size_t)m * D + c + 4) = (f32x4){bf_lo(w[i].z) * rs * g1[0], bf_hi(w[i].z) * rs * g1[1], bf_lo(w[i].w) * rs * g1[2], bf_hi(w[i].w) * rs * g1[3]};
        }
    }
}
__device__ __forceinline__ void tw_phase(const Frame& F, int L) {
    const float* mu = F.ap->in[6] + (size_t)L * 3200;
    for (int it = F.bid * 512 + F.tid; it < M * 32; it += F.G * 512) {
        const int m = it >> 5, j = it & 31; u32x4 o = (u32x4){0u, 0u, 0u, 0u};
        if (j < 16) {
            const int c0 = 3072 + 8 * j, t = m & (SEQ - 1);
            const u32x4 cw = *(const u32x4*)(F.RAW + (size_t)m * RAWLD + c0);
            u32x4 pw = (u32x4){0u, 0u, 0u, 0u}; if (t > 0) pw = *(const u32x4*)(F.RAW + (size_t)(m - 1) * RAWLD + c0);
            const f32x4 m0 = *(const f32x4*)(mu + c0), m1 = *(const f32x4*)(mu + c0 + 4);
            float s[8];
#define SH(i, cwv, pwv, muv, hi) { const float c_ = hi ? bf_hi(cwv) : bf_lo(cwv), p_ = hi ? bf_hi(pwv) : bf_lo(pwv); s[i] = c_ + (muv) * (p_ - c_); }
            SH(0, cw.x, pw.x, m0[0], 0) SH(1, cw.x, pw.x, m0[1], 1) SH(2, cw.y, pw.y, m0[2], 0) SH(3, cw.y, pw.y, m0[3], 1)
            SH(4, cw.z, pw.z, m1[0], 0) SH(5, cw.z, pw.z, m1[1], 1) SH(6, cw.w, pw.w, m1[2], 0) SH(7, cw.w, pw.w, m1[3], 1)
#undef SH
            if (j < 8) {
#pragma unroll
                for (int i = 0; i < 8; ++i) s[i] = tanhf_(s[i]);
            }
            o.x = pk_bf16(s[0], s[1]); o.y = pk_bf16(s[2], s[3]); o.z = pk_bf16(s[4], s[5]); o.w = pk_bf16(s[6], s[7]);
        }
        *(u32x4*)(F.TW + (size_t)m * 256 + 8 * j) = o;
    }
}
__device__ __forceinline__ void vmix_phase(const Frame& F, int L) {
    const float* mu = F.ap->in[6] + (size_t)L * 3200 + 2048;
    const int tid = F.tid, c0 = 2 * tid;
    const f32x2 muv = *(const f32x2*)(mu + c0);
    LAS float* vsh = (LAS float*)F.lds;
    LAS float* part = (LAS float*)(F.lds + 16384);
    LAS float* midl = (LAS float*)(F.lds + 16384 + 8192);
    bf16_t* dst = (L == 0) ? F.VF : F.S3;
    float v1r[64]; f32x2 v2r[32]; f32x2 v0v = (f32x2){0.f, 0.f};
    const int jj = tid & 31, cs = tid >> 5;
    if (L > 0) {
        const float* V1 = F.ap->in[12] + (size_t)(L - 1) * D * 32; const float* V2 = F.ap->in[13] + (size_t)(L - 1) * 32 * D;
#pragma unroll
        for (int i = 0; i < 64; ++i) v1r[i] = V1[(size_t)(cs * 64 + i) * 32 + jj];
#pragma unroll
        for (int j = 0; j < 32; ++j) v2r[j] = *(const f32x2*)(V2 + (size_t)j * D + c0);
        v0v = *(const f32x2*)(F.ap->in[11] + (size_t)(L - 1) * D + c0);
    }
    for (int grp = F.bid; grp < M / 4; grp += F.G) {
        const int m0 = grp * 4, t0 = m0 & (SEQ - 1);
        unsigned rw[5];
        rw[0] = (t0 > 0) ? *(const unsigned*)(F.RAW + (size_t)(m0 - 1) * RAWLD + 2048 + c0) : 0u;
#pragma unroll
        for (int i = 0; i < 4; ++i) rw[i + 1] = *(const unsigned*)(F.RAW + (size_t)(m0 + i) * RAWLD + 2048 + c0);
        f32x2 vs[4];
#pragma unroll
        for (int i = 0; i < 4; ++i) { const float c_lo = bf_lo(rw[i + 1]), c_hi = bf_hi(rw[i + 1]), p_lo = bf_lo(rw[i]), p_hi = bf_hi(rw[i]);
            vs[i].x = c_lo + muv.x * (p_lo - c_lo); vs[i].y = c_hi + muv.y * (p_hi - c_hi); }
        if (L == 0) {
#pragma unroll
            for (int i = 0; i < 4; ++i) *(unsigned*)(dst + (size_t)(m0 + i) * D + c0) = pk_bf16(vs[i].x, vs[i].y);
            continue;
        }
#pragma unroll
        for (int i = 0; i < 4; ++i) *(LAS f32x2*)(vsh + i * 1024 + c0) = vs[i];
        __syncthreads();
#pragma unroll
        for (int i = 0; i < 4; ++i) {
            float p = 0.f;
#pragma unroll
            for (int k4 = 0; k4 < 16; ++k4) { const f32x4 x = *(const LAS f32x4*)(vsh + i * 1024 + cs * 64 + 4 * k4);
                p += x[0] * v1r[4 * k4] + x[1] * v1r[4 * k4 + 1] + x[2] * v1r[4 * k4 + 2] + x[3] * v1r[4 * k4 + 3]; }
            part[(i * 16 + cs) * 32 + jj] = p;
        }
        __syncthreads();
        if (tid < 128) { const int i = tid >> 5; float s = 0.f;
#pragma unroll
            for (int k = 0; k < 16; ++k) s += part[(i * 16 + k) * 32 + jj];
            midl[i * 32 + jj] = s; }
        __syncthreads();
#pragma unroll
        for (int i = 0; i < 4; ++i) {
            float z0 = v0v.x, z1 = v0v.y;
#pragma unroll
            for (int j4 = 0; j4 < 8; ++j4) { const f32x4 mm = *(const LAS f32x4*)(midl + i * 32 + 4 * j4);
#pragma unroll
                for (int e = 0; e < 4; ++e) { z0 += mm[e] * v2r[4 * j4 + e].x; z1 += mm[e] * v2r[4 * j4 + e].y; } }
            const float g0 = sigmoidf_(z0), g1 = sigmoidf_(z1);
            const unsigned fw = *(const unsigned*)(F.VF + (size_t)(m0 + i) * D + c0);
            const float o0 = vs[i].x + (bf_lo(fw) - vs[i].x) * g0, o1 = vs[i].y + (bf_hi(fw) - vs[i].y) * g1;
            *(unsigned*)(dst + (size_t)(m0 + i) * D + c0) = pk_bf16(o0, o1);
        }
        __syncthreads();
    }
}
__device__ __forceinline__ void poold_phase(const Frame& F, const bf16_t* __restrict__ PIN, bf16_t* __restrict__ SGIO, const float* __restrict__ scale) {
    const rsrc_t rs_out = wt_rsrc(SGIO);
    for (int it = F.bid * 512 + F.tid; it < (M / 32) * 128; it += F.G * 512) {
        const int j = it & 127, m0 = (it >> 7) * 32, t0 = m0 & (SEQ - 1), w = 2 << (j >> 5);
        const bf16_t* col = PIN + 8 * j;
        const f32x4 sc0 = *(const f32x4*)(scale + 8 * j), sc1 = *(const f32x4*)(scale + 8 * j + 4);
        float s[8];
#pragma unroll
        for (int e = 0; e < 8; ++e) s[e] = 0.f;
        if (t0 > 0) {
            for (int i = 1; i < w; ++i) { const u32x4 x = *(const u32x4*)(col + (size_t)(m0 - i) * D);
                s[0] += bf_lo(x.x); s[1] += bf_hi(x.x); s[2] += bf_lo(x.y); s[3] += bf_hi(x.y); s[4] += bf_lo(x.z); s[5] += bf_hi(x.z); s[6] += bf_lo(x.w); s[7] += bf_hi(x.w); }
        }
        for (int sb = 0; sb < 4; ++sb) {
            u32x4 xv[8], ov[8], gv[8];
#pragma unroll
            for (int i = 0; i < 8; ++i) {
                const int ii = sb * 8 + i, t = t0 + ii; const size_t m = (size_t)(m0 + ii);
                const bool sub = (t >= w) && (ii > 0);
                xv[i] = *(const u32x4*)(col + m * D);
                ov[i] = *(const u32x4*)(col + (sub ? m - w : m) * D);
                gv[i] = *(const u32x4*)(SGIO + m * D + 8 * j);
            }
#pragma unroll
            for (int i = 0; i < 8; ++i) {
                const int ii = sb * 8 + i, t = t0 + ii; const size_t m = (size_t)(m0 + ii);
                const float fs = ((t >= w) && (ii > 0)) ? 1.0f : 0.0f;
                const u32x4 x = xv[i], o = ov[i], gw = gv[i];
                const float c[8] = {bf_lo(x.x), bf_hi(x.x), bf_lo(x.y), bf_hi(x.y), bf_lo(x.z), bf_hi(x.z), bf_lo(x.w), bf_hi(x.w)};
                const float d[8] = {bf_lo(o.x), bf_hi(o.x), bf_lo(o.y), bf_hi(o.y), bf_lo(o.z), bf_hi(o.z), bf_lo(o.w), bf_hi(o.w)};
#pragma unroll
                for (int e = 0; e < 8; ++e) s[e] += c[e] - fs * d[e];
                const float inv = __builtin_amdgcn_rcpf((float)((t + 1 < w) ? (t + 1) : w));
                u32x4 r; r.x = pk_bf16((s[0] * inv - c[0]) * sc0[0] * bf_lo(gw.x), (s[1] * inv - c[1]) * sc0[1] * bf_hi(gw.x)); r.y = pk_bf16((s[2] * inv - c[2]) * sc0[2] * bf_lo(gw.y), (s[3] * inv - c[3]) * sc0[3] * bf_hi(gw.y));
                r.z = pk_bf16((s[4] * inv - c[4]) * sc1[0] * bf_lo(gw.z), (s[5] * inv - c[5]) * sc1[1] * bf_hi(gw.z)); r.w = pk_bf16((s[6] * inv - c[6]) * sc1[2] * bf_lo(gw.w), (s[7] * inv - c[7]) * sc1[3] * bf_hi(gw.w));
                ST16_WT(rs_out, (m * D + 8 * j) * 2, r);
            }
        }
    }
}

constexpr int SC_T = 32;
constexpr int SC_ARR = SC_T * 64;
constexpr int SC_BUF_BYTES = 6 * SC_ARR * 4;
constexpr int SC_YS = 2 * SC_BUF_BYTES, SC_RAWR = SC_YS + SC_ARR * 4, SC_RAWK = SC_RAWR + SC_ARR * 4, SC_PREV = SC_RAWK + SC_ARR * 4;
static_assert(SC_PREV + 1024 <= 131072, "scan LDS");

#define QP(n) "quad_perm:[" #n "," #n "," #n "," #n "] row_mask:0xf bank_mask:0xf"
__device__ __forceinline__ void sc_matvec(float& o0, float& o1, const f32x2 x, const float (&S)[8]) {
    asm volatile("s_nop 1\n\t"
        "v_mul_f32_dpp %0, %2, %4 " QP(0) "\n\t"  "v_mul_f32_dpp %1, %3, %5 " QP(0) "\n\t"
        "v_fmac_f32_dpp %0, %2, %6 " QP(1) "\n\t" "v_fmac_f32_dpp %1, %3, %7 " QP(1) "\n\t"
        "v_fmac_f32_dpp %0, %2, %8 " QP(2) "\n\t" "v_fmac_f32_dpp %1, %3, %9 " QP(2) "\n\t"
        "v_fmac_f32_dpp %0, %2, %10 " QP(3) "\n\t" "v_fmac_f32_dpp %1, %3, %11 " QP(3)
        : "=&v"(o0), "=&v"(o1) : "v"(x.x), "v"(x.y), "v"(S[0]), "v"(S[1]), "v"(S[2]), "v"(S[3]), "v"(S[4]), "v"(S[5]), "v"(S[6]), "v"(S[7]));
}
__device__ __forceinline__ void sc_update(float (&S)[8], const f32x2 w, const f32x2 b, const f32x2 k, const float sa, const float vv) {
    asm volatile("s_nop 1\n\t"
        "v_mul_f32_dpp %0, %8, %0 " QP(0) "\n\t" "v_mul_f32_dpp %1, %9, %1 " QP(0) "\n\t"
        "v_mul_f32_dpp %2, %8, %2 " QP(1) "\n\t" "v_mul_f32_dpp %3, %9, %3 " QP(1) "\n\t"
        "v_mul_f32_dpp %4, %8, %4 " QP(2) "\n\t" "v_mul_f32_dpp %5, %9, %5 " QP(2) "\n\t"
        "v_mul_f32_dpp %6, %8, %6 " QP(3) "\n\t" "v_mul_f32_dpp %7, %9, %7 " QP(3) "\n\t"
        "v_fmac_f32_dpp %0, %10, %14 " QP(0) "\n\t" "v_fmac_f32_dpp %1, %11, %14 " QP(0) "\n\t"
        "v_fmac_f32_dpp %2, %10, %14 " QP(1) "\n\t" "v_fmac_f32_dpp %3, %11, %14 " QP(1) "\n\t"
        "v_fmac_f32_dpp %4, %10, %14 " QP(2) "\n\t" "v_fmac_f32_dpp %5, %11, %14 " QP(2) "\n\t"
        "v_fmac_f32_dpp %6, %10, %14 " QP(3) "\n\t" "v_fmac_f32_dpp %7, %11, %14 " QP(3) "\n\t"
        "v_fmac_f32_dpp %0, %12, %15 " QP(0) "\n\t" "v_fmac_f32_dpp %1, %13, %15 " QP(0) "\n\t"
        "v_fmac_f32_dpp %2, %12, %15 " QP(1) "\n\t" "v_fmac_f32_dpp %3, %13, %15 " QP(1) "\n\t"
        "v_fmac_f32_dpp %4, %12, %15 " QP(2) "\n\t" "v_fmac_f32_dpp %5, %13, %15 " QP(2) "\n\t"
        "v_fmac_f32_dpp %6, %12, %15 " QP(3) "\n\t" "v_fmac_f32_dpp %7, %13, %15 " QP(3)
        : "+v"(S[0]), "+v"(S[1]), "+v"(S[2]), "+v"(S[3]), "+v"(S[4]), "+v"(S[5]), "+v"(S[6]), "+v"(S[7])
        : "v"(w.x), "v"(w.y), "v"(b.x), "v"(b.y), "v"(k.x), "v"(k.y), "v"(sa), "v"(vv));
}
__device__ __forceinline__ float sc_red(float x) {
    asm volatile("s_nop 1\n\tv_add_f32_dpp %0, %0, %0 row_ror:4 row_mask:0xf bank_mask:0xf\n\ts_nop 1\n\tv_add_f32_dpp %0, %0, %0 row_ror:8 row_mask:0xf bank_mask:0xf" : "+v"(x));
    const auto r = __builtin_amdgcn_permlane32_swap(__float_as_uint(x), __float_as_uint(x), false, false);
    return __uint_as_float(r[0]) + __uint_as_float(r[1]);
}
#undef QP
struct ScanRegs { u32x2 rr, kr, ee, aa, vv; };
__device__ __forceinline__ void scan_phase(const Frame& F, int L, const bf16_t* VP) {
    const int tid = F.tid, lane = F.lane, wave = F.wave;
    LAS float* Ys = (LAS float*)(F.lds + SC_YS);
    LAS float* rawR = (LAS float*)(F.lds + SC_RAWR);
    LAS float* rawK = (LAS float*)(F.lds + SC_RAWK);
    LAS float* prevRK = (LAS float*)(F.lds + SC_PREV);
    const int tok = tid >> 4, q = tid & 15;
    const int kc = ((lane >> 5) << 2) | ((lane >> 2) & 3), row = wave * 8 + ((lane >> 4) & 1) * 4 + (lane & 3), koff = 8 * kc + 2 * (lane & 3);
    for (int unit = F.bid; unit < 256; unit += F.G) {
        const int b = unit >> 4, h = unit & 15, hc = h * 64 + 4 * q;
        const f32x4 kk4 = *(const f32x4*)(F.ap->in[14] + (size_t)L * D + hc), ka4 = *(const f32x4*)(F.ap->in[15] + (size_t)L * D + hc);
        const f32x4 rk4 = *(const f32x4*)(F.ap->in[16] + (size_t)L * D + hc);
        const f32x4 lw4 = *(const f32x4*)(F.ap->in[17] + (size_t)L * D + hc), lb4 = *(const f32x4*)(F.ap->in[18] + (size_t)L * D + hc);
        const f32x4 mur4 = *(const f32x4*)(F.ap->in[6] + (size_t)L * 3200 + hc), muk4 = *(const f32x4*)(F.ap->in[6] + (size_t)L * 3200 + 1024 + hc);
        const size_t mrow0 = (size_t)b * SEQ;
        float S[8];
#pragma unroll
        for (int j = 0; j < 8; ++j) S[j] = 0.f;
        ScanRegs R;
#define SC_LOAD(cidx) do { const size_t m_ = mrow0 + (size_t)(cidx) * SC_T + tok; \
            R.rr = *(const u32x2*)(F.RAW + m_ * RAWLD + hc); R.kr = *(const u32x2*)(F.RAW + m_ * RAWLD + 1024 + hc); \
            R.ee = *(const u32x2*)(F.S1 + m_ * D + hc); R.aa = *(const u32x2*)(F.S2 + m_ * D + hc); R.vv = *(const u32x2*)(VP + m_ * D + hc); } while (0)
#define SC_PREP(cidx) do { \
            const f32x4 rc = (f32x4){bf_lo(R.rr.x), bf_hi(R.rr.x), bf_lo(R.rr.y), bf_hi(R.rr.y)}; \
            const f32x4 kc = (f32x4){bf_lo(R.kr.x), bf_hi(R.kr.x), bf_lo(R.kr.y), bf_hi(R.kr.y)}; \
            *(LAS f32x4*)(rawR + tok * 64 + 4 * q) = rc; *(LAS f32x4*)(rawK + tok * 64 + 4 * q) = kc; \
            __syncthreads(); \
            f32x4 rp, kp; \
            if (tok > 0) { rp = *(const LAS f32x4*)(rawR + (tok - 1) * 64 + 4 * q); kp = *(const LAS f32x4*)(rawK + (tok - 1) * 64 + 4 * q); } \
            else if ((cidx) > 0) { rp = *(const LAS f32x4*)(prevRK + (((cidx) & 1) * 2 + 0) * 64 + 4 * q); kp = *(const LAS f32x4*)(prevRK + (((cidx) & 1) * 2 + 1) * 64 + 4 * q); } \
            else { rp = (f32x4){0.f, 0.f, 0.f, 0.f}; kp = rp; } \
            if (tok == SC_T - 1) { *(LAS f32x4*)(prevRK + ((((cidx) + 1) & 1) * 2 + 0) * 64 + 4 * q) = rc; *(LAS f32x4*)(prevRK + ((((cidx) + 1) & 1) * 2 + 1) * 64 + 4 * q) = kc; } \
            const f32x4 rs = rc + mur4 * (rp - rc), ks = kc + muk4 * (kp - kc); \
            const f32x4 ev = (f32x4){bf_lo(R.ee.x), bf_hi(R.ee.x), bf_lo(R.ee.y), bf_hi(R.ee.y)}; \
            const f32x4 av = (f32x4){bf_lo(R.aa.x), bf_hi(R.aa.x), bf_lo(R.aa.y), bf_hi(R.aa.y)}; \
            const f32x4 vv = (f32x4){bf_lo(R.vv.x), bf_hi(R.vv.x), bf_lo(R.vv.y), bf_hi(R.vv.y)}; \
            f32x4 kkv = ks * kk4; \
            float ss = kkv[0] * kkv[0] + kkv[1] * kkv[1] + kkv[2] * kkv[2] + kkv[3] * kkv[3]; ss = red16(ss); \
            const float inv = 1.0f / fmaxf(sqrtf(ss), 1e-12f); kkv = kkv * inv; \
            const f32x4 kmod = ks * (1.0f + (av - 1.0f) * ka4); \
            f32x4 wv; wv[0] = __expf(-ev[0]); wv[1] = __expf(-ev[1]); wv[2] = __expf(-ev[2]); wv[3] = __expf(-ev[3]); \
            LAS float* cb_ = (LAS float*)(F.lds + ((cidx) & 1) * SC_BUF_BYTES) + tok * 64 + 4 * q; \
            *(LAS f32x4*)(cb_ + 0 * SC_ARR) = rs; *(LAS f32x4*)(cb_ + 1 * SC_ARR) = wv; *(LAS f32x4*)(cb_ + 2 * SC_ARR) = kmod; \
            *(LAS f32x4*)(cb_ + 3 * SC_ARR) = -kkv; *(LAS f32x4*)(cb_ + 4 * SC_ARR) = kkv * av; *(LAS f32x4*)(cb_ + 5 * SC_ARR) = vv; } while (0)
        SC_LOAD(0);
        SC_PREP(0);
        __syncthreads();
        for (int c = 0; c < SEQ / SC_T; ++c) {
            if (c + 1 < SEQ / SC_T) SC_LOAD(c + 1);
            const LAS float* cb = (const LAS float*)(F.lds + (c & 1) * SC_BUF_BYTES);
            const LAS float* pin = cb + koff;
            const LAS float* pv = cb + 5 * SC_ARR + row;
#define SC_LD(dst, t_) do { dst##r = *(const LAS f32x2*)(pin + 0 * SC_ARR + (t_) * 64); dst##w = *(const LAS f32x2*)(pin + 1 * SC_ARR + (t_) * 64); dst##k = *(const LAS f32x2*)(pin + 2 * SC_ARR + (t_) * 64); \
                dst##a = *(const LAS f32x2*)(pin + 3 * SC_ARR + (t_) * 64); dst##b = *(const LAS f32x2*)(pin + 4 * SC_ARR + (t_) * 64); dst##v = pv[(t_) * 64]; } while (0)
#define SC_STEP(src, t_) do { float p0_, p1_; sc_matvec(p0_, p1_, src##a, S); const float sa_ = sc_red(p0_ + p1_); sc_update(S, src##w, src##b, src##k, sa_, src##v); \
                sc_matvec(p0_, p1_, src##r, S); const float y_ = sc_red(p0_ + p1_); if (kc == 0) Ys[(t_) * 64 + row] = y_; } while (0)
            f32x2 Ar, Aw, Ak, Aa, Ab, Br, Bw, Bk, Ba, Bb; float Av, Bv;
            SC_LD(A, 0);
            for (int t = 0; t < SC_T; t += 2) {
                SC_LD(B, t + 1);
                SC_STEP(A, t);
                if (t + 2 < SC_T) SC_LD(A, t + 2);
                SC_STEP(B, t + 1);
            }
#undef SC_LD
#undef SC_STEP
            __syncthreads();
            {
                const f32x4 y4 = *(const LAS f32x4*)(Ys + tok * 64 + 4 * q);
                const float mean = red16((y4[0] + y4[1]) + (y4[2] + y4[3])) * (1.0f / 64.0f);
                const f32x4 d = y4 - mean;
                const float var = red16((d[0] * d[0] + d[1] * d[1]) + (d[2] * d[2] + d[3] * d[3])) * (1.0f / 64.0f);
                const float rstd = __builtin_amdgcn_rsqf(var + LNX_EPS);
                const f32x4 rs = *(const LAS f32x4*)(cb + 0 * SC_ARR + tok * 64 + 4 * q), km = *(const LAS f32x4*)(cb + 2 * SC_ARR + tok * 64 + 4 * q), vv = *(const LAS f32x4*)(cb + 5 * SC_ARR + tok * 64 + 4 * q);
                const f32x4 pr = rs * km * rk4;
                const float bon = red16((pr[0] + pr[1]) + (pr[2] + pr[3]));
                const f32x4 z = d * rstd * lw4 + lb4 + bon * vv;
                u32x2 o; o.x = pk_bf16(z[0], z[1]); o.y = pk_bf16(z[2], z[3]);
                *(u32x2*)(F.RAW + (mrow0 + (size_t)c * SC_T + tok) * RAWLD + hc) = o;
            }
            if (c + 1 < SEQ / SC_T) SC_PREP(c + 1);
            __syncthreads();
        }
#undef SC_LOAD
#undef SC_PREP
    }
}


constexpr int C2_AT = 0, C2_RT = 2048, C2_BK = 4096, C2_VT = 8192, C2_NAK = 10240, C2_NRBK = 10752, C2_MT = 11776, C2_GTV = 12288, C2_BON = 12544, C2_CH = 12800;
constexpr int C2_YS = 8 * C2_CH;
constexpr int C2_PREV = C2_YS + 32768;
constexpr int C2_W2S = C2_PREV + 512, C2_A2S = C2_W2S + 8192;
constexpr int C2_V2S = C2_A2S + 8192;
static_assert(C2_V2S + 8192 <= 163776, "scan LDS");
typedef short s16x4 __attribute__((ext_vector_type(4)));
__device__ __forceinline__ u32x2 tr4(const LAS unsigned char* img, int k0, int lane) {
    return __builtin_bit_cast(u32x2, __builtin_amdgcn_ds_read_tr16_b64_v4i16((LAS s16x4*)(img + (k0 + ((lane & 15) >> 2)) * 32 + (lane & 3) * 8)));
}
__device__ __forceinline__ u32x2 tr4bk(const LAS unsigned char* img, int k0, int lane) {
    return __builtin_bit_cast(u32x2, __builtin_amdgcn_ds_read_tr16_b64_v4i16((LAS s16x4*)(img + (k0 + ((lane & 15) >> 2)) * 64 + (lane & 3) * 16)));
}
__device__ __forceinline__ void wr_row(LAS unsigned char* img, int lane, const unsigned (&w)[8]) {
    *(LAS u32x4*)(img + lane * 32) = (u32x4){w[0], w[1], w[2], w[3]}; *(LAS u32x4*)(img + lane * 32 + 16) = (u32x4){w[4], w[5], w[6], w[7]};
}
__device__ __forceinline__ bf16x8 mk_frag(u32x2 lo, u32x2 hi) { return __builtin_bit_cast(bf16x8, (u32x4){lo.x, lo.y, hi.x, hi.y}); }
__device__ __forceinline__ u32x2 pk4(const f32x4 a) { return (u32x2){pk_bf16(a[0], a[1]), pk_bf16(a[2], a[3])}; }
__device__ __forceinline__ float bf1(unsigned short v) { return __uint_as_float((unsigned)v << 16); }
__device__ __forceinline__ unsigned short f2bf(float x) { return (unsigned short)(pk_bf16(x, 0.f) & 0xffffu); }
__device__ __forceinline__ void st2(LAS unsigned char* p0, LAS unsigned char* p1, float a, float b) { const unsigned w = pk_bf16(a, b); *(LAS unsigned short*)p0 = (unsigned short)w; *(LAS unsigned short*)p1 = (unsigned short)(w >> 16); }
__device__ __forceinline__ void scan2_phase(const Frame& F, int L) {
    const int tid = F.tid, lane = F.lane, wave = F.wave, fr = lane & 15, fq = lane >> 4;
    LAS unsigned char* lds = F.lds;
    for (int unit = F.bid; unit < 256; unit += F.G) {
        int lane_u = lane; asm volatile("" : "+v"(lane_u));
        const int b = unit >> 4, h = unit & 15, ch = h * 64 + lane_u;
        const size_t mrow0 = (size_t)b * SEQ;
        const float c_kk = F.ap->in[14][(size_t)L * D + ch], c_ka = F.ap->in[15][(size_t)L * D + ch], c_rk = F.ap->in[16][(size_t)L * D + ch];
        const float c_mur = F.ap->in[6][(size_t)L * 3200 + ch], c_muk = F.ap->in[6][(size_t)L * 3200 + 1024 + ch];
        f32x4 St[4];
#pragma unroll
        for (int i = 0; i < 4; ++i) St[i] = (f32x4){0.f, 0.f, 0.f, 0.f};
        int tid_u = tid; asm volatile("" : "+v"(tid_u));
        for (int i = tid_u; i < 1024; i += 512) { const int which = i >> 9, e = i & 511;
            *(LAS u32x4*)(lds + C2_W2S + which * 8192 + e * 16) = *(const u32x4*)(F.EAT + (size_t)which * 65536 + (size_t)h * 64 * 64 + e * 8); }
        if (L > 0) for (int e = tid_u; e < 512; e += 512) { const int chl = e >> 3, p = e & 7;
            *(LAS u32x4*)(lds + C2_V2S + e * 16) = *(const u32x4*)(F.EAT + 131072 + (size_t)(h * 64 + chl) * 32 + ((8 * p) & 31)); }
        const float c_muw = F.ap->in[6][(size_t)L * 3200 + 3072 + lane_u], c_mua = F.ap->in[6][(size_t)L * 3200 + 3136 + lane_u], c_muv = F.ap->in[6][(size_t)L * 3200 + 2048 + ch];
        float c_v0[4];
#pragma unroll
        for (int i = 0; i < 4; ++i) c_v0[i] = F.ap->in[11][(size_t)(L > 0 ? L - 1 : 0) * D + h * 64 + 16 * i + (lane_u & 15)];
        float c_w0[4], c_a0[4];
#pragma unroll
        for (int i = 0; i < 4; ++i) { c_w0[i] = F.ap->in[7][(size_t)L * D + h * 64 + 16 * i + (lane_u & 15)]; c_a0[i] = F.ap->in[9][(size_t)L * D + h * 64 + 16 * i + (lane_u & 15)]; }
        __syncthreads();
        const auto rs_raw = __builtin_amdgcn_make_buffer_rsrc((void*)F.RAW, 0, (int)((size_t)M * RAWLD * 2), 0x00020000);
        const auto rs_vf = __builtin_amdgcn_make_buffer_rsrc((void*)F.VF, 0, M * D * 2, 0x00020000);
        const int voh = ch * 32, vol = lane * 32;
#define LDQ(vofs, q, tb) __builtin_bit_cast(u32x4, __builtin_amdgcn_raw_buffer_load_b128(rs_raw, (vofs) + (q) * 16, (int)(tb) * (RAWLD * 32), 0))
#define LDP(vofs, tb) __builtin_amdgcn_raw_buffer_load_b16(rs_raw, (vofs) + 30, (int)(tb) * (RAWLD * 32), 0)
#define QF(q, t) (((t) & 1) ? bf_hi((q)[(t) >> 1]) : bf_lo((q)[(t) >> 1]))
#define QP(q, pv, i) (((i) == 0) ? bf1(pv) : QF(q, ((i) > 0 ? (i) - 1 : 0)))

        for (int g = 0; g < SEQ / 128; ++g) {
            if (tid < 8) *(volatile LAS unsigned*)(lds + C2_PREV + tid * 4) = 0u;
            {
                int lane_ = lane; asm volatile("" : "+v"(lane_));
                const int fr = lane_ & 15, fq = lane_ >> 4;
                const int m0 = (int)mrow0 + g * 128 + wave * 16;
                LAS unsigned char* cb = lds + wave * C2_CH;
                LAS unsigned char* scr = lds + C2_YS + wave * 4096;
                const int tb = m0 >> 4, tbp = (tb > 0) ? tb - 1 : 0;
                unsigned rrq[8], krq[8], aaq[8], eeq[8], vvp[8];
                unsigned vrq[8], xrq[8], mixq[8]; unsigned short vprev, xprev;
                {
                    unsigned wdq[8], adq[8]; unsigned short wprev, aprev;
                    const bool has_prev = (g > 0) || (wave > 0);
                    const unsigned short pm = has_prev ? (unsigned short)0xffffu : (unsigned short)0;
                    wprev = LDP(vol + 3072 * 32, tbp) & pm; aprev = LDP(vol + 3136 * 32, tbp) & pm;
#pragma unroll
                    for (int q = 0; q < 2; ++q) { const u32x4 w4 = LDQ(vol + 3072 * 32, q, tb), a4 = LDQ(vol + 3136 * 32, q, tb);
#pragma unroll
                        for (int e = 0; e < 4; ++e) { wdq[4 * q + e] = w4[e]; adq[4 * q + e] = a4[e]; } }
                    {
                        vprev = LDP(voh + 2048 * 32, tbp) & pm; xprev = LDP(vol + 3200 * 32, tbp) & pm;
#pragma unroll
                        for (int q = 0; q < 2; ++q) { const u32x4 v4 = LDQ(voh + 2048 * 32, q, tb), x4 = LDQ(vol + 3200 * 32, q, tb);
                            const u32x4 f4 = __builtin_bit_cast(u32x4, __builtin_amdgcn_raw_buffer_load_b128(rs_vf, voh + q * 16, tb * (D * 32), 0));
#pragma unroll
                            for (int e = 0; e < 4; ++e) { vrq[4 * q + e] = v4[e]; xrq[4 * q + e] = x4[e]; mixq[4 * q + e] = f4[e]; } }
                    }
                    __builtin_amdgcn_sched_barrier(0);
                    unsigned twp[8], adp[8];
#pragma unroll
                    for (int t = 0; t < 16; t += 2) {
                        const float w0_ = QP(wdq, wprev, t), w1_ = QP(wdq, wprev, t + 1), w2_ = QP(wdq, wprev, t + 2), a0_ = QP(adq, aprev, t), a1_ = QP(adq, aprev, t + 1), a2_ = QP(adq, aprev, t + 2);
                        twp[t >> 1] = pk_bf16(tanhf_(w1_ + c_muw * (w0_ - w1_)), tanhf_(w2_ + c_muw * (w1_ - w2_)));
                        adp[t >> 1] = pk_bf16(a1_ + c_mua * (a0_ - a1_), a2_ + c_mua * (a1_ - a2_));
                    }
                    wr_row(scr, lane, twp); wr_row(scr + 2048, lane, adp);
                    asm volatile("s_waitcnt lgkmcnt(0)" ::: "memory");
                    f32x4 le[4], la[4];
#pragma unroll
                    for (int i = 0; i < 4; ++i) { le[i] = (f32x4){0.f, 0.f, 0.f, 0.f}; la[i] = le[i]; }
#pragma unroll
                    for (int s2 = 0; s2 < 2; ++s2) {
                        const int k0 = 32 * s2 + 8 * fq;
                        const bf16x8 fw = mk_frag(tr4(scr, k0, lane), tr4(scr, k0 + 4, lane)), fa = mk_frag(tr4(scr + 2048, k0, lane), tr4(scr + 2048, k0 + 4, lane));
#pragma unroll
                        for (int i = 0; i < 4; ++i) {
                            le[i] = __builtin_amdgcn_mfma_f32_16x16x32_bf16(fw, *(const LAS bf16x8*)(lds + C2_W2S + (16 * i + fr) * 128 + (32 * s2 + 8 * fq) * 2), le[i], 0, 0, 0);
                            la[i] = __builtin_amdgcn_mfma_f32_16x16x32_bf16(fa, *(const LAS bf16x8*)(lds + C2_A2S + (16 * i + fr) * 128 + (32 * s2 + 8 * fq) * 2), la[i], 0, 0, 0);
                        }
                    }
#pragma unroll
                    for (int i = 0; i < 4; ++i)
                        {
                            *(LAS u32x2*)(scr + (16 * i + fr) * 32 + fq * 8) = (u32x2){pk_bf16(0.60653065971f * sigmoidf_(le[i][0] + c_w0[i]), 0.60653065971f * sigmoidf_(le[i][1] + c_w0[i])), pk_bf16(0.60653065971f * sigmoidf_(le[i][2] + c_w0[i]), 0.60653065971f * sigmoidf_(le[i][3] + c_w0[i]))};
                            *(LAS u32x2*)(scr + 2048 + (16 * i + fr) * 32 + fq * 8) = (u32x2){pk_bf16(sigmoidf_(la[i][0] + c_a0[i]), sigmoidf_(la[i][1] + c_a0[i])), pk_bf16(sigmoidf_(la[i][2] + c_a0[i]), sigmoidf_(la[i][3] + c_a0[i]))};
                        }
                    asm volatile("s_waitcnt lgkmcnt(0)" ::: "memory");
#pragma unroll
                    for (int q = 0; q < 2; ++q) { const u32x4 we = *(const LAS u32x4*)(scr + lane * 32 + q * 16), wa = *(const LAS u32x4*)(scr + 2048 + lane * 32 + q * 16);
#pragma unroll
                        for (int e = 0; e < 4; ++e) { eeq[4 * q + e] = we[e]; aaq[4 * q + e] = wa[e]; } }
                    asm volatile("s_waitcnt lgkmcnt(0)" ::: "memory");
                }
                unsigned tch[7];
                {   const int tbn = ((int)mrow0 + (g + 1 < SEQ / 128 ? g + 1 : g) * 128 + wave * 16) >> 4;
                    tch[0] = __builtin_amdgcn_raw_buffer_load_b32(rs_raw, vol + 3072 * 32, tbn * (RAWLD * 32), 0); tch[1] = __builtin_amdgcn_raw_buffer_load_b32(rs_raw, vol + 3136 * 32, tbn * (RAWLD * 32), 0);
                    tch[2] = __builtin_amdgcn_raw_buffer_load_b32(rs_raw, vol + 3200 * 32, tbn * (RAWLD * 32), 0); tch[3] = __builtin_amdgcn_raw_buffer_load_b32(rs_raw, voh, tbn * (RAWLD * 32), 0);
                    tch[4] = __builtin_amdgcn_raw_buffer_load_b32(rs_raw, voh + 1024 * 32, tbn * (RAWLD * 32), 0); tch[5] = __builtin_amdgcn_raw_buffer_load_b32(rs_raw, voh + 2048 * 32, tbn * (RAWLD * 32), 0);
                    tch[6] = __builtin_amdgcn_raw_buffer_load_b32(rs_vf, voh, tbn * (D * 32), 0); }
                {
                    __builtin_amdgcn_sched_barrier(0);
#pragma unroll
                    for (int q = 0; q < 2; ++q) { const u32x4 r4 = LDQ(voh, q, tb), k4 = LDQ(voh + 1024 * 32, q, tb);
#pragma unroll
                        for (int e = 0; e < 4; ++e) { rrq[4 * q + e] = r4[e]; krq[4 * q + e] = k4[e]; } }
                    __builtin_amdgcn_sched_barrier(0);
                    if (L > 0) {
                        unsigned xp[8];
#pragma unroll
                        for (int i = 0; i < 8; ++i) { const unsigned xs = (i == 0) ? ((unsigned)xprev | (xrq[0] << 16)) : __builtin_amdgcn_alignbit(xrq[i], xrq[i > 0 ? i - 1 : 0], 16);
                            xp[i] = (lane < 32) ? xrq[i] : xs; }
                        wr_row(scr, lane, xp);
                        asm volatile("s_waitcnt lgkmcnt(0)" ::: "memory");
                        f32x4 mx[4];
#pragma unroll
                        for (int i = 0; i < 4; ++i) mx[i] = (f32x4){0.f, 0.f, 0.f, 0.f};
#pragma unroll
                        for (int s2 = 0; s2 < 2; ++s2) { const bf16x8 fx = mk_frag(tr4(scr, 32 * s2 + 8 * fq, lane), tr4(scr, 32 * s2 + 8 * fq + 4, lane));
#pragma unroll
                            for (int i = 0; i < 4; ++i) mx[i] = __builtin_amdgcn_mfma_f32_16x16x32_bf16(fx, *(const LAS bf16x8*)(lds + C2_V2S + (16 * i + fr) * 128 + (32 * s2 + 8 * fq) * 2), mx[i], 0, 0, 0); }
#pragma unroll
                        for (int i = 0; i < 4; ++i)
                            *(LAS u32x2*)(scr + (16 * i + fr) * 32 + fq * 8) = (u32x2){pk_bf16(sigmoidf_(mx[i][0] + c_v0[i]), sigmoidf_(mx[i][1] + c_v0[i])), pk_bf16(sigmoidf_(mx[i][2] + c_v0[i]), sigmoidf_(mx[i][3] + c_v0[i]))};
                        asm volatile("s_waitcnt lgkmcnt(0)" ::: "memory");
                    }
                    if (L > 0) {
                        const u32x4 mw0 = *(const LAS u32x4*)(scr + lane * 32), mw1 = *(const LAS u32x4*)(scr + lane * 32 + 16);
#pragma unroll
                        for (int t = 0; t < 16; t += 2) {
                            const float v0_ = QP(vrq, vprev, t), v1_ = QP(vrq, vprev, t + 1), v2_ = QP(vrq, vprev, t + 2), vs0 = v1_ + c_muv * (v0_ - v1_), vs1 = v2_ + c_muv * (v1_ - v2_);
                            const unsigned mwp = (t < 8) ? mw0[t >> 1] : mw1[(t - 8) >> 1];
                            const float mix0 = bf_lo(mwp), mix1 = bf_hi(mwp);
                            vvp[t >> 1] = pk_bf16(vs0 + (QF(mixq, t) - vs0) * mix0, vs1 + (QF(mixq, t + 1) - vs1) * mix1);
                        }
                    } else {
#pragma unroll
                        for (int t = 0; t < 16; t += 2) {
                            const float v0_ = QP(vrq, vprev, t), v1_ = QP(vrq, vprev, t + 1), v2_ = QP(vrq, vprev, t + 2);
                            vvp[t >> 1] = pk_bf16(v1_ + c_muv * (v0_ - v1_), v2_ + c_muv * (v1_ - v2_));
                        }
#pragma unroll
                        for (int q = 0; q < 2; ++q) __builtin_amdgcn_raw_buffer_store_b128(__builtin_bit_cast(decltype(__builtin_amdgcn_raw_buffer_load_b128(rs_vf, 0, 0, 0)), (u32x4){vvp[4 * q], vvp[4 * q + 1], vvp[4 * q + 2], vvp[4 * q + 3]}), rs_vf, voh + q * 16, tb * (D * 32), 0);
                    }
                    asm volatile("s_waitcnt lgkmcnt(0)" ::: "memory");
                }
                float rprev = 0.f, kprev = 0.f;
                {
                    const float rp_g = bf1(LDP(voh, tbp)), kp_g = bf1(LDP(voh + 1024 * 32, tbp));
                    rprev = (wave > 0 || g > 0) ? rp_g : 0.f; kprev = (wave > 0 || g > 0) ? kp_g : 0.f;
                }
                const float rprev0 = rprev, kprev0 = kprev;
                float sql = 0.f, pbl = 0.f; unsigned sqp[4], pbp[4];
#pragma unroll
                for (int t = 0; t < 16; ++t) {
                    const float r_c = QF(rrq, t), k_c = QF(krq, t);
                    const float rs = r_c + c_mur * (rprev - r_c), ks = k_c + c_muk * (kprev - k_c); rprev = r_c; kprev = k_c;
                    const float al = QF(aaq, t), kmod = ks * (1.0f + (al - 1.0f) * c_ka), kkv = ks * c_kk;
                    if (t & 1) { sqp[(t >> 1) & 3] = pk_bf16(sql, kkv * kkv); pbp[(t >> 1) & 3] = pk_bf16(pbl, rs * kmod * c_rk); }
                    if ((t & 7) == 7) { *(LAS u32x4*)(scr + lane * 32 + (t >> 3) * 16) = (u32x4){sqp[0], sqp[1], sqp[2], sqp[3]}; *(LAS u32x4*)(scr + 2048 + lane * 32 + (t >> 3) * 16) = (u32x4){pbp[0], pbp[1], pbp[2], pbp[3]}; }
                    else { sql = kkv * kkv; pbl = rs * kmod * c_rk; }
                }
                asm volatile("s_waitcnt lgkmcnt(0)" ::: "memory");
                {
                    f32x4 sn = (f32x4){0.f, 0.f, 0.f, 0.f}, sb = sn;
                    const bf16x8 ones = __builtin_bit_cast(bf16x8, (u32x4){0x3f803f80u, 0x3f803f80u, 0x3f803f80u, 0x3f803f80u});
#pragma unroll
                    for (int s2 = 0; s2 < 2; ++s2) { const int k0 = 32 * s2 + 8 * fq;
                        sn = __builtin_amdgcn_mfma_f32_16x16x32_bf16(mk_frag(tr4(scr, k0, lane), tr4(scr, k0 + 4, lane)), ones, sn, 0, 0, 0);
                        sb = __builtin_amdgcn_mfma_f32_16x16x32_bf16(mk_frag(tr4(scr + 2048, k0, lane), tr4(scr + 2048, k0 + 4, lane)), ones, sb, 0, 0, 0); }
                    if (fr == 0) { *(LAS f32x4*)(cb + C2_BON + 64 + fq * 16) = sn; *(LAS f32x4*)(cb + C2_BON + fq * 16) = sb; }
                }
                asm volatile("s_waitcnt lgkmcnt(0)" ::: "memory");
                f32x4 n2v[4];
#pragma unroll
                for (int i = 0; i < 4; ++i) n2v[i] = *(const LAS f32x4*)(cb + C2_BON + 64 + i * 16);
#pragma unroll
                for (int i = 0; i < 7; ++i) asm volatile("" :: "v"(tch[i]));
                float lg = 0.f, gcarry = 1.0f;
                unsigned atp[4], rtp[4]; unsigned bkp[16];
                float btl = 0.f, ktl = 0.f, atl = 0.f, rtl = 0.f;
                rprev = rprev0; kprev = kprev0;
#pragma unroll
                for (int t = 0; t < 16; ++t) {
                    const float r_c = QF(rrq, t), k_c = QF(krq, t);
                    const float rs = r_c + c_mur * (rprev - r_c), ks = k_c + c_muk * (kprev - k_c); rprev = r_c; kprev = k_c;
                    const float al = QF(aaq, t), kmod = ks * (1.0f + (al - 1.0f) * c_ka), kkv = ks * c_kk;
                    const float kkn = kkv * __builtin_amdgcn_rsqf(fmaxf(n2v[t >> 2][t & 3], 1e-24f));
                    const float gprev = gcarry; lg -= QF(eeq, t);
                    const float gcur = __expf(lg), ginv = __builtin_amdgcn_rcpf(gcur); gcarry = gcur;
                    const float at = -kkn * gprev, rt = rs * gcur, bt = kkn * al * ginv, kt = kmod * ginv;
                    if (t & 1) {
                        atp[(t >> 1) & 3] = pk_bf16(atl, at); rtp[(t >> 1) & 3] = pk_bf16(rtl, rt); bkp[t >> 1] = pk_bf16(btl, bt); bkp[8 + (t >> 1)] = pk_bf16(ktl, kt);
                        if ((t & 7) == 7) { *(LAS u32x4*)(cb + C2_AT + lane * 32 + (t >> 3) * 16) = (u32x4){atp[0], atp[1], atp[2], atp[3]}; *(LAS u32x4*)(cb + C2_RT + lane * 32 + (t >> 3) * 16) = (u32x4){rtp[0], rtp[1], rtp[2], rtp[3]}; }
                    } else { btl = bt; ktl = kt; atl = at; rtl = rt; }
                }
                *(LAS float*)(cb + C2_GTV + lane * 4) = __expf(lg);
#pragma unroll
                for (int q = 0; q < 4; ++q) *(LAS u32x4*)(cb + C2_BK + lane * 64 + q * 16) = (u32x4){bkp[2 * q], bkp[2 * q + 1], bkp[8 + 2 * q], bkp[8 + 2 * q + 1]};
#pragma unroll
                for (int q = 0; q < 2; ++q) *(LAS u32x4*)(cb + C2_VT + lane * 32 + q * 16) = (u32x4){vvp[4 * q], vvp[4 * q + 1], vvp[4 * q + 2], vvp[4 * q + 3]};
                asm volatile("s_waitcnt lgkmcnt(0)" ::: "memory");
                f32x4 nab = (f32x4){0.f, 0.f, 0.f, 0.f}, nabT = nab, nakT = nab, nrbT = nab, nrkT = nab;
#pragma unroll
                for (int s2 = 0; s2 < 2; ++s2) {
                    const int k0 = 32 * s2 + 8 * fq;
                    const bf16x8 fa = mk_frag(tr4(cb + C2_AT, k0, lane), tr4(cb + C2_AT, k0 + 4, lane)), fr_ = mk_frag(tr4(cb + C2_RT, k0, lane), tr4(cb + C2_RT, k0 + 4, lane));
                    const bf16x8 fb = mk_frag(tr4bk(cb + C2_BK, k0, lane), tr4bk(cb + C2_BK, k0 + 4, lane)), fk = mk_frag(tr4bk(cb + C2_BK + 8, k0, lane), tr4bk(cb + C2_BK + 8, k0 + 4, lane));
                    nab = __builtin_amdgcn_mfma_f32_16x16x32_bf16(fa, fb, nab, 0, 0, 0); nabT = __builtin_amdgcn_mfma_f32_16x16x32_bf16(fb, fa, nabT, 0, 0, 0);
                    nakT = __builtin_amdgcn_mfma_f32_16x16x32_bf16(fk, fa, nakT, 0, 0, 0);
                    nrbT = __builtin_amdgcn_mfma_f32_16x16x32_bf16(fb, fr_, nrbT, 0, 0, 0); nrkT = __builtin_amdgcn_mfma_f32_16x16x32_bf16(fk, fr_, nrkT, 0, 0, 0);
                }
                const u32x2 z2 = (u32x2){0u, 0u};
                f32x4 dg;
#pragma unroll
                for (int r = 0; r < 4; ++r) {
                    const int c = 4 * fq + r;
                    dg[r] = (c == fr) ? 1.f : 0.f;
                    nakT[r] = (c < fr) ? nakT[r] : 0.f; nabT[r] = (c < fr) ? nabT[r] : 0.f; nab[r] = (fr < c) ? nab[r] : 0.f;
                    nrbT[r] = (c <= fr) ? nrbT[r] : 0.f; nrkT[r] = (c <= fr) ? nrkT[r] : 0.f;
                }
                *(LAS u32x2*)(cb + C2_NAK + fr * 32 + fq * 8) = pk4(nakT);
                { const u32x2 wb = pk4(nrbT), wk = pk4(nrkT); *(LAS u32x4*)(cb + C2_NRBK + fr * 64 + fq * 16) = (u32x4){wb.x, wb.y, wk.x, wk.y}; }
#define FRG(X) mk_frag(pk4(X), z2)
#define MM(X, Y) __builtin_amdgcn_mfma_f32_16x16x32_bf16(FRG(X), FRG(Y), (f32x4){0.f, 0.f, 0.f, 0.f}, 0, 0, 0)
                {
                    const f32x4 p2 = MM(nabT, nab), q2 = MM(nab, nabT);
                    const f32x4 p4 = MM(q2, p2), q4 = MM(p2, q2);
                    const f32x4 p8 = MM(q4, p4);
                    const f32x4 m1 = MM(nabT + dg, p2 + dg);
                    const f32x4 m2t = MM(p8 + dg, q4 + dg);
                    const f32x4 mt = MM(m1, m2t);
                    *(LAS u32x2*)(cb + C2_MT + fr * 32 + fq * 8) = pk4(mt);
                }
#undef FRG
#undef MM
            }
            __syncthreads();
            if (wave < 4) {
                const int vrow = 16 * wave + fr;
                const u32x2 z2 = (u32x2){0u, 0u};
#define CH_DECL(P) u32x2 P##nak, P##mt, P##vq; bf16x8 P##fa0, P##fa1, P##fr0, P##fr1, P##nrbk, P##bk0, P##bk1, P##bk2, P##bk3; f32x4 P##g0, P##g1, P##g2, P##g3;
#define CH_LOAD(P, c_) do { const LAS unsigned char* cb = lds + (c_) * C2_CH; \
                    P##vq = *(const LAS u32x2*)(cb + C2_VT + vrow * 32 + fq * 8); P##nak = *(const LAS u32x2*)(cb + C2_NAK + fr * 32 + fq * 8); P##mt = *(const LAS u32x2*)(cb + C2_MT + fr * 32 + fq * 8); \
                    P##fa0 = mk_frag(tr4(cb + C2_AT, 4 * fq, lane), tr4(cb + C2_AT, 16 + 4 * fq, lane)); P##fa1 = mk_frag(tr4(cb + C2_AT, 32 + 4 * fq, lane), tr4(cb + C2_AT, 48 + 4 * fq, lane)); \
                    P##fr0 = mk_frag(tr4(cb + C2_RT, 4 * fq, lane), tr4(cb + C2_RT, 16 + 4 * fq, lane)); P##fr1 = mk_frag(tr4(cb + C2_RT, 32 + 4 * fq, lane), tr4(cb + C2_RT, 48 + 4 * fq, lane)); \
                    P##nrbk = *(const LAS bf16x8*)(cb + C2_NRBK + fr * 64 + fq * 16); \
                    P##bk0 = *(const LAS bf16x8*)(cb + C2_BK + (fr) * 64 + fq * 16); P##bk1 = *(const LAS bf16x8*)(cb + C2_BK + (16 + fr) * 64 + fq * 16); \
                    P##bk2 = *(const LAS bf16x8*)(cb + C2_BK + (32 + fr) * 64 + fq * 16); P##bk3 = *(const LAS bf16x8*)(cb + C2_BK + (48 + fr) * 64 + fq * 16); \
                    P##g0 = *(const LAS f32x4*)(cb + C2_GTV + (4 * fq) * 4); P##g1 = *(const LAS f32x4*)(cb + C2_GTV + (16 + 4 * fq) * 4); \
                    P##g2 = *(const LAS f32x4*)(cb + C2_GTV + (32 + 4 * fq) * 4); P##g3 = *(const LAS f32x4*)(cb + C2_GTV + (48 + 4 * fq) * 4); } while (0)
#define CH_STEP(P, c_) do { \
                    const bf16x8 bs0 = mk_frag(pk4(St[0]), pk4(St[1])), bs1 = mk_frag(pk4(St[2]), pk4(St[3]));     \
                    f32x4 acc = (f32x4){0.f, 0.f, 0.f, 0.f}, y = acc, u = acc; \
                    acc = __builtin_amdgcn_mfma_f32_16x16x32_bf16(mk_frag(P##nak, z2), mk_frag(P##vq, z2), acc, 0, 0, 0); \
                    acc = __builtin_amdgcn_mfma_f32_16x16x32_bf16(P##fa0, bs0, acc, 0, 0, 0); \
                    acc = __builtin_amdgcn_mfma_f32_16x16x32_bf16(P##fa1, bs1, acc, 0, 0, 0); \
                    y = __builtin_amdgcn_mfma_f32_16x16x32_bf16(P##fr0, bs0, y, 0, 0, 0); \
                    y = __builtin_amdgcn_mfma_f32_16x16x32_bf16(P##fr1, bs1, y, 0, 0, 0); \
                    u = __builtin_amdgcn_mfma_f32_16x16x32_bf16(mk_frag(P##mt, z2), mk_frag(pk4(acc), z2), u, 0, 0, 0); \
                    const bf16x8 buv = mk_frag(pk4(u), P##vq); \
                    St[0] = __builtin_amdgcn_mfma_f32_16x16x32_bf16(P##bk0, buv, St[0], 0, 0, 0); St[1] = __builtin_amdgcn_mfma_f32_16x16x32_bf16(P##bk1, buv, St[1], 0, 0, 0); \
                    St[2] = __builtin_amdgcn_mfma_f32_16x16x32_bf16(P##bk2, buv, St[2], 0, 0, 0); St[3] = __builtin_amdgcn_mfma_f32_16x16x32_bf16(P##bk3, buv, St[3], 0, 0, 0); \
                    y = __builtin_amdgcn_mfma_f32_16x16x32_bf16(P##nrbk, buv, y, 0, 0, 0); \
                    St[0] = St[0] * P##g0; St[1] = St[1] * P##g1; St[2] = St[2] * P##g2; St[3] = St[3] * P##g3; \
                    _Pragma("unroll") for (int r = 0; r < 4; ++r) *(LAS float*)(lds + C2_YS + (size_t)(((c_) * 16 + 4 * fq + r) * 64 + vrow) * 4) = y[r]; \
                    if (lane == 0) asm volatile("ds_add_u32 %0, %1" :: "v"((unsigned)(size_t)(lds + C2_PREV + (c_) * 4)), "v"(1u) : "memory");     } while (0)
                CH_DECL(A) CH_DECL(B)
                CH_LOAD(A, 0);
                for (int c = 0; c < 8; c += 2) {
                    CH_LOAD(B, c + 1);
                    CH_STEP(A, c);
                    if (c + 2 < 8) CH_LOAD(A, c + 2);
                    CH_STEP(B, c + 1);
                }
#undef CH_DECL
#undef CH_LOAD
#undef CH_STEP
            } else {
                int lane_p = lane; asm volatile("" : "+v"(lane_p));
                const int pj = lane_p & 3;
                f32x4 lw[4], lb[4];
#pragma unroll
                for (int i = 0; i < 4; ++i) { lw[i] = *(const f32x4*)(F.ap->in[17] + (size_t)L * D + h * 64 + 16 * pj + 4 * i); lb[i] = *(const f32x4*)(F.ap->in[18] + (size_t)L * D + h * 64 + 16 * pj + 4 * i); }
                for (int cc = wave - 4; cc < 8; cc += 4) {
                    const LAS unsigned char* cb = lds + cc * C2_CH;
                    const int tl = lane_p >> 2, ptok = cc * 16 + tl;
                    while (*(volatile LAS unsigned*)(lds + C2_PREV + cc * 4) < 4u) __builtin_amdgcn_s_sleep(1);
                    f32x4 y4[4]; float sm = 0.f;
#pragma unroll
                    for (int i = 0; i < 4; ++i) { y4[i] = *(const volatile LAS f32x4*)(lds + C2_YS + (size_t)(ptok * 64 + 16 * pj + 4 * i) * 4); sm += (y4[i][0] + y4[i][1]) + (y4[i][2] + y4[i][3]); }
                    sm += dppf<0xB1>(sm); sm += dppf<0x4E>(sm);
                    const float mean = sm * (1.0f / 64.0f); float vs = 0.f;
#pragma unroll
                    for (int i = 0; i < 4; ++i) { y4[i] = y4[i] - mean; vs += (y4[i][0] * y4[i][0] + y4[i][1] * y4[i][1]) + (y4[i][2] * y4[i][2] + y4[i][3] * y4[i][3]); }
                    vs += dppf<0xB1>(vs); vs += dppf<0x4E>(vs);
                    const float rstd = __builtin_amdgcn_rsqf(vs * (1.0f / 64.0f) + LNX_EPS);
                    const float bon = *(const LAS float*)(cb + C2_BON + tl * 4);
                    unsigned ow[8];
#pragma unroll
                    for (int i = 0; i < 4; ++i) {
                        float z[4];
#pragma unroll
                        for (int e = 0; e < 4; ++e) { const float vvl = bf1(*(const LAS unsigned short*)(cb + C2_VT + (16 * pj + 4 * i + e) * 32 + tl * 2)); z[e] = y4[i][e] * rstd * lw[i][e] + lb[i][e] + bon * vvl; }
                        ow[2 * i] = pk_bf16(z[0], z[1]); ow[2 * i + 1] = pk_bf16(z[2], z[3]);
                    }
                    bf16_t* zp = F.S2 + (mrow0 + (size_t)g * 128 + ptok) * D + h * 64 + 16 * pj;
                    *(u32x4*)zp = (u32x4){ow[0], ow[1], ow[2], ow[3]}; *(u32x4*)(zp + 8) = (u32x4){ow[4], ow[5], ow[6], ow[7]};
                }
            }
            __syncthreads();
        }
    }
}

constexpr int LDS_BYTES = 163840;
constexpr int LDSCTL_OFF = 163776;
constexpr int PPL = 15;
constexpr int NPHASE = NLAYER * PPL + 1;

template <int PH> __device__ __forceinline__ void run_phase(Frame& F, int L) {
    using namespace pg8;
    { int t_ = threadIdx.x; asm volatile("" : "+v"(t_)); F.tid = t_; F.lane = t_ & 63; F.wave = __builtin_amdgcn_readfirstlane(t_ >> 6);
      int g_ = gridDim.x, b_ = blockIdx.x; asm volatile("" : "+s"(g_), "+s"(b_)); F.G = g_; F.bid = b_;
      ArgsP a_ = (ArgsP)__builtin_amdgcn_kernarg_segment_ptr(); asm volatile("" : "+s"(a_)); F.ap = a_; F.X = a_->out; set_ws(F, a_->ws); }
    if constexpr (PH == 0) {
        convert_weights(F, L);
        if (L == 0) rmsnorm_rows(F, F.ap->in[0], F.ap->in[1], F.S1, (bf16_t*)F.X);
        else rmsnorm_rows_bf(F, (const bf16_t*)F.X, F.ap->in[1] + (size_t)L * D, F.S1);
    } else if constexpr (PH == 1) {
        Gemm g{F.WinT + (size_t)R_RKV * D, F.S1, D, D, D, RAWLD / 256, M / 256, 0}; StaticOrder S; S.init(g.nM, g.nN, F.G, F.bid);
        EpiRawT E{F.RAW, RAWLD};
        gemm_phase(F.lds, g, S, E);
    } else if constexpr (PH == 2) {
    } else if constexpr (PH == 3) {
    } else if constexpr (PH == 4) {
        scan2_phase(F, L);
    } else if constexpr (PH == 5) {
    } else if constexpr (PH == 6) {
        Gemm g{F.S1, F.WinT, D, D, D, M / 256, 20, 0}; StaticOrder S; S.init(g.nM, g.nN, F.G, F.bid);
        EpiG<ACT_NONE, ACT_SILU, ACT_SILU, ACT_SIGMOID, ACT_SIGMOID> E{{F.RAW, D, nullptr, nullptr, nullptr, 0, nullptr, 0}, {F.RAWB, D, nullptr, nullptr, nullptr, 0, nullptr, 0}, 1024, {F.S2, D, nullptr, nullptr, F.S2, D, nullptr, 0}, 2048,
            {F.S3, D, nullptr, nullptr, nullptr, 0, nullptr, 0}, 3072, {F.RAW + (size_t)2 * M * D, D, nullptr, nullptr, nullptr, 0, nullptr, 0}, 4096};
        gemm_phase(F.lds, g, S, E);
    } else if constexpr (PH == 7) {
        Gemm g{F.S2, F.WrpT, D, D, D, M / 256, 4, 0}; StaticOrder S; S.init(g.nM, g.nN, F.G, F.bid);
        EpiG<ACT_NONE, ACT_NONE> E{{F.S3, D, nullptr, nullptr, F.S3, D, nullptr, 0}, {}, 1 << 30};
        gemm_phase(F.lds, g, S, E);
    } else if constexpr (PH == 8) {
    } else if constexpr (PH == 9) {
    } else if constexpr (PH == 10) {
        poold_phase(F, F.RAW, F.RAWB, F.ap->in[4] + (size_t)L * D);
    } else if constexpr (PH == 11) {
    } else if constexpr (PH == 12) {
        Gemm g{F.RAWB, F.WppT, D, D, D, M / 256, 4, 0}; StaticOrder S; S.init(g.nM, g.nN, F.G, F.bid);
        EpiG<ACT_NONE, ACT_NONE> E{{F.RAW, D, nullptr, nullptr, F.RAW + (size_t)2 * M * D, D, F.S3, D}, {}, 1 << 30};
        gemm_phase(F.lds, g, S, E);
    } else if constexpr (PH == 13) {
    } else if constexpr (PH == 14) {
        Gemm g{F.RAW, F.WoutT, D, D, D, M / 256, 4, 0}; StaticOrder S; S.init(g.nM, g.nN, F.G, F.bid);
        EpiG<ACT_NONE, ACT_NONE> E{{L == NLAYER - 1 ? F.S2 : (bf16_t*)F.X, D, nullptr, nullptr, nullptr, 0, (const bf16_t*)F.X, D}, {}, 1 << 30};
        gemm_phase(F.lds, g, S, E);
    } else {
        final_norm(F, F.S2);
    }
}
__device__ __forceinline__ void frame_init(Frame& F, unsigned char* lds_raw) {
    F.lds = (LAS unsigned char*)lds_raw;
    F.tid = threadIdx.x; F.lane = F.tid & 63; F.wave = __builtin_amdgcn_readfirstlane(F.tid >> 6); F.G = gridDim.x; F.bid = blockIdx.x;
    F.ap = (ArgsP)__builtin_amdgcn_kernarg_segment_ptr();
    F.X = F.ap->out;
    set_ws(F, F.ap->ws);
}
#ifndef PROBE_STAGE
#define PROBE_STAGE -1
#endif
#if MK_PER_PHASE
__global__ void __launch_bounds__(512, 2) mk_dump(Args args, size_t ws_off, int ld, int rowmask) {
    const bf16_t* src = (const bf16_t*)(args.ws + ws_off);
    for (size_t it = (size_t)blockIdx.x * 512 + threadIdx.x; it < (size_t)M * 512; it += (size_t)gridDim.x * 512) {
        const size_t m = it >> 9; const int c = (int)(it & 511) * 2; const unsigned w = *(const unsigned*)(src + (m & (size_t)rowmask) * ld + (ld == 256 ? (c & 255) : c));
        args.out[m * D + c] = 1000.f * bf_lo(w); args.out[m * D + c + 1] = 1000.f * bf_hi(w);
    }
}
template <int PH> __global__ void __launch_bounds__(512, 2) mk_phase(Args args) {
    extern __shared__ __attribute__((aligned(16))) unsigned char lds_raw[];
    Frame F; frame_init(F, lds_raw);
    run_phase<PH>(F, F.ap->ph_lo);
}
#else
__global__ void __launch_bounds__(512, 2) mk_fwd(Args args) {
    extern __shared__ __attribute__((aligned(16))) unsigned char lds_raw[];
    Frame F; frame_init(F, lds_raw);
    volatile LAS unsigned* ctlw = (volatile LAS unsigned*)(F.lds + LDSCTL_OFF);
    if (F.tid < 16) ctlw[F.tid] = 0u;
    __syncthreads();
    XcdBarrier bar = xcd_barrier_post((unsigned*)(F.ws + WS_CTL), ctlw);
    for (int L = 0; L < NLAYER; ++L) {
        run_phase<0>(F, L); xcd_barrier(bar);
        run_phase<1>(F, L); xcd_barrier(bar);
        run_phase<4>(F, L); xcd_barrier(bar);
        run_phase<6>(F, L); xcd_barrier(bar);
        run_phase<7>(F, L); xcd_barrier(bar);
        run_phase<10>(F, L); xcd_barrier(bar);
        run_phase<12>(F, L); xcd_barrier(bar);
        run_phase<14>(F, L); xcd_barrier(bar);
    }
    run_phase<15>(F, 0);
}
#endif

#if MK_PER_PHASE
template <int PH> static void launch_phase(int grid, hipStream_t stream, Args a, int L) { if (PH == 2 || PH == 3 || PH == 5 || PH == 11) return; a.ph_lo = L; a.ph_hi = PH; hipLaunchKernelGGL(mk_phase<PH>, dim3(grid), dim3(512), LDS_BYTES, stream, a); }
template <int PH> static bool set_lds() { return hipFuncSetAttribute((const void*)mk_phase<PH>, hipFuncAttributeMaxDynamicSharedMemorySize, LDS_BYTES) == hipSuccess; }
#endif
extern "C" void kernel_launch(void* const* d_in, const int* in_sizes, int n_in, void* d_out, int out_size, void* d_ws, size_t ws_size, hipStream_t stream) {
    static int grid = 0;
    if (grid == 0) {
        if (n_in != 22 || in_sizes[0] != M * D || out_size != M * D || ws_size < WS_END) { fprintf(stderr, "kernel_launch: unexpected shapes / workspace (%d inputs, ws %zu)\n", n_in, ws_size); grid = -1; return; }
        int dev = 0, cus = 0;
        if (hipGetDevice(&dev) != hipSuccess || hipDeviceGetAttribute(&cus, hipDeviceAttributeMultiprocessorCount, dev) != hipSuccess) { grid = -1; return; }
#if MK_PER_PHASE
        bool ok = set_lds<0>() && set_lds<1>() && set_lds<2>() && set_lds<3>() && set_lds<4>() && set_lds<5>() && set_lds<6>() && set_lds<7>() && set_lds<8>() && set_lds<9>() && set_lds<10>() && set_lds<11>()
               && set_lds<12>() && set_lds<13>() && set_lds<14>() && set_lds<15>();
        if (!ok) { fprintf(stderr, "kernel_launch: hipFuncSetAttribute failed\n"); grid = -1; return; }
#else
        int per_cu = 0;
        if (hipFuncSetAttribute((const void*)mk_fwd, hipFuncAttributeMaxDynamicSharedMemorySize, LDS_BYTES) != hipSuccess) { fprintf(stderr, "kernel_launch: hipFuncSetAttribute failed\n"); grid = -1; return; }
        if (hipOccupancyMaxActiveBlocksPerMultiprocessor(&per_cu, (const void*)mk_fwd, 512, LDS_BYTES) != hipSuccess || per_cu < 1) { fprintf(stderr, "kernel_launch: occupancy query says %d\n", per_cu); }
#endif
        (void)hipGetLastError();
        grid = cus;
    }
    if (grid < 0) return;
    Args a{};
    for (int i = 0; i < 22; ++i) a.in[i] = (const float*)d_in[i];
    a.out = (float*)d_out; a.ws = (unsigned char*)d_ws;
#if MK_PER_PHASE
    if (PROBE_STAGE >= 0) {
        const int L = 0;
        launch_phase<0>(grid, stream, a, L); launch_phase<1>(grid, stream, a, L);
        if (PROBE_STAGE >= 2) launch_phase<2>(grid, stream, a, L);
        if (PROBE_STAGE >= 3) launch_phase<3>(grid, stream, a, L);
        if (PROBE_STAGE >= 4) launch_phase<4>(grid, stream, a, L);
        if (PROBE_STAGE >= 5) launch_phase<5>(grid, stream, a, L);
        if (PROBE_STAGE >= 6) launch_phase<6>(grid, stream, a, L);
        if (PROBE_STAGE >= 7) launch_phase<7>(grid, stream, a, L);
        if (PROBE_STAGE >= 8) launch_phase<8>(grid, stream, a, L);
        if (PROBE_STAGE >= 9) launch_phase<9>(grid, stream, a, L);
        if (PROBE_STAGE >= 10) launch_phase<10>(grid, stream, a, L);
        if (PROBE_STAGE >= 11) launch_phase<11>(grid, stream, a, L);
        if (PROBE_STAGE >= 12) launch_phase<12>(grid, stream, a, L);
        if (PROBE_STAGE >= 13) launch_phase<13>(grid, stream, a, L);
        size_t off = WS_RAW; int ld = RAWLD; int rowmask = 0x7fffffff;
        if (PROBE_STAGE == 2) { off = WS_VFIRST; ld = D; }
        if (PROBE_STAGE == 3) { off = WS_S1; ld = D; }
        if (PROBE_STAGE == 5) { off = WS_S1; ld = D; }
#if defined(PROBE_ALT) || defined(PROBE_SWAP)
        if (PROBE_STAGE == 3) { off = WS_S2; ld = D; }
        if (PROBE_STAGE == 2) { off = WS_EAT; ld = 256; rowmask = 2047; }
        if (PROBE_STAGE == 1) { off = WS_RAW + 4608; ld = RAWLD; }
#endif
        if (PROBE_STAGE == 6) { off = WS_S2; ld = D; }
        if (PROBE_STAGE == 7 || PROBE_STAGE == 8) { off = WS_S3; ld = D; }
        if (PROBE_STAGE == 9) { off = WS_S2; ld = D; }
        if (PROBE_STAGE == 10) { off = WS_RAWB; ld = D; }
        if (PROBE_STAGE == 11) { off = WS_S2; ld = D; }
        if (PROBE_STAGE == 12 || PROBE_STAGE == 13) { off = WS_RAW; ld = D; }
        hipLaunchKernelGGL(mk_dump, dim3(grid), dim3(512), 0, stream, a, off, ld, rowmask);
        return;
    }
    for (int L = 0; L < NLAYER; ++L) {
        launch_phase<0>(grid, stream, a, L); launch_phase<1>(grid, stream, a, L); launch_phase<2>(grid, stream, a, L); launch_phase<3>(grid, stream, a, L);
        launch_phase<4>(grid, stream, a, L); launch_phase<5>(grid, stream, a, L); launch_phase<6>(grid, stream, a, L); launch_phase<7>(grid, stream, a, L);
        launch_phase<8>(grid, stream, a, L); launch_phase<9>(grid, stream, a, L); launch_phase<10>(grid, stream, a, L); launch_phase<11>(grid, stream, a, L);
        launch_phase<12>(grid, stream, a, L); launch_phase<13>(grid, stream, a, L); launch_phase<14>(grid, stream, a, L);
    }
    launch_phase<15>(grid, stream, a, 0);
#else
    (void)hipMemsetAsync((char*)d_ws + WS_CTL, 0, CTL_ZERO_BYTES, stream);
    a.ph_lo = 0; a.ph_hi = 0;
    hipLaunchKernelGGL(mk_fwd, dim3(grid), dim3(512), LDS_BYTES, stream, a);
#endif
}
```

```cpp
#include <hip/hip_runtime.h>
#include <cstdio>
#include <cstdint>

#define LAS __attribute__((address_space(3)))
typedef unsigned short bf16_t;
typedef short bf16x8 __attribute__((ext_vector_type(8)));
typedef float f32x4 __attribute__((ext_vector_type(4)));
typedef float f32x2 __attribute__((ext_vector_type(2)));
typedef unsigned u32x4 __attribute__((ext_vector_type(4)));
typedef unsigned u32x2 __attribute__((ext_vector_type(2)));

#define SCAN_DUP 0
#ifndef SCAN_DUP
#define SCAN_DUP 0
#endif
#ifndef MK_PER_PHASE
#define MK_PER_PHASE 0
#endif

constexpr int M = 32768, D = 1024, SEQ = 2048, NLAYER = 4, INW = 8320, NHEAD = 16;
constexpr int RAWLD = 3328;
constexpr int RAWLDB = 3456;
constexpr float NORM_EPS = 1e-6f, LNX_EPS = 64e-5f;

constexpr size_t MiB = 1u << 20;
constexpr size_t WS_CTL = 0, CTL_ZERO_BYTES = 16384;
constexpr size_t WS_WINT = 1 * MiB;
constexpr size_t WS_WPP = WS_WINT + (size_t)(INW + 128) * D * 2;
constexpr size_t WS_WRP = WS_WPP + 2 * MiB;
constexpr size_t WS_WOUT = WS_WRP + 2 * MiB;
constexpr size_t WS_LINT = WS_WOUT + 2 * MiB;
constexpr size_t WS_EAT = WS_LINT + MiB / 2;
constexpr size_t WS_VFIRST = 25 * MiB;
constexpr size_t WS_RAW = 89 * MiB;
constexpr size_t WS_RAWB = 153 * MiB;
constexpr size_t WS_S1 = 305 * MiB, WS_S2 = 369 * MiB, WS_S3 = 433 * MiB;
constexpr size_t WS_TW = 497 * MiB;
constexpr size_t WS_END = 513 * MiB;
static_assert(WS_EAT + MiB <= WS_VFIRST, "weights fit");
constexpr int R_RGATE = 2048, R_GRWKV = 3072, R_GPOOL = 4096, R_RKV = 5120, R_FOLD = 8320;

#define XB_TMO      128
#define XB_XCNT(j)  (256  + 64 * (j))
#define XB_XSUB(j)  (1280 + 64 * (j))
#define XB_XGEN(j)  (2304 + 64 * (j))
#define XB_TOP      3328
#define XB_TOPGEN   3392
#define XCD_BAR_WORDS 3456
#define XB_SPIN_CAP (1u << 18)

__device__ __forceinline__ unsigned xb_ld(unsigned* p)              { return __hip_atomic_load(p, __ATOMIC_RELAXED, __HIP_MEMORY_SCOPE_AGENT); }
__device__ __forceinline__ unsigned xb_add(unsigned* p, unsigned v) { return __hip_atomic_fetch_add(p, v, __ATOMIC_RELAXED, __HIP_MEMORY_SCOPE_AGENT); }
__device__ __forceinline__ unsigned xb_xcc_id() { return (unsigned)__builtin_amdgcn_s_getreg((3 << 11) | 20) & 0xFu; }
#define XB_SPIN(cond, bar) do { unsigned _sp = 0; while (cond) { __builtin_amdgcn_s_sleep(1); \
    if ((++_sp & 255u) == 0u) { if (xb_ld(&(bar)[XB_TMO])) break; if (_sp > XB_SPIN_CAP) { atomicAdd(&(bar)[XB_TMO], 1u); break; } } } } while (0)

__device__ __forceinline__ int lane_now() { int l; asm volatile("v_mbcnt_lo_u32_b32 %0, -1, 0\n\tv_mbcnt_hi_u32_b32 %0, -1, %0" : "=&v"(l)); return l; }
struct XcdBarrier { unsigned* bar; unsigned x; volatile LAS unsigned* st; int w0; };

__device__ __forceinline__ XcdBarrier xcd_barrier_post(unsigned* bar, volatile LAS unsigned* st) {
    XcdBarrier b; b.bar = bar; b.x = xb_xcc_id(); b.st = st; b.w0 = __builtin_amdgcn_readfirstlane((int)threadIdx.x >> 6);
    if (threadIdx.x == 0) (void)xb_add(&bar[XB_XCNT(b.x)], 1u);
    return b;
}
__device__ __forceinline__ void xcd_barrier_complete(unsigned* bar, unsigned x, unsigned& nloc, unsigned& nx) {
    const unsigned G = gridDim.x * gridDim.y * gridDim.z;
    unsigned sum, cnt, mine, sp = 0u;
    for (;;) {
        sum = 0u; cnt = 0u; mine = 0u;
#pragma unroll
        for (unsigned j = 0; j < 16; ++j) { const unsigned c = xb_ld(&bar[XB_XCNT(j)]); sum += c; cnt += (c > 0u) ? 1u : 0u; }
        if (sum == G) { mine = xb_ld(&bar[XB_XCNT(x)]); break; }
        __builtin_amdgcn_s_sleep(1);
        if ((++sp & 255u) == 0u) { if (xb_ld(&bar[XB_TMO])) { mine = xb_ld(&bar[XB_XCNT(x)]); break; } if (sp > XB_SPIN_CAP) { atomicAdd(&bar[XB_TMO], 1u); mine = xb_ld(&bar[XB_XCNT(x)]); break; } }
    }
    nloc = mine > 0u ? mine : 1u; nx = cnt > 0u ? cnt : 1u;
}
__device__ __forceinline__ void xcd_barrier(const XcdBarrier& b) {
    asm volatile("s_waitcnt vmcnt(0)" ::: "memory");
    __syncthreads();
    if (b.w0 == 0 && lane_now() == 0) {
        unsigned* bar = b.bar; asm volatile("" : "+s"(bar));
        __builtin_amdgcn_s_waitcnt(0);
        unsigned nloc = b.st[0], nx = b.st[1];
        if (nloc == 0u) { xcd_barrier_complete(bar, b.x, nloc, nx); b.st[0] = nloc; b.st[1] = nx; }
        const unsigned old = xb_add(&bar[XB_XSUB(b.x)], 1u);
        const unsigned gen = old / nloc;
        if (old + 1u == (gen + 1u) * nloc) {
            __builtin_amdgcn_fence(__ATOMIC_RELEASE, "agent");
            asm volatile("s_waitcnt vmcnt(0)" ::: "memory");
            const unsigned og = xb_add(&bar[XB_TOP], 1u);
            const unsigned tg = og / nx;
            if (og + 1u == (tg + 1u) * nx) xb_add(&bar[XB_TOPGEN], 1u);
            else XB_SPIN(xb_ld(&bar[XB_TOPGEN]) == tg, bar);
            __builtin_amdgcn_fence(__ATOMIC_ACQUIRE, "agent");
            xb_add(&bar[XB_XGEN(b.x)], 1u);
            asm volatile("s_waitcnt vmcnt(0)" ::: "memory");
        } else {
            XB_SPIN(xb_ld(&bar[XB_XGEN(b.x)]) == gen, bar);
            __builtin_amdgcn_fence(__ATOMIC_ACQUIRE, "agent");
            asm volatile("s_waitcnt vmcnt(0)" ::: "memory");
        }
    }
    __syncthreads();
}

typedef decltype(__builtin_amdgcn_make_buffer_rsrc((void*)nullptr, (short)0, 0, 0)) rsrc_t;
__device__ __forceinline__ rsrc_t wt_rsrc(const void* base) { return __builtin_amdgcn_make_buffer_rsrc((void*)base, 0, 0x7fffffff, 0x00020000); }
#define ST16_WT(rs, byteoff, v) __builtin_amdgcn_raw_buffer_store_b128(__builtin_bit_cast(decltype(__builtin_amdgcn_raw_buffer_load_b128(rs, 0, 0, 0)), (v)), rs, (int)(byteoff), 0, 16)
__device__ __forceinline__ float bf_lo(unsigned w) { return __uint_as_float(w << 16); }
__device__ __forceinline__ float bf_hi(unsigned w) { return __uint_as_float(w & 0xffff0000u); }
typedef __bf16 bf16x2_t __attribute__((ext_vector_type(2)));
__device__ __forceinline__ unsigned pk_bf16(float lo, float hi) { bf16x2_t v; v[0] = (__bf16)lo; v[1] = (__bf16)hi; return __builtin_bit_cast(unsigned, v); }
__device__ __forceinline__ unsigned short f2bf_s(float x) { return (unsigned short)(pk_bf16(x, 0.f) & 0xffffu); }
__device__ __forceinline__ float sigmoidf_(float x) { return __builtin_amdgcn_rcpf(1.0f + __expf(-x)); }
__device__ __forceinline__ float tanhf_(float x) { return 1.0f - 2.0f * __builtin_amdgcn_rcpf(1.0f + __expf(2.0f * x)); }
template <int CTRL> __device__ __forceinline__ float dppf(float x) { return __int_as_float(__builtin_amdgcn_update_dpp(0, __float_as_int(x), CTRL, 0xf, 0xf, true)); }
__device__ __forceinline__ float red8(float x) {
    x += dppf<0xB1>(x);
    x += dppf<0x4E>(x);
    x += dppf<0x141>(x);
    return x;
}
__device__ __forceinline__ float red16(float x) {
    x += dppf<0xB1>(x);
    x += dppf<0x4E>(x);
    x += dppf<0x141>(x);
    x += dppf<0x140>(x);
    return x;
}
__device__ __forceinline__ float red64(float x) {
    x = red16(x);
    return __int_as_float(__builtin_amdgcn_readlane(__float_as_int(x), 0)) + __int_as_float(__builtin_amdgcn_readlane(__float_as_int(x), 16)) +
           __int_as_float(__builtin_amdgcn_readlane(__float_as_int(x), 32)) + __int_as_float(__builtin_amdgcn_readlane(__float_as_int(x), 48));
}

namespace pg8 {
constexpr int BM = 256, BK = 64, HALF = 128, HTB = HALF * BK * 2, STAGE_BYTES = 8 * HTB, NXCD = 8, WGM = 8;
__host__ __device__ __forceinline__ int lds_byte(int r, int c) { const int st = (r >> 4) * 2 + (c >> 5), rr = r & 15, cc = c & 31, ob = rr * 64 + cc * 2; return st * 1024 + (ob ^ (((ob >> 9) & 1) << 5)); }
__host__ __device__ __forceinline__ void stage_rc(int b, int& R, int& C) { const int st = b / 1024, sb = b % 1024, swz = sb ^ (((sb >> 9) & 1) << 5); R = (st >> 1) * 16 + swz / 64; C = (st & 1) * 32 + (swz % 64) / 2; }
__host__ __device__ __forceinline__ int perm32(int rho) { const int n = rho >> 4, i = rho & 15; return 8 * (i >> 2) + 4 * n + (i & 3); }

struct Unit { int pm, pn; };
struct Gemm { const bf16_t* A; const bf16_t* Bt; int lda, ldb, K, nM, nN, a_pn_bytes; const bf16_t* A1 = nullptr; const bf16_t* Bt1 = nullptr; };

struct StaticOrder {
    int nM, nN, nwg, G, c;
    __device__ void init(int nM_, int nN_, int G_, int c_) { nM = nM_; nN = nN_; nwg = nM * nN; G = G_; c = c_; }
    __device__ bool next(int i, Unit& u) const {
        const long L = (long)i * G + c; if (L >= nwg) return false;
        int wgid = (int)L; { const int q = nwg / NXCD, r = nwg % NXCD, xcd = wgid % NXCD, off = wgid / NXCD; wgid = (xcd < r ? xcd * (q + 1) : r * (q + 1) + (xcd - r) * q) + off; }
        const int nig = WGM * nN, gid = wgid / nig, fm = gid * WGM, gsz = (nM - fm) < WGM ? (nM - fm) : WGM;
        u.pm = fm + ((wgid % nig) % gsz); u.pn = (wgid % nig) / gsz; return true;
    }
};

template <class Epi, bool ALIGN_EPI = true, bool SP2 = true, bool DUAL = false>
__device__ __forceinline__ void gemm_phase(LAS unsigned char* lds, const Gemm g, const StaticOrder& S, const Epi& E, int wv) {
    int tid_ = wv * 64 + lane_now(); asm volatile("" : "+v"(tid_));
    const int tid = tid_, wid = __builtin_amdgcn_readfirstlane(tid >> 6), lane = tid & 63, wr = wid >> 2, wc = wid & 3, fr = lane & 15, fq = lane >> 4;
    int K_ = g.K; asm volatile("" : "+s"(K_));
    const int K = K_, nt = K / BK;
    unsigned voffA[2], voffB[2];
#pragma unroll
    for (int i = 0; i < 2; ++i) { int R, C; stage_rc(tid * 16 + i * 8192, R, C); const int Rb = Epi::PERM ? ((R & ~31) + perm32(R & 31)) : R;
        voffA[i] = (unsigned)(R * g.lda + C) * 2u; voffB[i] = (unsigned)(Rb * g.ldb + C) * 2u; }
    const size_t kstep = (size_t)(BK * 2);
    const size_t hstepA = (size_t)HALF * g.lda * 2, hstepB = (size_t)HALF * g.ldb * 2;
    const size_t tstepA = 2 * hstepA, tstepB = 2 * hstepB;
    const unsigned ldsw = (unsigned)wid * 1024u;
    const int aoff = lds_byte(wr * 64 + fr, fq * 8), boff = lds_byte(wc * 32 + fr, fq * 8);
#define PG8_SA(b, h) (((b) * 2 + (h)) * HTB)
#define PG8_SB(b, h) ((4 + (b) * 2 + (h)) * HTB)
#define PG8_STAGE(bufoff, gbase, voff) do { _Pragma("unroll") for (int _i = 0; _i < 2; ++_i) \
        __builtin_amdgcn_global_load_lds((const unsigned*)((const char*)(gbase) + (voff)[_i]), (LAS unsigned*)(lds + (bufoff) + ldsw + _i * 8192), 16, 0, 0); } while (0)
#define PG8_LDA(dst, b, h) do { _Pragma("unroll") for (int m = 0; m < 4; ++m) _Pragma("unroll") for (int k = 0; k < 2; ++k) dst[m][k] = *(const LAS bf16x8*)(lds + PG8_SA(b, h) + aoff + m * 2048 + k * 1024); } while (0)
#define PG8_LDB(dst, b, h) do { _Pragma("unroll") for (int n = 0; n < 2; ++n) _Pragma("unroll") for (int k = 0; k < 2; ++k) dst[n][k] = *(const LAS bf16x8*)(lds + PG8_SB(b, h) + boff + n * 2048 + k * 1024); } while (0)
#define PG8_MMA(ai, bj, At, Bt) do { __builtin_amdgcn_s_setprio(1); _Pragma("unroll") for (int m = 0; m < 4; ++m) _Pragma("unroll") for (int n = 0; n < 2; ++n) _Pragma("unroll") for (int k = 0; k < 2; ++k) \
        acc[ai][bj][m][n] = __builtin_amdgcn_mfma_f32_16x16x32_bf16(Bt[n][k], At[m][k], acc[ai][bj][m][n], 0, 0, 0); __builtin_amdgcn_s_setprio(0); } while (0)
#define PG8_WAIT_V(n) asm volatile("s_waitcnt vmcnt(" #n ")" ::: "memory")
#define PG8_WAIT_L(n) asm volatile("s_waitcnt lgkmcnt(" #n ")" ::: "memory")
#define PG8_BAR __builtin_amdgcn_s_barrier()
#define PG8_SCHED __builtin_amdgcn_sched_barrier(0)
    Unit cur, nxt; int ui = 0;
    if (!S.next(0, cur)) return;
    f32x4 acc[2][2][4][2];
#pragma unroll
    for (int a = 0; a < 2; ++a)
#pragma unroll
        for (int b = 0; b < 2; ++b)
#pragma unroll
            for (int m = 0; m < 4; ++m)
#pragma unroll
                for (int n = 0; n < 2; ++n) acc[a][b][m][n] = (f32x4){0.f, 0.f, 0.f, 0.f};
    bf16x8 At[4][2], B0[2][2], B1[2][2];
    const char* cA = (const char*)g.A + (size_t)cur.pm * tstepA + (size_t)cur.pn * g.a_pn_bytes; const char* cB = (const char*)g.Bt + (size_t)cur.pn * tstepB;
    const char* const gA1 = (const char*)(DUAL ? g.A1 : g.A); const char* const gB1 = (const char*)(DUAL ? g.Bt1 : g.Bt);
    if constexpr (SP2) {
        PG8_STAGE(PG8_SB(0, 0), cB, voffB); PG8_STAGE(PG8_SB(0, 1), cB + hstepB, voffB); PG8_STAGE(PG8_SA(0, 0), cA, voffA); PG8_STAGE(PG8_SA(0, 1), cA + hstepA, voffA);
        if (wr == 1) PG8_BAR;
        PG8_WAIT_V(2); PG8_BAR;
        PG8_STAGE(PG8_SB(1, 0), cB + kstep, voffB); PG8_STAGE(PG8_SA(1, 0), cA + kstep, voffA); PG8_STAGE(PG8_SB(1, 1), cB + hstepB + kstep, voffB);
        PG8_WAIT_V(6); PG8_BAR;
    } else {
        PG8_STAGE(PG8_SB(0, 0), cB, voffB); PG8_STAGE(PG8_SA(0, 0), cA, voffA); PG8_STAGE(PG8_SB(0, 1), cB + hstepB, voffB); PG8_STAGE(PG8_SA(0, 1), cA + hstepA, voffA);
        if (wr == 1) PG8_BAR;
        PG8_WAIT_V(4); PG8_BAR;
        PG8_STAGE(PG8_SB(1, 0), cB + kstep, voffB); PG8_STAGE(PG8_SA(1, 0), cA + kstep, voffA); PG8_STAGE(PG8_SB(1, 1), cB + hstepB + kstep, voffB);
        PG8_WAIT_V(6); PG8_BAR;
    }
    for (;;) {
        int sec_ = ui & 1; asm volatile("" : "+s"(sec_));
        const bool second = DUAL && (sec_ != 0);
        bool has_next; if (DUAL && !second) { has_next = true; nxt = cur; } else has_next = S.next(DUAL ? ((ui + 1) >> 1) : ui + 1, nxt);
        const char* nbA = (DUAL && !second) ? gA1 : (const char*)g.A; const char* nbB = (DUAL && !second) ? gB1 : (const char*)g.Bt;
        const char* nA = has_next ? nbA + (size_t)nxt.pm * tstepA + (size_t)nxt.pn * g.a_pn_bytes : cA; const char* nB = has_next ? nbB + (size_t)nxt.pn * tstepB : cB;
        for (int t = 0; t < nt; t += 2) {
            const bool last = (t == nt - 2);
            const char* a1 = cA + (size_t)(t + 1) * kstep;
            const char* a2 = last ? nA : cA + (size_t)(t + 2) * kstep; const char* b2 = last ? nB : cB + (size_t)(t + 2) * kstep;
            const char* a3 = a2 + kstep; const char* b3 = b2 + kstep;
            if constexpr (SP2) {
            PG8_LDB(B0, 0, 0); PG8_LDB(B1, 0, 1); PG8_SCHED; PG8_LDA(At, 0, 0); PG8_STAGE(PG8_SA(1, 1), a1 + hstepA, voffA);
            PG8_WAIT_V(8); PG8_WAIT_L(0); PG8_BAR; PG8_MMA(0, 0, At, B0); PG8_MMA(0, 1, At, B1); PG8_BAR; PG8_SCHED;
            PG8_LDA(At, 0, 1); PG8_STAGE(PG8_SB(0, 0), b2, voffB); PG8_STAGE(PG8_SB(0, 1), b2 + hstepB, voffB); PG8_STAGE(PG8_SA(0, 0), a2, voffA);
            PG8_WAIT_V(8); PG8_WAIT_L(0); PG8_BAR; PG8_MMA(1, 0, At, B0); PG8_MMA(1, 1, At, B1); PG8_BAR; PG8_SCHED;
            PG8_LDB(B0, 1, 0); PG8_LDB(B1, 1, 1); PG8_SCHED; PG8_LDA(At, 1, 0); PG8_STAGE(PG8_SA(0, 1), a2 + hstepA, voffA);
            PG8_WAIT_V(8); PG8_WAIT_L(0); PG8_BAR; PG8_MMA(0, 0, At, B0); PG8_MMA(0, 1, At, B1); PG8_BAR; PG8_SCHED;
            PG8_LDA(At, 1, 1); PG8_STAGE(PG8_SB(1, 0), b3, voffB); PG8_STAGE(PG8_SB(1, 1), b3 + hstepB, voffB); PG8_STAGE(PG8_SA(1, 0), a3, voffA);
            PG8_WAIT_V(8); PG8_WAIT_L(0); PG8_BAR; PG8_MMA(1, 0, At, B0); PG8_MMA(1, 1, At, B1); PG8_BAR; PG8_SCHED;
            } else {
            PG8_LDB(B0, 0, 0); PG8_SCHED; PG8_LDA(At, 0, 0); PG8_STAGE(PG8_SA(1, 1), a1 + hstepA, voffA);
            PG8_WAIT_L(8); PG8_BAR; PG8_WAIT_L(0); PG8_MMA(0, 0, At, B0); PG8_BAR; PG8_SCHED;
            PG8_LDB(B1, 0, 1); PG8_STAGE(PG8_SB(0, 0), b2, voffB);
            PG8_BAR; PG8_WAIT_L(0); PG8_MMA(0, 1, At, B1); PG8_BAR;
            PG8_LDA(At, 0, 1); PG8_STAGE(PG8_SA(0, 0), a2, voffA);
            PG8_BAR; PG8_WAIT_L(0); PG8_MMA(1, 0, At, B0); PG8_BAR; PG8_SCHED;
            PG8_STAGE(PG8_SB(0, 1), b2 + hstepB, voffB);
            PG8_WAIT_V(6); PG8_BAR; PG8_MMA(1, 1, At, B1); PG8_BAR;
            PG8_LDB(B0, 1, 0); PG8_SCHED; PG8_LDA(At, 1, 0); PG8_STAGE(PG8_SA(0, 1), a2 + hstepA, voffA);
            PG8_WAIT_L(8); PG8_BAR; PG8_WAIT_L(0); PG8_MMA(0, 0, At, B0); PG8_BAR; PG8_SCHED;
            PG8_LDB(B1, 1, 1); PG8_STAGE(PG8_SB(1, 0), b3, voffB);
            PG8_BAR; PG8_WAIT_L(0); PG8_MMA(0, 1, At, B1); PG8_BAR;
            PG8_LDA(At, 1, 1); PG8_STAGE(PG8_SA(1, 0), a3, voffA);
            PG8_BAR; PG8_WAIT_L(0); PG8_MMA(1, 0, At, B0); PG8_BAR; PG8_SCHED;
            PG8_STAGE(PG8_SB(1, 1), b3 + hstepB, voffB);
            PG8_WAIT_V(6); PG8_BAR; PG8_MMA(1, 1, At, B1); PG8_BAR;
            }
        }
        if constexpr (ALIGN_EPI) { if (wr == 0) PG8_BAR; }
        if constexpr (DUAL) { if (!second) E.mid(acc, cur, wr, wc, fr, fq); else E(acc, cur, wr, wc, fr, fq); }
        else E(acc, cur, wr, wc, fr, fq);
        if (!has_next) break;
        if (!(DUAL && !second)) {
#pragma unroll
        for (int a = 0; a < 2; ++a)
#pragma unroll
            for (int b = 0; b < 2; ++b)
#pragma unroll
                for (int m = 0; m < 4; ++m)
#pragma unroll
                    for (int n = 0; n < 2; ++n) acc[a][b][m][n] = (f32x4){0.f, 0.f, 0.f, 0.f};
        }
        cur = nxt; cA = nA; cB = nB; ++ui;
        if constexpr (ALIGN_EPI) { if (wr == 1) PG8_BAR; }
    }
    PG8_WAIT_V(0);
    if constexpr (!ALIGN_EPI) { if (wr == 0) PG8_BAR; }
    PG8_BAR;
#undef PG8_SA
#undef PG8_SB
#undef PG8_STAGE
#undef PG8_LDA
#undef PG8_LDB
#undef PG8_MMA
#undef PG8_WAIT_V
#undef PG8_WAIT_L
#undef PG8_BAR
#undef PG8_SCHED
}

enum { ACT_NONE = 0, ACT_SILU = 1, ACT_SIGMOID = 2, ACT_DECAY = 3 };
template <int ACT> __device__ __forceinline__ float actf(float v) {
    if (ACT == ACT_SILU) return v * sigmoidf_(v);
    if (ACT == ACT_SIGMOID) return sigmoidf_(v);
    if (ACT == ACT_DECAY) return 0.60653065971f * sigmoidf_(v);
    return v;
}
struct EpiCfg {
    bf16_t* out; int ldo;
    const float* bias;
    const float* cscale;
    const bf16_t* in1; int ld1;
    const bf16_t* in2; int ld2;
};
template <int ACT_A, int ACT_B, int ACT_C = ACT_NONE, int ACT_D = ACT_NONE, int ACT_E = ACT_NONE> struct EpiG {
    static constexpr bool PERM = true;
    EpiCfg a, b; int split; EpiCfg c = {}; int split2 = 1 << 30; EpiCfg d = {}; int split3 = 1 << 30; EpiCfg e = {}; int split4 = 1 << 30;
    template <int ACT> __device__ __forceinline__ void run(const EpiCfg& c, int colt, const f32x4 (&acc)[2][2][4][2], const Unit& u, int wr, int wc, int fr, int fq) const {
        const int row0 = u.pm * BM + wr * 64 + fr, col0 = colt + wc * 32 + 8 * fq;
#pragma unroll
        for (int ai = 0; ai < 2; ++ai) {
            u32x4 w1[4][2], w2[4][2];
            if (c.in1) {
#pragma unroll
                for (int m = 0; m < 4; ++m)
#pragma unroll
                    for (int bj = 0; bj < 2; ++bj) w1[m][bj] = *(const u32x4*)(c.in1 + (size_t)(row0 + ai * HALF + m * 16) * c.ld1 + col0 + bj * HALF);
            }
            if (c.in2) {
#pragma unroll
                for (int m = 0; m < 4; ++m)
#pragma unroll
                    for (int bj = 0; bj < 2; ++bj) w2[m][bj] = *(const u32x4*)(c.in2 + (size_t)(row0 + ai * HALF + m * 16) * c.ld2 + col0 + bj * HALF);
            }
            asm volatile("" ::: "memory");
#pragma unroll
            for (int m = 0; m < 4; ++m) {
                const size_t row = (size_t)(row0 + ai * HALF + m * 16);
#pragma unroll
                for (int bj = 0; bj < 2; ++bj) {
                    const int cc = col0 + bj * HALF;
                    f32x4 v0 = acc[ai][bj][m][0], v1 = acc[ai][bj][m][1];
#pragma unroll
                    for (int j = 0; j < 4; ++j) { v0[j] = actf<ACT>(v0[j]); v1[j] = actf<ACT>(v1[j]); }
                    if (c.in1) { const u32x4 w = w1[m][bj];
                        v0[0] *= bf_lo(w.x); v0[1] *= bf_hi(w.x); v0[2] *= bf_lo(w.y); v0[3] *= bf_hi(w.y);
                        v1[0] *= bf_lo(w.z); v1[1] *= bf_hi(w.z); v1[2] *= bf_lo(w.w); v1[3] *= bf_hi(w.w); }
                    if (c.in2) { const u32x4 w = w2[m][bj];
                        v0[0] += bf_lo(w.x); v0[1] += bf_hi(w.x); v0[2] += bf_lo(w.y); v0[3] += bf_hi(w.y);
                        v1[0] += bf_lo(w.z); v1[1] += bf_hi(w.z); v1[2] += bf_lo(w.w); v1[3] += bf_hi(w.w); }
                    u32x4 w; w.x = pk_bf16(v0[0], v0[1]); w.y = pk_bf16(v0[2], v0[3]); w.z = pk_bf16(v1[0], v1[1]); w.w = pk_bf16(v1[2], v1[3]);
                    *(u32x4*)(c.out + row * c.ldo + cc) = w;
                }
            }
        }
    }
    __device__ __forceinline__ void operator()(const f32x4 (&acc)[2][2][4][2], const Unit& u, int wr, int wc, int fr, int fq) const {
        const int colt = u.pn * BM;
        if (colt >= split4) run<ACT_E>(e, colt - split4, acc, u, wr, wc, fr, fq);
        else if (colt >= split3) run<ACT_D>(d, colt - split3, acc, u, wr, wc, fr, fq);
        else if (colt >= split2) run<ACT_C>(c, colt - split2, acc, u, wr, wc, fr, fq);
        else if (colt >= split) run<ACT_B>(b, colt - split, acc, u, wr, wc, fr, fq);
        else run<ACT_A>(a, colt, acc, u, wr, wc, fr, fq);
    }
};
struct EpiMerge {
    static constexpr bool PERM = true;
    bf16_t* out; int ldo; const bf16_t* Gr; const bf16_t* Gp; int ldg;
    static __device__ __forceinline__ float gpc(float x) { return fmaxf(x, 8.6736174e-19f); }
    __device__ __forceinline__ void mid(f32x4 (&acc)[2][2][4][2], const Unit& u, int wr, int wc, int fr, int fq) const {
        const int row0 = u.pm * BM + wr * 64 + fr, col0 = u.pn * BM + wc * 32 + 8 * fq;
#pragma unroll
        for (int ai = 0; ai < 2; ++ai) {
            u32x4 w1[4][2], w2[4][2];
#pragma unroll
            for (int m = 0; m < 4; ++m)
#pragma unroll
                for (int bj = 0; bj < 2; ++bj) { const size_t o = (size_t)(row0 + ai * HALF + m * 16) * ldg + col0 + bj * HALF; w1[m][bj] = *(const u32x4*)(Gr + o); w2[m][bj] = *(const u32x4*)(Gp + o); }
#pragma unroll
            for (int m = 0; m < 4; ++m)
#pragma unroll
                for (int bj = 0; bj < 2; ++bj) {
                    const u32x4 a = w1[m][bj], b = w2[m][bj];
                    f32x4& v0 = acc[ai][bj][m][0]; f32x4& v1 = acc[ai][bj][m][1];
                    v0[0] *= bf_lo(a.x) * __builtin_amdgcn_rcpf(gpc(bf_lo(b.x))); v0[1] *= bf_hi(a.x) * __builtin_amdgcn_rcpf(gpc(bf_hi(b.x)));
                    v0[2] *= bf_lo(a.y) * __builtin_amdgcn_rcpf(gpc(bf_lo(b.y))); v0[3] *= bf_hi(a.y) * __builtin_amdgcn_rcpf(gpc(bf_hi(b.y)));
                    v1[0] *= bf_lo(a.z) * __builtin_amdgcn_rcpf(gpc(bf_lo(b.z))); v1[1] *= bf_hi(a.z) * __builtin_amdgcn_rcpf(gpc(bf_hi(b.z)));
                    v1[2] *= bf_lo(a.w) * __builtin_amdgcn_rcpf(gpc(bf_lo(b.w))); v1[3] *= bf_hi(a.w) * __builtin_amdgcn_rcpf(gpc(bf_hi(b.w)));
                }
        }
    }
    __device__ __forceinline__ void operator()(const f32x4 (&acc)[2][2][4][2], const Unit& u, int wr, int wc, int fr, int fq) const {
        const int row0 = u.pm * BM + wr * 64 + fr, col0 = u.pn * BM + wc * 32 + 8 * fq;
#pragma unroll
        for (int ai = 0; ai < 2; ++ai) {
            u32x4 w2[4][2];
#pragma unroll
            for (int m = 0; m < 4; ++m)
#pragma unroll
                for (int bj = 0; bj < 2; ++bj) w2[m][bj] = *(const u32x4*)(Gp + (size_t)(row0 + ai * HALF + m * 16) * ldg + col0 + bj * HALF);
            asm volatile("" ::: "memory");
#pragma unroll
            for (int m = 0; m < 4; ++m)
#pragma unroll
                for (int bj = 0; bj < 2; ++bj) {
                    const u32x4 b = w2[m][bj]; const f32x4 v0 = acc[ai][bj][m][0], v1 = acc[ai][bj][m][1];
                    u32x4 o; o.x = pk_bf16(v0[0] * gpc(bf_lo(b.x)), v0[1] * gpc(bf_hi(b.x))); o.y = pk_bf16(v0[2] * gpc(bf_lo(b.y)), v0[3] * gpc(bf_hi(b.y)));
                    o.z = pk_bf16(v1[0] * gpc(bf_lo(b.z)), v1[1] * gpc(bf_hi(b.z))); o.w = pk_bf16(v1[2] * gpc(bf_lo(b.w)), v1[3] * gpc(bf_hi(b.w)));
                    *(u32x4*)(out + (size_t)(row0 + ai * HALF + m * 16) * ldo + col0 + bj * HALF) = o;
                }
        }
    }
};
struct EpiRawT {
    static constexpr bool PERM = true;
    bf16_t* out; int ncols; const float* mu;
    __device__ __forceinline__ void operator()(const f32x4 (&acc)[2][2][4][2], const Unit& u, int wr, int wc, int fr, int fq) const {
        const int ch0 = u.pm * BM + wr * 64 + fr, tok0 = u.pn * BM + wc * 32 + 8 * fq;
        const bool lora = (u.pm * BM == 3072);
#pragma unroll
        for (int ai = 0; ai < 2; ++ai)
#pragma unroll
            for (int m = 0; m < 4; ++m) {
                const int ch = ch0 + ai * HALF + m * 16;
#pragma unroll
                for (int bj = 0; bj < 2; ++bj) {
                    const int tok = tok0 + bj * HALF;
                    const f32x4 v0 = acc[ai][bj][m][0], v1 = acc[ai][bj][m][1];
                    u32x4 w; w.x = pk_bf16(v0[0], v0[1]); w.y = pk_bf16(v0[2], v0[3]); w.z = pk_bf16(v1[0], v1[1]); w.w = pk_bf16(v1[2], v1[3]);
                    *(u32x4*)(out + ((size_t)(tok >> 4) * ncols + ch) * 16 + (tok & 15)) = w;
                    if (ai == 0 && lora) {
                        const float pv = __int_as_float(__builtin_amdgcn_ds_bpermute((((fq * 16 + fr) - 16) & 63) * 4, __float_as_int(v1[3])));
                        const float muc = mu[wr * 64 + m * 16 + fr];
                        const float x[9] = {pv, v0[0], v0[1], v0[2], v0[3], v1[0], v1[1], v1[2], v1[3]};
                        float y[8];
#pragma unroll
                        for (int e = 0; e < 8; ++e) { const float t_ = x[e + 1] + muc * (x[e] - x[e + 1]); y[e] = (wr == 0) ? tanhf_(t_) : t_; }
                        u32x4 w2; w2.x = pk_bf16(y[0], y[1]); w2.y = pk_bf16(y[2], y[3]); w2.z = pk_bf16(y[4], y[5]); w2.w = pk_bf16(y[6], y[7]);
                        *(u32x4*)(out + ((size_t)(tok >> 4) * ncols + ch + 256) * 16 + (tok & 15)) = w2;
                    }
                }
            }
    }
};
struct EpiResid {
    static constexpr bool PERM = false;
    float* X; int ldc; const float* Xin;
    __device__ __forceinline__ void operator()(const f32x4 (&acc)[2][2][4][2], const Unit& u, int wr, int wc, int fr, int fq) const {
        const int row0 = u.pm * BM + wr * 64 + fr, col0 = u.pn * BM + wc * 32 + 4 * fq;
#pragma unroll
        for (int ai = 0; ai < 2; ++ai)
#pragma unroll
            for (int m = 0; m < 4; ++m) { float* rowp = X + (size_t)(row0 + ai * HALF + m * 16) * ldc + col0;
#pragma unroll
                for (int bj = 0; bj < 2; ++bj)
#pragma unroll
                    for (int n = 0; n < 2; ++n) { f32x4* p = (f32x4*)(rowp + bj * HALF + n * 16); *p = *(const f32x4*)(Xin + (p - (f32x4*)X) * 4) + acc[ai][bj][m][n]; } }
    }
};
}

struct Args {
    const float* in[22];
    float* out; unsigned char* ws;
    int ph_lo, ph_hi;
};
typedef const Args __attribute__((address_space(4)))* ArgsP;
struct Frame {
    LAS unsigned char* lds;
    int tid, lane, wave, G, bid;
    ArgsP ap;
    float* X; unsigned char* ws;
    bf16_t *WinT, *WppT, *WrpT, *WoutT, *LinT, *EAT, *VF, *RAW, *RAWB, *S1, *S2, *S3, *TW;
};

__device__ __forceinline__ void set_ws(Frame& F, unsigned char* ws) {
    F.ws = ws;
    F.WinT = (bf16_t*)(ws + WS_WINT); F.WppT = (bf16_t*)(ws + WS_WPP); F.WrpT = (bf16_t*)(ws + WS_WRP); F.WoutT = (bf16_t*)(ws + WS_WOUT);
    F.LinT = (bf16_t*)(ws + WS_LINT); F.EAT = (bf16_t*)(ws + WS_EAT); F.VF = (bf16_t*)(ws + WS_VFIRST);
    F.RAW = (bf16_t*)(ws + WS_RAW); F.RAWB = (bf16_t*)(ws + WS_RAWB); F.S1 = (bf16_t*)(ws + WS_S1); F.S2 = (bf16_t*)(ws + WS_S2); F.S3 = (bf16_t*)(ws + WS_S3);
    F.TW = (bf16_t*)(ws + WS_TW);
}
__device__ __forceinline__ void transpose_cvt(const Frame& F, int rot, const float* src, int ldn, int K, int N, bf16_t* dst, int ldk) {
    LAS float* tile = (LAS float*)F.lds;
    const int tilesK = K / 64, tilesN = N / 64, nq = tilesK * ((tilesN + 3) >> 2);
    const int slot = (F.bid + rot) % F.G;
    for (int qd = slot; qd < nq; qd += F.G) {
        float v[4][8];
#pragma unroll
        for (int q = 0; q < 4; ++q) {
            const int nb_ = (qd / tilesK) * 4 + q, nb = (nb_ < tilesN) ? nb_ : tilesN - 1, k0 = (qd % tilesK) * 64, n0 = nb * 64;
#pragma unroll
            for (int i = 0; i < 8; ++i) { const int idx = F.tid + 512 * i, r = idx >> 6, c = idx & 63; v[q][i] = src[(size_t)(k0 + r) * ldn + n0 + c]; }
        }
#pragma unroll
        for (int q = 0; q < 4; ++q)
#pragma unroll
            for (int i = 0; i < 8; ++i) { const int idx = F.tid + 512 * i, r = idx >> 6, c = idx & 63; tile[q * 4160 + r * 65 + c] = v[q][i]; }
        __syncthreads();
#pragma unroll
        for (int q = 0; q < 4; ++q) {
            const int nb = (qd / tilesK) * 4 + q;
            if (nb < tilesN) {
                const int k0 = (qd % tilesK) * 64, n0 = nb * 64;
#pragma unroll
                for (int i = 0; i < 4; ++i) { const int idx = F.tid + 512 * i, n = idx >> 5, kp = idx & 31;
                    *(unsigned*)(dst + (size_t)(n0 + n) * ldk + k0 + 2 * kp) = pk_bf16(tile[q * 4160 + (2 * kp) * 65 + n], tile[q * 4160 + (2 * kp + 1) * 65 + n]); }
            }
        }
        __syncthreads();
    }
}
__device__ __forceinline__ void fold_weights(const Frame& F, int L) {
    const int fr = F.lane & 15, fq = F.lane >> 4;
    LAS float* red = (LAS float*)F.lds;
    for (int tl = F.bid; tl < 64 * 4; tl += F.G) {
        const int k0 = (tl >> 2) * 16, j0 = (tl & 3) * 16, jj = j0 + fr;
        f32x4 acc = (f32x4){0.f, 0.f, 0.f, 0.f};
        if (L > 0) {
            const int cw = F.wave * 128 + 4 * fq;
            const float* arow = F.ap->in[2] + (size_t)L * D * INW + 4096 + (size_t)(k0 + fr) * INW + cw;
            const float* mu = F.ap->in[6] + (size_t)L * 3200 + 2048 + cw;
            const float* V1 = F.ap->in[12] + (size_t)(L - 1) * D * 32 + (size_t)cw * 32 + (jj & 31);
#pragma unroll
            for (int s4 = 0; s4 < 8; ++s4) {
                const f32x4 a4 = *(const f32x4*)(arow + 16 * s4), m4 = *(const f32x4*)(mu + 16 * s4);
#pragma unroll
                for (int e = 0; e < 4; ++e) acc = __builtin_amdgcn_mfma_f32_16x16x4f32(a4[e], V1[(size_t)(16 * s4 + e) * 32] * ((jj < 32) ? (1.0f - m4[e]) : m4[e]), acc, 0, 0, 0);
            }
        }
        *(LAS f32x4*)(red + (F.wave * 64 + F.lane) * 4) = acc;
        __syncthreads();
        if (F.wave == 0) {
            f32x4 t = acc;
#pragma unroll
            for (int w = 1; w < 8; ++w) t += *(const LAS f32x4*)(red + (w * 64 + F.lane) * 4);
            *(u32x2*)(F.WinT + (size_t)(R_FOLD + jj) * D + k0 + 4 * fq) = (u32x2){pk_bf16(t[0], t[1]), pk_bf16(t[2], t[3])};
            unsigned zz = 0u; asm volatile("" : "+v"(zz));
            *(u32x2*)(F.WinT + (size_t)(R_FOLD + 64 + jj) * D + k0 + 4 * fq) = (u32x2){zz, zz};
        }
        __syncthreads();
    }
    if (L > 0) { const float* V2 = F.ap->in[13] + (size_t)(L - 1) * 32 * D;
        for (int idx = F.bid * 512 + F.tid; idx < D * 32; idx += F.G * 512) { const int n = idx >> 5, j = idx & 31; F.EAT[131072 + idx] = f2bf_s(V2[(size_t)j * D + n]); } }
}
__device__ __forceinline__ void fold_pool_lin(const Frame& F, int L) {
    const float* win = F.ap->in[2] + (size_t)L * D * INW;
    const int fr = F.lane & 15, fq = F.lane >> 4;
    for (int tl = F.bid * 8 + F.wave; tl < 4 * 64 * 16; tl += F.G * 8) {
        const int g = tl >> 10, k0 = ((tl >> 4) & 63) * 16, d0 = (tl & 15) * 16;
        const float* arow = win + (size_t)(k0 + fr) * INW + 256 * g + 4 * fq;
        const float* bcol = F.ap->in[3] + ((size_t)(L * 4 + g) * 256 + 4 * fq) * 256 + d0 + fr;
        f32x4 acc = (f32x4){0.f, 0.f, 0.f, 0.f};
#pragma unroll 4
        for (int s4 = 0; s4 < 16; ++s4) {
            const f32x4 a4 = *(const f32x4*)(arow + 16 * s4);
#pragma unroll
            for (int e = 0; e < 4; ++e) acc = __builtin_amdgcn_mfma_f32_16x16x4f32(a4[e], bcol[(size_t)(16 * s4 + e) * 256], acc, 0, 0, 0);
        }
        *(u32x2*)(F.WinT + (size_t)(256 * g + d0 + fr) * D + k0 + 4 * fq) = (u32x2){pk_bf16(acc[0], acc[1]), pk_bf16(acc[2], acc[3])};
    }
}
__device__ __forceinline__ void convert_weights_late(const Frame& F, int L) {
    LAS float* tile = (LAS float*)F.lds;
    const float* win = F.ap->in[2] + (size_t)L * D * INW;
    const int tid = F.wave * 64 + lane_now();
    constexpr int NQ = 7 * 64;
    float v[4][8];
#define LATE_SRC(j) ((j) == 0 ? win + 1024 : (j) == 1 ? win + 5248 : (j) == 2 ? win + 6272 : (j) == 3 ? win + 7296 : (j) == 4 ? F.ap->in[5] + (size_t)L * D * D : (j) == 5 ? F.ap->in[19] + (size_t)L * D * D : F.ap->in[20] + (size_t)L * D * D)
#define LATE_DST(j) ((j) == 0 ? F.WinT + (size_t)1024 * D : (j) == 1 ? F.WinT + (size_t)R_RGATE * D : (j) == 2 ? F.WinT + (size_t)R_GPOOL * D : (j) == 3 ? F.WinT + (size_t)R_GRWKV * D : (j) == 4 ? F.WppT : (j) == 5 ? F.WrpT : F.WoutT)
#define LATE_LOAD(qx) do { const int j_ = (qx) >> 6, k0_ = ((qx) & 15) * 64, nb_ = (((qx) >> 4) & 3) * 4; const float* src_ = LATE_SRC(j_); const int ldn_ = j_ < 4 ? INW : D; \
        _Pragma("unroll") for (int q = 0; q < 4; ++q) _Pragma("unroll") for (int i = 0; i < 8; ++i) { const int idx = tid + 512 * i, r = idx >> 6, c = idx & 63; v[q][i] = src_[(size_t)(k0_ + r) * ldn_ + (nb_ + q) * 64 + c]; } } while (0)
    int qd = F.bid;
    if (qd < NQ) LATE_LOAD(qd);
    while (qd < NQ) {
#pragma unroll
        for (int q = 0; q < 4; ++q)
#pragma unroll
            for (int i = 0; i < 8; ++i) { const int idx = tid + 512 * i, r = idx >> 6, c = idx & 63; tile[q * 4160 + r * 65 + c] = v[q][i]; }
        __syncthreads();
        const int qn = qd + F.G;
        if (qn < NQ) LATE_LOAD(qn);
        { const int j = qd >> 6, k0 = (qd & 15) * 64, nb = ((qd >> 4) & 3) * 4; bf16_t* dst = LATE_DST(j);
#pragma unroll
          for (int q = 0; q < 4; ++q)
#pragma unroll
            for (int i = 0; i < 4; ++i) { const int idx = tid + 512 * i, n = idx >> 5, kp = idx & 31;
                *(unsigned*)(dst + (size_t)((nb + q) * 64 + n) * D + k0 + 2 * kp) = pk_bf16(tile[q * 4160 + (2 * kp) * 65 + n], tile[q * 4160 + (2 * kp + 1) * 65 + n]); } }
        __syncthreads();
        qd = qn;
    }
#undef LATE_SRC
#undef LATE_DST
#undef LATE_LOAD
}
__device__ __forceinline__ void convert_weights(const Frame& F, int L) {
    transpose_cvt(F, 0, F.ap->in[2] + (size_t)L * D * INW + 2048, INW, D, 3200, F.WinT + (size_t)R_RKV * D, D);
    fold_pool_lin(F, L);
    fold_weights(F, L);
    transpose_cvt(F, 208, F.ap->in[8] + (size_t)L * 64 * D, D, 64, D, F.EAT, 64);
    transpose_cvt(F, 212, F.ap->in[10] + (size_t)L * 64 * D, D, 64, D, F.EAT + 65536, 64);
}
__device__ __forceinline__ void rmsnorm_rows(const Frame& F, const float* __restrict__ src, const float* __restrict__ g, bf16_t* __restrict__ H, bf16_t* __restrict__ copy_to) {
    const int ms = F.G * 8;
    for (int m = F.bid * 8 + F.wave; m < M; m += 4 * ms) {
        f32x4 v[4][4]; int mr[4];
#pragma unroll
        for (int r = 0; r < 4; ++r) { mr[r] = (m + r * ms < M) ? m + r * ms : m;
#pragma unroll
            for (int i = 0; i < 4; ++i) v[r][i] = *(const f32x4*)(src + (size_t)mr[r] * D + F.lane * 4 + 256 * i); }
#pragma unroll
        for (int r = 0; r < 4; ++r) {
            float ss = 0.f;
#pragma unroll
            for (int i = 0; i < 4; ++i) ss += v[r][i][0] * v[r][i][0] + v[r][i][1] * v[r][i][1] + v[r][i][2] * v[r][i][2] + v[r][i][3] * v[r][i][3];
            ss = red64(ss);
            const float rs = __builtin_amdgcn_rsqf(ss * (1.0f / D) + NORM_EPS);
#pragma unroll
            for (int i = 0; i < 4; ++i) {
                const int c = F.lane * 4 + 256 * i;
                if (copy_to) *(u32x2*)(copy_to + (size_t)mr[r] * D + c) = (u32x2){pk_bf16(v[r][i][0], v[r][i][1]), pk_bf16(v[r][i][2], v[r][i][3])};
                const f32x4 gg = *(const f32x4*)(g + c);
                u32x2 w; w.x = pk_bf16(v[r][i][0] * rs * gg[0], v[r][i][1] * rs * gg[1]); w.y = pk_bf16(v[r][i][2] * rs * gg[2], v[r][i][3] * rs * gg[3]);
                *(u32x2*)(H + (size_t)mr[r] * D + c) = w;
            }
        }
    }
}
__device__ __forceinline__ void rmsnorm_rows_bf(const Frame& F, const bf16_t* __restrict__ Xb, const float* __restrict__ g, bf16_t* __restrict__ H) {
    const int ms = F.G * 8;
    f32x4 g0[2], g1[2];
#pragma unroll
    for (int i = 0; i < 2; ++i) { g0[i] = *(const f32x4*)(g + F.lane * 8 + 512 * i); g1[i] = *(const f32x4*)(g + F.lane * 8 + 512 * i + 4); }
    for (int m = F.bid * 8 + F.wave; m < M; m += 4 * ms) {
        u32x4 w[4][2]; int mr[4];
#pragma unroll
        for (int r = 0; r < 4; ++r) { mr[r] = (m + r * ms < M) ? m + r * ms : m;
#pragma unroll
            for (int i = 0; i < 2; ++i) w[r][i] = *(const u32x4*)(Xb + (size_t)mr[r] * D + F.lane * 8 + 512 * i); }
#pragma unroll
        for (int r = 0; r < 4; ++r) {
            float ss = 0.f;
#pragma unroll
            for (int i = 0; i < 2; ++i)
#pragma unroll
                for (int e = 0; e < 4; ++e) { const float a = bf_lo(w[r][i][e]), b = bf_hi(w[r][i][e]); ss += a * a + b * b; }
            const float rs = __builtin_amdgcn_rsqf(red64(ss) * (1.0f / D) + NORM_EPS);
#pragma unroll
            for (int i = 0; i < 2; ++i) {
                const int c = F.lane * 8 + 512 * i; const u32x4 x = w[r][i];
                u32x4 o; o.x = pk_bf16(bf_lo(x.x) * rs * g0[i][0], bf_hi(x.x) * rs * g0[i][1]); o.y = pk_bf16(bf_lo(x.y) * rs * g0[i][2], bf_hi(x.y) * rs * g0[i][3]);
                o.z = pk_bf16(bf_lo(x.z) * rs * g1[i][0], bf_hi(x.z) * rs * g1[i][1]); o.w = pk_bf16(bf_lo(x.w) * rs * g1[i][2], bf_hi(x.w) * rs * g1[i][3]);
                *(u32x4*)(H + (size_t)mr[r] * D + c) = o;
            }
        }
    }
}
__device__ __forceinline__ void final_norm(const Frame& F, const bf16_t* __restrict__ Xb) {
    const float* __restrict__ g = F.ap->in[21];
    float* __restrict__ out = F.X;
    const int ms = F.G * 8;
    for (int m = F.bid * 8 + F.wave; m < M; m += 4 * ms) {
        u32x4 w[4][2]; int mr[4];
#pragma unroll
        for (int r = 0; r < 4; ++r) { mr[r] = (m + r * ms < M) ? m + r * ms : m;
#pragma unroll
            for (int i = 0; i < 2; ++i) w[r][i] = *(const u32x4*)(Xb + (size_t)mr[r] * D + F.lane * 8 + 512 * i); }
#pragma unroll
        for (int r = 0; r < 4; ++r) {
            float ss = 0.f;
#pragma unroll
            for (int i = 0; i < 2; ++i)
#pragma unroll
                for (int e = 0; e < 4; ++e) { const float a = bf_lo(w[r][i][e]), b = bf_hi(w[r][i][e]); ss += a * a + b * b; }
            const float rs = __builtin_amdgcn_rsqf(red64(ss) * (1.0f / D) + NORM_EPS);
#pragma unroll
            for (int i = 0; i < 2; ++i) {
                const int c = F.lane * 8 + 512 * i; const u32x4 x = w[r][i];
                const f32x4 g0 = *(const f32x4*)(g + c), g1 = *(const f32x4*)(g + c + 4);
                *(f32x4*)(out + (size_t)mr[r] * D + c) = (f32x4){bf_lo(x.x) * rs * g0[0], bf_hi(x.x) * rs * g0[1], bf_lo(x.y) * rs * g0[2], bf_hi(x.y) * rs * g0[3]};
                *(f32x4*)(out + (size_t)mr[r] * D + c + 4) = (f32x4){bf_lo(x.z) * rs * g1[0], bf_hi(x.z) * rs * g1[1], bf_lo(x.w) * rs * g1[2], bf_hi(x.w) * rs * g1[3]};
            }
        }
    }
}
__device__ __forceinline__ void tw_phase(const Frame& F, int L) {
    const float* mu = F.ap->in[6] + (size_t)L * 3200;
    for (int it = F.bid * 512 + F.tid; it < M * 32; it += F.G * 512) {
        const int m = it >> 5, j = it & 31; u32x4 o = (u32x4){0u, 0u, 0u, 0u};
        if (j < 16) {
            const int c0 = 3072 + 8 * j, t = m & (SEQ - 1);
            const u32x4 cw = *(const u32x4*)(F.RAW + (size_t)m * RAWLD + c0);
            u32x4 pw = (u32x4){0u, 0u, 0u, 0u}; if (t > 0) pw = *(const u32x4*)(F.RAW + (size_t)(m - 1) * RAWLD + c0);
            const f32x4 m0 = *(const f32x4*)(mu + c0), m1 = *(const f32x4*)(mu + c0 + 4);
            float s[8];
#define SH(i, cwv, pwv, muv, hi) { const float c_ = hi ? bf_hi(cwv) : bf_lo(cwv), p_ = hi ? bf_hi(pwv) : bf_lo(pwv); s[i] = c_ + (muv) * (p_ - c_); }
            SH(0, cw.x, pw.x, m0[0], 0) SH(1, cw.x, pw.x, m0[1], 1) SH(2, cw.y, pw.y, m0[2], 0) SH(3, cw.y, pw.y, m0[3], 1)
            SH(4, cw.z, pw.z, m1[0], 0) SH(5, cw.z, pw.z, m1[1], 1) SH(6, cw.w, pw.w, m1[2], 0) SH(7, cw.w, pw.w, m1[3], 1)
#undef SH
            if (j < 8) {
#pragma unroll
                for (int i = 0; i < 8; ++i) s[i] = tanhf_(s[i]);
            }
            o.x = pk_bf16(s[0], s[1]); o.y = pk_bf16(s[2], s[3]); o.z = pk_bf16(s[4], s[5]); o.w = pk_bf16(s[6], s[7]);
        }
        *(u32x4*)(F.TW + (size_t)m * 256 + 8 * j) = o;
    }
}
__device__ __forceinline__ void vmix_phase(const Frame& F, int L) {
    const float* mu = F.ap->in[6] + (size_t)L * 3200 + 2048;
    const int tid = F.tid, c0 = 2 * tid;
    const f32x2 muv = *(const f32x2*)(mu + c0);
    LAS float* vsh = (LAS float*)F.lds;
    LAS float* part = (LAS float*)(F.lds + 16384);
    LAS float* midl = (LAS float*)(F.lds + 16384 + 8192);
    bf16_t* dst = (L == 0) ? F.VF : F.S3;
    float v1r[64]; f32x2 v2r[32]; f32x2 v0v = (f32x2){0.f, 0.f};
    const int jj = tid & 31, cs = tid >> 5;
    if (L > 0) {
        const float* V1 = F.ap->in[12] + (size_t)(L - 1) * D * 32; const float* V2 = F.ap->in[13] + (size_t)(L - 1) * 32 * D;
#pragma unroll
        for (int i = 0; i < 64; ++i) v1r[i] = V1[(size_t)(cs * 64 + i) * 32 + jj];
#pragma unroll
        for (int j = 0; j < 32; ++j) v2r[j] = *(const f32x2*)(V2 + (size_t)j * D + c0);
        v0v = *(const f32x2*)(F.ap->in[11] + (size_t)(L - 1) * D + c0);
    }
    for (int grp = F.bid; grp < M / 4; grp += F.G) {
        const int m0 = grp * 4, t0 = m0 & (SEQ - 1);
        unsigned rw[5];
        rw[0] = (t0 > 0) ? *(const unsigned*)(F.RAW + (size_t)(m0 - 1) * RAWLD + 2048 + c0) : 0u;
#pragma unroll
        for (int i = 0; i < 4; ++i) rw[i + 1] = *(const unsigned*)(F.RAW + (size_t)(m0 + i) * RAWLD + 2048 + c0);
        f32x2 vs[4];
#pragma unroll
        for (int i = 0; i < 4; ++i) { const float c_lo = bf_lo(rw[i + 1]), c_hi = bf_hi(rw[i + 1]), p_lo = bf_lo(rw[i]), p_hi = bf_hi(rw[i]);
            vs[i].x = c_lo + muv.x * (p_lo - c_lo); vs[i].y = c_hi + muv.y * (p_hi - c_hi); }
        if (L == 0) {
#pragma unroll
            for (int i = 0; i < 4; ++i) *(unsigned*)(dst + (size_t)(m0 + i) * D + c0) = pk_bf16(vs[i].x, vs[i].y);
            continue;
        }
#pragma unroll
        for (int i = 0; i < 4; ++i) *(LAS f32x2*)(vsh + i * 1024 + c0) = vs[i];
        __syncthreads();
#pragma unroll
        for (int i = 0; i < 4; ++i) {
            float p = 0.f;
#pragma unroll
            for (int k4 = 0; k4 < 16; ++k4) { const f32x4 x = *(const LAS f32x4*)(vsh + i * 1024 + cs * 64 + 4 * k4);
                p += x[0] * v1r[4 * k4] + x[1] * v1r[4 * k4 + 1] + x[2] * v1r[4 * k4 + 2] + x[3] * v1r[4 * k4 + 3]; }
            part[(i * 16 + cs) * 32 + jj] = p;
        }
        __syncthreads();
        if (tid < 128) { const int i = tid >> 5; float s = 0.f;
#pragma unroll
            for (int k = 0; k < 16; ++k) s += part[(i * 16 + k) * 32 + jj];
            midl[i * 32 + jj] = s; }
        __syncthreads();
#pragma unroll
        for (int i = 0; i < 4; ++i) {
            float z0 = v0v.x, z1 = v0v.y;
#pragma unroll
            for (int j4 = 0; j4 < 8; ++j4) { const f32x4 mm = *(const LAS f32x4*)(midl + i * 32 + 4 * j4);
#pragma unroll
                for (int e = 0; e < 4; ++e) { z0 += mm[e] * v2r[4 * j4 + e].x; z1 += mm[e] * v2r[4 * j4 + e].y; } }
            const float g0 = sigmoidf_(z0), g1 = sigmoidf_(z1);
            const unsigned fw = *(const unsigned*)(F.VF + (size_t)(m0 + i) * D + c0);
            const float o0 = vs[i].x + (bf_lo(fw) - vs[i].x) * g0, o1 = vs[i].y + (bf_hi(fw) - vs[i].y) * g1;
            *(unsigned*)(dst + (size_t)(m0 + i) * D + c0) = pk_bf16(o0, o1);
        }
        __syncthreads();
    }
}
__device__ __forceinline__ void poold_phase(const Frame& F, const bf16_t* __restrict__ PIN, bf16_t* __restrict__ SGIO, const float* __restrict__ scale) {
    const rsrc_t rs_out = wt_rsrc(SGIO);
    for (int it = F.bid * 512 + F.tid; it < (M / 32) * 128; it += F.G * 512) {
        const int j = it & 127, m0 = (it >> 7) * 32, t0 = m0 & (SEQ - 1), w = 2 << (j >> 5);
        const bf16_t* col = PIN + 8 * j;
        const f32x4 sc0 = *(const f32x4*)(scale + 8 * j), sc1 = *(const f32x4*)(scale + 8 * j + 4);
        float s[8];
#pragma unroll
        for (int e = 0; e < 8; ++e) s[e] = 0.f;
        if (t0 > 0) {
            u32x4 xw[15];
#pragma unroll
            for (int i = 1; i < 16; ++i) xw[i - 1] = *(const u32x4*)(col + (size_t)(m0 - (i < w ? i : 1)) * D);
#pragma unroll
            for (int i = 1; i < 16; ++i) { const float f = (i < w) ? 1.0f : 0.0f; const u32x4 x = xw[i - 1];
                s[0] += f * bf_lo(x.x); s[1] += f * bf_hi(x.x); s[2] += f * bf_lo(x.y); s[3] += f * bf_hi(x.y); s[4] += f * bf_lo(x.z); s[5] += f * bf_hi(x.z); s[6] += f * bf_lo(x.w); s[7] += f * bf_hi(x.w); }
        }
        for (int sb = 0; sb < 4; ++sb) {
            u32x4 xv[8], ov[8], gv[8];
#pragma unroll
            for (int i = 0; i < 8; ++i) {
                const int ii = sb * 8 + i, t = t0 + ii; const size_t m = (size_t)(m0 + ii);
                const bool sub = (t >= w) && (ii > 0);
                xv[i] = *(const u32x4*)(col + m * D);
                ov[i] = *(const u32x4*)(col + (sub ? m - w : m) * D);
                gv[i] = *(const u32x4*)(SGIO + m * D + 8 * j);
            }
#pragma unroll
            for (int i = 0; i < 8; ++i) {
                const int ii = sb * 8 + i, t = t0 + ii; const size_t m = (size_t)(m0 + ii);
                const float fs = ((t >= w) && (ii > 0)) ? 1.0f : 0.0f;
                const u32x4 x = xv[i], o = ov[i], gw = gv[i];
                const float c[8] = {bf_lo(x.x), bf_hi(x.x), bf_lo(x.y), bf_hi(x.y), bf_lo(x.z), bf_hi(x.z), bf_lo(x.w), bf_hi(x.w)};
                const float d[8] = {bf_lo(o.x), bf_hi(o.x), bf_lo(o.y), bf_hi(o.y), bf_lo(o.z), bf_hi(o.z), bf_lo(o.w), bf_hi(o.w)};
#pragma unroll
                for (int e = 0; e < 8; ++e) s[e] += c[e] - fs * d[e];
                const float inv = __builtin_amdgcn_rcpf((float)((t + 1 < w) ? (t + 1) : w));
                u32x4 r; r.x = pk_bf16((s[0] * inv - c[0]) * sc0[0] * bf_lo(gw.x), (s[1] * inv - c[1]) * sc0[1] * bf_hi(gw.x)); r.y = pk_bf16((s[2] * inv - c[2]) * sc0[2] * bf_lo(gw.y), (s[3] * inv - c[3]) * sc0[3] * bf_hi(gw.y));
                r.z = pk_bf16((s[4] * inv - c[4]) * sc1[0] * bf_lo(gw.z), (s[5] * inv - c[5]) * sc1[1] * bf_hi(gw.z)); r.w = pk_bf16((s[6] * inv - c[6]) * sc1[2] * bf_lo(gw.w), (s[7] * inv - c[7]) * sc1[3] * bf_hi(gw.w));
                ST16_WT(rs_out, (m * D + 8 * j) * 2, r);
            }
        }
    }
}

constexpr int SC_T = 32;
constexpr int SC_ARR = SC_T * 64;
constexpr int SC_BUF_BYTES = 6 * SC_ARR * 4;
constexpr int SC_YS = 2 * SC_BUF_BYTES, SC_RAWR = SC_YS + SC_ARR * 4, SC_RAWK = SC_RAWR + SC_ARR * 4, SC_PREV = SC_RAWK + SC_ARR * 4;
static_assert(SC_PREV + 1024 <= 131072, "scan LDS");

#define QP(n) "quad_perm:[" #n "," #n "," #n "," #n "] row_mask:0xf bank_mask:0xf"
__device__ __forceinline__ void sc_matvec(float& o0, float& o1, const f32x2 x, const float (&S)[8]) {
    asm volatile("s_nop 1\n\t"
        "v_mul_f32_dpp %0, %2, %4 " QP(0) "\n\t"  "v_mul_f32_dpp %1, %3, %5 " QP(0) "\n\t"
        "v_fmac_f32_dpp %0, %2, %6 " QP(1) "\n\t" "v_fmac_f32_dpp %1, %3, %7 " QP(1) "\n\t"
        "v_fmac_f32_dpp %0, %2, %8 " QP(2) "\n\t" "v_fmac_f32_dpp %1, %3, %9 " QP(2) "\n\t"
        "v_fmac_f32_dpp %0, %2, %10 " QP(3) "\n\t" "v_fmac_f32_dpp %1, %3, %11 " QP(3)
        : "=&v"(o0), "=&v"(o1) : "v"(x.x), "v"(x.y), "v"(S[0]), "v"(S[1]), "v"(S[2]), "v"(S[3]), "v"(S[4]), "v"(S[5]), "v"(S[6]), "v"(S[7]));
}
__device__ __forceinline__ void sc_update(float (&S)[8], const f32x2 w, const f32x2 b, const f32x2 k, const float sa, const float vv) {
    asm volatile("s_nop 1\n\t"
        "v_mul_f32_dpp %0, %8, %0 " QP(0) "\n\t" "v_mul_f32_dpp %1, %9, %1 " QP(0) "\n\t"
        "v_mul_f32_dpp %2, %8, %2 " QP(1) "\n\t" "v_mul_f32_dpp %3, %9, %3 " QP(1) "\n\t"
        "v_mul_f32_dpp %4, %8, %4 " QP(2) "\n\t" "v_mul_f32_dpp %5, %9, %5 " QP(2) "\n\t"
        "v_mul_f32_dpp %6, %8, %6 " QP(3) "\n\t" "v_mul_f32_dpp %7, %9, %7 " QP(3) "\n\t"
        "v_fmac_f32_dpp %0, %10, %14 " QP(0) "\n\t" "v_fmac_f32_dpp %1, %11, %14 " QP(0) "\n\t"
        "v_fmac_f32_dpp %2, %10, %14 " QP(1) "\n\t" "v_fmac_f32_dpp %3, %11, %14 " QP(1) "\n\t"
        "v_fmac_f32_dpp %4, %10, %14 " QP(2) "\n\t" "v_fmac_f32_dpp %5, %11, %14 " QP(2) "\n\t"
        "v_fmac_f32_dpp %6, %10, %14 " QP(3) "\n\t" "v_fmac_f32_dpp %7, %11, %14 " QP(3) "\n\t"
        "v_fmac_f32_dpp %0, %12, %15 " QP(0) "\n\t" "v_fmac_f32_dpp %1, %13, %15 " QP(0) "\n\t"
        "v_fmac_f32_dpp %2, %12, %15 " QP(1) "\n\t" "v_fmac_f32_dpp %3, %13, %15 " QP(1) "\n\t"
        "v_fmac_f32_dpp %4, %12, %15 " QP(2) "\n\t" "v_fmac_f32_dpp %5, %13, %15 " QP(2) "\n\t"
        "v_fmac_f32_dpp %6, %12, %15 " QP(3) "\n\t" "v_fmac_f32_dpp %7, %13, %15 " QP(3)
        : "+v"(S[0]), "+v"(S[1]), "+v"(S[2]), "+v"(S[3]), "+v"(S[4]), "+v"(S[5]), "+v"(S[6]), "+v"(S[7])
        : "v"(w.x), "v"(w.y), "v"(b.x), "v"(b.y), "v"(k.x), "v"(k.y), "v"(sa), "v"(vv));
}
__device__ __forceinline__ float sc_red(float x) {
    asm volatile("s_nop 1\n\tv_add_f32_dpp %0, %0, %0 row_ror:4 row_mask:0xf bank_mask:0xf\n\ts_nop 1\n\tv_add_f32_dpp %0, %0, %0 row_ror:8 row_mask:0xf bank_mask:0xf" : "+v"(x));
    const auto r = __builtin_amdgcn_permlane32_swap(__float_as_uint(x), __float_as_uint(x), false, false);
    return __uint_as_float(r[0]) + __uint_as_float(r[1]);
}
#undef QP
struct ScanRegs { u32x2 rr, kr, ee, aa, vv; };
__device__ __forceinline__ void scan_phase(const Frame& F, int L, const bf16_t* VP) {
    const int tid = F.tid, lane = F.lane, wave = F.wave;
    LAS float* Ys = (LAS float*)(F.lds + SC_YS);
    LAS float* rawR = (LAS float*)(F.lds + SC_RAWR);
    LAS float* rawK = (LAS float*)(F.lds + SC_RAWK);
    LAS float* prevRK = (LAS float*)(F.lds + SC_PREV);
    const int tok = tid >> 4, q = tid & 15;
    const int kc = ((lane >> 5) << 2) | ((lane >> 2) & 3), row = wave * 8 + ((lane >> 4) & 1) * 4 + (lane & 3), koff = 8 * kc + 2 * (lane & 3);
    for (int unit = F.bid; unit < 256; unit += F.G) {
        const int b = unit >> 4, h = unit & 15, hc = h * 64 + 4 * q;
        const f32x4 kk4 = *(const f32x4*)(F.ap->in[14] + (size_t)L * D + hc), ka4 = *(const f32x4*)(F.ap->in[15] + (size_t)L * D + hc);
        const f32x4 rk4 = *(const f32x4*)(F.ap->in[16] + (size_t)L * D + hc);
        const f32x4 lw4 = *(const f32x4*)(F.ap->in[17] + (size_t)L * D + hc), lb4 = *(const f32x4*)(F.ap->in[18] + (size_t)L * D + hc);
        const f32x4 mur4 = *(const f32x4*)(F.ap->in[6] + (size_t)L * 3200 + hc), muk4 = *(const f32x4*)(F.ap->in[6] + (size_t)L * 3200 + 1024 + hc);
        const size_t mrow0 = (size_t)b * SEQ;
        float S[8];
#pragma unroll
        for (int j = 0; j < 8; ++j) S[j] = 0.f;
        ScanRegs R;
#define SC_LOAD(cidx) do { const size_t m_ = mrow0 + (size_t)(cidx) * SC_T + tok; \
            R.rr = *(const u32x2*)(F.RAW + m_ * RAWLD + hc); R.kr = *(const u32x2*)(F.RAW + m_ * RAWLD + 1024 + hc); \
            R.ee = *(const u32x2*)(F.S1 + m_ * D + hc); R.aa = *(const u32x2*)(F.S2 + m_ * D + hc); R.vv = *(const u32x2*)(VP + m_ * D + hc); } while (0)
#define SC_PREP(cidx) do { \
            const f32x4 rc = (f32x4){bf_lo(R.rr.x), bf_hi(R.rr.x), bf_lo(R.rr.y), bf_hi(R.rr.y)}; \
            const f32x4 kc = (f32x4){bf_lo(R.kr.x), bf_hi(R.kr.x), bf_lo(R.kr.y), bf_hi(R.kr.y)}; \
            *(LAS f32x4*)(rawR + tok * 64 + 4 * q) = rc; *(LAS f32x4*)(rawK + tok * 64 + 4 * q) = kc; \
            __syncthreads(); \
            f32x4 rp, kp; \
            if (tok > 0) { rp = *(const LAS f32x4*)(rawR + (tok - 1) * 64 + 4 * q); kp = *(const LAS f32x4*)(rawK + (tok - 1) * 64 + 4 * q); } \
            else if ((cidx) > 0) { rp = *(const LAS f32x4*)(prevRK + (((cidx) & 1) * 2 + 0) * 64 + 4 * q); kp = *(const LAS f32x4*)(prevRK + (((cidx) & 1) * 2 + 1) * 64 + 4 * q); } \
            else { rp = (f32x4){0.f, 0.f, 0.f, 0.f}; kp = rp; } \
            if (tok == SC_T - 1) { *(LAS f32x4*)(prevRK + ((((cidx) + 1) & 1) * 2 + 0) * 64 + 4 * q) = rc; *(LAS f32x4*)(prevRK + ((((cidx) + 1) & 1) * 2 + 1) * 64 + 4 * q) = kc; } \
            const f32x4 rs = rc + mur4 * (rp - rc), ks = kc + muk4 * (kp - kc); \
            const f32x4 ev = (f32x4){bf_lo(R.ee.x), bf_hi(R.ee.x), bf_lo(R.ee.y), bf_hi(R.ee.y)}; \
            const f32x4 av = (f32x4){bf_lo(R.aa.x), bf_hi(R.aa.x), bf_lo(R.aa.y), bf_hi(R.aa.y)}; \
            const f32x4 vv = (f32x4){bf_lo(R.vv.x), bf_hi(R.vv.x), bf_lo(R.vv.y), bf_hi(R.vv.y)}; \
            f32x4 kkv = ks * kk4; \
            float ss = kkv[0] * kkv[0] + kkv[1] * kkv[1] + kkv[2] * kkv[2] + kkv[3] * kkv[3]; ss = red16(ss); \
            const float inv = 1.0f / fmaxf(sqrtf(ss), 1e-12f); kkv = kkv * inv; \
            const f32x4 kmod = ks * (1.0f + (av - 1.0f) * ka4); \
            f32x4 wv; wv[0] = __expf(-ev[0]); wv[1] = __expf(-ev[1]); wv[2] = __expf(-ev[2]); wv[3] = __expf(-ev[3]); \
            LAS float* cb_ = (LAS float*)(F.lds + ((cidx) & 1) * SC_BUF_BYTES) + tok * 64 + 4 * q; \
            *(LAS f32x4*)(cb_ + 0 * SC_ARR) = rs; *(LAS f32x4*)(cb_ + 1 * SC_ARR) = wv; *(LAS f32x4*)(cb_ + 2 * SC_ARR) = kmod; \
            *(LAS f32x4*)(cb_ + 3 * SC_ARR) = -kkv; *(LAS f32x4*)(cb_ + 4 * SC_ARR) = kkv * av; *(LAS f32x4*)(cb_ + 5 * SC_ARR) = vv; } while (0)
        SC_LOAD(0);
        SC_PREP(0);
        __syncthreads();
        for (int c = 0; c < SEQ / SC_T; ++c) {
            if (c + 1 < SEQ / SC_T) SC_LOAD(c + 1);
            const LAS float* cb = (const LAS float*)(F.lds + (c & 1) * SC_BUF_BYTES);
            const LAS float* pin = cb + koff;
            const LAS float* pv = cb + 5 * SC_ARR + row;
#define SC_LD(dst, t_) do { dst##r = *(const LAS f32x2*)(pin + 0 * SC_ARR + (t_) * 64); dst##w = *(const LAS f32x2*)(pin + 1 * SC_ARR + (t_) * 64); dst##k = *(const LAS f32x2*)(pin + 2 * SC_ARR + (t_) * 64); \
                dst##a = *(const LAS f32x2*)(pin + 3 * SC_ARR + (t_) * 64); dst##b = *(const LAS f32x2*)(pin + 4 * SC_ARR + (t_) * 64); dst##v = pv[(t_) * 64]; } while (0)
#define SC_STEP(src, t_) do { float p0_, p1_; sc_matvec(p0_, p1_, src##a, S); const float sa_ = sc_red(p0_ + p1_); sc_update(S, src##w, src##b, src##k, sa_, src##v); \
                sc_matvec(p0_, p1_, src##r, S); const float y_ = sc_red(p0_ + p1_); if (kc == 0) Ys[(t_) * 64 + row] = y_; } while (0)
            f32x2 Ar, Aw, Ak, Aa, Ab, Br, Bw, Bk, Ba, Bb; float Av, Bv;
            SC_LD(A, 0);
            for (int t = 0; t < SC_T; t += 2) {
                SC_LD(B, t + 1);
                SC_STEP(A, t);
                if (t + 2 < SC_T) SC_LD(A, t + 2);
                SC_STEP(B, t + 1);
            }
#undef SC_LD
#undef SC_STEP
            __syncthreads();
            {
                const f32x4 y4 = *(const LAS f32x4*)(Ys + tok * 64 + 4 * q);
                const float mean = red16((y4[0] + y4[1]) + (y4[2] + y4[3])) * (1.0f / 64.0f);
                const f32x4 d = y4 - mean;
                const float var = red16((d[0] * d[0] + d[1] * d[1]) + (d[2] * d[2] + d[3] * d[3])) * (1.0f / 64.0f);
                const float rstd = __builtin_amdgcn_rsqf(var + LNX_EPS);
                const f32x4 rs = *(const LAS f32x4*)(cb + 0 * SC_ARR + tok * 64 + 4 * q), km = *(const LAS f32x4*)(cb + 2 * SC_ARR + tok * 64 + 4 * q), vv = *(const LAS f32x4*)(cb + 5 * SC_ARR + tok * 64 + 4 * q);
                const f32x4 pr = rs * km * rk4;
                const float bon = red16((pr[0] + pr[1]) + (pr[2] + pr[3]));
                const f32x4 z = d * rstd * lw4 + lb4 + bon * vv;
                u32x2 o; o.x = pk_bf16(z[0], z[1]); o.y = pk_bf16(z[2], z[3]);
                *(u32x2*)(F.RAW + (mrow0 + (size_t)c * SC_T + tok) * RAWLD + hc) = o;
            }
            if (c + 1 < SEQ / SC_T) SC_PREP(c + 1);
            __syncthreads();
        }
#undef SC_LOAD
#undef SC_PREP
    }
}


constexpr int C2_AT = 0, C2_RT = 2048, C2_BK = 4096, C2_VT = 8192, C2_NAK = 10240, C2_NRBK = 10752, C2_MT = 11776, C2_GTV = 12288, C2_BON = 12544, C2_CH = 12800;
constexpr int C2_YS = 8 * C2_CH;
constexpr int C2_PREV = C2_YS + 32768;
constexpr int C2_W2S = C2_PREV + 512, C2_A2S = C2_W2S + 8192;
constexpr int C2_V2S = C2_A2S + 8192;
static_assert(C2_V2S + 8192 + 512 <= 163776, "scan LDS");
typedef short s16x4 __attribute__((ext_vector_type(4)));
__device__ __forceinline__ u32x2 tr4(const LAS unsigned char* img, int k0, int lane) {
    return __builtin_bit_cast(u32x2, __builtin_amdgcn_ds_read_tr16_b64_v4i16((LAS s16x4*)(img + (k0 + ((lane & 15) >> 2)) * 32 + (lane & 3) * 8)));
}
__device__ __forceinline__ u32x2 tr4bk(const LAS unsigned char* img, int k0, int lane) {
    return __builtin_bit_cast(u32x2, __builtin_amdgcn_ds_read_tr16_b64_v4i16((LAS s16x4*)(img + (k0 + ((lane & 15) >> 2)) * 64 + (lane & 3) * 16)));
}
__device__ __forceinline__ void wr_row(LAS unsigned char* img, int lane, const unsigned (&w)[8]) {
    *(LAS u32x4*)(img + lane * 32) = (u32x4){w[0], w[1], w[2], w[3]}; *(LAS u32x4*)(img + lane * 32 + 16) = (u32x4){w[4], w[5], w[6], w[7]};
}
__device__ __forceinline__ bf16x8 mk_frag(u32x2 lo, u32x2 hi) { return __builtin_bit_cast(bf16x8, (u32x4){lo.x, lo.y, hi.x, hi.y}); }
__device__ __forceinline__ u32x2 pk4(const f32x4 a) { return (u32x2){pk_bf16(a[0], a[1]), pk_bf16(a[2], a[3])}; }
__device__ __forceinline__ float bf1(unsigned short v) { return __uint_as_float((unsigned)v << 16); }
__device__ __forceinline__ unsigned short f2bf(float x) { return (unsigned short)(pk_bf16(x, 0.f) & 0xffffu); }
__device__ __forceinline__ void st2(LAS unsigned char* p0, LAS unsigned char* p1, float a, float b) { const unsigned w = pk_bf16(a, b); *(LAS unsigned short*)p0 = (unsigned short)w; *(LAS unsigned short*)p1 = (unsigned short)(w >> 16); }
__device__ __forceinline__ void scan2_phase(const Frame& F, int L) {
    const int tid = F.tid, lane = F.lane, wave = F.wave, fr = lane & 15, fq = lane >> 4;
    LAS unsigned char* lds = F.lds;
    for (int unit0 = F.bid; unit0 < 256; unit0 += F.G) {
        const int unit = (unit0 & 7) * 32 + (unit0 >> 3);
        int lane_u = lane; asm volatile("" : "+v"(lane_u));
        const int b = unit >> 4, h = unit & 15, ch = h * 64 + lane_u;
        const size_t mrow0 = (size_t)b * SEQ;
        const float c_kk = F.ap->in[14][(size_t)L * D + ch], c_ka = F.ap->in[15][(size_t)L * D + ch], c_rk = F.ap->in[16][(size_t)L * D + ch];
        const float c_mur = F.ap->in[6][(size_t)L * 3200 + ch], c_muk = F.ap->in[6][(size_t)L * 3200 + 1024 + ch];
        f32x4 St[4];
#pragma unroll
        for (int i = 0; i < 4; ++i) St[i] = (f32x4){0.f, 0.f, 0.f, 0.f};
        int tid_u = wave * 64 + lane_now();
        if (tid_u < 24) *(volatile LAS unsigned*)(lds + C2_PREV + tid_u * 4) = 0u;
        if (tid_u < 128) *(LAS float*)(lds + C2_V2S + 8192 + tid_u * 4) = (tid_u < 64) ? F.ap->in[17][(size_t)L * D + h * 64 + tid_u] : F.ap->in[18][(size_t)L * D + h * 64 + tid_u - 64];
        for (int i = tid_u; i < 1024; i += 512) { const int which = i >> 9, e = i & 511;
            *(LAS u32x4*)(lds + C2_W2S + which * 8192 + e * 16) = *(const u32x4*)(F.EAT + (size_t)which * 65536 + (size_t)h * 64 * 64 + e * 8); }
        if (L > 0) for (int e = tid_u; e < 512; e += 512) { const int chl = e >> 3, p = e & 7;
            *(LAS u32x4*)(lds + C2_V2S + e * 16) = *(const u32x4*)(F.EAT + 131072 + (size_t)(h * 64 + chl) * 32 + ((8 * p) & 31)); }
        const float c_muw = F.ap->in[6][(size_t)L * 3200 + 3072 + lane_u], c_mua = F.ap->in[6][(size_t)L * 3200 + 3136 + lane_u], c_muv = F.ap->in[6][(size_t)L * 3200 + 2048 + ch];
        float c_v0[4];
#pragma unroll
        for (int i = 0; i < 4; ++i) c_v0[i] = F.ap->in[11][(size_t)(L > 0 ? L - 1 : 0) * D + h * 64 + 16 * i + (lane_u & 15)];
        float c_w0[4], c_a0[4];
#pragma unroll
        for (int i = 0; i < 4; ++i) { c_w0[i] = F.ap->in[7][(size_t)L * D + h * 64 + 16 * i + (lane_u & 15)]; c_a0[i] = F.ap->in[9][(size_t)L * D + h * 64 + 16 * i + (lane_u & 15)]; }
        __syncthreads();
        const auto rs_raw = __builtin_amdgcn_make_buffer_rsrc((void*)F.RAW, 0, (int)((size_t)M * RAWLDB * 2), 0x00020000);
        const auto rs_vf = __builtin_amdgcn_make_buffer_rsrc((void*)F.VF, 0, M * D * 2, 0x00020000);
        const int voh = ch * 32, vol = lane * 32;
#define LDQ(vofs, q, tb) __builtin_bit_cast(u32x4, __builtin_amdgcn_raw_buffer_load_b128(rs_raw, (vofs) + (q) * 16, (int)(tb) * (RAWLDB * 32), 0))
#define LDP(vofs, tb) __builtin_amdgcn_raw_buffer_load_b16(rs_raw, (vofs) + 30, (int)(tb) * (RAWLDB * 32), 0)
#define QF(q, t) (((t) & 1) ? bf_hi((q)[(t) >> 1]) : bf_lo((q)[(t) >> 1]))
#define QP(q, pv, i) (((i) == 0) ? bf1(pv) : QF(q, ((i) > 0 ? (i) - 1 : 0)))

        for (int g = 0; g < SEQ / 128; ++g) {
            while (*(volatile LAS unsigned*)(lds + C2_PREV + 64 + wave * 4) < (unsigned)g) __builtin_amdgcn_s_sleep(1);
            asm volatile("" ::: "memory");
            {
                int lane_ = lane; asm volatile("" : "+v"(lane_));
                const int fr = lane_ & 15, fq = lane_ >> 4;
                const int m0 = (int)mrow0 + g * 128 + wave * 16;
                LAS unsigned char* cb = lds + wave * C2_CH;
                LAS unsigned char* scr = lds + C2_YS + wave * 4096;
                const int tb = m0 >> 4, tbp = (tb > 0) ? tb - 1 : 0;
                unsigned rrq[8], krq[8], aaq[8], eeq[8], vvp[8];
                unsigned vrq[8], xrq[8], mixq[8]; unsigned short vprev, xprev;
                {
                    const bool has_prev = (g > 0) || (wave > 0);
                    const unsigned short pm = has_prev ? (unsigned short)0xffffu : (unsigned short)0;
                    unsigned twp[8], adp[8];
#pragma unroll
                    for (int q = 0; q < 2; ++q) { const u32x4 w4 = LDQ(vol + 3328 * 32, q, tb), a4 = LDQ(vol + 3392 * 32, q, tb);
#pragma unroll
                        for (int e = 0; e < 4; ++e) { twp[4 * q + e] = w4[e]; adp[4 * q + e] = a4[e]; } }
                    const unsigned short wprev = LDP(vol + 3072 * 32, tbp) & pm, aprev = LDP(vol + 3136 * 32, tbp) & pm;
                    const unsigned short wcur = __builtin_amdgcn_raw_buffer_load_b16(rs_raw, vol + 3072 * 32, tb * (RAWLDB * 32), 0), acur = __builtin_amdgcn_raw_buffer_load_b16(rs_raw, vol + 3136 * 32, tb * (RAWLDB * 32), 0);
                    {
                        vprev = LDP(voh + 2048 * 32, tbp) & pm; xprev = LDP(vol + 3200 * 32, tbp) & pm;
#pragma unroll
                        for (int q = 0; q < 2; ++q) { const u32x4 v4 = LDQ(voh + 2048 * 32, q, tb), x4 = LDQ(vol + 3200 * 32, q, tb);
                            const u32x4 f4 = __builtin_bit_cast(u32x4, __builtin_amdgcn_raw_buffer_load_b128(rs_vf, voh + q * 16, tb * (D * 32), 0));
#pragma unroll
                            for (int e = 0; e < 4; ++e) { vrq[4 * q + e] = v4[e]; xrq[4 * q + e] = x4[e]; mixq[4 * q + e] = f4[e]; } }
                    }
                    __builtin_amdgcn_sched_barrier(0);
                    if ((wave & 1) == 0) {
                        const float w1_ = bf1(wcur), a1_ = bf1(acur);
                        const unsigned fw = pk_bf16(tanhf_(w1_ + c_muw * (bf1(wprev) - w1_)), 0.f) & 0xffffu, fa = pk_bf16(a1_ + c_mua * (bf1(aprev) - a1_), 0.f) & 0xffffu;
                        twp[0] = (twp[0] & 0xffff0000u) | fw; adp[0] = (adp[0] & 0xffff0000u) | fa;
                    }
                    wr_row(scr, lane, twp); wr_row(scr + 2048, lane, adp);
                    asm volatile("s_waitcnt lgkmcnt(0)" ::: "memory");
                    f32x4 le[4], la[4];
#pragma unroll
                    for (int i = 0; i < 4; ++i) { le[i] = (f32x4){0.f, 0.f, 0.f, 0.f}; la[i] = le[i]; }
#pragma unroll
                    for (int s2 = 0; s2 < 2; ++s2) {
                        const int k0 = 32 * s2 + 8 * fq;
                        const bf16x8 fw = mk_frag(tr4(scr, k0, lane), tr4(scr, k0 + 4, lane)), fa = mk_frag(tr4(scr + 2048, k0, lane), tr4(scr + 2048, k0 + 4, lane));
#pragma unroll
                        for (int i = 0; i < 4; ++i) {
                            le[i] = __builtin_amdgcn_mfma_f32_16x16x32_bf16(fw, *(const LAS bf16x8*)(lds + C2_W2S + (16 * i + fr) * 128 + (32 * s2 + 8 * fq) * 2), le[i], 0, 0, 0);
                            la[i] = __builtin_amdgcn_mfma_f32_16x16x32_bf16(fa, *(const LAS bf16x8*)(lds + C2_A2S + (16 * i + fr) * 128 + (32 * s2 + 8 * fq) * 2), la[i], 0, 0, 0);
                        }
                    }
#pragma unroll
                    for (int i = 0; i < 4; ++i)
                        {
                            *(LAS u32x2*)(scr + (16 * i + fr) * 32 + fq * 8) = (u32x2){pk_bf16(0.60653065971f * sigmoidf_(le[i][0] + c_w0[i]), 0.60653065971f * sigmoidf_(le[i][1] + c_w0[i])), pk_bf16(0.60653065971f * sigmoidf_(le[i][2] + c_w0[i]), 0.60653065971f * sigmoidf_(le[i][3] + c_w0[i]))};
                            *(LAS u32x2*)(scr + 2048 + (16 * i + fr) * 32 + fq * 8) = (u32x2){pk_bf16(sigmoidf_(la[i][0] + c_a0[i]), sigmoidf_(la[i][1] + c_a0[i])), pk_bf16(sigmoidf_(la[i][2] + c_a0[i]), sigmoidf_(la[i][3] + c_a0[i]))};
                        }
                    asm volatile("s_waitcnt lgkmcnt(0)" ::: "memory");
#pragma unroll
                    for (int q = 0; q < 2; ++q) { const u32x4 we = *(const LAS u32x4*)(scr + lane * 32 + q * 16), wa = *(const LAS u32x4*)(scr + 2048 + lane * 32 + q * 16);
#pragma unroll
                        for (int e = 0; e < 4; ++e) { eeq[4 * q + e] = we[e]; aaq[4 * q + e] = wa[e]; } }
                    asm volatile("s_waitcnt lgkmcnt(0)" ::: "memory");
                }
                unsigned tch[7];
                {   const int tbn = ((int)mrow0 + (g + 1 < SEQ / 128 ? g + 1 : g) * 128 + wave * 16) >> 4;
                    tch[0] = __builtin_amdgcn_raw_buffer_load_b32(rs_raw, vol + 3328 * 32, tbn * (RAWLDB * 32), 0); tch[1] = __builtin_amdgcn_raw_buffer_load_b32(rs_raw, vol + 3392 * 32, tbn * (RAWLDB * 32), 0);
                    tch[2] = __builtin_amdgcn_raw_buffer_load_b32(rs_raw, vol + 3200 * 32, tbn * (RAWLDB * 32), 0); tch[3] = __builtin_amdgcn_raw_buffer_load_b32(rs_raw, voh, tbn * (RAWLDB * 32), 0);
                    tch[4] = __builtin_amdgcn_raw_buffer_load_b32(rs_raw, voh + 1024 * 32, tbn * (RAWLDB * 32), 0); tch[5] = __builtin_amdgcn_raw_buffer_load_b32(rs_raw, voh + 2048 * 32, tbn * (RAWLDB * 32), 0);
                    tch[6] = __builtin_amdgcn_raw_buffer_load_b32(rs_vf, voh, tbn * (D * 32), 0); }
                {
                    __builtin_amdgcn_sched_barrier(0);
#pragma unroll
                    for (int q = 0; q < 2; ++q) { const u32x4 r4 = LDQ(voh, q, tb), k4 = LDQ(voh + 1024 * 32, q, tb);
#pragma unroll
                        for (int e = 0; e < 4; ++e) { rrq[4 * q + e] = r4[e]; krq[4 * q + e] = k4[e]; } }
                    __builtin_amdgcn_sched_barrier(0);
                    if (L > 0) {
                        unsigned xp[8];
#pragma unroll
                        for (int i = 0; i < 8; ++i) { const unsigned xs = (i == 0) ? ((unsigned)xprev | (xrq[0] << 16)) : __builtin_amdgcn_alignbit(xrq[i], xrq[i > 0 ? i - 1 : 0], 16);
                            xp[i] = (lane < 32) ? xrq[i] : xs; }
                        wr_row(scr, lane, xp);
                        asm volatile("s_waitcnt lgkmcnt(0)" ::: "memory");
                        f32x4 mx[4];
#pragma unroll
                        for (int i = 0; i < 4; ++i) mx[i] = (f32x4){0.f, 0.f, 0.f, 0.f};
#pragma unroll
                        for (int s2 = 0; s2 < 2; ++s2) { const bf16x8 fx = mk_frag(tr4(scr, 32 * s2 + 8 * fq, lane), tr4(scr, 32 * s2 + 8 * fq + 4, lane));
#pragma unroll
                            for (int i = 0; i < 4; ++i) mx[i] = __builtin_amdgcn_mfma_f32_16x16x32_bf16(fx, *(const LAS bf16x8*)(lds + C2_V2S + (16 * i + fr) * 128 + (32 * s2 + 8 * fq) * 2), mx[i], 0, 0, 0); }
#pragma unroll
                        for (int i = 0; i < 4; ++i)
                            *(LAS u32x2*)(scr + (16 * i + fr) * 32 + fq * 8) = (u32x2){pk_bf16(sigmoidf_(mx[i][0] + c_v0[i]), sigmoidf_(mx[i][1] + c_v0[i])), pk_bf16(sigmoidf_(mx[i][2] + c_v0[i]), sigmoidf_(mx[i][3] + c_v0[i]))};
                        asm volatile("s_waitcnt lgkmcnt(0)" ::: "memory");
                    }
                    if (L > 0) {
                        const u32x4 mw0 = *(const LAS u32x4*)(scr + lane * 32), mw1 = *(const LAS u32x4*)(scr + lane * 32 + 16);
#pragma unroll
                        for (int t = 0; t < 16; t += 2) {
                            const float v0_ = QP(vrq, vprev, t), v1_ = QP(vrq, vprev, t + 1), v2_ = QP(vrq, vprev, t + 2), vs0 = v1_ + c_muv * (v0_ - v1_), vs1 = v2_ + c_muv * (v1_ - v2_);
                            const unsigned mwp = (t < 8) ? mw0[t >> 1] : mw1[(t - 8) >> 1];
                            const float mix0 = bf_lo(mwp), mix1 = bf_hi(mwp);
                            vvp[t >> 1] = pk_bf16(vs0 + (QF(mixq, t) - vs0) * mix0, vs1 + (QF(mixq, t + 1) - vs1) * mix1);
                        }
                    } else {
#pragma unroll
                        for (int t = 0; t < 16; t += 2) {
                            const float v0_ = QP(vrq, vprev, t), v1_ = QP(vrq, vprev, t + 1), v2_ = QP(vrq, vprev, t + 2);
                            vvp[t >> 1] = pk_bf16(v1_ + c_muv * (v0_ - v1_), v2_ + c_muv * (v1_ - v2_));
                        }
#pragma unroll
                        for (int q = 0; q < 2; ++q) __builtin_amdgcn_raw_buffer_store_b128(__builtin_bit_cast(decltype(__builtin_amdgcn_raw_buffer_load_b128(rs_vf, 0, 0, 0)), (u32x4){vvp[4 * q], vvp[4 * q + 1], vvp[4 * q + 2], vvp[4 * q + 3]}), rs_vf, voh + q * 16, tb * (D * 32), 0);
                    }
                    asm volatile("s_waitcnt lgkmcnt(0)" ::: "memory");
                }
                float rprev = 0.f, kprev = 0.f;
                {
                    const float rp_g = bf1(LDP(voh, tbp)), kp_g = bf1(LDP(voh + 1024 * 32, tbp));
                    rprev = (wave > 0 || g > 0) ? rp_g : 0.f; kprev = (wave > 0 || g > 0) ? kp_g : 0.f;
                }
#pragma unroll
                for (int i = 0; i < 7; ++i) asm volatile("" :: "v"(tch[i]));
                float lg = 0.f, gcarry = 1.0f, sql = 0.f, pbl = 0.f;
                unsigned sqp[4], pbp[4], atp[4], rtp[4]; unsigned bkp[16];
                float btl = 0.f, ktl = 0.f, atl = 0.f, rtl = 0.f;
#pragma unroll
                for (int t = 0; t < 16; ++t) {
                    const float r_c = QF(rrq, t), k_c = QF(krq, t);
                    const float rs = r_c + c_mur * (rprev - r_c), ks = k_c + c_muk * (kprev - k_c); rprev = r_c; kprev = k_c;
                    const float al = QF(aaq, t), kmod = ks * (1.0f + (al - 1.0f) * c_ka), kkv = ks * c_kk;
                    const float sq = kkv * kkv, pb = rs * kmod * c_rk;
                    const float gprev = gcarry; lg -= QF(eeq, t);
                    const float gcur = __expf(lg), ginv = __builtin_amdgcn_rcpf(gcur); gcarry = gcur;
                    const float at = -kkv * gprev, rt = rs * gcur, bt = kkv * al * ginv, kt = kmod * ginv;
                    if (t & 1) {
                        sqp[(t >> 1) & 3] = pk_bf16(sql, sq); pbp[(t >> 1) & 3] = pk_bf16(pbl, pb);
                        atp[(t >> 1) & 3] = pk_bf16(atl, at); rtp[(t >> 1) & 3] = pk_bf16(rtl, rt); bkp[t >> 1] = pk_bf16(btl, bt); bkp[8 + (t >> 1)] = pk_bf16(ktl, kt);
                        if ((t & 7) == 7) {
                            *(LAS u32x4*)(scr + lane * 32 + (t >> 3) * 16) = (u32x4){sqp[0], sqp[1], sqp[2], sqp[3]}; *(LAS u32x4*)(scr + 2048 + lane * 32 + (t >> 3) * 16) = (u32x4){pbp[0], pbp[1], pbp[2], pbp[3]};
                            *(LAS u32x4*)(cb + C2_AT + lane * 32 + (t >> 3) * 16) = (u32x4){atp[0], atp[1], atp[2], atp[3]}; *(LAS u32x4*)(cb + C2_RT + lane * 32 + (t >> 3) * 16) = (u32x4){rtp[0], rtp[1], rtp[2], rtp[3]}; }
                    } else { sql = sq; pbl = pb; btl = bt; ktl = kt; atl = at; rtl = rt; }
                }
                *(LAS float*)(cb + C2_GTV + lane * 4) = __expf(lg);
#pragma unroll
                for (int q = 0; q < 4; ++q) *(LAS u32x4*)(cb + C2_BK + lane * 64 + q * 16) = (u32x4){bkp[2 * q], bkp[2 * q + 1], bkp[8 + 2 * q], bkp[8 + 2 * q + 1]};
#pragma unroll
                for (int q = 0; q < 2; ++q) *(LAS u32x4*)(cb + C2_VT + lane * 32 + q * 16) = (u32x4){vvp[4 * q], vvp[4 * q + 1], vvp[4 * q + 2], vvp[4 * q + 3]};
                asm volatile("s_waitcnt lgkmcnt(0)" ::: "memory");
                f32x4 invr; float invf;
                {
                    f32x4 sn = (f32x4){0.f, 0.f, 0.f, 0.f}, sb = sn;
                    const bf16x8 ones = __builtin_bit_cast(bf16x8, (u32x4){0x3f803f80u, 0x3f803f80u, 0x3f803f80u, 0x3f803f80u});
#pragma unroll
                    for (int s2 = 0; s2 < 2; ++s2) { const int k0 = 32 * s2 + 8 * fq;
                        sn = __builtin_amdgcn_mfma_f32_16x16x32_bf16(mk_frag(tr4(scr, k0, lane), tr4(scr, k0 + 4, lane)), ones, sn, 0, 0, 0);
                        sb = __builtin_amdgcn_mfma_f32_16x16x32_bf16(mk_frag(tr4(scr + 2048, k0, lane), tr4(scr + 2048, k0 + 4, lane)), ones, sb, 0, 0, 0); }
#pragma unroll
                    for (int r = 0; r < 4; ++r) invr[r] = __builtin_amdgcn_rsqf(fmaxf(sn[r], 1e-24f));
                    if (fr == 0) { *(LAS f32x4*)(cb + C2_BON + fq * 16) = sb; *(LAS f32x4*)(cb + C2_BON + 128 + fq * 16) = invr; }
                    asm volatile("s_waitcnt lgkmcnt(0)" ::: "memory");
                    invf = *(const LAS float*)(cb + C2_BON + 128 + fr * 4);
                }
                f32x4 nab = (f32x4){0.f, 0.f, 0.f, 0.f}, nabT = nab, nakT = nab, nrbT = nab, nrkT = nab;
#pragma unroll
                for (int s2 = 0; s2 < 2; ++s2) {
                    const int k0 = 32 * s2 + 8 * fq;
                    const bf16x8 fa = mk_frag(tr4(cb + C2_AT, k0, lane), tr4(cb + C2_AT, k0 + 4, lane)), fr_ = mk_frag(tr4(cb + C2_RT, k0, lane), tr4(cb + C2_RT, k0 + 4, lane));
                    const bf16x8 fb = mk_frag(tr4bk(cb + C2_BK, k0, lane), tr4bk(cb + C2_BK, k0 + 4, lane)), fk = mk_frag(tr4bk(cb + C2_BK + 8, k0, lane), tr4bk(cb + C2_BK + 8, k0 + 4, lane));
                    nab = __builtin_amdgcn_mfma_f32_16x16x32_bf16(fa, fb, nab, 0, 0, 0); nabT = __builtin_amdgcn_mfma_f32_16x16x32_bf16(fb, fa, nabT, 0, 0, 0);
                    nakT = __builtin_amdgcn_mfma_f32_16x16x32_bf16(fk, fa, nakT, 0, 0, 0);
                    nrbT = __builtin_amdgcn_mfma_f32_16x16x32_bf16(fb, fr_, nrbT, 0, 0, 0); nrkT = __builtin_amdgcn_mfma_f32_16x16x32_bf16(fk, fr_, nrkT, 0, 0, 0);
                }
                const u32x2 z2 = (u32x2){0u, 0u};
                f32x4 dg;
#pragma unroll
                for (int r = 0; r < 4; ++r) {
                    const int c = 4 * fq + r;
                    dg[r] = (c == fr) ? 1.f : 0.f;
                    nakT[r] = (c < fr) ? nakT[r] : 0.f; nabT[r] = (c < fr) ? nabT[r] : 0.f; nab[r] = (fr < c) ? nab[r] : 0.f;
                    nrbT[r] = (c <= fr) ? nrbT[r] : 0.f; nrkT[r] = (c <= fr) ? nrkT[r] : 0.f;
                }
                {
                    const f32x4 f2 = invr * invf;
                    nab = nab * f2; nabT = nabT * f2; nakT = nakT * invf;
                }
                *(LAS u32x2*)(cb + C2_NAK + fr * 32 + fq * 8) = pk4(nakT);
                { const u32x2 wb = pk4(nrbT), wk = pk4(nrkT); *(LAS u32x4*)(cb + C2_NRBK + fr * 64 + fq * 16) = (u32x4){wb.x, wb.y, wk.x, wk.y}; }
#define FRG(X) mk_frag(pk4(X), z2)
#define MM(X, Y) __builtin_amdgcn_mfma_f32_16x16x32_bf16(FRG(X), FRG(Y), (f32x4){0.f, 0.f, 0.f, 0.f}, 0, 0, 0)
                {
                    const f32x4 p2 = MM(nabT, nab), q2 = MM(nab, nabT);
                    const f32x4 p4 = MM(q2, p2), q4 = MM(p2, q2);
                    const f32x4 p8 = MM(q4, p4);
                    const f32x4 m1 = MM(nabT + dg, p2 + dg);
                    const f32x4 m2t = MM(p8 + dg, q4 + dg);
                    const f32x4 mt = MM(m1, m2t);
                    *(LAS u32x2*)(cb + C2_MT + fr * 32 + fq * 8) = pk4(mt);
                }
#undef FRG
#undef MM
                asm volatile("" ::: "memory");
                if (lane == 0) *(volatile LAS unsigned*)(lds + C2_PREV + 32 + wave * 4) = (unsigned)(g + 1);
            }
            if (wave < 4) {
                const int vrow = 16 * wave + fr;
                const u32x2 z2 = (u32x2){0u, 0u};
#define CH_DECL(P) u32x2 P##nak, P##mt, P##vq; bf16x8 P##fa0, P##fa1, P##fr0, P##fr1, P##nrbk, P##bk0, P##bk1, P##bk2, P##bk3; f32x4 P##g0, P##g1, P##g2, P##g3;
#define CH_LOAD(P, c_) do { const LAS unsigned char* cb = lds + (c_) * C2_CH; \
                    while (*(volatile LAS unsigned*)(lds + C2_PREV + 32 + (c_) * 4) < (unsigned)(g + 1)) __builtin_amdgcn_s_sleep(1); \
                    asm volatile("" ::: "memory"); \
                    P##vq = *(const LAS u32x2*)(cb + C2_VT + vrow * 32 + fq * 8); P##nak = *(const LAS u32x2*)(cb + C2_NAK + fr * 32 + fq * 8); P##mt = *(const LAS u32x2*)(cb + C2_MT + fr * 32 + fq * 8); \
                    P##fa0 = mk_frag(tr4(cb + C2_AT, 4 * fq, lane), tr4(cb + C2_AT, 16 + 4 * fq, lane)); P##fa1 = mk_frag(tr4(cb + C2_AT, 32 + 4 * fq, lane), tr4(cb + C2_AT, 48 + 4 * fq, lane)); \
                    P##fr0 = mk_frag(tr4(cb + C2_RT, 4 * fq, lane), tr4(cb + C2_RT, 16 + 4 * fq, lane)); P##fr1 = mk_frag(tr4(cb + C2_RT, 32 + 4 * fq, lane), tr4(cb + C2_RT, 48 + 4 * fq, lane)); \
                    P##nrbk = *(const LAS bf16x8*)(cb + C2_NRBK + fr * 64 + fq * 16); \
                    P##bk0 = *(const LAS bf16x8*)(cb + C2_BK + (fr) * 64 + fq * 16); P##bk1 = *(const LAS bf16x8*)(cb + C2_BK + (16 + fr) * 64 + fq * 16); \
                    P##bk2 = *(const LAS bf16x8*)(cb + C2_BK + (32 + fr) * 64 + fq * 16); P##bk3 = *(const LAS bf16x8*)(cb + C2_BK + (48 + fr) * 64 + fq * 16); \
                    P##g0 = *(const LAS f32x4*)(cb + C2_GTV + (4 * fq) * 4); P##g1 = *(const LAS f32x4*)(cb + C2_GTV + (16 + 4 * fq) * 4); \
                    P##g2 = *(const LAS f32x4*)(cb + C2_GTV + (32 + 4 * fq) * 4); P##g3 = *(const LAS f32x4*)(cb + C2_GTV + (48 + 4 * fq) * 4); } while (0)
#define CH_STEP(P, c_) do { \
                    const bf16x8 bs0 = mk_frag(pk4(St[0]), pk4(St[1])), bs1 = mk_frag(pk4(St[2]), pk4(St[3]));     \
                    const f32x4 iv_ = *(const LAS f32x4*)(lds + (c_) * C2_CH + C2_BON + 128 + fq * 16);     \
                    f32x4 acc = (f32x4){0.f, 0.f, 0.f, 0.f}, y = acc, u = acc, accs = acc; \
                    acc = __builtin_amdgcn_mfma_f32_16x16x32_bf16(mk_frag(P##nak, z2), mk_frag(P##vq, z2), acc, 0, 0, 0); \
                    accs = __builtin_amdgcn_mfma_f32_16x16x32_bf16(P##fa0, bs0, accs, 0, 0, 0); \
                    accs = __builtin_amdgcn_mfma_f32_16x16x32_bf16(P##fa1, bs1, accs, 0, 0, 0); \
                    acc = acc + accs * iv_;                                                  \
                    y = __builtin_amdgcn_mfma_f32_16x16x32_bf16(P##fr0, bs0, y, 0, 0, 0); \
                    y = __builtin_amdgcn_mfma_f32_16x16x32_bf16(P##fr1, bs1, y, 0, 0, 0); \
                    u = __builtin_amdgcn_mfma_f32_16x16x32_bf16(mk_frag(P##mt, z2), mk_frag(pk4(acc), z2), u, 0, 0, 0); \
                    u = u * iv_;                                                              \
                    const bf16x8 buv = mk_frag(pk4(u), P##vq); \
                    St[0] = __builtin_amdgcn_mfma_f32_16x16x32_bf16(P##bk0, buv, St[0], 0, 0, 0); St[1] = __builtin_amdgcn_mfma_f32_16x16x32_bf16(P##bk1, buv, St[1], 0, 0, 0); \
                    St[2] = __builtin_amdgcn_mfma_f32_16x16x32_bf16(P##bk2, buv, St[2], 0, 0, 0); St[3] = __builtin_amdgcn_mfma_f32_16x16x32_bf16(P##bk3, buv, St[3], 0, 0, 0); \
                    y = __builtin_amdgcn_mfma_f32_16x16x32_bf16(P##nrbk, buv, y, 0, 0, 0); \
                    St[0] = St[0] * P##g0; St[1] = St[1] * P##g1; St[2] = St[2] * P##g2; St[3] = St[3] * P##g3; \
                    _Pragma("unroll") for (int r = 0; r < 4; ++r) *(LAS float*)(lds + C2_YS + (size_t)(((c_) * 16 + 4 * fq + r) * 64 + vrow) * 4) = y[r]; \
                    if (lane == 0) asm volatile("ds_add_u32 %0, %1" :: "v"((unsigned)(size_t)(lds + C2_PREV + (c_) * 4)), "v"(1u) : "memory");     } while (0)
                CH_DECL(A) CH_DECL(B)
                CH_LOAD(A, 0);
                for (int c = 0; c < 8; c += 2) {
                    CH_LOAD(B, c + 1);
                    CH_STEP(A, c);
                    if (c + 2 < 8) CH_LOAD(A, c + 2);
                    CH_STEP(B, c + 1);
                }
#undef CH_DECL
#undef CH_LOAD
#undef CH_STEP
            } else {
                int lane_p = lane; asm volatile("" : "+v"(lane_p));
                const int pj = lane_p & 3;
                f32x4 lw[4], lb[4];
#pragma unroll
                for (int i = 0; i < 4; ++i) { lw[i] = *(const LAS f32x4*)(lds + C2_V2S + 8192 + (16 * pj + 4 * i) * 4); lb[i] = *(const LAS f32x4*)(lds + C2_V2S + 8192 + 256 + (16 * pj + 4 * i) * 4); }
                for (int cc = wave - 4; cc < 8; cc += 4) {
                    const LAS unsigned char* cb = lds + cc * C2_CH;
                    const int tl = lane_p >> 2, ptok = cc * 16 + tl;
                    while (*(volatile LAS unsigned*)(lds + C2_PREV + cc * 4) < 4u * (unsigned)(g + 1)) __builtin_amdgcn_s_sleep(1);
                    asm volatile("" ::: "memory");
                    f32x4 y4[4]; float sm = 0.f;
#pragma unroll
                    for (int i = 0; i < 4; ++i) { y4[i] = *(const volatile LAS f32x4*)(lds + C2_YS + (size_t)(ptok * 64 + 16 * pj + 4 * i) * 4); sm += (y4[i][0] + y4[i][1]) + (y4[i][2] + y4[i][3]); }
                    sm += dppf<0xB1>(sm); sm += dppf<0x4E>(sm);
                    const float mean = sm * (1.0f / 64.0f); float vs = 0.f;
#pragma unroll
                    for (int i = 0; i < 4; ++i) { y4[i] = y4[i] - mean; vs += (y4[i][0] * y4[i][0] + y4[i][1] * y4[i][1]) + (y4[i][2] * y4[i][2] + y4[i][3] * y4[i][3]); }
                    vs += dppf<0xB1>(vs); vs += dppf<0x4E>(vs);
                    const float rstd = __builtin_amdgcn_rsqf(vs * (1.0f / 64.0f) + LNX_EPS);
                    const float bon = *(const LAS float*)(cb + C2_BON + tl * 4);
                    unsigned ow[8];
#pragma unroll
                    for (int i = 0; i < 4; ++i) {
                        float z[4];
#pragma unroll
                        for (int e = 0; e < 4; ++e) { const float vvl = bf1(*(const LAS unsigned short*)(cb + C2_VT + (16 * pj + 4 * i + e) * 32 + tl * 2)); z[e] = y4[i][e] * rstd * lw[i][e] + lb[i][e] + bon * vvl; }
                        ow[2 * i] = pk_bf16(z[0], z[1]); ow[2 * i + 1] = pk_bf16(z[2], z[3]);
                    }
                    bf16_t* zp = F.S2 + (mrow0 + (size_t)g * 128 + ptok) * D + h * 64 + 16 * pj;
                    *(u32x4*)zp = (u32x4){ow[0], ow[1], ow[2], ow[3]}; *(u32x4*)(zp + 8) = (u32x4){ow[4], ow[5], ow[6], ow[7]};
                    asm volatile("s_waitcnt lgkmcnt(0)" ::: "memory");
                    if (lane_p == 0) *(volatile LAS unsigned*)(lds + C2_PREV + 64 + cc * 4) = (unsigned)(g + 1);
                }
            }
        }
        __syncthreads();
    }
}

constexpr int LDS_BYTES = 163840;
constexpr int LDSCTL_OFF = 163776;
constexpr int PPL = 15;
constexpr int NPHASE = NLAYER * PPL + 1;

template <int PH> __device__ __forceinline__ void run_phase(Frame& F, int L) {
    using namespace pg8;
    { int l_ = lane_now(); asm volatile("" : "+v"(l_)); F.lane = l_; F.tid = F.wave * 64 + l_;
      int g_ = gridDim.x, b_ = blockIdx.x; asm volatile("" : "+s"(g_), "+s"(b_)); F.G = g_; F.bid = b_;
      ArgsP a_ = (ArgsP)__builtin_amdgcn_kernarg_segment_ptr(); asm volatile("" : "+s"(a_)); F.ap = a_; F.X = a_->out; set_ws(F, a_->ws); }
    if constexpr (PH == 0) {
        convert_weights(F, L);
        if (L == 0) rmsnorm_rows(F, F.ap->in[0], F.ap->in[1], F.S1, (bf16_t*)F.X);
        else rmsnorm_rows_bf(F, (const bf16_t*)F.X, F.ap->in[1] + (size_t)L * D, F.S1);
    } else if constexpr (PH == 1) {
        Gemm g{F.WinT + (size_t)R_RKV * D, F.S1, D, D, D, RAWLD / 256, M / 256, 0}; StaticOrder S; S.init(g.nM, g.nN, F.G, F.bid);
        EpiRawT E{F.RAW, RAWLDB, F.ap->in[6] + (size_t)L * 3200 + 3072};
        gemm_phase(F.lds, g, S, E, F.wave);
        { const int rem = (g.nM * g.nN) % F.G;
          if (rem == 0) convert_weights_late(F, L);
          else if (F.bid >= rem) { F.G -= rem; F.bid -= rem; convert_weights_late(F, L); } }
    } else if constexpr (PH == 2) {
    } else if constexpr (PH == 3) {
    } else if constexpr (PH == 4) {
        scan2_phase(F, L);
    } else if constexpr (PH == 5) {
    } else if constexpr (PH == 6) {
        Gemm g{F.S1, F.WinT, D, D, D, M / 256, 20, 0}; StaticOrder S; S.init(g.nM, g.nN, F.G, F.bid);
        EpiG<ACT_NONE, ACT_SILU, ACT_SILU, ACT_SIGMOID, ACT_SIGMOID> E{{F.RAW, D, nullptr, nullptr, nullptr, 0, nullptr, 0}, {F.RAWB, D, nullptr, nullptr, nullptr, 0, nullptr, 0}, 1024, {F.S2, D, nullptr, nullptr, F.S2, D, nullptr, 0}, 2048,
            {F.S3, D, nullptr, nullptr, nullptr, 0, nullptr, 0}, 3072, {F.RAW + (size_t)2 * M * D, D, nullptr, nullptr, nullptr, 0, nullptr, 0}, 4096};
        gemm_phase(F.lds, g, S, E, F.wave);
    } else if constexpr (PH == 7) {
        Gemm g{F.S2, F.WrpT, D, D, D, M / 256, 4, 0}; StaticOrder S; S.init(g.nM, g.nN, F.G, F.bid);
        EpiG<ACT_NONE, ACT_NONE> E{{F.S3, D, nullptr, nullptr, F.S3, D, nullptr, 0}, {}, 1 << 30};
        gemm_phase(F.lds, g, S, E, F.wave);
    } else if constexpr (PH == 8) {
        Gemm g{F.S2, F.WrpT, D, D, D, M / 256, 4, 0, F.RAWB, F.WppT}; StaticOrder S; S.init(g.nM, g.nN, F.G, F.bid);
        EpiMerge E{F.RAW, D, F.S3, F.RAW + (size_t)2 * M * D, D};
        gemm_phase<EpiMerge, true, true, true>(F.lds, g, S, E, F.wave);
    } else if constexpr (PH == 9) {
    } else if constexpr (PH == 10) {
        poold_phase(F, F.RAW, F.RAWB, F.ap->in[4] + (size_t)L * D);
    } else if constexpr (PH == 11) {
    } else if constexpr (PH == 12) {
        Gemm g{F.RAWB, F.WppT, D, D, D, M / 256, 4, 0}; StaticOrder S; S.init(g.nM, g.nN, F.G, F.bid);
        EpiG<ACT_NONE, ACT_NONE> E{{F.RAW, D, nullptr, nullptr, F.RAW + (size_t)2 * M * D, D, F.S3, D}, {}, 1 << 30};
        gemm_phase(F.lds, g, S, E, F.wave);
    } else if constexpr (PH == 13) {
    } else if constexpr (PH == 14) {
        Gemm g{F.RAW, F.WoutT, D, D, D, M / 256, 4, 0}; StaticOrder S; S.init(g.nM, g.nN, F.G, F.bid);
        EpiG<ACT_NONE, ACT_NONE> E{{L == NLAYER - 1 ? F.S2 : (bf16_t*)F.X, D, nullptr, nullptr, nullptr, 0, (const bf16_t*)F.X, D}, {}, 1 << 30};
        gemm_phase(F.lds, g, S, E, F.wave);
    } else {
        final_norm(F, F.S2);
    }
}
__device__ __forceinline__ void frame_init(Frame& F, unsigned char* lds_raw) {
    F.lds = (LAS unsigned char*)lds_raw;
    F.tid = threadIdx.x; F.lane = F.tid & 63; F.wave = __builtin_amdgcn_readfirstlane(F.tid >> 6); F.G = gridDim.x; F.bid = blockIdx.x;
    F.ap = (ArgsP)__builtin_amdgcn_kernarg_segment_ptr();
    F.X = F.ap->out;
    set_ws(F, F.ap->ws);
}
#ifndef PROBE_STAGE
#define PROBE_STAGE -1
#endif
#if MK_PER_PHASE
__global__ void __launch_bounds__(512, 2) mk_dump(Args args, size_t ws_off, int ld, int rowmask) {
    const bf16_t* src = (const bf16_t*)(args.ws + ws_off);
    for (size_t it = (size_t)blockIdx.x * 512 + threadIdx.x; it < (size_t)M * 512; it += (size_t)gridDim.x * 512) {
        const size_t m = it >> 9; const int c = (int)(it & 511) * 2; const unsigned w = *(const unsigned*)(src + (m & (size_t)rowmask) * ld + (ld == 256 ? (c & 255) : c));
        args.out[m * D + c] = 1000.f * bf_lo(w); args.out[m * D + c + 1] = 1000.f * bf_hi(w);
    }
}
template <int PH> __global__ void __launch_bounds__(512, 2) mk_phase(Args args) {
    extern __shared__ __attribute__((aligned(16))) unsigned char lds_raw[];
    Frame F; frame_init(F, lds_raw);
    run_phase<PH>(F, F.ap->ph_lo);
}
#else
__global__ void __launch_bounds__(512, 2) mk_fwd(Args args) {
    extern __shared__ __attribute__((aligned(16))) unsigned char lds_raw[];
    Frame F; frame_init(F, lds_raw);
    volatile LAS unsigned* ctlw = (volatile LAS unsigned*)(F.lds + LDSCTL_OFF);
    if (F.tid < 16) ctlw[F.tid] = 0u;
    __syncthreads();
    XcdBarrier bar = xcd_barrier_post((unsigned*)(F.ws + WS_CTL), ctlw);
    for (int L = 0; L < NLAYER; ++L) {
        run_phase<0>(F, L); xcd_barrier(bar);
        run_phase<1>(F, L); xcd_barrier(bar);
        run_phase<4>(F, L); xcd_barrier(bar);
        run_phase<6>(F, L); xcd_barrier(bar);
        run_phase<10>(F, L); xcd_barrier(bar);
        run_phase<8>(F, L); xcd_barrier(bar);
        run_phase<14>(F, L); xcd_barrier(bar);
    }
    run_phase<15>(F, 0);
}
#endif

#if MK_PER_PHASE
template <int PH> static void launch_phase(int grid, hipStream_t stream, Args a, int L) { if (PH == 2 || PH == 3 || PH == 5 || PH == 11) return; a.ph_lo = L; a.ph_hi = PH; hipLaunchKernelGGL(mk_phase<PH>, dim3(grid), dim3(512), LDS_BYTES, stream, a); }
template <int PH> static bool set_lds() { return hipFuncSetAttribute((const void*)mk_phase<PH>, hipFuncAttributeMaxDynamicSharedMemorySize, LDS_BYTES) == hipSuccess; }
#endif
extern "C" void kernel_launch(void* const* d_in, const int* in_sizes, int n_in, void* d_out, int out_size, void* d_ws, size_t ws_size, hipStream_t stream) {
    static int grid = 0;
    if (grid == 0) {
        if (n_in != 22 || in_sizes[0] != M * D || out_size != M * D || ws_size < WS_END) { fprintf(stderr, "kernel_launch: unexpected shapes / workspace (%d inputs, ws %zu)\n", n_in, ws_size); grid = -1; return; }
        int dev = 0, cus = 0;
        if (hipGetDevice(&dev) != hipSuccess || hipDeviceGetAttribute(&cus, hipDeviceAttributeMultiprocessorCount, dev) != hipSuccess) { grid = -1; return; }
#if MK_PER_PHASE
        bool ok = set_lds<0>() && set_lds<1>() && set_lds<2>() && set_lds<3>() && set_lds<4>() && set_lds<5>() && set_lds<6>() && set_lds<7>() && set_lds<8>() && set_lds<9>() && set_lds<10>() && set_lds<11>()
               && set_lds<12>() && set_lds<13>() && set_lds<14>() && set_lds<15>();
        if (!ok) { fprintf(stderr, "kernel_launch: hipFuncSetAttribute failed\n"); grid = -1; return; }
#else
        int per_cu = 0;
        if (hipFuncSetAttribute((const void*)mk_fwd, hipFuncAttributeMaxDynamicSharedMemorySize, LDS_BYTES) != hipSuccess) { fprintf(stderr, "kernel_launch: hipFuncSetAttribute failed\n"); grid = -1; return; }
        if (hipOccupancyMaxActiveBlocksPerMultiprocessor(&per_cu, (const void*)mk_fwd, 512, LDS_BYTES) != hipSuccess || per_cu < 1) { fprintf(stderr, "kernel_launch: occupancy query says %d\n", per_cu); }
#endif
        (void)hipGetLastError();
        grid = cus;
    }
    if (grid < 0) return;
    Args a{};
    for (int i = 0; i < 22; ++i) a.in[i] = (const float*)d_in[i];
    a.out = (float*)d_out; a.ws = (unsigned char*)d_ws;
#if MK_PER_PHASE
    if (PROBE_STAGE >= 0) {
        const int L = 0;
        launch_phase<0>(grid, stream, a, L); launch_phase<1>(grid, stream, a, L);
        if (PROBE_STAGE >= 2) launch_phase<2>(grid, stream, a, L);
        if (PROBE_STAGE >= 3) launch_phase<3>(grid, stream, a, L);
        if (PROBE_STAGE >= 4) launch_phase<4>(grid, stream, a, L);
        if (PROBE_STAGE >= 5) launch_phase<5>(grid, stream, a, L);
        if (PROBE_STAGE >= 6) launch_phase<6>(grid, stream, a, L);
        if (PROBE_STAGE >= 7) launch_phase<7>(grid, stream, a, L);
        if (PROBE_STAGE >= 8) launch_phase<8>(grid, stream, a, L);
        if (PROBE_STAGE >= 9) launch_phase<9>(grid, stream, a, L);
        if (PROBE_STAGE >= 10) launch_phase<10>(grid, stream, a, L);
        if (PROBE_STAGE >= 11) launch_phase<11>(grid, stream, a, L);
        if (PROBE_STAGE >= 12) launch_phase<12>(grid, stream, a, L);
        if (PROBE_STAGE >= 13) launch_phase<13>(grid, stream, a, L);
        size_t off = WS_RAW; int ld = RAWLD; int rowmask = 0x7fffffff;
        if (PROBE_STAGE == 2) { off = WS_VFIRST; ld = D; }
        if (PROBE_STAGE == 3) { off = WS_S1; ld = D; }
        if (PROBE_STAGE == 5) { off = WS_S1; ld = D; }
#if defined(PROBE_ALT) || defined(PROBE_SWAP)
        if (PROBE_STAGE == 3) { off = WS_S2; ld = D; }
        if (PROBE_STAGE == 2) { off = WS_EAT; ld = 256; rowmask = 2047; }
        if (PROBE_STAGE == 1) { off = WS_RAW + 4608; ld = RAWLD; }
#endif
        if (PROBE_STAGE == 6) { off = WS_S2; ld = D; }
        if (PROBE_STAGE == 7 || PROBE_STAGE == 8) { off = WS_S3; ld = D; }
        if (PROBE_STAGE == 9) { off = WS_S2; ld = D; }
        if (PROBE_STAGE == 10) { off = WS_RAWB; ld = D; }
        if (PROBE_STAGE == 11) { off = WS_S2; ld = D; }
        if (PROBE_STAGE == 12 || PROBE_STAGE == 13) { off = WS_RAW; ld = D; }
        hipLaunchKernelGGL(mk_dump, dim3(grid), dim3(512), 0, stream, a, off, ld, rowmask);
        return;
    }
    for (int L = 0; L < NLAYER; ++L) {
        launch_phase<0>(grid, stream, a, L); launch_phase<1>(grid, stream, a, L); launch_phase<2>(grid, stream, a, L); launch_phase<3>(grid, stream, a, L);
        launch_phase<4>(grid, stream, a, L); launch_phase<5>(grid, stream, a, L); launch_phase<6>(grid, stream, a, L); launch_phase<7>(grid, stream, a, L);
        launch_phase<8>(grid, stream, a, L); launch_phase<9>(grid, stream, a, L); launch_phase<10>(grid, stream, a, L); launch_phase<11>(grid, stream, a, L);
        launch_phase<12>(grid, stream, a, L); launch_phase<13>(grid, stream, a, L); launch_phase<14>(grid, stream, a, L);
    }
    launch_phase<15>(grid, stream, a, 0);
#else
    (void)hipMemsetAsync((char*)d_ws + WS_CTL, 0, CTL_ZERO_BYTES, stream);
    a.ph_lo = 0; a.ph_hi = 0;
    hipLaunchKernelGGL(mk_fwd, dim3(grid), dim3(512), LDS_BYTES, stream, a);
#endif
}
```
